# Optimizing an MI355X kernel written in HIP

```python
import math
import jax, jax.numpy as jnp
from jax import lax
import numpy as np

D_MODEL = 1024
BATCH = 4
SEQ = 8192
DEPTH = 4
DEC_BATCH = 32
DEC_SEQ = 2048
PAST_LEN = 128

HEAD_DIM = 64
HEADS_PER_GROUP = 4
DILATED_GROUPS = ((128, 1), (512, 4), (2048, 16))
N_GROUPS_A = 3
N_HEADS_A = N_GROUPS_A * HEADS_PER_GROUP
ATTN_WIDTH = N_HEADS_A * HEAD_DIM
ATTN_OUT = HEADS_PER_GROUP * HEAD_DIM
NUM_BUCKETS = 32
MAX_DISTANCE = 1024
SG_CHUNK = 128
SG_GROUPS = 8
SG_WIDTH = 1024
SG_GROUP_CH = SG_WIDTH // SG_GROUPS
D_FF = 2816
CONV_WIDTH = 3
IN_WIDTH = 3 * ATTN_WIDTH + 2 * SG_WIDTH + 2 * D_MODEL
EPS = 1e-6

kernel_name = "hybrid_dilated_attn_spatial_gating_encoder"


def rmsnorm(x, g):
    xf = x.astype(jnp.float32)
    y = xf * lax.rsqrt(jnp.mean(xf * xf, axis=-1, keepdims=True) + EPS)
    return (y * g.astype(jnp.float32)).astype(x.dtype)


def t5_bucket(rel):
    nb = NUM_BUCKETS // 2
    max_exact = nb // 2
    ret = np.where(rel > 0, nb, 0)
    n = np.abs(rel)
    nf = np.maximum(n, 1).astype(np.float32)
    large = max_exact + (np.log(nf / max_exact) / math.log(MAX_DISTANCE / max_exact) * (nb - max_exact)).astype(np.int32)
    large = np.minimum(large, nb - 1)
    return (ret + np.where(n < max_exact, n, large)).astype(np.int32)


def dilated_window_attn(q, k, v, bias_tab, dil, half):
    B, S, H, Dh = q.shape
    L = S // dil
    qb_size = half
    nblk = -(-L // qb_size)
    Lp = nblk * qb_size

    def to_sub(t):
        t = t.reshape(B, L, dil, H, Dh).transpose(0, 2, 1, 3, 4)
        return jnp.pad(t, ((0, 0), (0, 0), (0, Lp - L), (0, 0), (0, 0)))

    def neighbourhood(t):
        t = jnp.pad(t, ((0, 0), (0, 0), (qb_size, qb_size), (0, 0), (0, 0)))
        t = t.reshape(B, dil, nblk + 2, qb_size, H, Dh)
        return jnp.concatenate([t[:, :, :-2], t[:, :, 1:-1], t[:, :, 2:]], axis=3)

    qs = to_sub(q).reshape(B, dil, nblk, qb_size, H, Dh)
    kw = neighbourhood(to_sub(k))
    vw = neighbourhood(to_sub(v))

    p_idx = np.arange(qb_size)[:, None]
    c_idx = np.arange(3 * qb_size)[None, :]
    rel_sub = c_idx - qb_size - p_idx
    band = np.abs(rel_sub) <= half
    key_pos = (np.arange(nblk)[:, None] - 1) * qb_size + np.arange(3 * qb_size)[None, :]
    kvalid = (key_pos >= 0) & (key_pos < L)
    mask = jnp.asarray(band[None] & kvalid[:, None, :])
    bucket = jnp.asarray(t5_bucket(rel_sub * dil))
    bias = jnp.transpose(bias_tab.astype(jnp.float32)[bucket], (2, 0, 1))

    scale = Dh ** -0.5
    s = jnp.einsum('bgnqhd,bgnkhd->bgnhqk', qs.astype(jnp.float32), kw.astype(jnp.float32)) * scale + bias
    s = jnp.where(mask[None, None, :, None], s, -1e30)
    m = jnp.max(s, axis=-1, keepdims=True)
    p = jnp.exp(s - m)
    denom = jnp.sum(p, axis=-1, keepdims=True)
    o = jnp.einsum('bgnhqk,bgnkhd->bgnqhd', p / denom, vw.astype(jnp.float32))
    lse = jnp.transpose((m + jnp.log(denom))[..., 0], (0, 1, 2, 4, 3))

    def from_sub(t):
        rest = t.shape[4:]
        t = t.reshape((B, dil, Lp) + rest)[:, :, :L]
        t = jnp.moveaxis(t, 1, 2)
        return t.reshape((B, S) + rest)

    return from_sub(o), from_sub(lse)


def spatial_gating(u, v, v_gain, w_s, b_s):
    B, S, C = v.shape
    vn = rmsnorm(v, v_gain).reshape(B, S // SG_CHUNK, SG_CHUNK, SG_GROUPS, SG_GROUP_CH)
    z = jnp.einsum('gpq,bnqgc->bnpgc', w_s, vn) + b_s.T[:, :, None]
    return u * z.reshape(B, S, C)


def token_mixer(h, rel_bias, w_in, v_gain, w_s, b_s, w_proj_a, w_proj_b, w_out):
    B, S, _ = h.shape
    proj = jnp.einsum('bsd,de->bse', h, w_in)
    splits = [ATTN_WIDTH, 2 * ATTN_WIDTH, 3 * ATTN_WIDTH, 3 * ATTN_WIDTH + 2 * SG_WIDTH]
    q, k, v, uv, gates = jnp.split(proj, splits, axis=-1)
    shp = (B, S, N_GROUPS_A, HEADS_PER_GROUP, HEAD_DIM)
    q, k, v = q.reshape(shp), k.reshape(shp), v.reshape(shp)

    outs, lses = [], []
    for g, (win, dil) in enumerate(DILATED_GROUPS):
        o_g, l_g = dilated_window_attn(q[:, :, g], k[:, :, g], v[:, :, g],
                                       rel_bias[:, g * HEADS_PER_GROUP:(g + 1) * HEADS_PER_GROUP],
                                       dil, win // (2 * dil))
        outs.append(o_g)
        lses.append(l_g)
    wts = jax.nn.softmax(jnp.stack(lses, axis=0), axis=0)
    o_a = jnp.sum(wts[..., None] * jnp.stack(outs, axis=0), axis=0)
    y_a = jnp.einsum('bse,ed->bsd', o_a.reshape(B, S, ATTN_OUT).astype(h.dtype), w_proj_a)

    uv = jax.nn.gelu(uv)
    u, vv = jnp.split(uv, 2, axis=-1)
    y_b = jnp.einsum('bse,ed->bsd', spatial_gating(u, vv, v_gain, w_s, b_s), w_proj_b)

    g_a, g_b = jnp.split(gates, 2, axis=-1)
    merged = jax.nn.sigmoid(g_a) * y_a + jax.nn.sigmoid(g_b) * y_b
    return jnp.einsum('bsd,de->bse', merged, w_out)


def conv_ffn(h, w_up, conv_w, conv_b, w_down):
    a = jnp.einsum('bsd,df->bsf', h, w_up)
    ap = jnp.pad(a, ((0, 0), (1, 1), (0, 0)))
    a = ap[:, :-2] * conv_w[0] + ap[:, 1:-1] * conv_w[1] + ap[:, 2:] * conv_w[2] + conv_b
    gate, val = jnp.split(a, 2, axis=-1)
    return jnp.einsum('bsf,fd->bsd', jax.nn.gelu(gate) * val, w_down)


def trunk(x, rel_bias, norm_mix, w_in, v_gain, w_s, b_s, w_proj_a, w_proj_b, w_out,
          norm_ffn, w_up, conv_w, conv_b, w_down, norm_final):
    for l in range(DEPTH):
        x = x + token_mixer(rmsnorm(x, norm_mix[l]), rel_bias, w_in[l], v_gain[l], w_s[l], b_s[l],
                            w_proj_a[l], w_proj_b[l], w_out[l])
        x = x + conv_ffn(rmsnorm(x, norm_ffn[l]), w_up[l], conv_w[l], conv_b[l], w_down[l])
    return rmsnorm(x, norm_final)


def setup_inputs(seed: int = 0) -> dict:
    key = jax.random.key(seed)
    ks = jax.random.split(key, 20)
    f32 = jnp.float32
    res_scale = (2.0 * DEPTH) ** -0.5
    nrm = lambda k, shp, s: jax.random.normal(k, shp, f32) * s
    return {
        "x_prompt": nrm(ks[0], (BATCH, SEQ, D_MODEL), 1.0),
        "x_sample": nrm(ks[1], (DEC_BATCH, DEC_SEQ, D_MODEL), 1.0),
        "rel_bias": nrm(ks[2], (NUM_BUCKETS, N_HEADS_A), 0.5),
        "norm_mix": 1.0 + nrm(ks[3], (DEPTH, D_MODEL), 0.02),
        "w_in": nrm(ks[4], (DEPTH, D_MODEL, IN_WIDTH), D_MODEL ** -0.5),
        "v_gain": 1.0 + nrm(ks[5], (DEPTH, SG_WIDTH), 0.02),
        "w_s": nrm(ks[6], (DEPTH, SG_GROUPS, SG_CHUNK, SG_CHUNK), SG_CHUNK ** -0.5),
        "b_s": 1.0 + nrm(ks[7], (DEPTH, SG_GROUPS, SG_CHUNK), 0.02),
        "w_proj_a": nrm(ks[8], (DEPTH, ATTN_OUT, D_MODEL), ATTN_OUT ** -0.5),
        "w_proj_b": nrm(ks[9], (DEPTH, SG_WIDTH, D_MODEL), SG_WIDTH ** -0.5),
        "w_out": nrm(ks[10], (DEPTH, D_MODEL, D_MODEL), D_MODEL ** -0.5 * res_scale),
        "norm_ffn": 1.0 + nrm(ks[11], (DEPTH, D_MODEL), 0.02),
        "w_up": nrm(ks[12], (DEPTH, D_MODEL, 2 * D_FF), D_MODEL ** -0.5),
        "conv_w": nrm(ks[13], (DEPTH, CONV_WIDTH, 2 * D_FF), CONV_WIDTH ** -0.5),
        "conv_b": nrm(ks[14], (DEPTH, 2 * D_FF), 0.02),
        "w_down": nrm(ks[15], (DEPTH, D_FF, D_MODEL), D_FF ** -0.5 * res_scale),
        "norm_final": 1.0 + nrm(ks[16], (D_MODEL,), 0.02),
    }


def reference(x_prompt, x_sample, rel_bias, norm_mix, w_in, v_gain, w_s, b_s, w_proj_a, w_proj_b,
              w_out, norm_ffn, w_up, conv_w, conv_b, w_down, norm_final):
    y_prompt = trunk(x_prompt, rel_bias, norm_mix, w_in, v_gain, w_s, b_s, w_proj_a, w_proj_b, w_out,
                     norm_ffn, w_up, conv_w, conv_b, w_down, norm_final)
    y_sample = trunk(x_sample, rel_bias, norm_mix, w_in, v_gain, w_s, b_s, w_proj_a, w_proj_b, w_out,
                     norm_ffn, w_up, conv_w, conv_b, w_down, norm_final)
    return (y_prompt, y_sample)
```

```cpp
#include <hip/hip_runtime.h>
#include <hip/hip_cooperative_groups.h>
#include <cstdio>
#include <cstdint>
namespace cg = cooperative_groups;

#ifndef ONE_LAUNCH
#define ONE_LAUNCH 1
#endif

namespace pg8 {
#define PG8_LAS __attribute__((address_space(3)))
typedef unsigned short bf16_t;
typedef short bf16x8 __attribute__((ext_vector_type(8)));
typedef float f32x4 __attribute__((ext_vector_type(4)));
typedef unsigned u32x4 __attribute__((ext_vector_type(4)));
constexpr int BM = 256, BK = 64, HALF = 128, HTB = HALF * BK * 2  , STAGE_BYTES = 8 * HTB, NXCD = 8, WGM = 8;

__host__ __device__ __forceinline__ int lds_byte(int r, int c) { const int st = (r >> 4) * 2 + (c >> 5), rr = r & 15, cc = c & 31, ob = rr * 64 + cc * 2; return st * 1024 + (ob ^ (((ob >> 9) & 1) << 5)); }
__host__ __device__ __forceinline__ void stage_rc(int b, int& R, int& C) { const int st = b / 1024, sb = b % 1024, swz = sb ^ (((sb >> 9) & 1) << 5); R = (st >> 1) * 16 + swz / 64; C = (st & 1) * 32 + (swz % 64) / 2; }
__host__ __device__ __forceinline__ int perm32(int rho) { const int n = rho >> 4, i = rho & 15; return 8 * (i >> 2) + 4 * n + (i & 3); }

struct Unit { int pm, pn; };
struct Gemm { const bf16_t* A; const bf16_t* Bt; int M, N, K; };

struct StaticOrder {
    int nM, nN, nwg, G, c;
    __host__ __device__ void init(int M, int N, int G_, int c_) { nM = M / BM; nN = N / BM; nwg = nM * nN; G = G_; c = c_; }
    __host__ __device__ bool next(int i, Unit& u) const {
        const long L = (long)i * G + c; if (L >= nwg) return false;
        int wgid = (int)L; { const int q = nwg / NXCD, r = nwg % NXCD, xcd = wgid % NXCD, off = wgid / NXCD; wgid = (xcd < r ? xcd * (q + 1) : r * (q + 1) + (xcd - r) * q) + off; }
        const int nig = WGM * nN, gid = wgid / nig, fm = gid * WGM, gsz = (nM - fm) < WGM ? (nM - fm) : WGM;
        u.pm = fm + ((wgid % nig) % gsz); u.pn = (wgid % nig) / gsz; return true;
    }
    __device__ __forceinline__ void a_ready(const Unit&) const {}
    __device__ __forceinline__ void done(const Unit&) const {}
};

__device__ __forceinline__ unsigned cvt_pk_bf16(float lo, float hi) { unsigned r; asm volatile("v_cvt_pk_bf16_f32 %0, %1, %2" : "=v"(r) : "v"(lo), "v"(hi)); return r; }

__device__ __forceinline__ float fast_sigmoid(float x) { return __builtin_amdgcn_rcpf(1.0f + __builtin_amdgcn_exp2f(-1.4426950408889634f * x)); }
__device__ __forceinline__ float gelu_tanh(float x) {
    const float y = x * (1.0f + 0.044715f * x * x) * (2.0f * 0.7978845608028654f);
    return x * __builtin_amdgcn_rcpf(1.0f + __builtin_amdgcn_exp2f(-1.4426950408889634f * y));
}
__device__ __forceinline__ float bf2f(unsigned short b) { return __uint_as_float(((unsigned)b) << 16); }
__device__ __forceinline__ u32x4 pack8(const f32x4 a, const f32x4 b) { u32x4 w; w.x = cvt_pk_bf16(a[0], a[1]); w.y = cvt_pk_bf16(a[2], a[3]); w.z = cvt_pk_bf16(b[0], b[1]); w.w = cvt_pk_bf16(b[2], b[3]); return w; }
__device__ __forceinline__ void unpack8(const u32x4 w, f32x4& a, f32x4& b) {
    a[0] = __uint_as_float(w.x << 16); a[1] = __uint_as_float(w.x & 0xffff0000u); a[2] = __uint_as_float(w.y << 16); a[3] = __uint_as_float(w.y & 0xffff0000u);
    b[0] = __uint_as_float(w.z << 16); b[1] = __uint_as_float(w.z & 0xffff0000u); b[2] = __uint_as_float(w.w << 16); b[3] = __uint_as_float(w.w & 0xffff0000u);
}
__device__ __forceinline__ float row_rs(const float* ss, int row) {
    const f32x4* sp = (const f32x4*)(ss + (size_t)row * 16);
    const f32x4 s = (sp[0] + sp[1]) + (sp[2] + sp[3]);
    return rsqrtf(((s[0] + s[1]) + (s[2] + s[3])) * (1.0f / 1024.0f) + 1e-6f);
}

struct EpiIn {
    static constexpr bool PERM = true, AFTER_DRAIN = false;
    bf16_t* QKV; bf16_t* U; bf16_t* GV; bf16_t* G; const float* ss; float* ssv;
    __device__ __forceinline__ void operator()(const f32x4 (&acc)[2][2][4][2], const Unit& u, int wr, int wc, int fr, int fq) const {
        const int pn = u.pn;
#pragma unroll
        for (int ai = 0; ai < 2; ++ai)
#pragma unroll
            for (int m = 0; m < 4; ++m) {
                const int row = u.pm * BM + ai * HALF + wr * 64 + m * 16 + fr;
                const float rs = row_rs(ss, row);
                float q = 0.f;
#pragma unroll
                for (int bj = 0; bj < 2; ++bj) {
                    const int col = pn * BM + bj * HALF + wc * 32 + 8 * fq;
                    f32x4 v0 = acc[ai][bj][m][0] * rs, v1 = acc[ai][bj][m][1] * rs;
                    bf16_t* dst;
                    if (pn < 9) { if (pn < 3) { v0 = v0 * 0.125f; v1 = v1 * 0.125f; } dst = QKV + (size_t)row * 2304 + col; }
                    else if (pn < 17) {
#pragma unroll
                        for (int e = 0; e < 4; ++e) { v0[e] = gelu_tanh(v0[e]); v1[e] = gelu_tanh(v1[e]); }
                        if (pn < 13) dst = U + (size_t)row * 1024 + (col - 2304);
                        else { dst = GV + (size_t)row * 1024 + (col - 3328);
#pragma unroll
                            for (int e = 0; e < 4; ++e) q += v0[e] * v0[e] + v1[e] * v1[e]; }
                    } else {
#pragma unroll
                        for (int e = 0; e < 4; ++e) { v0[e] = fast_sigmoid(v0[e]); v1[e] = fast_sigmoid(v1[e]); }
                        dst = G + (size_t)row * 2048 + (col - 4352);
                    }
                    *(u32x4*)dst = pack8(v0, v1);
                }
                if (pn >= 13 && pn < 17) { q += __shfl_xor(q, 16); q += __shfl_xor(q, 32); if (fq == 0) ssv[(size_t)row * 16 + (pn - 13) * 4 + wc] = q; }
                asm volatile("" ::: "memory");
            }
    }
};
template <int MODE> struct EpiGate {
    static constexpr bool PERM = true, AFTER_DRAIN = false;
    bf16_t* O; const bf16_t* G; int goff;
    __device__ __forceinline__ void operator()(const f32x4 (&acc)[2][2][4][2], const Unit& u, int wr, int wc, int fr, int fq) const {
#pragma unroll
        for (int ai = 0; ai < 2; ++ai)
#pragma unroll
            for (int m = 0; m < 4; ++m) {
                const int row = u.pm * BM + ai * HALF + wr * 64 + m * 16 + fr;
#pragma unroll
                for (int bj = 0; bj < 2; ++bj) {
                    const int col = u.pn * BM + bj * HALF + wc * 32 + 8 * fq;
                    f32x4 g0, g1; unpack8(*(const u32x4*)(G + (size_t)row * 2048 + goff + col), g0, g1);
                    f32x4 v0 = acc[ai][bj][m][0] * g0, v1 = acc[ai][bj][m][1] * g1;
                    bf16_t* dst = O + (size_t)row * 1024 + col;
                    if (MODE == 1) { f32x4 p0, p1; unpack8(*(const u32x4*)dst, p0, p1); v0 = v0 + p0; v1 = v1 + p1; }
                    *(u32x4*)dst = pack8(v0, v1);
                }
                asm volatile("" ::: "memory");
            }
    }
};
struct EpiRes {
    static constexpr bool PERM = true, AFTER_DRAIN = false;
    float* X; bf16_t* XB; float* ss;
    __device__ __forceinline__ void operator()(const f32x4 (&acc)[2][2][4][2], const Unit& u, int wr, int wc, int fr, int fq) const {
#pragma unroll
        for (int ai = 0; ai < 2; ++ai)
#pragma unroll
            for (int m = 0; m < 4; ++m) {
                const int row = u.pm * BM + ai * HALF + wr * 64 + m * 16 + fr;
                float q = 0.f;
#pragma unroll
                for (int bj = 0; bj < 2; ++bj) {
                    const int col = u.pn * BM + bj * HALF + wc * 32 + 8 * fq;
                    float* xp = X + (size_t)row * 1024 + col;
                    f32x4 x0 = *(const f32x4*)xp + acc[ai][bj][m][0], x1 = *(const f32x4*)(xp + 4) + acc[ai][bj][m][1];
                    *(f32x4*)xp = x0; *(f32x4*)(xp + 4) = x1;
                    *(u32x4*)(XB + (size_t)row * 1024 + col) = pack8(x0, x1);
#pragma unroll
                    for (int e = 0; e < 4; ++e) q += x0[e] * x0[e] + x1[e] * x1[e];
                }
                q += __shfl_xor(q, 16); q += __shfl_xor(q, 32);
                if (fq == 0) ss[(size_t)row * 16 + u.pn * 4 + wc] = q;
                asm volatile("" ::: "memory");
            }
    }
};
struct EpiUp {
    static constexpr bool PERM = true, AFTER_DRAIN = false;
    bf16_t* A; const float* ss;
    __device__ __forceinline__ void operator()(const f32x4 (&acc)[2][2][4][2], const Unit& u, int wr, int wc, int fr, int fq) const {
#pragma unroll
        for (int ai = 0; ai < 2; ++ai)
#pragma unroll
            for (int m = 0; m < 4; ++m) {
                const int row = u.pm * BM + ai * HALF + wr * 64 + m * 16 + fr;
                const float rs = row_rs(ss, row);
#pragma unroll
                for (int bj = 0; bj < 2; ++bj) {
                    const int col = u.pn * BM + bj * HALF + wc * 32 + 8 * fq;
                    *(u32x4*)(A + (size_t)row * 5632 + col) = pack8(acc[ai][bj][m][0] * rs, acc[ai][bj][m][1] * rs);
                }
                asm volatile("" ::: "memory");
            }
    }
};

template <class Epi, class Sched, bool ALIGN_EPI = false, bool SP2 = false>
__device__ __forceinline__ void gemm_phase(PG8_LAS unsigned char* lds, const Gemm g, const Sched& S, const Epi& E, const int tid) {
    const int wid = __builtin_amdgcn_readfirstlane(tid >> 6), lane = tid & 63, wr = wid >> 2, wc = wid & 3, fr = lane & 15, fq = lane >> 4;
    const int K = g.K, nt = K / BK;
    unsigned voffA[2], voffB[2];
#pragma unroll
    for (int i = 0; i < 2; ++i) { int R, C; stage_rc(tid * 16 + i * 8192, R, C); const int Rb = Epi::PERM ? ((R & ~31) + perm32(R & 31)) : R;
        voffA[i] = (unsigned)(R * K + C) * 2u; voffB[i] = (unsigned)(Rb * K + C) * 2u; }
    const size_t kstep = (size_t)(BK * 2);
    const size_t hstep = (size_t)HALF * K * 2;
    const size_t tstep = 2 * hstep;
    const unsigned ldsw = (unsigned)wid * 1024u;
    const int aoff = lds_byte(wr * 64 + fr, fq * 8), boff = lds_byte(wc * 32 + fr, fq * 8);
#define PG8_SA(b, h) (((b) * 2 + (h)) * HTB)
#define PG8_SB(b, h) ((4 + (b) * 2 + (h)) * HTB)
#define PG8_STAGE(bufoff, gbase, voff) do { _Pragma("unroll") for (int _i = 0; _i < 2; ++_i) \
        __builtin_amdgcn_global_load_lds((const unsigned*)((const char*)(gbase) + (voff)[_i]), (PG8_LAS unsigned*)(lds + (bufoff) + ldsw + _i * 8192), 16, 0, 0); } while (0)
#define PG8_LDA(dst, b, h) do { _Pragma("unroll") for (int m = 0; m < 4; ++m) _Pragma("unroll") for (int k = 0; k < 2; ++k) dst[m][k] = *(const PG8_LAS bf16x8*)(lds + PG8_SA(b, h) + aoff + m * 2048 + k * 1024); } while (0)
#define PG8_LDB(dst, b, h) do { _Pragma("unroll") for (int n = 0; n < 2; ++n) _Pragma("unroll") for (int k = 0; k < 2; ++k) dst[n][k] = *(const PG8_LAS bf16x8*)(lds + PG8_SB(b, h) + boff + n * 2048 + k * 1024); } while (0)
#define PG8_MMA(ai, bj, At, Bt) do { __builtin_amdgcn_s_setprio(1); _Pragma("unroll") for (int m = 0; m < 4; ++m) _Pragma("unroll") for (int n = 0; n < 2; ++n) _Pragma("unroll") for (int k = 0; k < 2; ++k) \
        acc[ai][bj][m][n] = __builtin_amdgcn_mfma_f32_16x16x32_bf16(Bt[n][k], At[m][k], acc[ai][bj][m][n], 0, 0, 0); __builtin_amdgcn_s_setprio(0); } while (0)
#define PG8_WAIT_V(n) asm volatile("s_waitcnt vmcnt(" #n ")" ::: "memory")
#define PG8_WAIT_L(n) asm volatile("s_waitcnt lgkmcnt(" #n ")" ::: "memory")
#define PG8_BAR __builtin_amdgcn_s_barrier()
#define PG8_SCHED __builtin_amdgcn_sched_barrier(0)
    Unit cur, nxt; int ui = 0;
    if (!S.next(0, cur)) return;
    f32x4 acc[2][2][4][2];
#pragma unroll
    for (int a = 0; a < 2; ++a)
#pragma unroll
        for (int b = 0; b < 2; ++b)
#pragma unroll
            for (int m = 0; m < 4; ++m)
#pragma unroll
                for (int n = 0; n < 2; ++n) acc[a][b][m][n] = (f32x4){0.f, 0.f, 0.f, 0.f};
    bf16x8 At[4][2], B0[2][2], B1[2][2];
    const char* cA = (const char*)g.A + (size_t)cur.pm * tstep; const char* cB = (const char*)g.Bt + (size_t)cur.pn * tstep;
    S.a_ready(cur);
    if constexpr (SP2) {
        PG8_STAGE(PG8_SB(0, 0), cB, voffB); PG8_STAGE(PG8_SB(0, 1), cB + hstep, voffB); PG8_STAGE(PG8_SA(0, 0), cA, voffA); PG8_STAGE(PG8_SA(0, 1), cA + hstep, voffA);
        if (wr == 1) PG8_BAR;
        PG8_WAIT_V(2); PG8_BAR;
        PG8_STAGE(PG8_SB(1, 0), cB + kstep, voffB); PG8_STAGE(PG8_SA(1, 0), cA + kstep, voffA); PG8_STAGE(PG8_SB(1, 1), cB + hstep + kstep, voffB);
        PG8_WAIT_V(6); PG8_BAR;
    } else {
        PG8_STAGE(PG8_SB(0, 0), cB, voffB); PG8_STAGE(PG8_SA(0, 0), cA, voffA); PG8_STAGE(PG8_SB(0, 1), cB + hstep, voffB); PG8_STAGE(PG8_SA(0, 1), cA + hstep, voffA);
        if (wr == 1) PG8_BAR;
        PG8_WAIT_V(4); PG8_BAR;
        PG8_STAGE(PG8_SB(1, 0), cB + kstep, voffB); PG8_STAGE(PG8_SA(1, 0), cA + kstep, voffA); PG8_STAGE(PG8_SB(1, 1), cB + hstep + kstep, voffB);
        PG8_WAIT_V(6); PG8_BAR;
    }
    for (;;) {
        const bool has_next = S.next(ui + 1, nxt);
        const char* nA = has_next ? (const char*)g.A + (size_t)nxt.pm * tstep : cA; const char* nB = has_next ? (const char*)g.Bt + (size_t)nxt.pn * tstep : cB;
        for (int t = 0; t < nt; t += 2) {
            const bool last = (t == nt - 2);
            const char* a1 = cA + (size_t)(t + 1) * kstep;
            const char* a2 = last ? nA : cA + (size_t)(t + 2) * kstep; const char* b2 = last ? nB : cB + (size_t)(t + 2) * kstep;
            const char* a3 = a2 + kstep; const char* b3 = b2 + kstep;
            if (last && has_next) S.a_ready(nxt);
            if constexpr (SP2) {
            PG8_LDB(B0, 0, 0); PG8_LDB(B1, 0, 1); PG8_SCHED; PG8_LDA(At, 0, 0); PG8_STAGE(PG8_SA(1, 1), a1 + hstep, voffA);
            PG8_WAIT_V(8); PG8_WAIT_L(0); PG8_BAR; PG8_MMA(0, 0, At, B0); PG8_MMA(0, 1, At, B1); PG8_BAR; PG8_SCHED;
            PG8_LDA(At, 0, 1); PG8_STAGE(PG8_SB(0, 0), b2, voffB); PG8_STAGE(PG8_SB(0, 1), b2 + hstep, voffB); PG8_STAGE(PG8_SA(0, 0), a2, voffA);
            PG8_WAIT_V(8); PG8_WAIT_L(0); PG8_BAR; PG8_MMA(1, 0, At, B0); PG8_MMA(1, 1, At, B1); PG8_BAR; PG8_SCHED;
            PG8_LDB(B0, 1, 0); PG8_LDB(B1, 1, 1); PG8_SCHED; PG8_LDA(At, 1, 0); PG8_STAGE(PG8_SA(0, 1), a2 + hstep, voffA);
            PG8_WAIT_V(8); PG8_WAIT_L(0); PG8_BAR; PG8_MMA(0, 0, At, B0); PG8_MMA(0, 1, At, B1); PG8_BAR; PG8_SCHED;
            PG8_LDA(At, 1, 1); PG8_STAGE(PG8_SB(1, 0), b3, voffB); PG8_STAGE(PG8_SB(1, 1), b3 + hstep, voffB); PG8_STAGE(PG8_SA(1, 0), a3, voffA);
            PG8_WAIT_V(8); PG8_WAIT_L(0); PG8_BAR; PG8_MMA(1, 0, At, B0); PG8_MMA(1, 1, At, B1); PG8_BAR; PG8_SCHED;
            } else {
            PG8_LDB(B0, 0, 0); PG8_SCHED; PG8_LDA(At, 0, 0); PG8_STAGE(PG8_SA(1, 1), a1 + hstep, voffA);
            PG8_WAIT_L(8); PG8_BAR; PG8_WAIT_L(0); PG8_MMA(0, 0, At, B0); PG8_BAR; PG8_SCHED;
            PG8_LDB(B1, 0, 1); PG8_STAGE(PG8_SB(0, 0), b2, voffB);
            PG8_BAR; PG8_WAIT_L(0); PG8_MMA(0, 1, At, B1); PG8_BAR;
            PG8_LDA(At, 0, 1); PG8_STAGE(PG8_SA(0, 0), a2, voffA);
            PG8_BAR; PG8_WAIT_L(0); PG8_MMA(1, 0, At, B0); PG8_BAR; PG8_SCHED;
            PG8_STAGE(PG8_SB(0, 1), b2 + hstep, voffB);
            PG8_WAIT_V(6); PG8_BAR; PG8_MMA(1, 1, At, B1); PG8_BAR;
            PG8_LDB(B0, 1, 0); PG8_SCHED; PG8_LDA(At, 1, 0); PG8_STAGE(PG8_SA(0, 1), a2 + hstep, voffA);
            PG8_WAIT_L(8); PG8_BAR; PG8_WAIT_L(0); PG8_MMA(0, 0, At, B0); PG8_BAR; PG8_SCHED;
            PG8_LDB(B1, 1, 1); PG8_STAGE(PG8_SB(1, 0), b3, voffB);
            PG8_BAR; PG8_WAIT_L(0); PG8_MMA(0, 1, At, B1); PG8_BAR;
            PG8_LDA(At, 1, 1); PG8_STAGE(PG8_SA(1, 0), a3, voffA);
            PG8_BAR; PG8_WAIT_L(0); PG8_MMA(1, 0, At, B0); PG8_BAR; PG8_SCHED;
            PG8_STAGE(PG8_SB(1, 1), b3 + hstep, voffB);
            PG8_WAIT_V(6); PG8_BAR; PG8_MMA(1, 1, At, B1); PG8_BAR;
            }
        }
        if constexpr (ALIGN_EPI) { if (wr == 0) PG8_BAR; }
        if constexpr (!Epi::AFTER_DRAIN) { E(acc, cur, wr, wc, fr, fq); S.done(cur); }
        if (!has_next) break;
#pragma unroll
        for (int a = 0; a < 2; ++a)
#pragma unroll
            for (int b = 0; b < 2; ++b)
#pragma unroll
                for (int m = 0; m < 4; ++m)
#pragma unroll
                    for (int n = 0; n < 2; ++n) acc[a][b][m][n] = (f32x4){0.f, 0.f, 0.f, 0.f};
        cur = nxt; cA = nA; cB = nB; ++ui;
        if constexpr (ALIGN_EPI) { if (wr == 1) PG8_BAR; }
    }
    PG8_WAIT_V(0);
    if constexpr (!ALIGN_EPI) { if (wr == 0) PG8_BAR; }
    PG8_BAR;
    if constexpr (Epi::AFTER_DRAIN) { E.fused(acc, cur, wr, wc, fr, fq, lds, wid, lane); S.done(cur); }
#undef PG8_SA
#undef PG8_SB
#undef PG8_STAGE
#undef PG8_LDA
#undef PG8_LDB
#undef PG8_MMA
#undef PG8_WAIT_V
#undef PG8_WAIT_L
#undef PG8_BAR
#undef PG8_SCHED
}
}


#define LAS __attribute__((address_space(3)))
#ifndef SKIPMASK
#define SKIPMASK 0
#endif
typedef unsigned short bf16;
using pg8::f32x4; using pg8::u32x4; using pg8::bf16x8;
typedef float f32x16 __attribute__((ext_vector_type(16)));
typedef short v4i16_t __attribute__((ext_vector_type(4)));
typedef unsigned u32x2 __attribute__((ext_vector_type(2)));

constexpr int DM = 1024, DEPTH = 4, NTOK = 98304, NPROMPT = 32768, CH = 32768, NCHUNK = NTOK / CH;
constexpr int NIN = 6400, DFF = 2816, NUP = 5632;
constexpr int LDS_BYTES = 147456, NTHR = 512;
constexpr float EPS = 1e-6f, LOG2E = 1.4426950408889634f;
constexpr size_t OFF_IN = 0, OFF_PA = OFF_IN + (size_t)NIN * DM, OFF_PB = OFF_PA + (size_t)DM * 256, OFF_OUT = OFF_PB + (size_t)DM * DM, OFF_UP = OFF_OUT + (size_t)DM * DM,
                 OFF_DN = OFF_UP + (size_t)NUP * DM, OFF_WS = OFF_DN + (size_t)DM * DFF, W_LAYER = OFF_WS + 8 * 128 * 128;
constexpr size_t MiB = 1u << 20;
constexpr size_t WS_W = 0, WS_R1 = 144 * MiB, WS_R2 = WS_R1 + (size_t)CH * 12800, WS_XB = WS_R2 + (size_t)CH * 5632, WS_SS = WS_XB + (size_t)CH * 2048, WS_SSV = WS_SS + (size_t)CH * 64, WS_END = WS_SSV + (size_t)CH * 64;
static_assert(W_LAYER * 2 * DEPTH <= WS_R1, "weights fit");
constexpr int PH_PER_CHUNK = 2 + 8 * DEPTH, N_PHASES = 1 + NCHUNK * PH_PER_CHUNK;

struct Args { const float* in[17]; float* out; unsigned char* ws; int ph_lo, ph_hi; };

__device__ __forceinline__ float wave_sum(float v) {
#pragma unroll
    for (int o = 1; o < 64; o <<= 1) v += __shfl_xor(v, o);
    return v;
}
__device__ __forceinline__ unsigned pk2(float lo, float hi) { return pg8::cvt_pk_bf16(lo, hi); }
#define LDS_WAIT() asm volatile("s_waitcnt lgkmcnt(0)" ::: "memory")

__device__ __forceinline__ void tr_item(const float* W, int K, int N, bf16* WT, const float* gain, LAS float* scr, int item, int lane) {
    const int nblk = N / 32, kb = item / nblk, nb = item % nblk, k0 = 64 * kb, n0 = 32 * nb;
#pragma unroll 8
    for (int i = 0; i < 32; ++i) { const int kk = 2 * i + (lane >> 5); const float g = gain ? gain[k0 + kk] : 1.0f; scr[kk * 33 + (lane & 31)] = W[(size_t)(k0 + kk) * N + n0 + (lane & 31)] * g; }
    LDS_WAIT();
    const int c = lane & 7;
#pragma unroll
    for (int j = 0; j < 4; ++j) { const int n = (lane >> 3) + 8 * j; const LAS float* s = scr + (8 * c) * 33 + n;
        u32x4 o; o.x = pk2(s[0 * 33], s[1 * 33]); o.y = pk2(s[2 * 33], s[3 * 33]); o.z = pk2(s[4 * 33], s[5 * 33]); o.w = pk2(s[6 * 33], s[7 * 33]);
        *(u32x4*)(WT + (size_t)(n0 + n) * K + k0 + 8 * c) = o; }
    LDS_WAIT();
}
__device__ __forceinline__ void p0_weights(const Args& a, LAS unsigned char* lds, int tid, int G, int bid) {
    const int wave = tid >> 6, lane = tid & 63;
    LAS float* scr = (LAS float*)(lds + wave * 16384);
    const int gw = bid * 8 + wave, NGW = G * 8;
    constexpr int I_IN = 16 * 200, I_PA = 4 * 32, I_PB = 16 * 32, I_OUT = 16 * 32, I_UP = 16 * 176, I_DN = 44 * 32, PER = I_IN + I_PA + I_PB + I_OUT + I_UP + I_DN;
    bf16* Wb = (bf16*)(a.ws + WS_W);
    for (int it = gw; it < DEPTH * PER; it += NGW) {
        const int l = it / PER; int r = it % PER; bf16* wl = Wb + (size_t)l * W_LAYER;
        if (r < I_IN) { tr_item(a.in[4] + (size_t)l * DM * NIN, DM, NIN, wl + OFF_IN, a.in[3] + l * DM, scr, r, lane); continue; } r -= I_IN;
        if (r < I_PA) { tr_item(a.in[8] + (size_t)l * 256 * DM, 256, DM, wl + OFF_PA, nullptr, scr, r, lane); continue; } r -= I_PA;
        if (r < I_PB) { tr_item(a.in[9] + (size_t)l * DM * DM, DM, DM, wl + OFF_PB, nullptr, scr, r, lane); continue; } r -= I_PB;
        if (r < I_OUT) { tr_item(a.in[10] + (size_t)l * DM * DM, DM, DM, wl + OFF_OUT, nullptr, scr, r, lane); continue; } r -= I_OUT;
        if (r < I_UP) { tr_item(a.in[12] + (size_t)l * DM * NUP, DM, NUP, wl + OFF_UP, a.in[11] + l * DM, scr, r, lane); continue; } r -= I_UP;
        tr_item(a.in[15] + (size_t)l * DFF * DM, DFF, DM, wl + OFF_DN, nullptr, scr, r, lane);
    }
    for (int i = bid * NTHR + tid; i < DEPTH * 131072 / 4; i += G * NTHR) {
        const int l = i / 32768, e = (i % 32768) * 4;
        const f32x4 v = *(const f32x4*)(a.in[6] + (size_t)l * 131072 + e);
        u32x2 o; o.x = pk2(v[0], v[1]); o.y = pk2(v[2], v[3]);
        *(u32x2*)(Wb + (size_t)l * W_LAYER + OFF_WS + e) = o;
    }
}
__device__ __forceinline__ void p0x(const Args& a, int chunk, int tid, int G, int bid) {
    const int wave = tid >> 6, lane = tid & 63, gw = bid * 8 + wave, NGW = G * 8;
    bf16* XB = (bf16*)(a.ws + WS_XB); float* SS = (float*)(a.ws + WS_SS);
    for (int m = gw; m < CH; m += NGW) {
        const size_t tok = (size_t)chunk * CH + m;
        const float* src = tok < NPROMPT ? a.in[0] + tok * DM : a.in[1] + (tok - NPROMPT) * DM;
        float* dst = a.out + tok * DM;
        float s = 0.f;
#pragma unroll
        for (int j = 0; j < 4; ++j) { const f32x4 v = *(const f32x4*)(src + (lane + 64 * j) * 4); s += (v[0] * v[0] + v[1] * v[1]) + (v[2] * v[2] + v[3] * v[3]);
            *(f32x4*)(dst + (lane + 64 * j) * 4) = v; u32x2 o; o.x = pk2(v[0], v[1]); o.y = pk2(v[2], v[3]); *(u32x2*)(XB + (size_t)m * DM + (lane + 64 * j) * 4) = o; }
        s = wave_sum(s);
        if (lane < 16) SS[(size_t)m * 16 + lane] = lane == 0 ? s : 0.f;
    }
}
__device__ __forceinline__ void pfinal(const Args& a, int chunk, int tid, int G, int bid) {
    const int wave = tid >> 6, lane = tid & 63, gw = bid * 8 + wave, NGW = G * 8;
    const float* SS = (const float*)(a.ws + WS_SS); const float* nf = a.in[16];
    for (int m = gw; m < CH; m += NGW) {
        float* x = a.out + ((size_t)chunk * CH + m) * DM;
        const float rs = pg8::row_rs(SS, m);
#pragma unroll
        for (int j = 0; j < 4; ++j) { const int c = (lane + 64 * j) * 4; const f32x4 v = *(const f32x4*)(x + c), g = *(const f32x4*)(nf + c); *(f32x4*)(x + c) = v * rs * g; }
    }
}
__device__ __forceinline__ int t5_bucket(int rel) {
    const int n = rel < 0 ? -rel : rel;
    const int b = n < 8 ? n : 8 + (n >= 15) + (n >= 27) + (n >= 50) + (n >= 91) + (n >= 166) + (n >= 305) + (n >= 559);
    return (rel > 0 ? 16 : 0) + b;
}
__device__ __forceinline__ void attn_unit(const bf16* QKV, bf16* OUTG, float* LSE, const float* rel_bias, LAS unsigned char* lds, int unit, int S, int tid) {
    const int wave = tid >> 6, lane = tid & 63;
    constexpr int upg = CH / 64;
    const int g = unit / upg, rem = unit % upg;
    const int ups = S / 64, seq = rem / ups, rem2 = rem % ups;
    const int d = 1 << (2 * g), L = S / d, nqb = L / 64, r = rem2 / nqb, qb = rem2 % nqb;
    const int tokbase = seq * S + r;
#pragma unroll
    for (int i = 0; i < 12; ++i) {
        const int idx = tid + i * NTHR, kk = idx >> 5, ch = idx & 31, lk = 64 * qb - 64 + kk;
        u32x4 v = (u32x4){0u, 0u, 0u, 0u};
        if (lk >= 0 && lk < L) v = *(const u32x4*)(QKV + (size_t)(tokbase + lk * d) * 2304 + 1536 + g * 256 + ch * 8);
        *(LAS u32x4*)(lds + kk * 576 + ch * 16) = v;
    }
    LAS float* bt = (LAS float*)(lds + 110592);
    for (int i = tid; i < 516; i += NTHR) { const int h = i / 129, j = i % 129 - 64; bt[i] = rel_bias[t5_bucket(j * d) * 12 + g * 4 + h]; }
    __syncthreads();
    const int h = wave & 3, qh = wave >> 2, n = lane & 31, hi = lane >> 5;
    const int qbase = 64 * qb + 32 * qh;
    const size_t tokq = (size_t)tokbase + (size_t)(qbase + n) * d;
    const bf16* qp = QKV + tokq * 2304 + g * 256 + h * 64 + 8 * hi;
    bf16x8 qf[4];
#pragma unroll
    for (int s = 0; s < 4; ++s) qf[s] = *(const bf16x8*)(qp + 16 * s);
    f32x16 st[5];
#pragma unroll
    for (int kt = 0; kt < 5; ++kt) {
        const int lk = qbase - 64 + 32 * kt + n, lkc = lk < 0 ? 0 : (lk > L - 1 ? L - 1 : lk);
        const bf16* kp = QKV + (size_t)(tokbase + lkc * d) * 2304 + 768 + g * 256 + h * 64 + 8 * hi;
        f32x16 acc;
#pragma unroll
        for (int e = 0; e < 16; ++e) acc[e] = 0.f;
#pragma unroll
        for (int s = 0; s < 4; ++s) acc = __builtin_amdgcn_mfma_f32_32x32x16_bf16(*(const bf16x8*)(kp + 16 * s), qf[s], acc, 0, 0, 0);
        st[kt] = acc;
    }
    float mx = -3.0e38f;
#pragma unroll
    for (int kt = 0; kt < 5; ++kt)
#pragma unroll
        for (int i = 0; i < 16; ++i) {
            const int m = (i & 3) + 8 * (i >> 2) + 4 * hi, j = 32 * kt + m - 64 - n, lk2 = qbase - 64 + 32 * kt + m;
            const bool ok = (j >= -64) && (j <= 64) && (lk2 >= 0) && (lk2 < L);
            const int jc = j < -64 ? -64 : (j > 64 ? 64 : j);
            const float sv = ok ? st[kt][i] + bt[h * 129 + jc + 64] : -1e30f;
            st[kt][i] = sv; mx = fmaxf(mx, sv);
        }
    mx = fmaxf(mx, __shfl_xor(mx, 32));
    float sum = 0.f;
#pragma unroll
    for (int kt = 0; kt < 5; ++kt)
#pragma unroll
        for (int i = 0; i < 16; ++i) { const float p = __builtin_amdgcn_exp2f((st[kt][i] - mx) * LOG2E); st[kt][i] = p; sum += p; }
    sum += __shfl_xor(sum, 32);
    const float inv = 1.0f / sum, lse = mx + __logf(sum);
    f32x16 o0, o1;
#pragma unroll
    for (int e = 0; e < 16; ++e) { o0[e] = 0.f; o1[e] = 0.f; }
    const int q4 = (lane & 15) >> 2, p4 = lane & 3, gsel = (lane >> 4) & 1;
    const unsigned vbase = (unsigned)((32 * qh + 4 * hi + q4) * 576 + h * 128 + (16 * gsel + 4 * p4) * 2);
#pragma unroll
    for (int kt = 0; kt < 5; ++kt)
#pragma unroll
        for (int s2 = 0; s2 < 2; ++s2) {
            u32x4 pw; pw.x = pk2(st[kt][8 * s2 + 0], st[kt][8 * s2 + 1]); pw.y = pk2(st[kt][8 * s2 + 2], st[kt][8 * s2 + 3]); pw.z = pk2(st[kt][8 * s2 + 4], st[kt][8 * s2 + 5]); pw.w = pk2(st[kt][8 * s2 + 6], st[kt][8 * s2 + 7]);
            const bf16x8 pf = __builtin_bit_cast(bf16x8, pw);
            const unsigned ro = vbase + (unsigned)((32 * kt + 16 * s2) * 576);
            {
                const v4i16_t r1 = __builtin_amdgcn_ds_read_tr16_b64_v4i16((LAS v4i16_t*)(lds + ro)), r2 = __builtin_amdgcn_ds_read_tr16_b64_v4i16((LAS v4i16_t*)(lds + ro + 8 * 576));
                const bf16x8 vf = (bf16x8){r1[0], r1[1], r1[2], r1[3], r2[0], r2[1], r2[2], r2[3]};
                o0 = __builtin_amdgcn_mfma_f32_32x32x16_bf16(vf, pf, o0, 0, 0, 0);
            }
            {
                const v4i16_t r1 = __builtin_amdgcn_ds_read_tr16_b64_v4i16((LAS v4i16_t*)(lds + ro + 64)), r2 = __builtin_amdgcn_ds_read_tr16_b64_v4i16((LAS v4i16_t*)(lds + ro + 64 + 8 * 576));
                const bf16x8 vf = (bf16x8){r1[0], r1[1], r1[2], r1[3], r2[0], r2[1], r2[2], r2[3]};
                o1 = __builtin_amdgcn_mfma_f32_32x32x16_bf16(vf, pf, o1, 0, 0, 0);
            }
        }
    bf16* op = OUTG + ((size_t)g * CH + tokq) * 256 + h * 64;
#pragma unroll
    for (int grp = 0; grp < 4; ++grp) {
        u32x2 w0, w1;
        w0.x = pk2(o0[4 * grp + 0] * inv, o0[4 * grp + 1] * inv); w0.y = pk2(o0[4 * grp + 2] * inv, o0[4 * grp + 3] * inv);
        w1.x = pk2(o1[4 * grp + 0] * inv, o1[4 * grp + 1] * inv); w1.y = pk2(o1[4 * grp + 2] * inv, o1[4 * grp + 3] * inv);
        *(u32x2*)(op + 8 * grp + 4 * hi) = w0; *(u32x2*)(op + 32 + 8 * grp + 4 * hi) = w1;
    }
    if (hi == 0) LSE[((size_t)g * CH + tokq) * 4 + h] = lse;
    __syncthreads();
}
__device__ __forceinline__ void sg_unit(bf16* U, const bf16* GV, const float* ssv, const bf16* WSb, const float* gain, const float* bs, LAS unsigned char* lds, int unit, int tid) {
    const int wave = tid >> 6, lane = tid & 63;
    const int nch = unit >> 3, gg = unit & 7, tok0 = nch * 128;
    LAS float* rv = (LAS float*)lds;
    if (tid < 128) rv[tid] = pg8::row_rs(ssv, tok0 + tid);
    __syncthreads();
    for (int it = tid; it < 1024; it += NTHR) {
        const int cc = it & 15, q = (it >> 4) * 2;
        f32x4 a0, a1, b0, b1;
        pg8::unpack8(*(const u32x4*)(GV + (size_t)(tok0 + q) * 1024 + gg * 128 + cc * 8), a0, a1);
        pg8::unpack8(*(const u32x4*)(GV + (size_t)(tok0 + q + 1) * 1024 + gg * 128 + cc * 8), b0, b1);
        const float r0 = rv[q], r1 = rv[q + 1];
#pragma unroll
        for (int e = 0; e < 4; ++e) {
            *(LAS unsigned*)(lds + 1024 + (cc * 8 + e) * 272 + q * 2) = pk2(a0[e] * r0, b0[e] * r1);
            *(LAS unsigned*)(lds + 1024 + (cc * 8 + 4 + e) * 272 + q * 2) = pk2(a1[e] * r0, b1[e] * r1);
        }
    }
    __syncthreads();
    const int ln = lane & 15, kq = lane >> 4;
    bf16x8 bfr[4];
#pragma unroll
    for (int ks = 0; ks < 4; ++ks) bfr[ks] = *(const bf16x8*)(WSb + (size_t)gg * 16384 + (wave * 16 + ln) * 128 + 32 * ks + 8 * kq);
    f32x4 acc[8];
#pragma unroll
    for (int ct = 0; ct < 8; ++ct) {
        acc[ct] = (f32x4){0.f, 0.f, 0.f, 0.f};
#pragma unroll
        for (int ks = 0; ks < 4; ++ks) {
            const bf16x8 af = *(const LAS bf16x8*)(lds + 1024 + (ct * 16 + ln) * 272 + (32 * ks + 8 * kq) * 2);
            acc[ct] = __builtin_amdgcn_mfma_f32_16x16x32_bf16(af, bfr[ks], acc[ct], 0, 0, 0);
        }
    }
    const int tok = tok0 + wave * 16 + ln;
    const float bias = bs[gg * 128 + wave * 16 + ln];
#pragma unroll
    for (int ct = 0; ct < 8; ++ct) {
        const int chn = gg * 128 + ct * 16 + kq * 4;
        const f32x4 gn = *(const f32x4*)(gain + chn);
        bf16* up = U + (size_t)tok * 1024 + chn;
        const u32x2 uw = *(const u32x2*)up;
        const float u0 = __uint_as_float(uw.x << 16), u1 = __uint_as_float(uw.x & 0xffff0000u), u2 = __uint_as_float(uw.y << 16), u3 = __uint_as_float(uw.y & 0xffff0000u);
        u32x2 o; o.x = pk2(u0 * (gn[0] * acc[ct][0] + bias), u1 * (gn[1] * acc[ct][1] + bias)); o.y = pk2(u2 * (gn[2] * acc[ct][2] + bias), u3 * (gn[3] * acc[ct][3] + bias));
        *(u32x2*)up = o;
    }
    __syncthreads();
}
__device__ __forceinline__ void p_merge(const bf16* OUTG, const float* LSE, bf16* OA, int tid, int G, int bid) {
    for (int it = bid * NTHR + tid; it < CH * 32; it += G * NTHR) {
        const int tok = it >> 5, c8 = it & 31, h = c8 >> 3;
        const float l0 = LSE[(size_t)tok * 4 + h], l1 = LSE[((size_t)CH + tok) * 4 + h], l2 = LSE[((size_t)2 * CH + tok) * 4 + h];
        const float mx = fmaxf(l0, fmaxf(l1, l2));
        float w0 = __expf(l0 - mx), w1 = __expf(l1 - mx), w2 = __expf(l2 - mx);
        const float inv = 1.0f / (w0 + w1 + w2); w0 *= inv; w1 *= inv; w2 *= inv;
        f32x4 a0, a1, b0, b1, c0, c1;
        pg8::unpack8(*(const u32x4*)(OUTG + (size_t)tok * 256 + c8 * 8), a0, a1);
        pg8::unpack8(*(const u32x4*)(OUTG + ((size_t)CH + tok) * 256 + c8 * 8), b0, b1);
        pg8::unpack8(*(const u32x4*)(OUTG + ((size_t)2 * CH + tok) * 256 + c8 * 8), c0, c1);
        *(u32x4*)(OA + (size_t)tok * 256 + c8 * 8) = pg8::pack8(a0 * w0 + b0 * w1 + c0 * w2, a1 * w0 + b1 * w1 + c1 * w2);
    }
}
__device__ __forceinline__ void p_conv(const bf16* A, bf16* FG, const float* cw, const float* cb, int S, int tid, int G, int bid) {
    constexpr int RUN = 8, NFC = DFF / 8;
    for (int it = bid * NTHR + tid; it < (CH / RUN) * NFC; it += G * NTHR) {
        const int fc = it % NFC, t0 = (it / NFC) * RUN, f = fc * 8;
        f32x4 wg[3][2], wv[3][2], bg[2], bv[2];
#pragma unroll
        for (int k = 0; k < 3; ++k) { wg[k][0] = *(const f32x4*)(cw + k * NUP + f); wg[k][1] = *(const f32x4*)(cw + k * NUP + f + 4); wv[k][0] = *(const f32x4*)(cw + k * NUP + DFF + f); wv[k][1] = *(const f32x4*)(cw + k * NUP + DFF + f + 4); }
        bg[0] = *(const f32x4*)(cb + f); bg[1] = *(const f32x4*)(cb + f + 4); bv[0] = *(const f32x4*)(cb + DFF + f); bv[1] = *(const f32x4*)(cb + DFF + f + 4);
        const f32x4 z4 = (f32x4){0.f, 0.f, 0.f, 0.f};
        f32x4 pg0 = z4, pg1 = z4, pv0 = z4, pv1 = z4, cg0, cg1, cv0, cv1;
        if ((t0 & (S - 1)) != 0) { pg8::unpack8(*(const u32x4*)(A + (size_t)(t0 - 1) * NUP + f), pg0, pg1); pg8::unpack8(*(const u32x4*)(A + (size_t)(t0 - 1) * NUP + DFF + f), pv0, pv1); }
        pg8::unpack8(*(const u32x4*)(A + (size_t)t0 * NUP + f), cg0, cg1); pg8::unpack8(*(const u32x4*)(A + (size_t)t0 * NUP + DFF + f), cv0, cv1);
#pragma unroll
        for (int i = 0; i < RUN; ++i) {
            const int t = t0 + i;
            f32x4 ng0 = z4, ng1 = z4, nv0 = z4, nv1 = z4;
            if (((t + 1) & (S - 1)) != 0) { pg8::unpack8(*(const u32x4*)(A + (size_t)(t + 1) * NUP + f), ng0, ng1); pg8::unpack8(*(const u32x4*)(A + (size_t)(t + 1) * NUP + DFF + f), nv0, nv1); }
            f32x4 g0 = pg0 * wg[0][0] + cg0 * wg[1][0] + ng0 * wg[2][0] + bg[0], g1 = pg1 * wg[0][1] + cg1 * wg[1][1] + ng1 * wg[2][1] + bg[1];
            const f32x4 v0 = pv0 * wv[0][0] + cv0 * wv[1][0] + nv0 * wv[2][0] + bv[0], v1 = pv1 * wv[0][1] + cv1 * wv[1][1] + nv1 * wv[2][1] + bv[1];
#pragma unroll
            for (int e = 0; e < 4; ++e) { g0[e] = pg8::gelu_tanh(g0[e]) * v0[e]; g1[e] = pg8::gelu_tanh(g1[e]) * v1[e]; }
            *(u32x4*)(FG + (size_t)t * DFF + f) = pg8::pack8(g0, g1);
            pg0 = cg0; pg1 = cg1; pv0 = cv0; pv1 = cv1; cg0 = ng0; cg1 = ng1; cv0 = nv0; cv1 = nv1;
        }
    }
}

__global__ void __launch_bounds__(NTHR, 2) fwd_kernel(Args a_in) {
    extern __shared__ __attribute__((aligned(16))) unsigned char lds_raw[];
    LAS unsigned char* lds = (LAS unsigned char*)lds_raw;
    cg::grid_group grid = cg::this_grid();
    const int ph_lo = a_in.ph_lo, ph_hi = a_in.ph_hi;
    for (int ph = ph_lo; ph < ph_hi; ++ph) {
#if defined(__HIP_DEVICE_COMPILE__)
        typedef const __attribute__((address_space(4))) unsigned long long* cu64p4;
        cu64p4 ap = (cu64p4)__builtin_amdgcn_kernarg_segment_ptr();
        asm volatile("" : "+s"(ap));
        Args a;
#pragma unroll
        for (int i = 0; i < 17; ++i) a.in[i] = (const float*)ap[i];
        a.out = (float*)ap[17]; a.ws = (unsigned char*)ap[18]; a.ph_lo = ph_lo; a.ph_hi = ph_hi;
#else
        const Args a = a_in;
#endif
        int tid = threadIdx.x, G = gridDim.x, bid = blockIdx.x;
        asm volatile("" : "+v"(tid)); asm volatile("" : "+s"(G)); asm volatile("" : "+s"(bid));
        unsigned char* ws = a.ws;
        bf16* Wb = (bf16*)(ws + WS_W);
        bf16* QKV = (bf16*)(ws + WS_R1); bf16* U = QKV + (size_t)CH * 2304; bf16* GV = U + (size_t)CH * 1024; bf16* GT = GV + (size_t)CH * 1024;
        bf16* AF = (bf16*)(ws + WS_R1);
        bf16* MG = GV;
        bf16* OUTG = (bf16*)(ws + WS_R2); bf16* OA = OUTG + (size_t)3 * CH * 256; float* LSE = (float*)(OA + (size_t)CH * 256);
        bf16* FG = (bf16*)(ws + WS_R2);
        bf16* XB = (bf16*)(ws + WS_XB); float* SS = (float*)(ws + WS_SS); float* SSV = (float*)(ws + WS_SSV);
        if (ph == 0 && !(SKIPMASK & 256)) p0_weights(a, lds, tid, G, bid);
        else {
            const int chunk = (ph - 1) / PH_PER_CHUNK, sub = (ph - 1) % PH_PER_CHUNK;
            const int S = chunk == 0 ? 8192 : 2048;
            if (sub == 0 && !(SKIPMASK & 512)) p0x(a, chunk, tid, G, bid);
            else if (sub == PH_PER_CHUNK - 1) pfinal(a, chunk, tid, G, bid);
            else {
                const int l = (sub - 1) >> 3, k = (sub - 1) & 7;
                const bf16* wl = Wb + (size_t)l * W_LAYER;
                float* X = a.out + (size_t)chunk * CH * DM;
                if (k == 0 && !(SKIPMASK & 1)) {
                    pg8::Gemm g{XB, wl + OFF_IN, CH, NIN, DM}; pg8::StaticOrder So; So.init(CH, NIN, G, bid);
                    pg8::EpiIn E{QKV, U, GV, GT, SS, SSV};
                    pg8::gemm_phase<pg8::EpiIn, pg8::StaticOrder, true, true>(lds, g, So, E, tid);
                } else if (k == 1 && !(SKIPMASK & 2)) {
                    constexpr int NATT = 3 * (CH / 64), NSG = (CH / 128) * 8;
                    for (int it = bid; it < NATT + NSG; it += G) {
                        if (it < NATT) { if (!(SKIPMASK & 1024)) attn_unit(QKV, OUTG, LSE, a.in[2], lds, it, S, tid);
                        } else if (!(SKIPMASK & 2048)) sg_unit(U, GV, SSV, wl + OFF_WS, a.in[5] + l * 1024, a.in[7] + l * 1024, lds, it - NATT, tid);
                    }
                } else if (k == 2 && !(SKIPMASK & 4)) p_merge(OUTG, LSE, OA, tid, G, bid);
                else if (k == 3 && !(SKIPMASK & 8)) {
                    if (!(SKIPMASK & 4096)) { int kpa = 256; asm volatile("" : "+s"(kpa)); pg8::Gemm g{OA, wl + OFF_PA, CH, DM, kpa}; pg8::StaticOrder So; So.init(CH, DM, G, bid);
                      pg8::EpiGate<0> E{MG, GT, 0};
                      pg8::gemm_phase<pg8::EpiGate<0>, pg8::StaticOrder, true, true>(lds, g, So, E, tid); }
                    if (!(SKIPMASK & 8192)) { pg8::Gemm g{U, wl + OFF_PB, CH, DM, DM}; pg8::StaticOrder So; So.init(CH, DM, G, bid);
                      pg8::EpiGate<1> E{MG, GT, 1024};
                      pg8::gemm_phase<pg8::EpiGate<1>, pg8::StaticOrder, true, true>(lds, g, So, E, tid); }
                } else if (k == 4 && !(SKIPMASK & 16)) {
                    pg8::Gemm g{MG, wl + OFF_OUT, CH, DM, DM}; pg8::StaticOrder So; So.init(CH, DM, G, bid);
                    pg8::EpiRes E{X, XB, SS};
                    pg8::gemm_phase<pg8::EpiRes, pg8::StaticOrder, true, true>(lds, g, So, E, tid);
                } else if (k == 5 && !(SKIPMASK & 32)) {
                    pg8::Gemm g{XB, wl + OFF_UP, CH, NUP, DM}; pg8::StaticOrder So; So.init(CH, NUP, G, bid);
                    pg8::EpiUp E{AF, SS};
                    pg8::gemm_phase<pg8::EpiUp, pg8::StaticOrder, true, true>(lds, g, So, E, tid);
                } else if (k == 6 && !(SKIPMASK & 64)) p_conv(AF, FG, a.in[13] + (size_t)l * 3 * NUP, a.in[14] + (size_t)l * NUP, S, tid, G, bid);
                else if (!(SKIPMASK & 128)) {
                    pg8::Gemm g{FG, wl + OFF_DN, CH, DM, DFF}; pg8::StaticOrder So; So.init(CH, DM, G, bid);
                    pg8::EpiRes E{X, XB, SS};
                    pg8::gemm_phase<pg8::EpiRes, pg8::StaticOrder, true, true>(lds, g, So, E, tid);
                }
            }
        }
        if (ph + 1 < ph_hi) grid.sync();
    }
}

extern "C" void kernel_launch(void* const* d_in, const int* in_sizes, int n_in, void* d_out, int out_size, void* d_ws, size_t ws_size, hipStream_t stream) {
    static int grid = 0;
    if (grid == 0) {
        if (n_in != 17 || out_size != NTOK * DM || ws_size < WS_END) { fprintf(stderr, "kernel_launch: unexpected shapes: n_in %d out %d ws %zu (need %zu)\n", n_in, out_size, ws_size, (size_t)WS_END); grid = -1; return; }
        int dev = 0, cus = 0, per_cu = 0;
        (void)hipGetDevice(&dev); (void)hipDeviceGetAttribute(&cus, hipDeviceAttributeMultiprocessorCount, dev);
        if (hipFuncSetAttribute((const void*)fwd_kernel, hipFuncAttributeMaxDynamicSharedMemorySize, LDS_BYTES) != hipSuccess) { fprintf(stderr, "kernel_launch: hipFuncSetAttribute failed\n"); grid = -1; return; }
        if (hipOccupancyMaxActiveBlocksPerMultiprocessor(&per_cu, (const void*)fwd_kernel, NTHR, LDS_BYTES) != hipSuccess || per_cu < 1) { fprintf(stderr, "kernel_launch: occupancy query says %d\n", per_cu); per_cu = 1; }
        (void)hipGetLastError();
        grid = cus * per_cu;
        if (grid <= 0) grid = 256;
    }
    if (grid < 0) return;
    Args a{};
    for (int i = 0; i < 17; ++i) a.in[i] = (const float*)d_in[i];
    a.out = (float*)d_out; a.ws = (unsigned char*)d_ws;
#if ONE_LAUNCH
    a.ph_lo = 0; a.ph_hi = N_PHASES;
    void* args[] = {&a};
    hipError_t e = hipLaunchCooperativeKernel((const void*)fwd_kernel, dim3(grid), dim3(NTHR), args, LDS_BYTES, stream);
    if (e != hipSuccess) fprintf(stderr, "cooperative launch failed: %s (grid %d)\n", hipGetErrorString(e), grid);
#else
    for (int ph = 0; ph < N_PHASES; ++ph) {
        a.ph_lo = ph; a.ph_hi = ph + 1;
        hipLaunchKernelGGL(fwd_kernel, dim3(grid), dim3(NTHR), LDS_BYTES, stream, a);
    }
#endif
}
```

```cpp
#include <hip/hip_runtime.h>
#include <hip/hip_cooperative_groups.h>
#include <cstdio>
#include <cstdint>
namespace cg = cooperative_groups;

#ifndef ONE_LAUNCH
#define ONE_LAUNCH 1
#endif

namespace pg8 {
#define PG8_LAS __attribute__((address_space(3)))
typedef unsigned short bf16_t;
typedef short bf16x8 __attribute__((ext_vector_type(8)));
typedef float f32x4 __attribute__((ext_vector_type(4)));
typedef unsigned u32x4 __attribute__((ext_vector_type(4)));
constexpr int BM = 256, BK = 64, HALF = 128, HTB = HALF * BK * 2  , STAGE_BYTES = 8 * HTB, NXCD = 8, WGM = 8;

__host__ __device__ __forceinline__ int lds_byte(int r, int c) { const int st = (r >> 4) * 2 + (c >> 5), rr = r & 15, cc = c & 31, ob = rr * 64 + cc * 2; return st * 1024 + (ob ^ (((ob >> 9) & 1) << 5)); }
__host__ __device__ __forceinline__ void stage_rc(int b, int& R, int& C) { const int st = b / 1024, sb = b % 1024, swz = sb ^ (((sb >> 9) & 1) << 5); R = (st >> 1) * 16 + swz / 64; C = (st & 1) * 32 + (swz % 64) / 2; }
__host__ __device__ __forceinline__ int perm32(int rho) { const int n = rho >> 4, i = rho & 15; return 8 * (i >> 2) + 4 * n + (i & 3); }

struct Unit { int pm, pn; };
struct Gemm { const bf16_t* A; const bf16_t* Bt; int M, N, K; };

struct StaticOrder {
    int nM, nN, nwg, G, c;
    __host__ __device__ void init(int M, int N, int G_, int c_) { nM = M / BM; nN = N / BM; nwg = nM * nN; G = G_; c = c_; }
    __host__ __device__ bool next(int i, Unit& u) const {
        const long L = (long)i * G + c; if (L >= nwg) return false;
        int wgid = (int)L; { const int q = nwg / NXCD, r = nwg % NXCD, xcd = wgid % NXCD, off = wgid / NXCD; wgid = (xcd < r ? xcd * (q + 1) : r * (q + 1) + (xcd - r) * q) + off; }
        const int nig = WGM * nN, gid = wgid / nig, fm = gid * WGM, gsz = (nM - fm) < WGM ? (nM - fm) : WGM;
        u.pm = fm + ((wgid % nig) % gsz); u.pn = (wgid % nig) / gsz; return true;
    }
    __device__ __forceinline__ void a_ready(const Unit&) const {}
    __device__ __forceinline__ void done(const Unit&) const {}
};

__device__ __forceinline__ unsigned cvt_pk_bf16(float lo, float hi) { unsigned r; asm volatile("v_cvt_pk_bf16_f32 %0, %1, %2" : "=v"(r) : "v"(lo), "v"(hi)); return r; }

__device__ __forceinline__ float fast_sigmoid(float x) { return __builtin_amdgcn_rcpf(1.0f + __builtin_amdgcn_exp2f(-1.4426950408889634f * x)); }
__device__ __forceinline__ float gelu_tanh(float x) {
    const float y = x * (1.0f + 0.044715f * x * x) * (2.0f * 0.7978845608028654f);
    return x * __builtin_amdgcn_rcpf(1.0f + __builtin_amdgcn_exp2f(-1.4426950408889634f * y));
}
__device__ __forceinline__ float bf2f(unsigned short b) { return __uint_as_float(((unsigned)b) << 16); }
__device__ __forceinline__ u32x4 pack8(const f32x4 a, const f32x4 b) { u32x4 w; w.x = cvt_pk_bf16(a[0], a[1]); w.y = cvt_pk_bf16(a[2], a[3]); w.z = cvt_pk_bf16(b[0], b[1]); w.w = cvt_pk_bf16(b[2], b[3]); return w; }
__device__ __forceinline__ void unpack8(const u32x4 w, f32x4& a, f32x4& b) {
    a[0] = __uint_as_float(w.x << 16); a[1] = __uint_as_float(w.x & 0xffff0000u); a[2] = __uint_as_float(w.y << 16); a[3] = __uint_as_float(w.y & 0xffff0000u);
    b[0] = __uint_as_float(w.z << 16); b[1] = __uint_as_float(w.z & 0xffff0000u); b[2] = __uint_as_float(w.w << 16); b[3] = __uint_as_float(w.w & 0xffff0000u);
}
__device__ __forceinline__ float row_rs(const float* ss, int row) {
    const f32x4* sp = (const f32x4*)(ss + (size_t)row * 16);
    const f32x4 s = (sp[0] + sp[1]) + (sp[2] + sp[3]);
    return rsqrtf(((s[0] + s[1]) + (s[2] + s[3])) * (1.0f / 1024.0f) + 1e-6f);
}

struct EpiIn {
    static constexpr bool PERM = true, AFTER_DRAIN = false;
    bf16_t* QKV; bf16_t* U; bf16_t* GV; bf16_t* G; const float* ss; float* ssv;
    __device__ __forceinline__ void operator()(const f32x4 (&acc)[2][2][4][2], const Unit& u, int wr, int wc, int fr, int fq) const {
        const int pn = u.pn;
#pragma unroll
        for (int ai = 0; ai < 2; ++ai)
#pragma unroll
            for (int m = 0; m < 4; ++m) {
                const int row = u.pm * BM + ai * HALF + wr * 64 + m * 16 + fr;
                const float rs = row_rs(ss, row);
                float q = 0.f;
#pragma unroll
                for (int bj = 0; bj < 2; ++bj) {
                    const int col = pn * BM + bj * HALF + wc * 32 + 8 * fq;
                    f32x4 v0 = acc[ai][bj][m][0] * rs, v1 = acc[ai][bj][m][1] * rs;
                    bf16_t* dst;
                    if (pn < 9) { if (pn < 3) { v0 = v0 * 0.125f; v1 = v1 * 0.125f; } dst = QKV + (size_t)row * 2304 + col; }
                    else if (pn < 17) {
#pragma unroll
                        for (int e = 0; e < 4; ++e) { v0[e] = gelu_tanh(v0[e]); v1[e] = gelu_tanh(v1[e]); }
                        if (pn < 13) dst = U + (size_t)row * 1024 + (col - 2304);
                        else { dst = GV + (size_t)row * 1024 + (col - 3328);
#pragma unroll
                            for (int e = 0; e < 4; ++e) q += v0[e] * v0[e] + v1[e] * v1[e]; }
                    } else {
#pragma unroll
                        for (int e = 0; e < 4; ++e) { v0[e] = fast_sigmoid(v0[e]); v1[e] = fast_sigmoid(v1[e]); }
                        dst = G + (size_t)row * 2048 + (col - 4352);
                    }
                    *(u32x4*)dst = pack8(v0, v1);
                }
                if (pn >= 13 && pn < 17) { q += __shfl_xor(q, 16); q += __shfl_xor(q, 32); if (fq == 0) ssv[(size_t)row * 16 + (pn - 13) * 4 + wc] = q; }
                asm volatile("" ::: "memory");
            }
    }
};
template <int MODE> struct EpiGate {
    static constexpr bool PERM = true, AFTER_DRAIN = false;
    bf16_t* O; const bf16_t* G; int goff;
    __device__ __forceinline__ void operator()(const f32x4 (&acc)[2][2][4][2], const Unit& u, int wr, int wc, int fr, int fq) const {
#pragma unroll
        for (int ai = 0; ai < 2; ++ai)
#pragma unroll
            for (int m = 0; m < 4; ++m) {
                const int row = u.pm * BM + ai * HALF + wr * 64 + m * 16 + fr;
#pragma unroll
                for (int bj = 0; bj < 2; ++bj) {
                    const int col = u.pn * BM + bj * HALF + wc * 32 + 8 * fq;
                    f32x4 g0, g1; unpack8(*(const u32x4*)(G + (size_t)row * 2048 + goff + col), g0, g1);
                    f32x4 v0 = acc[ai][bj][m][0] * g0, v1 = acc[ai][bj][m][1] * g1;
                    bf16_t* dst = O + (size_t)row * 1024 + col;
                    if (MODE == 1) { f32x4 p0, p1; unpack8(*(const u32x4*)dst, p0, p1); v0 = v0 + p0; v1 = v1 + p1; }
                    *(u32x4*)dst = pack8(v0, v1);
                }
                asm volatile("" ::: "memory");
            }
    }
};
struct EpiRes {
    static constexpr bool PERM = true, AFTER_DRAIN = false;
    float* X; bf16_t* XB; float* ss;
    __device__ __forceinline__ void operator()(const f32x4 (&acc)[2][2][4][2], const Unit& u, int wr, int wc, int fr, int fq) const {
#pragma unroll
        for (int ai = 0; ai < 2; ++ai)
#pragma unroll
            for (int m = 0; m < 4; ++m) {
                const int row = u.pm * BM + ai * HALF + wr * 64 + m * 16 + fr;
                float q = 0.f;
#pragma unroll
                for (int bj = 0; bj < 2; ++bj) {
                    const int col = u.pn * BM + bj * HALF + wc * 32 + 8 * fq;
                    float* xp = X + (size_t)row * 1024 + col;
                    f32x4 x0 = *(const f32x4*)xp + acc[ai][bj][m][0], x1 = *(const f32x4*)(xp + 4) + acc[ai][bj][m][1];
                    *(f32x4*)xp = x0; *(f32x4*)(xp + 4) = x1;
                    *(u32x4*)(XB + (size_t)row * 1024 + col) = pack8(x0, x1);
#pragma unroll
                    for (int e = 0; e < 4; ++e) q += x0[e] * x0[e] + x1[e] * x1[e];
                }
                q += __shfl_xor(q, 16); q += __shfl_xor(q, 32);
                if (fq == 0) ss[(size_t)row * 16 + u.pn * 4 + wc] = q;
                asm volatile("" ::: "memory");
            }
    }
};
struct EpiUp {
    static constexpr bool PERM = true, AFTER_DRAIN = false;
    bf16_t* A; const float* ss;
    __device__ __forceinline__ void operator()(const f32x4 (&acc)[2][2][4][2], const Unit& u, int wr, int wc, int fr, int fq) const {
#pragma unroll
        for (int ai = 0; ai < 2; ++ai)
#pragma unroll
            for (int m = 0; m < 4; ++m) {
                const int row = u.pm * BM + ai * HALF + wr * 64 + m * 16 + fr;
                const float rs = row_rs(ss, row);
#pragma unroll
                for (int bj = 0; bj < 2; ++bj) {
                    const int col = u.pn * BM + bj * HALF + wc * 32 + 8 * fq;
                    *(u32x4*)(A + (size_t)row * 5632 + col) = pack8(acc[ai][bj][m][0] * rs, acc[ai][bj][m][1] * rs);
                }
                asm volatile("" ::: "memory");
            }
    }
};

template <class Epi, class Sched, bool ALIGN_EPI = false, bool SP2 = false>
__device__ __forceinline__ void gemm_phase(PG8_LAS unsigned char* lds, const Gemm g, const Sched& S, const Epi& E, const int tid) {
    const int wid = __builtin_amdgcn_readfirstlane(tid >> 6), lane = tid & 63, wr = wid >> 2, wc = wid & 3, fr = lane & 15, fq = lane >> 4;
    const int K = g.K, nt = K / BK;
    unsigned voffA[2], voffB[2];
#pragma unroll
    for (int i = 0; i < 2; ++i) { int R, C; stage_rc(tid * 16 + i * 8192, R, C); const int Rb = Epi::PERM ? ((R & ~31) + perm32(R & 31)) : R;
        voffA[i] = (unsigned)(R * K + C) * 2u; voffB[i] = (unsigned)(Rb * K + C) * 2u; }
    const size_t kstep = (size_t)(BK * 2);
    const size_t hstep = (size_t)HALF * K * 2;
    const size_t tstep = 2 * hstep;
    const unsigned ldsw = (unsigned)wid * 1024u;
    const int aoff = lds_byte(wr * 64 + fr, fq * 8), boff = lds_byte(wc * 32 + fr, fq * 8);
#define PG8_SA(b, h) (((b) * 2 + (h)) * HTB)
#define PG8_SB(b, h) ((4 + (b) * 2 + (h)) * HTB)
#define PG8_STAGE(bufoff, gbase, voff) do { _Pragma("unroll") for (int _i = 0; _i < 2; ++_i) \
        __builtin_amdgcn_global_load_lds((const unsigned*)((const char*)(gbase) + (voff)[_i]), (PG8_LAS unsigned*)(lds + (bufoff) + ldsw + _i * 8192), 16, 0, 0); } while (0)
#define PG8_LDA(dst, b, h) do { _Pragma("unroll") for (int m = 0; m < 4; ++m) _Pragma("unroll") for (int k = 0; k < 2; ++k) dst[m][k] = *(const PG8_LAS bf16x8*)(lds + PG8_SA(b, h) + aoff + m * 2048 + k * 1024); } while (0)
#define PG8_LDB(dst, b, h) do { _Pragma("unroll") for (int n = 0; n < 2; ++n) _Pragma("unroll") for (int k = 0; k < 2; ++k) dst[n][k] = *(const PG8_LAS bf16x8*)(lds + PG8_SB(b, h) + boff + n * 2048 + k * 1024); } while (0)
#define PG8_MMA(ai, bj, At, Bt) do { __builtin_amdgcn_s_setprio(1); _Pragma("unroll") for (int m = 0; m < 4; ++m) _Pragma("unroll") for (int n = 0; n < 2; ++n) _Pragma("unroll") for (int k = 0; k < 2; ++k) \
        acc[ai][bj][m][n] = __builtin_amdgcn_mfma_f32_16x16x32_bf16(Bt[n][k], At[m][k], acc[ai][bj][m][n], 0, 0, 0); __builtin_amdgcn_s_setprio(0); } while (0)
#define PG8_WAIT_V(n) asm volatile("s_waitcnt vmcnt(" #n ")" ::: "memory")
#define PG8_WAIT_L(n) asm volatile("s_waitcnt lgkmcnt(" #n ")" ::: "memory")
#define PG8_BAR __builtin_amdgcn_s_barrier()
#define PG8_SCHED __builtin_amdgcn_sched_barrier(0)
    Unit cur, nxt; int ui = 0;
    if (!S.next(0, cur)) return;
    f32x4 acc[2][2][4][2];
#pragma unroll
    for (int a = 0; a < 2; ++a)
#pragma unroll
        for (int b = 0; b < 2; ++b)
#pragma unroll
            for (int m = 0; m < 4; ++m)
#pragma unroll
                for (int n = 0; n < 2; ++n) acc[a][b][m][n] = (f32x4){0.f, 0.f, 0.f, 0.f};
    bf16x8 At[4][2], B0[2][2], B1[2][2];
    const char* cA = (const char*)g.A + (size_t)cur.pm * tstep; const char* cB = (const char*)g.Bt + (size_t)cur.pn * tstep;
    S.a_ready(cur);
    if constexpr (SP2) {
        PG8_STAGE(PG8_SB(0, 0), cB, voffB); PG8_STAGE(PG8_SB(0, 1), cB + hstep, voffB); PG8_STAGE(PG8_SA(0, 0), cA, voffA); PG8_STAGE(PG8_SA(0, 1), cA + hstep, voffA);
        if (wr == 1) PG8_BAR;
        PG8_WAIT_V(2); PG8_BAR;
        PG8_STAGE(PG8_SB(1, 0), cB + kstep, voffB); PG8_STAGE(PG8_SA(1, 0), cA + kstep, voffA); PG8_STAGE(PG8_SB(1, 1), cB + hstep + kstep, voffB);
        PG8_WAIT_V(6); PG8_BAR;
    } else {
        PG8_STAGE(PG8_SB(0, 0), cB, voffB); PG8_STAGE(PG8_SA(0, 0), cA, voffA); PG8_STAGE(PG8_SB(0, 1), cB + hstep, voffB); PG8_STAGE(PG8_SA(0, 1), cA + hstep, voffA);
        if (wr == 1) PG8_BAR;
        PG8_WAIT_V(4); PG8_BAR;
        PG8_STAGE(PG8_SB(1, 0), cB + kstep, voffB); PG8_STAGE(PG8_SA(1, 0), cA + kstep, voffA); PG8_STAGE(PG8_SB(1, 1), cB + hstep + kstep, voffB);
        PG8_WAIT_V(6); PG8_BAR;
    }
    for (;;) {
        const bool has_next = S.next(ui + 1, nxt);
        const char* nA = has_next ? (const char*)g.A + (size_t)nxt.pm * tstep : cA; const char* nB = has_next ? (const char*)g.Bt + (size_t)nxt.pn * tstep : cB;
        for (int t = 0; t < nt; t += 2) {
            const bool last = (t == nt - 2);
            const char* a1 = cA + (size_t)(t + 1) * kstep;
            const char* a2 = last ? nA : cA + (size_t)(t + 2) * kstep; const char* b2 = last ? nB : cB + (size_t)(t + 2) * kstep;
            const char* a3 = a2 + kstep; const char* b3 = b2 + kstep;
            if (last && has_next) S.a_ready(nxt);
            if constexpr (SP2) {
            PG8_LDB(B0, 0, 0); PG8_LDB(B1, 0, 1); PG8_SCHED; PG8_LDA(At, 0, 0); PG8_STAGE(PG8_SA(1, 1), a1 + hstep, voffA);
            PG8_WAIT_V(8); PG8_WAIT_L(0); PG8_BAR; PG8_MMA(0, 0, At, B0); PG8_MMA(0, 1, At, B1); PG8_BAR; PG8_SCHED;
            PG8_LDA(At, 0, 1); PG8_STAGE(PG8_SB(0, 0), b2, voffB); PG8_STAGE(PG8_SB(0, 1), b2 + hstep, voffB); PG8_STAGE(PG8_SA(0, 0), a2, voffA);
            PG8_WAIT_V(8); PG8_WAIT_L(0); PG8_BAR; PG8_MMA(1, 0, At, B0); PG8_MMA(1, 1, At, B1); PG8_BAR; PG8_SCHED;
            PG8_LDB(B0, 1, 0); PG8_LDB(B1, 1, 1); PG8_SCHED; PG8_LDA(At, 1, 0); PG8_STAGE(PG8_SA(0, 1), a2 + hstep, voffA);
            PG8_WAIT_V(8); PG8_WAIT_L(0); PG8_BAR; PG8_MMA(0, 0, At, B0); PG8_MMA(0, 1, At, B1); PG8_BAR; PG8_SCHED;
            PG8_LDA(At, 1, 1); PG8_STAGE(PG8_SB(1, 0), b3, voffB); PG8_STAGE(PG8_SB(1, 1), b3 + hstep, voffB); PG8_STAGE(PG8_SA(1, 0), a3, voffA);
            PG8_WAIT_V(8); PG8_WAIT_L(0); PG8_BAR; PG8_MMA(1, 0, At, B0); PG8_MMA(1, 1, At, B1); PG8_BAR; PG8_SCHED;
            } else {
            PG8_LDB(B0, 0, 0); PG8_SCHED; PG8_LDA(At, 0, 0); PG8_STAGE(PG8_SA(1, 1), a1 + hstep, voffA);
            PG8_WAIT_L(8); PG8_BAR; PG8_WAIT_L(0); PG8_MMA(0, 0, At, B0); PG8_BAR; PG8_SCHED;
            PG8_LDB(B1, 0, 1); PG8_STAGE(PG8_SB(0, 0), b2, voffB);
            PG8_BAR; PG8_WAIT_L(0); PG8_MMA(0, 1, At, B1); PG8_BAR;
            PG8_LDA(At, 0, 1); PG8_STAGE(PG8_SA(0, 0), a2, voffA);
            PG8_BAR; PG8_WAIT_L(0); PG8_MMA(1, 0, At, B0); PG8_BAR; PG8_SCHED;
            PG8_STAGE(PG8_SB(0, 1), b2 + hstep, voffB);
            PG8_WAIT_V(6); PG8_BAR; PG8_MMA(1, 1, At, B1); PG8_BAR;
            PG8_LDB(B0, 1, 0); PG8_SCHED; PG8_LDA(At, 1, 0); PG8_STAGE(PG8_SA(0, 1), a2 + hstep, voffA);
            PG8_WAIT_L(8); PG8_BAR; PG8_WAIT_L(0); PG8_MMA(0, 0, At, B0); PG8_BAR; PG8_SCHED;
            PG8_LDB(B1, 1, 1); PG8_STAGE(PG8_SB(1, 0), b3, voffB);
            PG8_BAR; PG8_WAIT_L(0); PG8_MMA(0, 1, At, B1); PG8_BAR;
            PG8_LDA(At, 1, 1); PG8_STAGE(PG8_SA(1, 0), a3, voffA);
            PG8_BAR; PG8_WAIT_L(0); PG8_MMA(1, 0, At, B0); PG8_BAR; PG8_SCHED;
            PG8_STAGE(PG8_SB(1, 1), b3 + hstep, voffB);
            PG8_WAIT_V(6); PG8_BAR; PG8_MMA(1, 1, At, B1); PG8_BAR;
            }
        }
        if constexpr (ALIGN_EPI) { if (wr == 0) PG8_BAR; }
        if constexpr (!Epi::AFTER_DRAIN) { E(acc, cur, wr, wc, fr, fq); S.done(cur); }
        if (!has_next) break;
#pragma unroll
        for (int a = 0; a < 2; ++a)
#pragma unroll
            for (int b = 0; b < 2; ++b)
#pragma unroll
                for (int m = 0; m < 4; ++m)
#pragma unroll
                    for (int n = 0; n < 2; ++n) acc[a][b][m][n] = (f32x4){0.f, 0.f, 0.f, 0.f};
        cur = nxt; cA = nA; cB = nB; ++ui;
        if constexpr (ALIGN_EPI) { if (wr == 1) PG8_BAR; }
    }
    PG8_WAIT_V(0);
    if constexpr (!ALIGN_EPI) { if (wr == 0) PG8_BAR; }
    PG8_BAR;
    if constexpr (Epi::AFTER_DRAIN) { E.fused(acc, cur, wr, wc, fr, fq, lds, wid, lane); S.done(cur); }
#undef PG8_SA
#undef PG8_SB
#undef PG8_STAGE
#undef PG8_LDA
#undef PG8_LDB
#undef PG8_MMA
#undef PG8_WAIT_V
#undef PG8_WAIT_L
#undef PG8_BAR
#undef PG8_SCHED
}
}


#define LAS __attribute__((address_space(3)))
#ifndef SKIPMASK
#define SKIPMASK 0
#endif
#ifndef PROBE_KIND
#define PROBE_KIND -1
#endif
typedef unsigned short bf16;
using pg8::f32x4; using pg8::u32x4; using pg8::bf16x8;
typedef float f32x16 __attribute__((ext_vector_type(16)));
typedef short v4i16_t __attribute__((ext_vector_type(4)));
typedef unsigned u32x2 __attribute__((ext_vector_type(2)));

constexpr int DM = 1024, DEPTH = 4, NTOK = 98304, NPROMPT = 32768, CH = 32768, NCHUNK = NTOK / CH;
constexpr int NIN = 6400, DFF = 2816, NUP = 5632;
constexpr int LDS_BYTES = 147456, NTHR = 512;
constexpr float EPS = 1e-6f, LOG2E = 1.4426950408889634f;
constexpr size_t OFF_IN = 0, OFF_PA = OFF_IN + (size_t)NIN * DM, OFF_PB = OFF_PA + (size_t)DM * 256, OFF_OUT = OFF_PB + (size_t)DM * DM, OFF_UP = OFF_OUT + (size_t)DM * DM,
                 OFF_DN = OFF_UP + (size_t)NUP * DM, OFF_WS = OFF_DN + (size_t)DM * DFF, W_LAYER = OFF_WS + 8 * 128 * 128;
constexpr size_t MiB = 1u << 20;
constexpr size_t WS_W = 0, WS_R1 = 144 * MiB, WS_R2 = WS_R1 + (size_t)CH * 12800, WS_XB = WS_R2 + (size_t)CH * 5632, WS_SS = WS_XB + (size_t)CH * 2048, WS_SSV = WS_SS + (size_t)CH * 64, WS_BAR = WS_SSV + (size_t)CH * 64, WS_END = WS_BAR + 65536;
static_assert(W_LAYER * 2 * DEPTH <= WS_R1, "weights fit");
constexpr int KPL = (PROBE_KIND >= 0 && PROBE_KIND < 8) ? 9 : 8;
constexpr int PH_PER_CHUNK = 2 + KPL * DEPTH, N_PHASES = 1 + NCHUNK * PH_PER_CHUNK;

struct Args { const float* in[17]; float* out; unsigned char* ws; int ph_lo, ph_hi; };

__device__ __forceinline__ float wave_sum(float v) {
#pragma unroll
    for (int o = 1; o < 64; o <<= 1) v += __shfl_xor(v, o);
    return v;
}
__device__ __forceinline__ unsigned pk2(float lo, float hi) { return pg8::cvt_pk_bf16(lo, hi); }
#define LDS_WAIT() asm volatile("s_waitcnt lgkmcnt(0)" ::: "memory")

__device__ __forceinline__ void tr_item(const float* W, int K, int N, bf16* WT, const float* gain, LAS float* scr, int item, int lane) {
    const int nblk = N / 32, kb = item / nblk, nb = item % nblk, k0 = 64 * kb, n0 = 32 * nb;
#pragma unroll 8
    for (int i = 0; i < 32; ++i) { const int kk = 2 * i + (lane >> 5); const float g = gain ? gain[k0 + kk] : 1.0f; scr[kk * 33 + (lane & 31)] = W[(size_t)(k0 + kk) * N + n0 + (lane & 31)] * g; }
    LDS_WAIT();
    const int c = lane & 7;
#pragma unroll
    for (int j = 0; j < 4; ++j) { const int n = (lane >> 3) + 8 * j; const LAS float* s = scr + (8 * c) * 33 + n;
        u32x4 o; o.x = pk2(s[0 * 33], s[1 * 33]); o.y = pk2(s[2 * 33], s[3 * 33]); o.z = pk2(s[4 * 33], s[5 * 33]); o.w = pk2(s[6 * 33], s[7 * 33]);
        *(u32x4*)(WT + (size_t)(n0 + n) * K + k0 + 8 * c) = o; }
    LDS_WAIT();
}
__device__ __forceinline__ void p0_weights(const Args& a, LAS unsigned char* lds, int tid, int G, int bid) {
    const int wave = tid >> 6, lane = tid & 63;
    LAS float* scr = (LAS float*)(lds + wave * 16384);
    const int gw = bid * 8 + wave, NGW = G * 8;
    constexpr int I_IN = 16 * 200, I_PA = 4 * 32, I_PB = 16 * 32, I_OUT = 16 * 32, I_UP = 16 * 176, I_DN = 44 * 32, PER = I_IN + I_PA + I_PB + I_OUT + I_UP + I_DN;
    bf16* Wb = (bf16*)(a.ws + WS_W);
    for (int it = gw; it < DEPTH * PER; it += NGW) {
        const int l = it / PER; int r = it % PER; bf16* wl = Wb + (size_t)l * W_LAYER;
        if (r < I_IN) { tr_item(a.in[4] + (size_t)l * DM * NIN, DM, NIN, wl + OFF_IN, a.in[3] + l * DM, scr, r, lane); continue; } r -= I_IN;
        if (r < I_PA) { tr_item(a.in[8] + (size_t)l * 256 * DM, 256, DM, wl + OFF_PA, nullptr, scr, r, lane); continue; } r -= I_PA;
        if (r < I_PB) { tr_item(a.in[9] + (size_t)l * DM * DM, DM, DM, wl + OFF_PB, nullptr, scr, r, lane); continue; } r -= I_PB;
        if (r < I_OUT) { tr_item(a.in[10] + (size_t)l * DM * DM, DM, DM, wl + OFF_OUT, nullptr, scr, r, lane); continue; } r -= I_OUT;
        if (r < I_UP) { tr_item(a.in[12] + (size_t)l * DM * NUP, DM, NUP, wl + OFF_UP, a.in[11] + l * DM, scr, r, lane); continue; } r -= I_UP;
        tr_item(a.in[15] + (size_t)l * DFF * DM, DFF, DM, wl + OFF_DN, nullptr, scr, r, lane);
    }
    for (int i = bid * NTHR + tid; i < DEPTH * 131072 / 4; i += G * NTHR) {
        const int l = i / 32768, e = (i % 32768) * 4;
        const f32x4 v = *(const f32x4*)(a.in[6] + (size_t)l * 131072 + e);
        u32x2 o; o.x = pk2(v[0], v[1]); o.y = pk2(v[2], v[3]);
        *(u32x2*)(Wb + (size_t)l * W_LAYER + OFF_WS + e) = o;
    }
}
__device__ __forceinline__ void p0x(const Args& a, int chunk, int tid, int G, int bid) {
    const int wave = tid >> 6, lane = tid & 63, gw = bid * 8 + wave, NGW = G * 8;
    bf16* XB = (bf16*)(a.ws + WS_XB); float* SS = (float*)(a.ws + WS_SS);
    for (int m = gw; m < CH; m += NGW) {
        const size_t tok = (size_t)chunk * CH + m;
        const float* src = tok < NPROMPT ? a.in[0] + tok * DM : a.in[1] + (tok - NPROMPT) * DM;
        float* dst = a.out + tok * DM;
        float s = 0.f;
#pragma unroll
        for (int j = 0; j < 4; ++j) { const f32x4 v = *(const f32x4*)(src + (lane + 64 * j) * 4); s += (v[0] * v[0] + v[1] * v[1]) + (v[2] * v[2] + v[3] * v[3]);
            *(f32x4*)(dst + (lane + 64 * j) * 4) = v; u32x2 o; o.x = pk2(v[0], v[1]); o.y = pk2(v[2], v[3]); *(u32x2*)(XB + (size_t)m * DM + (lane + 64 * j) * 4) = o; }
        s = wave_sum(s);
        if (lane < 16) SS[(size_t)m * 16 + lane] = lane == 0 ? s : 0.f;
    }
}
__device__ __forceinline__ void pfinal(const Args& a, int chunk, int tid, int G, int bid) {
    const int wave = tid >> 6, lane = tid & 63, gw = bid * 8 + wave, NGW = G * 8;
    const float* SS = (const float*)(a.ws + WS_SS); const float* nf = a.in[16];
    for (int m = gw; m < CH; m += NGW) {
        float* x = a.out + ((size_t)chunk * CH + m) * DM;
        const float rs = pg8::row_rs(SS, m);
#pragma unroll
        for (int j = 0; j < 4; ++j) { const int c = (lane + 64 * j) * 4; const f32x4 v = *(const f32x4*)(x + c), g = *(const f32x4*)(nf + c); *(f32x4*)(x + c) = v * rs * g; }
    }
}
__device__ __forceinline__ int t5_bucket(int rel) {
    const int n = rel < 0 ? -rel : rel;
    const int b = n < 8 ? n : 8 + (n >= 15) + (n >= 27) + (n >= 50) + (n >= 91) + (n >= 166) + (n >= 305) + (n >= 559);
    return (rel > 0 ? 16 : 0) + b;
}
__device__ __forceinline__ void attn_unit(const bf16* QKV, bf16* OUTG, float* LSE, const float* rel_bias, LAS unsigned char* lds, int unit, int S, int tid) {
    const int wave = tid >> 6, lane = tid & 63;
    constexpr int upg = CH / 64;
    const int g = unit / upg, rem = unit % upg;
    const int ups = S / 64, seq = rem / ups, rem2 = rem % ups;
    const int d = 1 << (2 * g), L = S / d, nqb = L / 64, r = rem2 / nqb, qb = rem2 % nqb;
    const int tokbase = seq * S + r;
#pragma unroll
    for (int i = 0; i < 12; ++i) {
        const int idx = tid + i * NTHR, kk = idx >> 5, ch = idx & 31, lk = 64 * qb - 64 + kk;
        u32x4 v = (u32x4){0u, 0u, 0u, 0u};
        if (lk >= 0 && lk < L) v = *(const u32x4*)(QKV + (size_t)(tokbase + lk * d) * 2304 + 1536 + g * 256 + ch * 8);
        *(LAS u32x4*)(lds + kk * 576 + ch * 16) = v;
    }
    LAS float* bt = (LAS float*)(lds + 110592);
    for (int i = tid; i < 516; i += NTHR) { const int h = i / 129, j = i % 129 - 64; bt[i] = rel_bias[t5_bucket(j * d) * 12 + g * 4 + h]; }
    __syncthreads();
    const int h = wave & 3, qh = wave >> 2, n = lane & 31, hi = lane >> 5;
    const int qbase = 64 * qb + 32 * qh;
    const size_t tokq = (size_t)tokbase + (size_t)(qbase + n) * d;
    const bf16* qp = QKV + tokq * 2304 + g * 256 + h * 64 + 8 * hi;
    bf16x8 qf[4];
#pragma unroll
    for (int s = 0; s < 4; ++s) qf[s] = *(const bf16x8*)(qp + 16 * s);
    f32x16 st[5];
#pragma unroll
    for (int kt = 0; kt < 5; ++kt) {
        const int lk = qbase - 64 + 32 * kt + n, lkc = lk < 0 ? 0 : (lk > L - 1 ? L - 1 : lk);
        const bf16* kp = QKV + (size_t)(tokbase + lkc * d) * 2304 + 768 + g * 256 + h * 64 + 8 * hi;
        f32x16 acc;
#pragma unroll
        for (int e = 0; e < 16; ++e) acc[e] = 0.f;
#pragma unroll
        for (int s = 0; s < 4; ++s) acc = __builtin_amdgcn_mfma_f32_32x32x16_bf16(*(const bf16x8*)(kp + 16 * s), qf[s], acc, 0, 0, 0);
        st[kt] = acc;
    }
    float mx = -3.0e38f;
#pragma unroll
    for (int kt = 0; kt < 5; ++kt)
#pragma unroll
        for (int i = 0; i < 16; ++i) {
            const int m = (i & 3) + 8 * (i >> 2) + 4 * hi, j = 32 * kt + m - 64 - n, lk2 = qbase - 64 + 32 * kt + m;
            const bool ok = (j >= -64) && (j <= 64) && (lk2 >= 0) && (lk2 < L);
            const int jc = j < -64 ? -64 : (j > 64 ? 64 : j);
            const float sv = ok ? st[kt][i] + bt[h * 129 + jc + 64] : -1e30f;
            st[kt][i] = sv; mx = fmaxf(mx, sv);
        }
    mx = fmaxf(mx, __shfl_xor(mx, 32));
    float sum = 0.f;
#pragma unroll
    for (int kt = 0; kt < 5; ++kt)
#pragma unroll
        for (int i = 0; i < 16; ++i) { const float p = __builtin_amdgcn_exp2f((st[kt][i] - mx) * LOG2E); st[kt][i] = p; sum += p; }
    sum += __shfl_xor(sum, 32);
    const float inv = 1.0f / sum, lse = mx + __logf(sum);
    f32x16 o0, o1;
#pragma unroll
    for (int e = 0; e < 16; ++e) { o0[e] = 0.f; o1[e] = 0.f; }
    const int q4 = (lane & 15) >> 2, p4 = lane & 3, gsel = (lane >> 4) & 1;
    const unsigned vbase = (unsigned)((32 * qh + 4 * hi + q4) * 576 + h * 128 + (16 * gsel + 4 * p4) * 2);
#pragma unroll
    for (int kt = 0; kt < 5; ++kt)
#pragma unroll
        for (int s2 = 0; s2 < 2; ++s2) {
            u32x4 pw; pw.x = pk2(st[kt][8 * s2 + 0], st[kt][8 * s2 + 1]); pw.y = pk2(st[kt][8 * s2 + 2], st[kt][8 * s2 + 3]); pw.z = pk2(st[kt][8 * s2 + 4], st[kt][8 * s2 + 5]); pw.w = pk2(st[kt][8 * s2 + 6], st[kt][8 * s2 + 7]);
            const bf16x8 pf = __builtin_bit_cast(bf16x8, pw);
            const unsigned ro = vbase + (unsigned)((32 * kt + 16 * s2) * 576);
            {
                const v4i16_t r1 = __builtin_amdgcn_ds_read_tr16_b64_v4i16((LAS v4i16_t*)(lds + ro)), r2 = __builtin_amdgcn_ds_read_tr16_b64_v4i16((LAS v4i16_t*)(lds + ro + 8 * 576));
                const bf16x8 vf = (bf16x8){r1[0], r1[1], r1[2], r1[3], r2[0], r2[1], r2[2], r2[3]};
                o0 = __builtin_amdgcn_mfma_f32_32x32x16_bf16(vf, pf, o0, 0, 0, 0);
            }
            {
                const v4i16_t r1 = __builtin_amdgcn_ds_read_tr16_b64_v4i16((LAS v4i16_t*)(lds + ro + 64)), r2 = __builtin_amdgcn_ds_read_tr16_b64_v4i16((LAS v4i16_t*)(lds + ro + 64 + 8 * 576));
                const bf16x8 vf = (bf16x8){r1[0], r1[1], r1[2], r1[3], r2[0], r2[1], r2[2], r2[3]};
                o1 = __builtin_amdgcn_mfma_f32_32x32x16_bf16(vf, pf, o1, 0, 0, 0);
            }
        }
    bf16* op = OUTG + ((size_t)g * CH + tokq) * 256 + h * 64;
#pragma unroll
    for (int grp = 0; grp < 4; ++grp) {
        u32x2 w0, w1;
        w0.x = pk2(o0[4 * grp + 0] * inv, o0[4 * grp + 1] * inv); w0.y = pk2(o0[4 * grp + 2] * inv, o0[4 * grp + 3] * inv);
        w1.x = pk2(o1[4 * grp + 0] * inv, o1[4 * grp + 1] * inv); w1.y = pk2(o1[4 * grp + 2] * inv, o1[4 * grp + 3] * inv);
        *(u32x2*)(op + 8 * grp + 4 * hi) = w0; *(u32x2*)(op + 32 + 8 * grp + 4 * hi) = w1;
    }
    if (hi == 0) LSE[((size_t)g * CH + tokq) * 4 + h] = lse;
    __syncthreads();
}
__device__ __forceinline__ void sg_unit(bf16* U, const bf16* GV, const float* ssv, const bf16* WSb, const float* gain, const float* bs, LAS unsigned char* lds, int unit, int tid) {
    const int wave = tid >> 6, lane = tid & 63;
    const int nch = unit >> 3, gg = unit & 7, tok0 = nch * 128;
    LAS float* rv = (LAS float*)lds;
    if (tid < 128) rv[tid] = pg8::row_rs(ssv, tok0 + tid);
    __syncthreads();
    for (int it = tid; it < 1024; it += NTHR) {
        const int cc = it & 15, q = (it >> 4) * 2;
        f32x4 a0, a1, b0, b1;
        pg8::unpack8(*(const u32x4*)(GV + (size_t)(tok0 + q) * 1024 + gg * 128 + cc * 8), a0, a1);
        pg8::unpack8(*(const u32x4*)(GV + (size_t)(tok0 + q + 1) * 1024 + gg * 128 + cc * 8), b0, b1);
        const float r0 = rv[q], r1 = rv[q + 1];
#pragma unroll
        for (int e = 0; e < 4; ++e) {
            *(LAS unsigned*)(lds + 1024 + (cc * 8 + e) * 272 + q * 2) = pk2(a0[e] * r0, b0[e] * r1);
            *(LAS unsigned*)(lds + 1024 + (cc * 8 + 4 + e) * 272 + q * 2) = pk2(a1[e] * r0, b1[e] * r1);
        }
    }
    __syncthreads();
    const int ln = lane & 15, kq = lane >> 4;
    bf16x8 bfr[4];
#pragma unroll
    for (int ks = 0; ks < 4; ++ks) bfr[ks] = *(const bf16x8*)(WSb + (size_t)gg * 16384 + (wave * 16 + ln) * 128 + 32 * ks + 8 * kq);
    f32x4 acc[8];
#pragma unroll
    for (int ct = 0; ct < 8; ++ct) {
        acc[ct] = (f32x4){0.f, 0.f, 0.f, 0.f};
#pragma unroll
        for (int ks = 0; ks < 4; ++ks) {
            const bf16x8 af = *(const LAS bf16x8*)(lds + 1024 + (ct * 16 + ln) * 272 + (32 * ks + 8 * kq) * 2);
            acc[ct] = __builtin_amdgcn_mfma_f32_16x16x32_bf16(af, bfr[ks], acc[ct], 0, 0, 0);
        }
    }
    const int tok = tok0 + wave * 16 + ln;
    const float bias = bs[gg * 128 + wave * 16 + ln];
#pragma unroll
    for (int ct = 0; ct < 8; ++ct) {
        const int chn = gg * 128 + ct * 16 + kq * 4;
        const f32x4 gn = *(const f32x4*)(gain + chn);
        bf16* up = U + (size_t)tok * 1024 + chn;
        const u32x2 uw = *(const u32x2*)up;
        const float u0 = __uint_as_float(uw.x << 16), u1 = __uint_as_float(uw.x & 0xffff0000u), u2 = __uint_as_float(uw.y << 16), u3 = __uint_as_float(uw.y & 0xffff0000u);
        u32x2 o; o.x = pk2(u0 * (gn[0] * acc[ct][0] + bias), u1 * (gn[1] * acc[ct][1] + bias)); o.y = pk2(u2 * (gn[2] * acc[ct][2] + bias), u3 * (gn[3] * acc[ct][3] + bias));
        *(u32x2*)up = o;
    }
    __syncthreads();
}
__device__ __forceinline__ void p_merge(const bf16* OUTG, const float* LSE, bf16* OA, int tid, int G, int bid) {
    for (int it = bid * NTHR + tid; it < CH * 32; it += G * NTHR) {
        const int tok = it >> 5, c8 = it & 31, h = c8 >> 3;
        const float l0 = LSE[(size_t)tok * 4 + h], l1 = LSE[((size_t)CH + tok) * 4 + h], l2 = LSE[((size_t)2 * CH + tok) * 4 + h];
        const float mx = fmaxf(l0, fmaxf(l1, l2));
        float w0 = __expf(l0 - mx), w1 = __expf(l1 - mx), w2 = __expf(l2 - mx);
        const float inv = 1.0f / (w0 + w1 + w2); w0 *= inv; w1 *= inv; w2 *= inv;
        f32x4 a0, a1, b0, b1, c0, c1;
        pg8::unpack8(*(const u32x4*)(OUTG + (size_t)tok * 256 + c8 * 8), a0, a1);
        pg8::unpack8(*(const u32x4*)(OUTG + ((size_t)CH + tok) * 256 + c8 * 8), b0, b1);
        pg8::unpack8(*(const u32x4*)(OUTG + ((size_t)2 * CH + tok) * 256 + c8 * 8), c0, c1);
        *(u32x4*)(OA + (size_t)tok * 256 + c8 * 8) = pg8::pack8(a0 * w0 + b0 * w1 + c0 * w2, a1 * w0 + b1 * w1 + c1 * w2);
    }
}
__device__ __forceinline__ void p_conv(const bf16* A, bf16* FG, const float* cw, const float* cb, int S, int tid, int G, int bid) {
    constexpr int RUN = 8, NFC = DFF / 8;
    for (int it = bid * NTHR + tid; it < (CH / RUN) * NFC; it += G * NTHR) {
        const int fc = it % NFC, t0 = (it / NFC) * RUN, f = fc * 8;
        f32x4 wg[3][2], wv[3][2], bg[2], bv[2];
#pragma unroll
        for (int k = 0; k < 3; ++k) { wg[k][0] = *(const f32x4*)(cw + k * NUP + f); wg[k][1] = *(const f32x4*)(cw + k * NUP + f + 4); wv[k][0] = *(const f32x4*)(cw + k * NUP + DFF + f); wv[k][1] = *(const f32x4*)(cw + k * NUP + DFF + f + 4); }
        bg[0] = *(const f32x4*)(cb + f); bg[1] = *(const f32x4*)(cb + f + 4); bv[0] = *(const f32x4*)(cb + DFF + f); bv[1] = *(const f32x4*)(cb + DFF + f + 4);
        const f32x4 z4 = (f32x4){0.f, 0.f, 0.f, 0.f};
        f32x4 pg0 = z4, pg1 = z4, pv0 = z4, pv1 = z4, cg0, cg1, cv0, cv1;
        if ((t0 & (S - 1)) != 0) { pg8::unpack8(*(const u32x4*)(A + (size_t)(t0 - 1) * NUP + f), pg0, pg1); pg8::unpack8(*(const u32x4*)(A + (size_t)(t0 - 1) * NUP + DFF + f), pv0, pv1); }
        pg8::unpack8(*(const u32x4*)(A + (size_t)t0 * NUP + f), cg0, cg1); pg8::unpack8(*(const u32x4*)(A + (size_t)t0 * NUP + DFF + f), cv0, cv1);
#pragma unroll
        for (int i = 0; i < RUN; ++i) {
            const int t = t0 + i;
            f32x4 ng0 = z4, ng1 = z4, nv0 = z4, nv1 = z4;
            if (((t + 1) & (S - 1)) != 0) { pg8::unpack8(*(const u32x4*)(A + (size_t)(t + 1) * NUP + f), ng0, ng1); pg8::unpack8(*(const u32x4*)(A + (size_t)(t + 1) * NUP + DFF + f), nv0, nv1); }
            f32x4 g0 = pg0 * wg[0][0] + cg0 * wg[1][0] + ng0 * wg[2][0] + bg[0], g1 = pg1 * wg[0][1] + cg1 * wg[1][1] + ng1 * wg[2][1] + bg[1];
            const f32x4 v0 = pv0 * wv[0][0] + cv0 * wv[1][0] + nv0 * wv[2][0] + bv[0], v1 = pv1 * wv[0][1] + cv1 * wv[1][1] + nv1 * wv[2][1] + bv[1];
#pragma unroll
            for (int e = 0; e < 4; ++e) { g0[e] = pg8::gelu_tanh(g0[e]) * v0[e]; g1[e] = pg8::gelu_tanh(g1[e]) * v1[e]; }
            *(u32x4*)(FG + (size_t)t * DFF + f) = pg8::pack8(g0, g1);
            pg0 = cg0; pg1 = cg1; pv0 = cv0; pv1 = cv1; cg0 = ng0; cg1 = ng1; cv0 = nv0; cv1 = nv1;
        }
    }
}

#define XB_TMO      128
#define XB_XCNT(j)  (256  + 64 * (j))
#define XB_XSUB(j)  (1280 + 64 * (j))
#define XB_XGEN(j)  (2304 + 64 * (j))
#define XB_TOP      3328
#define XB_TOPGEN   3392
#define XCD_BAR_WORDS 3456
#define XB_SPIN_CAP (1u << 18)

__device__ __forceinline__ unsigned xb_ld(unsigned* p)              { return __hip_atomic_load(p, __ATOMIC_RELAXED, __HIP_MEMORY_SCOPE_AGENT); }
__device__ __forceinline__ unsigned xb_add(unsigned* p, unsigned v) { return __hip_atomic_fetch_add(p, v, __ATOMIC_RELAXED, __HIP_MEMORY_SCOPE_AGENT); }
__device__ __forceinline__ unsigned xb_xcc_id() { return (unsigned)__builtin_amdgcn_s_getreg((3 << 11) | 20) & 0xFu; }
#define XB_SPIN(cond, bar) do { unsigned _sp = 0; while (cond) { __builtin_amdgcn_s_sleep(1); \
    if ((++_sp & 255u) == 0u) { if (xb_ld(&(bar)[XB_TMO])) break; if (_sp > XB_SPIN_CAP) { atomicAdd(&(bar)[XB_TMO], 1u); break; } } } } while (0)

struct XcdBarrier {
    unsigned* bar; unsigned x;
    volatile LAS unsigned* st;
};

__device__ __forceinline__ XcdBarrier xcd_barrier_post(unsigned* bar, volatile LAS unsigned* st, const int tid) {
    XcdBarrier b; b.bar = bar; b.x = xb_xcc_id(); b.st = st;
    if (tid == 0) (void)xb_add(&bar[XB_XCNT(b.x)], 1u);
    return b;
}
__device__ __forceinline__ void xcd_barrier_complete(unsigned* bar, unsigned x, unsigned& nloc, unsigned& nx) {
    const unsigned G = gridDim.x * gridDim.y * gridDim.z;
    unsigned sum, cnt, mine, sp = 0u;
    for (;;) {
        sum = 0u; cnt = 0u; mine = 0u;
#pragma unroll
        for (unsigned j = 0; j < 16; ++j) { const unsigned c = xb_ld(&bar[XB_XCNT(j)]); sum += c; cnt += (c > 0u) ? 1u : 0u; mine = (j == x) ? c : mine; }
        if (sum == G) break;
        __builtin_amdgcn_s_sleep(1);
        if ((++sp & 255u) == 0u) { if (xb_ld(&bar[XB_TMO])) break; if (sp > XB_SPIN_CAP) { atomicAdd(&bar[XB_TMO], 1u); break; } }
    }
    nloc = mine > 0u ? mine : 1u; nx = cnt > 0u ? cnt : 1u;
}

__device__ __forceinline__ void xcd_barrier(const XcdBarrier& b, const int tid) {
    asm volatile("s_waitcnt vmcnt(0)" ::: "memory");
    __syncthreads();
    if (tid == 0) {
        unsigned* bar = b.bar;
        __builtin_amdgcn_s_waitcnt(0);
        unsigned nloc = b.st[0], nx = b.st[1];
        if (nloc == 0u) { xcd_barrier_complete(bar, b.x, nloc, nx); b.st[0] = nloc; b.st[1] = nx; }
        const unsigned old = xb_add(&bar[XB_XSUB(b.x)], 1u);
        const unsigned gen = old / nloc;
        if (old + 1u == (gen + 1u) * nloc) {
            __builtin_amdgcn_fence(__ATOMIC_RELEASE, "agent");
            asm volatile("s_waitcnt vmcnt(0)" ::: "memory");
            const unsigned og = xb_add(&bar[XB_TOP], 1u);
            const unsigned tg = og / nx;
            if (og + 1u == (tg + 1u) * nx) xb_add(&bar[XB_TOPGEN], 1u);
            else XB_SPIN(xb_ld(&bar[XB_TOPGEN]) == tg, bar);
            __builtin_amdgcn_fence(__ATOMIC_ACQUIRE, "agent");
            xb_add(&bar[XB_XGEN(b.x)], 1u);
            asm volatile("s_waitcnt vmcnt(0)" ::: "memory");
        } else {
            XB_SPIN(xb_ld(&bar[XB_XGEN(b.x)]) == gen, bar);
            __builtin_amdgcn_fence(__ATOMIC_ACQUIRE, "agent");
            asm volatile("s_waitcnt vmcnt(0)" ::: "memory");
        }
    }
    __syncthreads();
}


__global__ void __launch_bounds__(NTHR, 2) fwd_kernel(Args a_in) {
    extern __shared__ __attribute__((aligned(16))) unsigned char lds_raw[];
    LAS unsigned char* lds = (LAS unsigned char*)lds_raw;
    cg::grid_group grid = cg::this_grid();
    const int ph_lo = a_in.ph_lo, ph_hi = a_in.ph_hi;
    volatile LAS unsigned* xst = (volatile LAS unsigned*)(lds + 139264);
    if (threadIdx.x < 2) xst[threadIdx.x] = 0u;
    __syncthreads();
    const unsigned xcc = xcd_barrier_post((unsigned*)(a_in.ws + WS_BAR), xst, (int)threadIdx.x).x;
    for (int ph = ph_lo; ph < ph_hi; ++ph) {
#if defined(__HIP_DEVICE_COMPILE__)
        typedef const __attribute__((address_space(4))) unsigned long long* cu64p4;
        cu64p4 ap = (cu64p4)__builtin_amdgcn_kernarg_segment_ptr();
        asm volatile("" : "+s"(ap));
        Args a;
#pragma unroll
        for (int i = 0; i < 17; ++i) a.in[i] = (const float*)ap[i];
        a.out = (float*)ap[17]; a.ws = (unsigned char*)ap[18]; a.ph_lo = ph_lo; a.ph_hi = ph_hi;
#else
        const Args a = a_in;
#endif
        int tid = threadIdx.x, G = gridDim.x, bid = blockIdx.x;
        asm volatile("" : "+v"(tid)); asm volatile("" : "+s"(G)); asm volatile("" : "+s"(bid));
        unsigned char* ws = a.ws;
        bf16* Wb = (bf16*)(ws + WS_W);
        bf16* QKV = (bf16*)(ws + WS_R1); bf16* U = QKV + (size_t)CH * 2304; bf16* GV = U + (size_t)CH * 1024; bf16* GT = GV + (size_t)CH * 1024;
        bf16* AF = (bf16*)(ws + WS_R1);
        bf16* MG = GV;
        bf16* OUTG = (bf16*)(ws + WS_R2); bf16* OA = OUTG + (size_t)3 * CH * 256; float* LSE = (float*)(OA + (size_t)CH * 256);
        bf16* FG = (bf16*)(ws + WS_R2);
        bf16* XB = (bf16*)(ws + WS_XB); float* SS = (float*)(ws + WS_SS); float* SSV = (float*)(ws + WS_SSV);
        if (ph == 0 && !(SKIPMASK & 256)) p0_weights(a, lds, tid, G, bid);
        else {
            const int chunk = (ph - 1) / PH_PER_CHUNK, sub = (ph - 1) % PH_PER_CHUNK;
            const int S = chunk == 0 ? 8192 : 2048;
            if (sub == 0 && !(SKIPMASK & 512)) p0x(a, chunk, tid, G, bid);
            else if (sub == PH_PER_CHUNK - 1) pfinal(a, chunk, tid, G, bid);
            else {
                const int l = (sub - 1) / KPL, ki = (sub - 1) % KPL, k = (KPL == 9 && ki > PROBE_KIND) ? ki - 1 : ki; const bool dup = (KPL == 9 && ki == PROBE_KIND + 1);
                const bf16* wl = Wb + (size_t)l * W_LAYER;
                float* X = a.out + (size_t)chunk * CH * DM;
                if (k == 0 && !(SKIPMASK & 1)) {
                    pg8::Gemm g{XB, wl + OFF_IN, CH, NIN, DM}; pg8::StaticOrder So; So.init(CH, NIN, G, bid);
                    pg8::EpiIn E{QKV, U, GV, GT, SS, SSV};
                    pg8::gemm_phase<pg8::EpiIn, pg8::StaticOrder, true, true>(lds, g, So, E, tid);
                } else if (k == 1 && !(SKIPMASK & 2)) {
                    constexpr int NATT = 3 * (CH / 64), NSG = (CH / 128) * 8;
                    for (int it = bid; it < NATT + NSG; it += G) {
                        if (it < NATT) { if (!(SKIPMASK & 1024)) attn_unit(QKV, OUTG, LSE, a.in[2], lds, it, S, tid);
                        } else if (!(SKIPMASK & 2048) && !dup) sg_unit(U, GV, SSV, wl + OFF_WS, a.in[5] + l * 1024, a.in[7] + l * 1024, lds, it - NATT, tid);
                    }
                } else if (k == 2 && !(SKIPMASK & 4)) p_merge(OUTG, LSE, OA, tid, G, bid);
                else if (k == 3 && !(SKIPMASK & 8)) {
                    if (!(SKIPMASK & 4096)) { int kpa = 256; asm volatile("" : "+s"(kpa)); pg8::Gemm g{OA, wl + OFF_PA, CH, DM, kpa}; pg8::StaticOrder So; So.init(CH, DM, G, bid);
                      pg8::EpiGate<0> E{MG, GT, 0};
                      pg8::gemm_phase<pg8::EpiGate<0>, pg8::StaticOrder, true, true>(lds, g, So, E, tid); }
                    if (!(SKIPMASK & 8192)) { pg8::Gemm g{U, wl + OFF_PB, CH, DM, DM}; pg8::StaticOrder So; So.init(CH, DM, G, bid);
                      pg8::EpiGate<1> E{MG, GT, 1024};
                      pg8::gemm_phase<pg8::EpiGate<1>, pg8::StaticOrder, true, true>(lds, g, So, E, tid); }
                } else if (k == 4 && !(SKIPMASK & 16)) {
                    pg8::Gemm g{MG, wl + OFF_OUT, CH, DM, DM}; pg8::StaticOrder So; So.init(CH, DM, G, bid);
                    pg8::EpiRes E{X, XB, SS};
                    pg8::gemm_phase<pg8::EpiRes, pg8::StaticOrder, true, true>(lds, g, So, E, tid);
                } else if (k == 5 && !(SKIPMASK & 32)) {
                    pg8::Gemm g{XB, wl + OFF_UP, CH, NUP, DM}; pg8::StaticOrder So; So.init(CH, NUP, G, bid);
                    pg8::EpiUp E{AF, SS};
                    pg8::gemm_phase<pg8::EpiUp, pg8::StaticOrder, true, true>(lds, g, So, E, tid);
                } else if (k == 6 && !(SKIPMASK & 64)) p_conv(AF, FG, a.in[13] + (size_t)l * 3 * NUP, a.in[14] + (size_t)l * NUP, S, tid, G, bid);
                else if (!(SKIPMASK & 128)) {
                    pg8::Gemm g{FG, wl + OFF_DN, CH, DM, DFF}; pg8::StaticOrder So; So.init(CH, DM, G, bid);
                    pg8::EpiRes E{X, XB, SS};
                    pg8::gemm_phase<pg8::EpiRes, pg8::StaticOrder, true, true>(lds, g, So, E, tid);
                }
            }
        }
        if (ph + 1 < ph_hi) {
            if (ph == ph_lo) grid.sync();
            XcdBarrier xb; xb.bar = (unsigned*)(a.ws + WS_BAR); xb.x = xcc; xb.st = xst;
            xcd_barrier(xb, tid);
            if (PROBE_KIND == 100) xcd_barrier(xb, tid);
        }
    }
}

extern "C" void kernel_launch(void* const* d_in, const int* in_sizes, int n_in, void* d_out, int out_size, void* d_ws, size_t ws_size, hipStream_t stream) {
    static int grid = 0;
    if (grid == 0) {
        if (n_in != 17 || out_size != NTOK * DM || ws_size < WS_END) { fprintf(stderr, "kernel_launch: unexpected shapes: n_in %d out %d ws %zu (need %zu)\n", n_in, out_size, ws_size, (size_t)WS_END); grid = -1; return; }
        int dev = 0, cus = 0, per_cu = 0;
        (void)hipGetDevice(&dev); (void)hipDeviceGetAttribute(&cus, hipDeviceAttributeMultiprocessorCount, dev);
        if (hipFuncSetAttribute((const void*)fwd_kernel, hipFuncAttributeMaxDynamicSharedMemorySize, LDS_BYTES) != hipSuccess) { fprintf(stderr, "kernel_launch: hipFuncSetAttribute failed\n"); grid = -1; return; }
        if (hipOccupancyMaxActiveBlocksPerMultiprocessor(&per_cu, (const void*)fwd_kernel, NTHR, LDS_BYTES) != hipSuccess || per_cu < 1) { fprintf(stderr, "kernel_launch: occupancy query says %d\n", per_cu); per_cu = 1; }
        (void)hipGetLastError();
        grid = cus * per_cu;
        if (grid <= 0) grid = 256;
    }
    if (grid < 0) return;
    if (hipMemsetAsync((char*)d_ws + WS_BAR, 0, 65536, stream) != hipSuccess) { fprintf(stderr, "kernel_launch: memset failed\n"); return; }
    Args a{};
    for (int i = 0; i < 17; ++i) a.in[i] = (const float*)d_in[i];
    a.out = (float*)d_out; a.ws = (unsigned char*)d_ws;
#if ONE_LAUNCH
    a.ph_lo = 0; a.ph_hi = N_PHASES;
    void* args[] = {&a};
    hipError_t e = hipLaunchCooperativeKernel((const void*)fwd_kernel, dim3(grid), dim3(NTHR), args, LDS_BYTES, stream);
    if (e != hipSuccess) fprintf(stderr, "cooperative launch failed: %s (grid %d)\n", hipGetErrorString(e), grid);
#else
    for (int ph = 0; ph < N_PHASES; ++ph) {
        a.ph_lo = ph; a.ph_hi = ph + 1;
        hipLaunchKernelGGL(fwd_kernel, dim3(grid), dim3(NTHR), LDS_BYTES, stream, a);
    }
#endif
}
```

```cpp
#include <hip/hip_runtime.h>
#include <hip/hip_cooperative_groups.h>
#include <cstdio>
#include <cstdint>
namespace cg = cooperative_groups;

#ifndef ONE_LAUNCH
#define ONE_LAUNCH 1
#endif

namespace pg8 {
#define PG8_LAS __attribute__((address_space(3)))
typedef unsigned short bf16_t;
typedef short bf16x8 __attribute__((ext_vector_type(8)));
typedef float f32x4 __attribute__((ext_vector_type(4)));
typedef unsigned u32x4 __attribute__((ext_vector_type(4)));
constexpr int BM = 256, BK = 64, HALF = 128, HTB = HALF * BK * 2  , STAGE_BYTES = 8 * HTB, NXCD = 8, WGM = 8;

__host__ __device__ __forceinline__ int lds_byte(int r, int c) { const int st = (r >> 4) * 2 + (c >> 5), rr = r & 15, cc = c & 31, ob = rr * 64 + cc * 2; return st * 1024 + (ob ^ (((ob >> 9) & 1) << 5)); }
__host__ __device__ __forceinline__ void stage_rc(int b, int& R, int& C) { const int st = b / 1024, sb = b % 1024, swz = sb ^ (((sb >> 9) & 1) << 5); R = (st >> 1) * 16 + swz / 64; C = (st & 1) * 32 + (swz % 64) / 2; }
__host__ __device__ __forceinline__ int perm32(int rho) { const int n = rho >> 4, i = rho & 15; return 8 * (i >> 2) + 4 * n + (i & 3); }

struct Unit { int pm, pn; };
struct Gemm { const bf16_t* A; const bf16_t* Bt; int M, N, K; };

struct StaticOrder {
    int nM, nN, nwg, G, c;
    __host__ __device__ void init(int M, int N, int G_, int c_) { nM = M / BM; nN = N / BM; nwg = nM * nN; G = G_; c = c_; }
    __host__ __device__ bool next(int i, Unit& u) const {
        const long L = (long)i * G + c; if (L >= nwg) return false;
        int wgid = (int)L; { const int q = nwg / NXCD, r = nwg % NXCD, xcd = wgid % NXCD, off = wgid / NXCD; wgid = (xcd < r ? xcd * (q + 1) : r * (q + 1) + (xcd - r) * q) + off; }
        const int nig = WGM * nN, gid = wgid / nig, fm = gid * WGM, gsz = (nM - fm) < WGM ? (nM - fm) : WGM;
        u.pm = fm + ((wgid % nig) % gsz); u.pn = (wgid % nig) / gsz; return true;
    }
    __device__ __forceinline__ void a_ready(const Unit&) const {}
    __device__ __forceinline__ void done(const Unit&) const {}
};

__device__ __forceinline__ unsigned cvt_pk_bf16(float lo, float hi) { unsigned r; asm volatile("v_cvt_pk_bf16_f32 %0, %1, %2" : "=v"(r) : "v"(lo), "v"(hi)); return r; }

__device__ __forceinline__ float fast_sigmoid(float x) { return __builtin_amdgcn_rcpf(1.0f + __builtin_amdgcn_exp2f(-1.4426950408889634f * x)); }
__device__ __forceinline__ float gelu_tanh(float x) {
    const float y = x * (1.0f + 0.044715f * x * x) * (2.0f * 0.7978845608028654f);
    return x * __builtin_amdgcn_rcpf(1.0f + __builtin_amdgcn_exp2f(-1.4426950408889634f * y));
}
__device__ __forceinline__ float bf2f(unsigned short b) { return __uint_as_float(((unsigned)b) << 16); }
__device__ __forceinline__ u32x4 pack8(const f32x4 a, const f32x4 b) { u32x4 w; w.x = cvt_pk_bf16(a[0], a[1]); w.y = cvt_pk_bf16(a[2], a[3]); w.z = cvt_pk_bf16(b[0], b[1]); w.w = cvt_pk_bf16(b[2], b[3]); return w; }
__device__ __forceinline__ void unpack8(const u32x4 w, f32x4& a, f32x4& b) {
    a[0] = __uint_as_float(w.x << 16); a[1] = __uint_as_float(w.x & 0xffff0000u); a[2] = __uint_as_float(w.y << 16); a[3] = __uint_as_float(w.y & 0xffff0000u);
    b[0] = __uint_as_float(w.z << 16); b[1] = __uint_as_float(w.z & 0xffff0000u); b[2] = __uint_as_float(w.w << 16); b[3] = __uint_as_float(w.w & 0xffff0000u);
}
__device__ __forceinline__ float row_rs(const float* ss, int row) {
    const f32x4* sp = (const f32x4*)(ss + (size_t)row * 16);
    const f32x4 s = (sp[0] + sp[1]) + (sp[2] + sp[3]);
    return rsqrtf(((s[0] + s[1]) + (s[2] + s[3])) * (1.0f / 1024.0f) + 1e-6f);
}

__device__ __forceinline__ void rows_rs(const float* ss, int row0, int fq, float (&rsv)[2][4]) {
    f32x4 part[2][4];
#pragma unroll
    for (int ai = 0; ai < 2; ++ai)
#pragma unroll
        for (int m = 0; m < 4; ++m) part[ai][m] = *(const f32x4*)(ss + (size_t)(row0 + ai * HALF + m * 16) * 16 + fq * 4);
#pragma unroll
    for (int ai = 0; ai < 2; ++ai)
#pragma unroll
        for (int m = 0; m < 4; ++m) { float t = (part[ai][m][0] + part[ai][m][1]) + (part[ai][m][2] + part[ai][m][3]); t += __shfl_xor(t, 16); t += __shfl_xor(t, 32); rsv[ai][m] = rsqrtf(t * (1.0f / 1024.0f) + 1e-6f); }
}

struct EpiIn {
    static constexpr bool PERM = true, AFTER_DRAIN = false;
    bf16_t* QKV; bf16_t* U; bf16_t* GV; bf16_t* G; const float* ss; float* ssv;
    __device__ __forceinline__ void operator()(const f32x4 (&acc)[2][2][4][2], const Unit& u, int wr, int wc, int fr, int fq) const {
        const int pn = u.pn;
        float rsv[2][4]; rows_rs(ss, u.pm * BM + wr * 64 + fr, fq, rsv);
#pragma unroll
        for (int ai = 0; ai < 2; ++ai)
#pragma unroll
            for (int m = 0; m < 4; ++m) {
                const int row = u.pm * BM + ai * HALF + wr * 64 + m * 16 + fr;
                const float rs = rsv[ai][m];
                float q = 0.f;
#pragma unroll
                for (int bj = 0; bj < 2; ++bj) {
                    const int col = pn * BM + bj * HALF + wc * 32 + 8 * fq;
                    f32x4 v0 = acc[ai][bj][m][0] * rs, v1 = acc[ai][bj][m][1] * rs;
                    bf16_t* dst;
                    if (pn < 9) { if (pn < 3) { v0 = v0 * 0.125f; v1 = v1 * 0.125f; } dst = QKV + (size_t)row * 2304 + col; }
                    else if (pn < 17) {
#pragma unroll
                        for (int e = 0; e < 4; ++e) { v0[e] = gelu_tanh(v0[e]); v1[e] = gelu_tanh(v1[e]); }
                        if (pn < 13) dst = U + (size_t)row * 1024 + (col - 2304);
                        else { dst = GV + (size_t)row * 1024 + (col - 3328);
#pragma unroll
                            for (int e = 0; e < 4; ++e) q += v0[e] * v0[e] + v1[e] * v1[e]; }
                    } else {
#pragma unroll
                        for (int e = 0; e < 4; ++e) { v0[e] = fast_sigmoid(v0[e]); v1[e] = fast_sigmoid(v1[e]); }
                        dst = G + (size_t)row * 2048 + (col - 4352);
                    }
                    *(u32x4*)dst = pack8(v0, v1);
                }
                if (pn >= 13 && pn < 17) { q += __shfl_xor(q, 16); q += __shfl_xor(q, 32); if (fq == 0) ssv[(size_t)row * 16 + (pn - 13) * 4 + wc] = q; }
                asm volatile("" ::: "memory");
            }
    }
};
template <int MODE> struct EpiGate {
    static constexpr bool PERM = true, AFTER_DRAIN = false;
    bf16_t* O; const bf16_t* G; int goff;
    __device__ __forceinline__ void operator()(const f32x4 (&acc)[2][2][4][2], const Unit& u, int wr, int wc, int fr, int fq) const {
#pragma unroll
        for (int ai = 0; ai < 2; ++ai) {
            u32x4 gw[4][2], pw[4][2];
#pragma unroll
            for (int m = 0; m < 4; ++m)
#pragma unroll
                for (int bj = 0; bj < 2; ++bj) {
                    const int row = u.pm * BM + ai * HALF + wr * 64 + m * 16 + fr, col = u.pn * BM + bj * HALF + wc * 32 + 8 * fq;
                    gw[m][bj] = *(const u32x4*)(G + (size_t)row * 2048 + goff + col);
                    if (MODE == 1) pw[m][bj] = *(const u32x4*)(O + (size_t)row * 1024 + col);
                }
#pragma unroll
            for (int m = 0; m < 4; ++m)
#pragma unroll
                for (int bj = 0; bj < 2; ++bj) {
                    const int row = u.pm * BM + ai * HALF + wr * 64 + m * 16 + fr, col = u.pn * BM + bj * HALF + wc * 32 + 8 * fq;
                    f32x4 g0, g1; unpack8(gw[m][bj], g0, g1);
                    f32x4 v0 = acc[ai][bj][m][0] * g0, v1 = acc[ai][bj][m][1] * g1;
                    if (MODE == 1) { f32x4 p0, p1; unpack8(pw[m][bj], p0, p1); v0 = v0 + p0; v1 = v1 + p1; }
                    *(u32x4*)(O + (size_t)row * 1024 + col) = pack8(v0, v1);
                }
            asm volatile("" ::: "memory");
        }
    }
};
struct EpiRes {
    static constexpr bool PERM = true, AFTER_DRAIN = false;
    float* X; bf16_t* XB; float* ss;
    __device__ __forceinline__ void operator()(const f32x4 (&acc)[2][2][4][2], const Unit& u, int wr, int wc, int fr, int fq) const {
#pragma unroll
        for (int ai = 0; ai < 2; ++ai) {
            f32x4 xv[4][2][2];
#pragma unroll
            for (int m = 0; m < 4; ++m)
#pragma unroll
                for (int bj = 0; bj < 2; ++bj) {
                    const float* xp = X + (size_t)(u.pm * BM + ai * HALF + wr * 64 + m * 16 + fr) * 1024 + u.pn * BM + bj * HALF + wc * 32 + 8 * fq;
                    xv[m][bj][0] = *(const f32x4*)xp; xv[m][bj][1] = *(const f32x4*)(xp + 4);
                }
#pragma unroll
            for (int m = 0; m < 4; ++m) {
                const int row = u.pm * BM + ai * HALF + wr * 64 + m * 16 + fr;
                float q = 0.f;
#pragma unroll
                for (int bj = 0; bj < 2; ++bj) {
                    const int col = u.pn * BM + bj * HALF + wc * 32 + 8 * fq;
                    float* xp = X + (size_t)row * 1024 + col;
                    const f32x4 x0 = xv[m][bj][0] + acc[ai][bj][m][0], x1 = xv[m][bj][1] + acc[ai][bj][m][1];
                    *(f32x4*)xp = x0; *(f32x4*)(xp + 4) = x1;
                    *(u32x4*)(XB + (size_t)row * 1024 + col) = pack8(x0, x1);
#pragma unroll
                    for (int e = 0; e < 4; ++e) q += x0[e] * x0[e] + x1[e] * x1[e];
                }
                q += __shfl_xor(q, 16); q += __shfl_xor(q, 32);
                if (fq == 0) ss[(size_t)row * 16 + u.pn * 4 + wc] = q;
            }
            asm volatile("" ::: "memory");
        }
    }
};
struct EpiUp {
    static constexpr bool PERM = true, AFTER_DRAIN = false;
    bf16_t* A; const float* ss;
    __device__ __forceinline__ void operator()(const f32x4 (&acc)[2][2][4][2], const Unit& u, int wr, int wc, int fr, int fq) const {
        float rsv[2][4]; rows_rs(ss, u.pm * BM + wr * 64 + fr, fq, rsv);
#pragma unroll
        for (int ai = 0; ai < 2; ++ai)
#pragma unroll
            for (int m = 0; m < 4; ++m) {
                const int row = u.pm * BM + ai * HALF + wr * 64 + m * 16 + fr;
                const float rs = rsv[ai][m];
#pragma unroll
                for (int bj = 0; bj < 2; ++bj) {
                    const int col = u.pn * BM + bj * HALF + wc * 32 + 8 * fq;
                    *(u32x4*)(A + (size_t)row * 5632 + col) = pack8(acc[ai][bj][m][0] * rs, acc[ai][bj][m][1] * rs);
                }
                asm volatile("" ::: "memory");
            }
    }
};

template <class Epi, class Sched, bool ALIGN_EPI = false, bool SP2 = false>
__device__ __forceinline__ void gemm_phase(PG8_LAS unsigned char* lds, const Gemm g, const Sched& S, const Epi& E, const int tid) {
    const int wid = __builtin_amdgcn_readfirstlane(tid >> 6), lane = tid & 63, wr = wid >> 2, wc = wid & 3, fr = lane & 15, fq = lane >> 4;
    const int K = g.K, nt = K / BK;
    unsigned voffA[2], voffB[2];
#pragma unroll
    for (int i = 0; i < 2; ++i) { int R, C; stage_rc(tid * 16 + i * 8192, R, C); const int Rb = Epi::PERM ? ((R & ~31) + perm32(R & 31)) : R;
        voffA[i] = (unsigned)(R * K + C) * 2u; voffB[i] = (unsigned)(Rb * K + C) * 2u; }
    const size_t kstep = (size_t)(BK * 2);
    const size_t hstep = (size_t)HALF * K * 2;
    const size_t tstep = 2 * hstep;
    const unsigned ldsw = (unsigned)wid * 1024u;
    const int aoff = lds_byte(wr * 64 + fr, fq * 8), boff = lds_byte(wc * 32 + fr, fq * 8);
#define PG8_SA(b, h) (((b) * 2 + (h)) * HTB)
#define PG8_SB(b, h) ((4 + (b) * 2 + (h)) * HTB)
#define PG8_STAGE(bufoff, gbase, voff) do { _Pragma("unroll") for (int _i = 0; _i < 2; ++_i) \
        __builtin_amdgcn_global_load_lds((const unsigned*)((const char*)(gbase) + (voff)[_i]), (PG8_LAS unsigned*)(lds + (bufoff) + ldsw + _i * 8192), 16, 0, 0); } while (0)
#define PG8_LDA(dst, b, h) do { _Pragma("unroll") for (int m = 0; m < 4; ++m) _Pragma("unroll") for (int k = 0; k < 2; ++k) dst[m][k] = *(const PG8_LAS bf16x8*)(lds + PG8_SA(b, h) + aoff + m * 2048 + k * 1024); } while (0)
#define PG8_LDB(dst, b, h) do { _Pragma("unroll") for (int n = 0; n < 2; ++n) _Pragma("unroll") for (int k = 0; k < 2; ++k) dst[n][k] = *(const PG8_LAS bf16x8*)(lds + PG8_SB(b, h) + boff + n * 2048 + k * 1024); } while (0)
#define PG8_MMA(ai, bj, At, Bt) do { __builtin_amdgcn_s_setprio(1); _Pragma("unroll") for (int m = 0; m < 4; ++m) _Pragma("unroll") for (int n = 0; n < 2; ++n) _Pragma("unroll") for (int k = 0; k < 2; ++k) \
        acc[ai][bj][m][n] = __builtin_amdgcn_mfma_f32_16x16x32_bf16(Bt[n][k], At[m][k], acc[ai][bj][m][n], 0, 0, 0); __builtin_amdgcn_s_setprio(0); } while (0)
#define PG8_WAIT_V(n) asm volatile("s_waitcnt vmcnt(" #n ")" ::: "memory")
#define PG8_WAIT_L(n) asm volatile("s_waitcnt lgkmcnt(" #n ")" ::: "memory")
#define PG8_BAR __builtin_amdgcn_s_barrier()
#define PG8_SCHED __builtin_amdgcn_sched_barrier(0)
    Unit cur, nxt; int ui = 0;
    if (!S.next(0, cur)) return;
    f32x4 acc[2][2][4][2];
#pragma unroll
    for (int a = 0; a < 2; ++a)
#pragma unroll
        for (int b = 0; b < 2; ++b)
#pragma unroll
            for (int m = 0; m < 4; ++m)
#pragma unroll
                for (int n = 0; n < 2; ++n) acc[a][b][m][n] = (f32x4){0.f, 0.f, 0.f, 0.f};
    bf16x8 At[4][2], B0[2][2], B1[2][2];
    const char* cA = (const char*)g.A + (size_t)cur.pm * tstep; const char* cB = (const char*)g.Bt + (size_t)cur.pn * tstep;
    S.a_ready(cur);
    if constexpr (SP2) {
        PG8_STAGE(PG8_SB(0, 0), cB, voffB); PG8_STAGE(PG8_SB(0, 1), cB + hstep, voffB); PG8_STAGE(PG8_SA(0, 0), cA, voffA); PG8_STAGE(PG8_SA(0, 1), cA + hstep, voffA);
        if (wr == 1) PG8_BAR;
        PG8_WAIT_V(2); PG8_BAR;
        PG8_STAGE(PG8_SB(1, 0), cB + kstep, voffB); PG8_STAGE(PG8_SA(1, 0), cA + kstep, voffA); PG8_STAGE(PG8_SB(1, 1), cB + hstep + kstep, voffB);
        PG8_WAIT_V(6); PG8_BAR;
    } else {
        PG8_STAGE(PG8_SB(0, 0), cB, voffB); PG8_STAGE(PG8_SA(0, 0), cA, voffA); PG8_STAGE(PG8_SB(0, 1), cB + hstep, voffB); PG8_STAGE(PG8_SA(0, 1), cA + hstep, voffA);
        if (wr == 1) PG8_BAR;
        PG8_WAIT_V(4); PG8_BAR;
        PG8_STAGE(PG8_SB(1, 0), cB + kstep, voffB); PG8_STAGE(PG8_SA(1, 0), cA + kstep, voffA); PG8_STAGE(PG8_SB(1, 1), cB + hstep + kstep, voffB);
        PG8_WAIT_V(6); PG8_BAR;
    }
    for (;;) {
        const bool has_next = S.next(ui + 1, nxt);
        const char* nA = has_next ? (const char*)g.A + (size_t)nxt.pm * tstep : cA; const char* nB = has_next ? (const char*)g.Bt + (size_t)nxt.pn * tstep : cB;
        for (int t = 0; t < nt; t += 2) {
            const bool last = (t == nt - 2);
            const char* a1 = cA + (size_t)(t + 1) * kstep;
            const char* a2 = last ? nA : cA + (size_t)(t + 2) * kstep; const char* b2 = last ? nB : cB + (size_t)(t + 2) * kstep;
            const char* a3 = a2 + kstep; const char* b3 = b2 + kstep;
            if (last && has_next) S.a_ready(nxt);
            if constexpr (SP2) {
            PG8_LDB(B0, 0, 0); PG8_LDB(B1, 0, 1); PG8_SCHED; PG8_LDA(At, 0, 0); PG8_STAGE(PG8_SA(1, 1), a1 + hstep, voffA);
            PG8_WAIT_V(8); PG8_WAIT_L(0); PG8_BAR; PG8_MMA(0, 0, At, B0); PG8_MMA(0, 1, At, B1); PG8_BAR; PG8_SCHED;
            PG8_LDA(At, 0, 1); PG8_STAGE(PG8_SB(0, 0), b2, voffB); PG8_STAGE(PG8_SB(0, 1), b2 + hstep, voffB); PG8_STAGE(PG8_SA(0, 0), a2, voffA);
            PG8_WAIT_V(8); PG8_WAIT_L(0); PG8_BAR; PG8_MMA(1, 0, At, B0); PG8_MMA(1, 1, At, B1); PG8_BAR; PG8_SCHED;
            PG8_LDB(B0, 1, 0); PG8_LDB(B1, 1, 1); PG8_SCHED; PG8_LDA(At, 1, 0); PG8_STAGE(PG8_SA(0, 1), a2 + hstep, voffA);
            PG8_WAIT_V(8); PG8_WAIT_L(0); PG8_BAR; PG8_MMA(0, 0, At, B0); PG8_MMA(0, 1, At, B1); PG8_BAR; PG8_SCHED;
            PG8_LDA(At, 1, 1); PG8_STAGE(PG8_SB(1, 0), b3, voffB); PG8_STAGE(PG8_SB(1, 1), b3 + hstep, voffB); PG8_STAGE(PG8_SA(1, 0), a3, voffA);
            PG8_WAIT_V(8); PG8_WAIT_L(0); PG8_BAR; PG8_MMA(1, 0, At, B0); PG8_MMA(1, 1, At, B1); PG8_BAR; PG8_SCHED;
            } else {
            PG8_LDB(B0, 0, 0); PG8_SCHED; PG8_LDA(At, 0, 0); PG8_STAGE(PG8_SA(1, 1), a1 + hstep, voffA);
            PG8_WAIT_L(8); PG8_BAR; PG8_WAIT_L(0); PG8_MMA(0, 0, At, B0); PG8_BAR; PG8_SCHED;
            PG8_LDB(B1, 0, 1); PG8_STAGE(PG8_SB(0, 0), b2, voffB);
            PG8_BAR; PG8_WAIT_L(0); PG8_MMA(0, 1, At, B1); PG8_BAR;
            PG8_LDA(At, 0, 1); PG8_STAGE(PG8_SA(0, 0), a2, voffA);
            PG8_BAR; PG8_WAIT_L(0); PG8_MMA(1, 0, At, B0); PG8_BAR; PG8_SCHED;
            PG8_STAGE(PG8_SB(0, 1), b2 + hstep, voffB);
            PG8_WAIT_V(6); PG8_BAR; PG8_MMA(1, 1, At, B1); PG8_BAR;
            PG8_LDB(B0, 1, 0); PG8_SCHED; PG8_LDA(At, 1, 0); PG8_STAGE(PG8_SA(0, 1), a2 + hstep, voffA);
            PG8_WAIT_L(8); PG8_BAR; PG8_WAIT_L(0); PG8_MMA(0, 0, At, B0); PG8_BAR; PG8_SCHED;
            PG8_LDB(B1, 1, 1); PG8_STAGE(PG8_SB(1, 0), b3, voffB);
            PG8_BAR; PG8_WAIT_L(0); PG8_MMA(0, 1, At, B1); PG8_BAR;
            PG8_LDA(At, 1, 1); PG8_STAGE(PG8_SA(1, 0), a3, voffA);
            PG8_BAR; PG8_WAIT_L(0); PG8_MMA(1, 0, At, B0); PG8_BAR; PG8_SCHED;
            PG8_STAGE(PG8_SB(1, 1), b3 + hstep, voffB);
            PG8_WAIT_V(6); PG8_BAR; PG8_MMA(1, 1, At, B1); PG8_BAR;
            }
        }
        if constexpr (ALIGN_EPI) { if (wr == 0) PG8_BAR; }
        if constexpr (!Epi::AFTER_DRAIN) { E(acc, cur, wr, wc, fr, fq); S.done(cur); }
        if (!has_next) break;
#pragma unroll
        for (int a = 0; a < 2; ++a)
#pragma unroll
            for (int b = 0; b < 2; ++b)
#pragma unroll
                for (int m = 0; m < 4; ++m)
#pragma unroll
                    for (int n = 0; n < 2; ++n) acc[a][b][m][n] = (f32x4){0.f, 0.f, 0.f, 0.f};
        cur = nxt; cA = nA; cB = nB; ++ui;
        if constexpr (ALIGN_EPI) { if (wr == 1) PG8_BAR; }
    }
    PG8_WAIT_V(0);
    if constexpr (!ALIGN_EPI) { if (wr == 0) PG8_BAR; }
    PG8_BAR;
    if constexpr (Epi::AFTER_DRAIN) { E.fused(acc, cur, wr, wc, fr, fq, lds, wid, lane); S.done(cur); }
#undef PG8_SA
#undef PG8_SB
#undef PG8_STAGE
#undef PG8_LDA
#undef PG8_LDB
#undef PG8_MMA
#undef PG8_WAIT_V
#undef PG8_WAIT_L
#undef PG8_BAR
#undef PG8_SCHED
}
}


#define LAS __attribute__((address_space(3)))
#ifndef SKIPMASK
#define SKIPMASK 0
#endif
#ifndef PROBE_KIND
#define PROBE_KIND -1
#endif
typedef unsigned short bf16;
using pg8::f32x4; using pg8::u32x4; using pg8::bf16x8;
typedef float f32x16 __attribute__((ext_vector_type(16)));
typedef short v4i16_t __attribute__((ext_vector_type(4)));
typedef unsigned u32x2 __attribute__((ext_vector_type(2)));

constexpr int DM = 1024, DEPTH = 4, NTOK = 98304, NPROMPT = 32768, CH = 32768, NCHUNK = NTOK / CH;
constexpr int NIN = 6400, DFF = 2816, NUP = 5632;
constexpr int LDS_BYTES = 147456, NTHR = 512;
constexpr float EPS = 1e-6f, LOG2E = 1.4426950408889634f;
constexpr size_t OFF_IN = 0, OFF_PA = OFF_IN + (size_t)NIN * DM, OFF_PB = OFF_PA + (size_t)DM * 256, OFF_OUT = OFF_PB + (size_t)DM * DM, OFF_UP = OFF_OUT + (size_t)DM * DM,
                 OFF_DN = OFF_UP + (size_t)NUP * DM, OFF_WS = OFF_DN + (size_t)DM * DFF, W_LAYER = OFF_WS + 8 * 128 * 128;
constexpr size_t MiB = 1u << 20;
constexpr size_t WS_W = 0, WS_R1 = 144 * MiB, WS_R2 = WS_R1 + (size_t)CH * 12800, WS_XB = WS_R2 + (size_t)CH * 5632, WS_SS = WS_XB + (size_t)CH * 2048, WS_SSV = WS_SS + (size_t)CH * 64, WS_BAR = WS_SSV + (size_t)CH * 64, WS_END = WS_BAR + 65536;
static_assert(W_LAYER * 2 * DEPTH <= WS_R1, "weights fit");
constexpr int PROBE_DUPK = (PROBE_KIND == 8) ? 1 : PROBE_KIND;
constexpr int KPL = (PROBE_DUPK >= 0 && PROBE_DUPK < 8) ? 9 : 8;
constexpr int PH_PER_CHUNK = 2 + KPL * DEPTH, N_PHASES = 1 + NCHUNK * PH_PER_CHUNK;

struct Args { const float* in[17]; float* out; unsigned char* ws; int ph_lo, ph_hi; };

__device__ __forceinline__ float wave_sum(float v) {
#pragma unroll
    for (int o = 1; o < 64; o <<= 1) v += __shfl_xor(v, o);
    return v;
}
__device__ __forceinline__ unsigned pk2(float lo, float hi) { return pg8::cvt_pk_bf16(lo, hi); }
#define LDS_WAIT() asm volatile("s_waitcnt lgkmcnt(0)" ::: "memory")

__device__ __forceinline__ void tr_item(const float* W, int K, int N, bf16* WT, const float* gain, LAS float* scr, int item, int lane) {
    const int nblk = N / 32, kb = item / nblk, nb = item % nblk, k0 = 64 * kb, n0 = 32 * nb;
#pragma unroll 8
    for (int i = 0; i < 32; ++i) { const int kk = 2 * i + (lane >> 5); const float g = gain ? gain[k0 + kk] : 1.0f; scr[kk * 33 + (lane & 31)] = W[(size_t)(k0 + kk) * N + n0 + (lane & 31)] * g; }
    LDS_WAIT();
    const int c = lane & 7;
#pragma unroll
    for (int j = 0; j < 4; ++j) { const int n = (lane >> 3) + 8 * j; const LAS float* s = scr + (8 * c) * 33 + n;
        u32x4 o; o.x = pk2(s[0 * 33], s[1 * 33]); o.y = pk2(s[2 * 33], s[3 * 33]); o.z = pk2(s[4 * 33], s[5 * 33]); o.w = pk2(s[6 * 33], s[7 * 33]);
        *(u32x4*)(WT + (size_t)(n0 + n) * K + k0 + 8 * c) = o; }
    LDS_WAIT();
}
__device__ __forceinline__ void p0_weights(const Args& a, LAS unsigned char* lds, int tid, int G, int bid) {
    const int wave = tid >> 6, lane = tid & 63;
    LAS float* scr = (LAS float*)(lds + wave * 16384);
    const int gw = bid * 8 + wave, NGW = G * 8;
    constexpr int I_IN = 16 * 200, I_PA = 4 * 32, I_PB = 16 * 32, I_OUT = 16 * 32, I_UP = 16 * 176, I_DN = 44 * 32, PER = I_IN + I_PA + I_PB + I_OUT + I_UP + I_DN;
    bf16* Wb = (bf16*)(a.ws + WS_W);
    for (int it = gw; it < DEPTH * PER; it += NGW) {
        const int l = it / PER; int r = it % PER; bf16* wl = Wb + (size_t)l * W_LAYER;
        if (r < I_IN) { tr_item(a.in[4] + (size_t)l * DM * NIN, DM, NIN, wl + OFF_IN, a.in[3] + l * DM, scr, r, lane); continue; } r -= I_IN;
        if (r < I_PA) { tr_item(a.in[8] + (size_t)l * 256 * DM, 256, DM, wl + OFF_PA, nullptr, scr, r, lane); continue; } r -= I_PA;
        if (r < I_PB) { tr_item(a.in[9] + (size_t)l * DM * DM, DM, DM, wl + OFF_PB, nullptr, scr, r, lane); continue; } r -= I_PB;
        if (r < I_OUT) { tr_item(a.in[10] + (size_t)l * DM * DM, DM, DM, wl + OFF_OUT, nullptr, scr, r, lane); continue; } r -= I_OUT;
        if (r < I_UP) { tr_item(a.in[12] + (size_t)l * DM * NUP, DM, NUP, wl + OFF_UP, a.in[11] + l * DM, scr, r, lane); continue; } r -= I_UP;
        tr_item(a.in[15] + (size_t)l * DFF * DM, DFF, DM, wl + OFF_DN, nullptr, scr, r, lane);
    }
    for (int i = bid * NTHR + tid; i < DEPTH * 131072 / 4; i += G * NTHR) {
        const int l = i / 32768, e = (i % 32768) * 4;
        const f32x4 v = *(const f32x4*)(a.in[6] + (size_t)l * 131072 + e);
        u32x2 o; o.x = pk2(v[0], v[1]); o.y = pk2(v[2], v[3]);
        *(u32x2*)(Wb + (size_t)l * W_LAYER + OFF_WS + e) = o;
    }
}
__device__ __forceinline__ void p0x(const Args& a, int chunk, int tid, int G, int bid) {
    const int wave = tid >> 6, lane = tid & 63, gw = bid * 8 + wave, NGW = G * 8;
    bf16* XB = (bf16*)(a.ws + WS_XB); float* SS = (float*)(a.ws + WS_SS);
    for (int m = gw; m < CH; m += NGW) {
        const size_t tok = (size_t)chunk * CH + m;
        const float* src = tok < NPROMPT ? a.in[0] + tok * DM : a.in[1] + (tok - NPROMPT) * DM;
        float* dst = a.out + tok * DM;
        float s = 0.f;
#pragma unroll
        for (int j = 0; j < 4; ++j) { const f32x4 v = *(const f32x4*)(src + (lane + 64 * j) * 4); s += (v[0] * v[0] + v[1] * v[1]) + (v[2] * v[2] + v[3] * v[3]);
            *(f32x4*)(dst + (lane + 64 * j) * 4) = v; u32x2 o; o.x = pk2(v[0], v[1]); o.y = pk2(v[2], v[3]); *(u32x2*)(XB + (size_t)m * DM + (lane + 64 * j) * 4) = o; }
        s = wave_sum(s);
        if (lane < 16) SS[(size_t)m * 16 + lane] = lane == 0 ? s : 0.f;
    }
}
__device__ __forceinline__ void pfinal(const Args& a, int chunk, int tid, int G, int bid) {
    const int wave = tid >> 6, lane = tid & 63, gw = bid * 8 + wave, NGW = G * 8;
    const float* SS = (const float*)(a.ws + WS_SS); const float* nf = a.in[16];
    for (int m = gw; m < CH; m += NGW) {
        float* x = a.out + ((size_t)chunk * CH + m) * DM;
        const float rs = pg8::row_rs(SS, m);
#pragma unroll
        for (int j = 0; j < 4; ++j) { const int c = (lane + 64 * j) * 4; const f32x4 v = *(const f32x4*)(x + c), g = *(const f32x4*)(nf + c); *(f32x4*)(x + c) = v * rs * g; }
    }
}
__device__ __forceinline__ int t5_bucket(int rel) {
    const int n = rel < 0 ? -rel : rel;
    const int b = n < 8 ? n : 8 + (n >= 15) + (n >= 27) + (n >= 50) + (n >= 91) + (n >= 166) + (n >= 305) + (n >= 559);
    return (rel > 0 ? 16 : 0) + b;
}
__device__ __forceinline__ void attn_unit(const bf16* QKV, bf16* OUTG, float* LSE, const float* rel_bias, LAS unsigned char* lds, int unit, int S, int tid) {
    const int wave = tid >> 6, lane = tid & 63;
    constexpr int upg = CH / 64;
    const int g = unit / upg, rem = unit % upg;
    const int ups = S / 64, seq = rem / ups, rem2 = rem % ups;
    const int d = 1 << (2 * g), L = S / d, nqb = L / 64, r = rem2 / nqb, qb = rem2 % nqb;
    const int tokbase = seq * S + r;
    const int h = wave & 3, qh = wave >> 2, n = lane & 31, hi = lane >> 5;
    const int qbase = 64 * qb + 32 * qh;
    const size_t tokq = (size_t)tokbase + (size_t)(qbase + n) * d;
    const bf16* qp = QKV + tokq * 2304 + g * 256 + h * 64 + 8 * hi;
    bf16x8 qf[4], kf[5][4];
#pragma unroll
    for (int s = 0; s < 4; ++s) qf[s] = *(const bf16x8*)(qp + 16 * s);
#pragma unroll
    for (int kt = 0; kt < 5; ++kt) {
        const int lk = qbase - 64 + 32 * kt + n, lkc = lk < 0 ? 0 : (lk > L - 1 ? L - 1 : lk);
        const bf16* kp = QKV + (size_t)(tokbase + lkc * d) * 2304 + 768 + g * 256 + h * 64 + 8 * hi;
#pragma unroll
        for (int s = 0; s < 4; ++s) kf[kt][s] = *(const bf16x8*)(kp + 16 * s);
    }
#pragma unroll
    for (int i = 0; i < 12; ++i) {
        const int idx = tid + i * NTHR, kk = idx >> 5, ch = idx & 31, lk = 64 * qb - 64 + kk;
        u32x4 v = (u32x4){0u, 0u, 0u, 0u};
        if (lk >= 0 && lk < L) v = *(const u32x4*)(QKV + (size_t)(tokbase + lk * d) * 2304 + 1536 + g * 256 + ch * 8);
        *(LAS u32x4*)(lds + kk * 576 + ch * 16) = v;
    }
    LAS float* bt = (LAS float*)(lds + 110592);
    for (int i = tid; i < 516; i += NTHR) { const int hh = i / 129, j = i % 129 - 64; bt[i] = rel_bias[t5_bucket(j * d) * 12 + g * 4 + hh]; }
    f32x16 st[5];
#pragma unroll
    for (int kt = 0; kt < 5; ++kt) {
        f32x16 acc;
#pragma unroll
        for (int e = 0; e < 16; ++e) acc[e] = 0.f;
#pragma unroll
        for (int s = 0; s < 4; ++s) acc = __builtin_amdgcn_mfma_f32_32x32x16_bf16(kf[kt][s], qf[s], acc, 0, 0, 0);
        st[kt] = acc;
    }
    __syncthreads();
    float mx = -3.0e38f;
#pragma unroll
    for (int kt = 0; kt < 5; ++kt)
#pragma unroll
        for (int i = 0; i < 16; ++i) {
            const int m = (i & 3) + 8 * (i >> 2) + 4 * hi, j = 32 * kt + m - 64 - n, lk2 = qbase - 64 + 32 * kt + m;
            const bool ok = (j >= -64) && (j <= 64) && (lk2 >= 0) && (lk2 < L);
            const int jc = j < -64 ? -64 : (j > 64 ? 64 : j);
            const float sv = ok ? st[kt][i] + bt[h * 129 + jc + 64] : -1e30f;
            st[kt][i] = sv; mx = fmaxf(mx, sv);
        }
    mx = fmaxf(mx, __shfl_xor(mx, 32));
    float sum = 0.f;
#pragma unroll
    for (int kt = 0; kt < 5; ++kt)
#pragma unroll
        for (int i = 0; i < 16; ++i) { const float p = __builtin_amdgcn_exp2f((st[kt][i] - mx) * LOG2E); st[kt][i] = p; sum += p; }
    sum += __shfl_xor(sum, 32);
    const float inv = 1.0f / sum, lse = mx + __logf(sum);
    f32x16 o0, o1;
#pragma unroll
    for (int e = 0; e < 16; ++e) { o0[e] = 0.f; o1[e] = 0.f; }
    const int q4 = (lane & 15) >> 2, p4 = lane & 3, gsel = (lane >> 4) & 1;
    const unsigned vbase = (unsigned)((32 * qh + 4 * hi + q4) * 576 + h * 128 + (16 * gsel + 4 * p4) * 2);
#pragma unroll
    for (int kt = 0; kt < 5; ++kt)
#pragma unroll
        for (int s2 = 0; s2 < 2; ++s2) {
            u32x4 pw; pw.x = pk2(st[kt][8 * s2 + 0], st[kt][8 * s2 + 1]); pw.y = pk2(st[kt][8 * s2 + 2], st[kt][8 * s2 + 3]); pw.z = pk2(st[kt][8 * s2 + 4], st[kt][8 * s2 + 5]); pw.w = pk2(st[kt][8 * s2 + 6], st[kt][8 * s2 + 7]);
            const bf16x8 pf = __builtin_bit_cast(bf16x8, pw);
            const unsigned ro = vbase + (unsigned)((32 * kt + 16 * s2) * 576);
            {
                const v4i16_t r1 = __builtin_amdgcn_ds_read_tr16_b64_v4i16((LAS v4i16_t*)(lds + ro)), r2 = __builtin_amdgcn_ds_read_tr16_b64_v4i16((LAS v4i16_t*)(lds + ro + 8 * 576));
                const bf16x8 vf = (bf16x8){r1[0], r1[1], r1[2], r1[3], r2[0], r2[1], r2[2], r2[3]};
                o0 = __builtin_amdgcn_mfma_f32_32x32x16_bf16(vf, pf, o0, 0, 0, 0);
            }
            {
                const v4i16_t r1 = __builtin_amdgcn_ds_read_tr16_b64_v4i16((LAS v4i16_t*)(lds + ro + 64)), r2 = __builtin_amdgcn_ds_read_tr16_b64_v4i16((LAS v4i16_t*)(lds + ro + 64 + 8 * 576));
                const bf16x8 vf = (bf16x8){r1[0], r1[1], r1[2], r1[3], r2[0], r2[1], r2[2], r2[3]};
                o1 = __builtin_amdgcn_mfma_f32_32x32x16_bf16(vf, pf, o1, 0, 0, 0);
            }
        }
    bf16* op = OUTG + ((size_t)g * CH + tokq) * 256 + h * 64;
#pragma unroll
    for (int grp = 0; grp < 4; ++grp) {
        u32x2 w0, w1;
        w0.x = pk2(o0[4 * grp + 0] * inv, o0[4 * grp + 1] * inv); w0.y = pk2(o0[4 * grp + 2] * inv, o0[4 * grp + 3] * inv);
        w1.x = pk2(o1[4 * grp + 0] * inv, o1[4 * grp + 1] * inv); w1.y = pk2(o1[4 * grp + 2] * inv, o1[4 * grp + 3] * inv);
        *(u32x2*)(op + 8 * grp + 4 * hi) = w0; *(u32x2*)(op + 32 + 8 * grp + 4 * hi) = w1;
    }
    if (hi == 0) LSE[((size_t)g * CH + tokq) * 4 + h] = lse;
    __syncthreads();
}
constexpr int SG_WLDS = 17920;
__device__ __forceinline__ void sg_wave_unit(bf16* U, bf16* UO, const bf16* GV, const float* ssv, const bf16* WSb, const float* gain, const float* bs, LAS unsigned char* wl, int unit, int lane) {
    const int hf = unit & 1, gg = (unit >> 1) & 7, nch = unit >> 4, tok0 = nch * 128, cb = gg * 128 + hf * 64;
    LAS float* rvl = (LAS float*)(wl + 17408);
    rvl[lane] = pg8::row_rs(ssv, tok0 + lane); rvl[lane + 64] = pg8::row_rs(ssv, tok0 + lane + 64);
    LDS_WAIT();
    {
        const int c8 = lane & 7, q0 = lane >> 3;
#pragma unroll
        for (int i = 0; i < 16; ++i) {
            const int q = q0 + 8 * i;
            f32x4 a0, a1; pg8::unpack8(*(const u32x4*)(GV + (size_t)(tok0 + q) * 1024 + cb + c8 * 8), a0, a1);
            const float r = rvl[q];
            const u32x4 w = pg8::pack8(a0 * r, a1 * r);
            *(LAS u32x2*)(wl + q * 136 + c8 * 16) = (u32x2){w.x, w.y}; *(LAS u32x2*)(wl + q * 136 + c8 * 16 + 8) = (u32x2){w.z, w.w};
        }
    }
    LDS_WAIT();
    const int ln = lane & 15, kq = lane >> 4, qq = ln >> 2, pp = ln & 3;
    bf16x8 afr[4][4];
#pragma unroll
    for (int ct = 0; ct < 4; ++ct)
#pragma unroll
        for (int ks = 0; ks < 4; ++ks) {
            const unsigned ad = (unsigned)((32 * ks + 8 * kq + qq) * 136 + (32 * (ct >> 1) + 8 * pp + 4 * (ct & 1)) * 2);
            const v4i16_t r1 = __builtin_amdgcn_ds_read_tr16_b64_v4i16((LAS v4i16_t*)(wl + ad)), r2 = __builtin_amdgcn_ds_read_tr16_b64_v4i16((LAS v4i16_t*)(wl + ad + 4 * 136));
            afr[ct][ks] = (bf16x8){r1[0], r1[1], r1[2], r1[3], r2[0], r2[1], r2[2], r2[3]};
        }
    f32x4 gn[2][2];
#pragma unroll
    for (int t = 0; t < 2; ++t) { gn[t][0] = *(const f32x4*)(gain + cb + 32 * t + 8 * kq); gn[t][1] = *(const f32x4*)(gain + cb + 32 * t + 8 * kq + 4); }
#pragma unroll 2
    for (int pt = 0; pt < 8; ++pt) {
        const int pr = pt * 16 + ln;
        bf16x8 bfr[4];
#pragma unroll
        for (int ks = 0; ks < 4; ++ks) bfr[ks] = *(const bf16x8*)(WSb + (size_t)gg * 16384 + pr * 128 + 32 * ks + 8 * kq);
        bf16* up = U + (size_t)(tok0 + pr) * 1024 + cb + 8 * kq; bf16* uo = UO + (size_t)(tok0 + pr) * 1024 + cb + 8 * kq;
        const u32x4 uw0 = *(const u32x4*)up, uw1 = *(const u32x4*)(up + 32);
        const float bias = bs[gg * 128 + pr];
        f32x4 acc[4];
#pragma unroll
        for (int ct = 0; ct < 4; ++ct) {
            acc[ct] = (f32x4){0.f, 0.f, 0.f, 0.f};
#pragma unroll
            for (int ks = 0; ks < 4; ++ks) acc[ct] = __builtin_amdgcn_mfma_f32_16x16x32_bf16(afr[ct][ks], bfr[ks], acc[ct], 0, 0, 0);
        }
        f32x4 u0, u1;
        pg8::unpack8(uw0, u0, u1);
        *(u32x4*)uo = pg8::pack8(u0 * (gn[0][0] * acc[0] + bias), u1 * (gn[0][1] * acc[1] + bias));
        pg8::unpack8(uw1, u0, u1);
        *(u32x4*)(uo + 32) = pg8::pack8(u0 * (gn[1][0] * acc[2] + bias), u1 * (gn[1][1] * acc[3] + bias));
    }
    LDS_WAIT();
}
__device__ __forceinline__ void p_merge(const bf16* OUTG, const float* LSE, bf16* OA, int tid, int G, int bid) {
    for (int it = bid * NTHR + tid; it < CH * 32; it += G * NTHR) {
        const int tok = it >> 5, c8 = it & 31, h = c8 >> 3;
        const float l0 = LSE[(size_t)tok * 4 + h], l1 = LSE[((size_t)CH + tok) * 4 + h], l2 = LSE[((size_t)2 * CH + tok) * 4 + h];
        const float mx = fmaxf(l0, fmaxf(l1, l2));
        float w0 = __expf(l0 - mx), w1 = __expf(l1 - mx), w2 = __expf(l2 - mx);
        const float inv = 1.0f / (w0 + w1 + w2); w0 *= inv; w1 *= inv; w2 *= inv;
        f32x4 a0, a1, b0, b1, c0, c1;
        pg8::unpack8(*(const u32x4*)(OUTG + (size_t)tok * 256 + c8 * 8), a0, a1);
        pg8::unpack8(*(const u32x4*)(OUTG + ((size_t)CH + tok) * 256 + c8 * 8), b0, b1);
        pg8::unpack8(*(const u32x4*)(OUTG + ((size_t)2 * CH + tok) * 256 + c8 * 8), c0, c1);
        *(u32x4*)(OA + (size_t)tok * 256 + c8 * 8) = pg8::pack8(a0 * w0 + b0 * w1 + c0 * w2, a1 * w0 + b1 * w1 + c1 * w2);
    }
}
__device__ __forceinline__ void p_conv(const bf16* A, bf16* FG, const float* cw, const float* cb, int S, int tid, int G, int bid) {
    constexpr int RUN = 8, NFC = DFF / 8;
    for (int it = bid * NTHR + tid; it < (CH / RUN) * NFC; it += G * NTHR) {
        const int fc = it % NFC, t0 = (it / NFC) * RUN, f = fc * 8;
        f32x4 wg[3][2], wv[3][2], bg[2], bv[2];
#pragma unroll
        for (int k = 0; k < 3; ++k) { wg[k][0] = *(const f32x4*)(cw + k * NUP + f); wg[k][1] = *(const f32x4*)(cw + k * NUP + f + 4); wv[k][0] = *(const f32x4*)(cw + k * NUP + DFF + f); wv[k][1] = *(const f32x4*)(cw + k * NUP + DFF + f + 4); }
        bg[0] = *(const f32x4*)(cb + f); bg[1] = *(const f32x4*)(cb + f + 4); bv[0] = *(const f32x4*)(cb + DFF + f); bv[1] = *(const f32x4*)(cb + DFF + f + 4);
        const f32x4 z4 = (f32x4){0.f, 0.f, 0.f, 0.f};
        f32x4 pg0 = z4, pg1 = z4, pv0 = z4, pv1 = z4, cg0, cg1, cv0, cv1;
        if ((t0 & (S - 1)) != 0) { pg8::unpack8(*(const u32x4*)(A + (size_t)(t0 - 1) * NUP + f), pg0, pg1); pg8::unpack8(*(const u32x4*)(A + (size_t)(t0 - 1) * NUP + DFF + f), pv0, pv1); }
        pg8::unpack8(*(const u32x4*)(A + (size_t)t0 * NUP + f), cg0, cg1); pg8::unpack8(*(const u32x4*)(A + (size_t)t0 * NUP + DFF + f), cv0, cv1);
#pragma unroll
        for (int i = 0; i < RUN; ++i) {
            const int t = t0 + i;
            f32x4 ng0 = z4, ng1 = z4, nv0 = z4, nv1 = z4;
            if (((t + 1) & (S - 1)) != 0) { pg8::unpack8(*(const u32x4*)(A + (size_t)(t + 1) * NUP + f), ng0, ng1); pg8::unpack8(*(const u32x4*)(A + (size_t)(t + 1) * NUP + DFF + f), nv0, nv1); }
            f32x4 g0 = pg0 * wg[0][0] + cg0 * wg[1][0] + ng0 * wg[2][0] + bg[0], g1 = pg1 * wg[0][1] + cg1 * wg[1][1] + ng1 * wg[2][1] + bg[1];
            const f32x4 v0 = pv0 * wv[0][0] + cv0 * wv[1][0] + nv0 * wv[2][0] + bv[0], v1 = pv1 * wv[0][1] + cv1 * wv[1][1] + nv1 * wv[2][1] + bv[1];
#pragma unroll
            for (int e = 0; e < 4; ++e) { g0[e] = pg8::gelu_tanh(g0[e]) * v0[e]; g1[e] = pg8::gelu_tanh(g1[e]) * v1[e]; }
            *(u32x4*)(FG + (size_t)t * DFF + f) = pg8::pack8(g0, g1);
            pg0 = cg0; pg1 = cg1; pv0 = cv0; pv1 = cv1; cg0 = ng0; cg1 = ng1; cv0 = nv0; cv1 = nv1;
        }
    }
}

#define XB_TMO      128
#define XB_XCNT(j)  (256  + 64 * (j))
#define XB_XSUB(j)  (1280 + 64 * (j))
#define XB_XGEN(j)  (2304 + 64 * (j))
#define XB_TOP      3328
#define XB_TOPGEN   3392
#define XCD_BAR_WORDS 3456
#define XB_SPIN_CAP (1u << 18)

__device__ __forceinline__ unsigned xb_ld(unsigned* p)              { return __hip_atomic_load(p, __ATOMIC_RELAXED, __HIP_MEMORY_SCOPE_AGENT); }
__device__ __forceinline__ unsigned xb_add(unsigned* p, unsigned v) { return __hip_atomic_fetch_add(p, v, __ATOMIC_RELAXED, __HIP_MEMORY_SCOPE_AGENT); }
__device__ __forceinline__ unsigned xb_xcc_id() { return (unsigned)__builtin_amdgcn_s_getreg((3 << 11) | 20) & 0xFu; }
#define XB_SPIN(cond, bar) do { unsigned _sp = 0; while (cond) { __builtin_amdgcn_s_sleep(1); \
    if ((++_sp & 255u) == 0u) { if (xb_ld(&(bar)[XB_TMO])) break; if (_sp > XB_SPIN_CAP) { atomicAdd(&(bar)[XB_TMO], 1u); break; } } } } while (0)

struct XcdBarrier {
    unsigned* bar; unsigned x;
    volatile LAS unsigned* st;
};

__device__ __forceinline__ XcdBarrier xcd_barrier_post(unsigned* bar, volatile LAS unsigned* st, const int tid) {
    XcdBarrier b; b.bar = bar; b.x = xb_xcc_id(); b.st = st;
    if (tid == 0) (void)xb_add(&bar[XB_XCNT(b.x)], 1u);
    return b;
}
__device__ __forceinline__ void xcd_barrier_complete(unsigned* bar, unsigned x, unsigned& nloc, unsigned& nx) {
    const unsigned G = gridDim.x * gridDim.y * gridDim.z;
    unsigned sum, cnt, mine, sp = 0u;
    for (;;) {
        sum = 0u; cnt = 0u; mine = 0u;
#pragma unroll
        for (unsigned j = 0; j < 16; ++j) { const unsigned c = xb_ld(&bar[XB_XCNT(j)]); sum += c; cnt += (c > 0u) ? 1u : 0u; mine = (j == x) ? c : mine; }
        if (sum == G) break;
        __builtin_amdgcn_s_sleep(1);
        if ((++sp & 255u) == 0u) { if (xb_ld(&bar[XB_TMO])) break; if (sp > XB_SPIN_CAP) { atomicAdd(&bar[XB_TMO], 1u); break; } }
    }
    nloc = mine > 0u ? mine : 1u; nx = cnt > 0u ? cnt : 1u;
}

__device__ __forceinline__ void xcd_barrier(const XcdBarrier& b, const int tid) {
    asm volatile("s_waitcnt vmcnt(0)" ::: "memory");
    __syncthreads();
    if (tid == 0) {
        unsigned* bar = b.bar;
        __builtin_amdgcn_s_waitcnt(0);
        unsigned nloc = b.st[0], nx = b.st[1];
        if (nloc == 0u) { xcd_barrier_complete(bar, b.x, nloc, nx); b.st[0] = nloc; b.st[1] = nx; }
        const unsigned old = xb_add(&bar[XB_XSUB(b.x)], 1u);
        const unsigned gen = old / nloc;
        if (old + 1u == (gen + 1u) * nloc) {
            __builtin_amdgcn_fence(__ATOMIC_RELEASE, "agent");
            asm volatile("s_waitcnt vmcnt(0)" ::: "memory");
            const unsigned og = xb_add(&bar[XB_TOP], 1u);
            const unsigned tg = og / nx;
            if (og + 1u == (tg + 1u) * nx) xb_add(&bar[XB_TOPGEN], 1u);
            else XB_SPIN(xb_ld(&bar[XB_TOPGEN]) == tg, bar);
            __builtin_amdgcn_fence(__ATOMIC_ACQUIRE, "agent");
            xb_add(&bar[XB_XGEN(b.x)], 1u);
            asm volatile("s_waitcnt vmcnt(0)" ::: "memory");
        } else {
            XB_SPIN(xb_ld(&bar[XB_XGEN(b.x)]) == gen, bar);
            __builtin_amdgcn_fence(__ATOMIC_ACQUIRE, "agent");
            asm volatile("s_waitcnt vmcnt(0)" ::: "memory");
        }
    }
    __syncthreads();
}


__global__ void __launch_bounds__(NTHR, 2) fwd_kernel(Args a_in) {
    extern __shared__ __attribute__((aligned(16))) unsigned char lds_raw[];
    LAS unsigned char* lds = (LAS unsigned char*)lds_raw;
    cg::grid_group grid = cg::this_grid();
    const int ph_lo = a_in.ph_lo, ph_hi = a_in.ph_hi;
    volatile LAS unsigned* xst = (volatile LAS unsigned*)(lds + LDS_BYTES - 16);
    if (threadIdx.x < 2) xst[threadIdx.x] = 0u;
    __syncthreads();
    const unsigned xcc = xcd_barrier_post((unsigned*)(a_in.ws + WS_BAR), xst, (int)threadIdx.x).x;
    for (int ph = ph_lo; ph < ph_hi; ++ph) {
#if defined(__HIP_DEVICE_COMPILE__)
        typedef const __attribute__((address_space(4))) unsigned long long* cu64p4;
        cu64p4 ap = (cu64p4)__builtin_amdgcn_kernarg_segment_ptr();
        asm volatile("" : "+s"(ap));
        Args a;
#pragma unroll
        for (int i = 0; i < 17; ++i) a.in[i] = (const float*)ap[i];
        a.out = (float*)ap[17]; a.ws = (unsigned char*)ap[18]; a.ph_lo = ph_lo; a.ph_hi = ph_hi;
#else
        const Args a = a_in;
#endif
        int tid = threadIdx.x, G = gridDim.x, bid = blockIdx.x;
        asm volatile("" : "+v"(tid)); asm volatile("" : "+s"(G)); asm volatile("" : "+s"(bid));
        unsigned char* ws = a.ws;
        bf16* Wb = (bf16*)(ws + WS_W);
        bf16* QKV = (bf16*)(ws + WS_R1); bf16* U = QKV + (size_t)CH * 2304; bf16* GV = U + (size_t)CH * 1024; bf16* GT = GV + (size_t)CH * 1024;
        bf16* AF = (bf16*)(ws + WS_R1);
        bf16* MG = GV;
        bf16* OUTG = (bf16*)(ws + WS_R2); bf16* OA = OUTG + (size_t)3 * CH * 256; float* LSE = (float*)(OA + (size_t)CH * 256);
        bf16* FG = (bf16*)(ws + WS_R2);
        bf16* XB = (bf16*)(ws + WS_XB); float* SS = (float*)(ws + WS_SS); float* SSV = (float*)(ws + WS_SSV);
        if (ph == 0 && !(SKIPMASK & 256)) p0_weights(a, lds, tid, G, bid);
        else {
            const int chunk = (ph - 1) / PH_PER_CHUNK, sub = (ph - 1) % PH_PER_CHUNK;
            const int S = chunk == 0 ? 8192 : 2048;
            if (sub == 0 && !(SKIPMASK & 512)) p0x(a, chunk, tid, G, bid);
            else if (sub == PH_PER_CHUNK - 1) pfinal(a, chunk, tid, G, bid);
            else {
                const int l = (sub - 1) / KPL, ki = (sub - 1) % KPL, k = (KPL == 9 && ki > PROBE_DUPK) ? ki - 1 : ki; const bool dup = (KPL == 9 && ki == PROBE_DUPK + 1);
                const bf16* wl = Wb + (size_t)l * W_LAYER;
                float* X = a.out + (size_t)chunk * CH * DM;
                if (k == 0 && !(SKIPMASK & 1)) {
                    pg8::Gemm g{XB, wl + OFF_IN, CH, NIN, DM}; pg8::StaticOrder So; So.init(CH, NIN, G, bid);
                    pg8::EpiIn E{QKV, U, GV, GT, SS, SSV};
                    pg8::gemm_phase<pg8::EpiIn, pg8::StaticOrder, true, true>(lds, g, So, E, tid);
                } else if (k == 1 && !(SKIPMASK & 2)) {
                    constexpr int NATT = 3 * (CH / 64), NSGW = (CH / 128) * 16;
                    if (!(SKIPMASK & 1024) && !(dup && PROBE_KIND == 8)) for (int it = bid; it < NATT; it += G) attn_unit(QKV, OUTG, LSE, a.in[2], lds, it, S, tid);
                    if (!(SKIPMASK & 2048) && (!dup || PROBE_KIND == 8)) {
                        bf16* UO = dup ? (bf16*)(ws + WS_R2 + (size_t)CH * 2096) : U;
                        const int wave = __builtin_amdgcn_readfirstlane(tid >> 6);
                        for (int wu = bid * 8 + wave; wu < NSGW; wu += G * 8) sg_wave_unit(U, UO, GV, SSV, wl + OFF_WS, a.in[5] + l * 1024, a.in[7] + l * 1024, lds + wave * SG_WLDS, wu, tid & 63);
                    }
                } else if (k == 2 && !(SKIPMASK & 4)) p_merge(OUTG, LSE, OA, tid, G, bid);
                else if (k == 3 && !(SKIPMASK & 8)) {
                    if (!(SKIPMASK & 4096)) { int kpa = 256; asm volatile("" : "+s"(kpa)); pg8::Gemm g{OA, wl + OFF_PA, CH, DM, kpa}; pg8::StaticOrder So; So.init(CH, DM, G, bid);
                      pg8::EpiGate<0> E{MG, GT, 0};
                      pg8::gemm_phase<pg8::EpiGate<0>, pg8::StaticOrder, true, true>(lds, g, So, E, tid); }
                    if (!(SKIPMASK & 8192)) { pg8::Gemm g{U, wl + OFF_PB, CH, DM, DM}; pg8::StaticOrder So; So.init(CH, DM, G, bid);
                      pg8::EpiGate<1> E{MG, GT, 1024};
                      pg8::gemm_phase<pg8::EpiGate<1>, pg8::StaticOrder, true, true>(lds, g, So, E, tid); }
                } else if (k == 4 && !(SKIPMASK & 16)) {
                    pg8::Gemm g{MG, wl + OFF_OUT, CH, DM, DM}; pg8::StaticOrder So; So.init(CH, DM, G, bid);
                    pg8::EpiRes E{X, XB, SS};
                    pg8::gemm_phase<pg8::EpiRes, pg8::StaticOrder, true, true>(lds, g, So, E, tid);
                } else if (k == 5 && !(SKIPMASK & 32)) {
                    pg8::Gemm g{XB, wl + OFF_UP, CH, NUP, DM}; pg8::StaticOrder So; So.init(CH, NUP, G, bid);
                    pg8::EpiUp E{AF, SS};
                    pg8::gemm_phase<pg8::EpiUp, pg8::StaticOrder, true, true>(lds, g, So, E, tid);
                } else if (k == 6 && !(SKIPMASK & 64)) p_conv(AF, FG, a.in[13] + (size_t)l * 3 * NUP, a.in[14] + (size_t)l * NUP, S, tid, G, bid);
                else if (!(SKIPMASK & 128)) {
                    pg8::Gemm g{FG, wl + OFF_DN, CH, DM, DFF}; pg8::StaticOrder So; So.init(CH, DM, G, bid);
                    pg8::EpiRes E{X, XB, SS};
                    pg8::gemm_phase<pg8::EpiRes, pg8::StaticOrder, true, true>(lds, g, So, E, tid);
                }
            }
        }
        if (ph + 1 < ph_hi) {
            if (ph == ph_lo) grid.sync();
            XcdBarrier xb; xb.bar = (unsigned*)(a.ws + WS_BAR); xb.x = xcc; xb.st = xst;
            xcd_barrier(xb, tid);
            if (PROBE_KIND == 100) xcd_barrier(xb, tid);
        }
    }
}

extern "C" void kernel_launch(void* const* d_in, const int* in_sizes, int n_in, void* d_out, int out_size, void* d_ws, size_t ws_size, hipStream_t stream) {
    static int grid = 0;
    if (grid == 0) {
        if (n_in != 17 || out_size != NTOK * DM || ws_size < WS_END) { fprintf(stderr, "kernel_launch: unexpected shapes: n_in %d out %d ws %zu (need %zu)\n", n_in, out_size, ws_size, (size_t)WS_END); grid = -1; return; }
        int dev = 0, cus = 0, per_cu = 0;
        (void)hipGetDevice(&dev); (void)hipDeviceGetAttribute(&cus, hipDeviceAttributeMultiprocessorCount, dev);
        if (hipFuncSetAttribute((const void*)fwd_kernel, hipFuncAttributeMaxDynamicSharedMemorySize, LDS_BYTES) != hipSuccess) { fprintf(stderr, "kernel_launch: hipFuncSetAttribute failed\n"); grid = -1; return; }
        if (hipOccupancyMaxActiveBlocksPerMultiprocessor(&per_cu, (const void*)fwd_kernel, NTHR, LDS_BYTES) != hipSuccess || per_cu < 1) { fprintf(stderr, "kernel_launch: occupancy query says %d\n", per_cu); per_cu = 1; }
        (void)hipGetLastError();
        grid = cus * per_cu;
        if (grid <= 0) grid = 256;
    }
    if (grid < 0) return;
    if (hipMemsetAsync((char*)d_ws + WS_BAR, 0, 65536, stream) != hipSuccess) { fprintf(stderr, "kernel_launch: memset failed\n"); return; }
    Args a{};
    for (int i = 0; i < 17; ++i) a.in[i] = (const float*)d_in[i];
    a.out = (float*)d_out; a.ws = (unsigned char*)d_ws;
#if ONE_LAUNCH
    a.ph_lo = 0; a.ph_hi = N_PHASES;
    void* args[] = {&a};
    hipError_t e = hipLaunchCooperativeKernel((const void*)fwd_kernel, dim3(grid), dim3(NTHR), args, LDS_BYTES, stream);
    if (e != hipSuccess) fprintf(stderr, "cooperative launch failed: %s (grid %d)\n", hipGetErrorString(e), grid);
#else
    for (int ph = 0; ph < N_PHASES; ++ph) {
        a.ph_lo = ph; a.ph_hi = ph + 1;
        hipLaunchKernelGGL(fwd_kernel, dim3(grid), dim3(NTHR), LDS_BYTES, stream, a);
    }
#endif
}
```

```cpp
#include <hip/hip_runtime.h>
#include <hip/hip_cooperative_groups.h>
#include <cstdio>
#include <cstdint>
namespace cg = cooperative_groups;

#ifndef ONE_LAUNCH
#define ONE_LAUNCH 1
#endif

namespace pg8 {
#define PG8_LAS __attribute__((address_space(3)))
typedef unsigned short bf16_t;
typedef short bf16x8 __attribute__((ext_vector_type(8)));
typedef float f32x4 __attribute__((ext_vector_type(4)));
typedef unsigned u32x4 __attribute__((ext_vector_type(4)));
constexpr int BM = 256, BK = 64, HALF = 128, HTB = HALF * BK * 2  , STAGE_BYTES = 8 * HTB, NXCD = 8, WGM = 8;

__host__ __device__ __forceinline__ int lds_byte(int r, int c) { const int st = (r >> 4) * 2 + (c >> 5), rr = r & 15, cc = c & 31, ob = rr * 64 + cc * 2; return st * 1024 + (ob ^ (((ob >> 9) & 1) << 5)); }
__host__ __device__ __forceinline__ void stage_rc(int b, int& R, int& C) { const int st = b / 1024, sb = b % 1024, swz = sb ^ (((sb >> 9) & 1) << 5); R = (st >> 1) * 16 + swz / 64; C = (st & 1) * 32 + (swz % 64) / 2; }
__host__ __device__ __forceinline__ int perm32(int rho) { const int n = rho >> 4, i = rho & 15; return 8 * (i >> 2) + 4 * n + (i & 3); }

struct Unit { int pm, pn; };
struct Gemm { const bf16_t* A; const bf16_t* Bt; int M, N, K; };

struct StaticOrder {
    int nM, nN, nwg, G, c;
    __host__ __device__ void init(int M, int N, int G_, int c_) { nM = M / BM; nN = N / BM; nwg = nM * nN; G = G_; c = c_; }
    __host__ __device__ bool next(int i, Unit& u) const {
        const long L = (long)i * G + c; if (L >= nwg) return false;
        int wgid = (int)L; { const int q = nwg / NXCD, r = nwg % NXCD, xcd = wgid % NXCD, off = wgid / NXCD; wgid = (xcd < r ? xcd * (q + 1) : r * (q + 1) + (xcd - r) * q) + off; }
        const int nig = WGM * nN, gid = wgid / nig, fm = gid * WGM, gsz = (nM - fm) < WGM ? (nM - fm) : WGM;
        u.pm = fm + ((wgid % nig) % gsz); u.pn = (wgid % nig) / gsz; return true;
    }
    __device__ __forceinline__ void a_ready(const Unit&) const {}
    __device__ __forceinline__ void done(const Unit&) const {}
};

__device__ __forceinline__ unsigned cvt_pk_bf16(float lo, float hi) { unsigned r; asm volatile("v_cvt_pk_bf16_f32 %0, %1, %2" : "=v"(r) : "v"(lo), "v"(hi)); return r; }

__device__ __forceinline__ float fast_sigmoid(float x) { return __builtin_amdgcn_rcpf(1.0f + __builtin_amdgcn_exp2f(-1.4426950408889634f * x)); }
__device__ __forceinline__ float gelu_tanh(float x) {
    const float y = x * (1.0f + 0.044715f * x * x) * (2.0f * 0.7978845608028654f);
    return x * __builtin_amdgcn_rcpf(1.0f + __builtin_amdgcn_exp2f(-1.4426950408889634f * y));
}
__device__ __forceinline__ float bf2f(unsigned short b) { return __uint_as_float(((unsigned)b) << 16); }
__device__ __forceinline__ u32x4 pack8(const f32x4 a, const f32x4 b) { u32x4 w; w.x = cvt_pk_bf16(a[0], a[1]); w.y = cvt_pk_bf16(a[2], a[3]); w.z = cvt_pk_bf16(b[0], b[1]); w.w = cvt_pk_bf16(b[2], b[3]); return w; }
__device__ __forceinline__ void unpack8(const u32x4 w, f32x4& a, f32x4& b) {
    a[0] = __uint_as_float(w.x << 16); a[1] = __uint_as_float(w.x & 0xffff0000u); a[2] = __uint_as_float(w.y << 16); a[3] = __uint_as_float(w.y & 0xffff0000u);
    b[0] = __uint_as_float(w.z << 16); b[1] = __uint_as_float(w.z & 0xffff0000u); b[2] = __uint_as_float(w.w << 16); b[3] = __uint_as_float(w.w & 0xffff0000u);
}
__device__ __forceinline__ float row_rs(const float* ss, int row) {
    const f32x4* sp = (const f32x4*)(ss + (size_t)row * 16);
    const f32x4 s = (sp[0] + sp[1]) + (sp[2] + sp[3]);
    return rsqrtf(((s[0] + s[1]) + (s[2] + s[3])) * (1.0f / 1024.0f) + 1e-6f);
}

__device__ __forceinline__ void rows_rs(const float* ss, int row0, int fq, float (&rsv)[2][4]) {
    f32x4 part[2][4];
#pragma unroll
    for (int ai = 0; ai < 2; ++ai)
#pragma unroll
        for (int m = 0; m < 4; ++m) part[ai][m] = *(const f32x4*)(ss + (size_t)(row0 + ai * HALF + m * 16) * 16 + fq * 4);
#pragma unroll
    for (int ai = 0; ai < 2; ++ai)
#pragma unroll
        for (int m = 0; m < 4; ++m) { float t = (part[ai][m][0] + part[ai][m][1]) + (part[ai][m][2] + part[ai][m][3]); t += __shfl_xor(t, 16); t += __shfl_xor(t, 32); rsv[ai][m] = rsqrtf(t * (1.0f / 1024.0f) + 1e-6f); }
}

struct EpiIn {
    static constexpr bool PERM = true, AFTER_DRAIN = false;
    bf16_t* QKV; bf16_t* U; bf16_t* GV; bf16_t* G; const float* ss; float* ssv;
    __device__ __forceinline__ void operator()(const f32x4 (&acc)[2][2][4][2], const Unit& u, int wr, int wc, int fr, int fq) const {
        const int pn = u.pn;
        float rsv[2][4]; rows_rs(ss, u.pm * BM + wr * 64 + fr, fq, rsv);
#pragma unroll
        for (int ai = 0; ai < 2; ++ai)
#pragma unroll
            for (int m = 0; m < 4; ++m) {
                const int row = u.pm * BM + ai * HALF + wr * 64 + m * 16 + fr;
                const float rs = rsv[ai][m];
                float q = 0.f;
#pragma unroll
                for (int bj = 0; bj < 2; ++bj) {
                    const int col = pn * BM + bj * HALF + wc * 32 + 8 * fq;
                    f32x4 v0 = acc[ai][bj][m][0] * rs, v1 = acc[ai][bj][m][1] * rs;
                    bf16_t* dst;
                    if (pn < 9) { if (pn < 3) { v0 = v0 * (0.125f * 1.4426950408889634f); v1 = v1 * (0.125f * 1.4426950408889634f); }     dst = QKV + (size_t)row * 2304 + col; }
                    else if (pn < 17) {
#pragma unroll
                        for (int e = 0; e < 4; ++e) { v0[e] = gelu_tanh(v0[e]); v1[e] = gelu_tanh(v1[e]); }
                        if (pn < 13) dst = U + (size_t)row * 1024 + (col - 2304);
                        else { dst = GV + (size_t)row * 1024 + (col - 3328);
#pragma unroll
                            for (int e = 0; e < 4; ++e) q += v0[e] * v0[e] + v1[e] * v1[e]; }
                    } else {
#pragma unroll
                        for (int e = 0; e < 4; ++e) { v0[e] = fast_sigmoid(v0[e]); v1[e] = fast_sigmoid(v1[e]); }
                        dst = G + (size_t)row * 2048 + (col - 4352);
                    }
                    *(u32x4*)dst = pack8(v0, v1);
                }
                if (pn >= 13 && pn < 17) { q += __shfl_xor(q, 16); q += __shfl_xor(q, 32); if (fq == 0) ssv[(size_t)row * 16 + (pn - 13) * 4 + wc] = q; }
                asm volatile("" ::: "memory");
            }
    }
};
template <int MODE> struct EpiGate {
    static constexpr bool PERM = true, AFTER_DRAIN = false;
    bf16_t* O; const bf16_t* G; int goff;
    __device__ __forceinline__ void operator()(const f32x4 (&acc)[2][2][4][2], const Unit& u, int wr, int wc, int fr, int fq) const {
#pragma unroll
        for (int ai = 0; ai < 2; ++ai) {
            u32x4 gw[4][2], pw[4][2];
#pragma unroll
            for (int m = 0; m < 4; ++m)
#pragma unroll
                for (int bj = 0; bj < 2; ++bj) {
                    const int row = u.pm * BM + ai * HALF + wr * 64 + m * 16 + fr, col = u.pn * BM + bj * HALF + wc * 32 + 8 * fq;
                    gw[m][bj] = *(const u32x4*)(G + (size_t)row * 2048 + goff + col);
                    if (MODE == 1) pw[m][bj] = *(const u32x4*)(O + (size_t)row * 1024 + col);
                }
#pragma unroll
            for (int m = 0; m < 4; ++m)
#pragma unroll
                for (int bj = 0; bj < 2; ++bj) {
                    const int row = u.pm * BM + ai * HALF + wr * 64 + m * 16 + fr, col = u.pn * BM + bj * HALF + wc * 32 + 8 * fq;
                    f32x4 g0, g1; unpack8(gw[m][bj], g0, g1);
                    f32x4 v0 = acc[ai][bj][m][0] * g0, v1 = acc[ai][bj][m][1] * g1;
                    if (MODE == 1) { f32x4 p0, p1; unpack8(pw[m][bj], p0, p1); v0 = v0 + p0; v1 = v1 + p1; }
                    *(u32x4*)(O + (size_t)row * 1024 + col) = pack8(v0, v1);
                }
            asm volatile("" ::: "memory");
        }
    }
};
struct EpiRes {
    static constexpr bool PERM = true, AFTER_DRAIN = false;
    float* X; bf16_t* XB; float* ss;
    __device__ __forceinline__ void operator()(const f32x4 (&acc)[2][2][4][2], const Unit& u, int wr, int wc, int fr, int fq) const {
#pragma unroll
        for (int ai = 0; ai < 2; ++ai) {
            f32x4 xv[4][2][2];
#pragma unroll
            for (int m = 0; m < 4; ++m)
#pragma unroll
                for (int bj = 0; bj < 2; ++bj) {
                    const float* xp = X + (size_t)(u.pm * BM + ai * HALF + wr * 64 + m * 16 + fr) * 1024 + u.pn * BM + bj * HALF + wc * 32 + 8 * fq;
                    xv[m][bj][0] = *(const f32x4*)xp; xv[m][bj][1] = *(const f32x4*)(xp + 4);
                }
#pragma unroll
            for (int m = 0; m < 4; ++m) {
                const int row = u.pm * BM + ai * HALF + wr * 64 + m * 16 + fr;
                float q = 0.f;
#pragma unroll
                for (int bj = 0; bj < 2; ++bj) {
                    const int col = u.pn * BM + bj * HALF + wc * 32 + 8 * fq;
                    float* xp = X + (size_t)row * 1024 + col;
                    const f32x4 x0 = xv[m][bj][0] + acc[ai][bj][m][0], x1 = xv[m][bj][1] + acc[ai][bj][m][1];
                    *(f32x4*)xp = x0; *(f32x4*)(xp + 4) = x1;
                    *(u32x4*)(XB + (size_t)row * 1024 + col) = pack8(x0, x1);
#pragma unroll
                    for (int e = 0; e < 4; ++e) q += x0[e] * x0[e] + x1[e] * x1[e];
                }
                q += __shfl_xor(q, 16); q += __shfl_xor(q, 32);
                if (fq == 0) ss[(size_t)row * 16 + u.pn * 4 + wc] = q;
            }
            asm volatile("" ::: "memory");
        }
    }
};
struct EpiUp {
    static constexpr bool PERM = true, AFTER_DRAIN = false;
    bf16_t* A; const float* ss;
    __device__ __forceinline__ void operator()(const f32x4 (&acc)[2][2][4][2], const Unit& u, int wr, int wc, int fr, int fq) const {
        float rsv[2][4]; rows_rs(ss, u.pm * BM + wr * 64 + fr, fq, rsv);
#pragma unroll
        for (int ai = 0; ai < 2; ++ai)
#pragma unroll
            for (int m = 0; m < 4; ++m) {
                const int row = u.pm * BM + ai * HALF + wr * 64 + m * 16 + fr;
                const float rs = rsv[ai][m];
#pragma unroll
                for (int bj = 0; bj < 2; ++bj) {
                    const int col = u.pn * BM + bj * HALF + wc * 32 + 8 * fq;
                    *(u32x4*)(A + (size_t)row * 5632 + col) = pack8(acc[ai][bj][m][0] * rs, acc[ai][bj][m][1] * rs);
                }
                asm volatile("" ::: "memory");
            }
    }
};

__device__ __forceinline__ float dpp_prev(float x) { return __int_as_float(__builtin_amdgcn_update_dpp(0, __float_as_int(x), 0x121, 0xf, 0xf, false)); }
__device__ __forceinline__ float dpp_next(float x) { return __int_as_float(__builtin_amdgcn_update_dpp(0, __float_as_int(x), 0x12F, 0xf, 0xf, false)); }
__device__ __forceinline__ f32x4 rot_prev(const f32x4 v) { f32x4 r; r[0] = dpp_prev(v[0]); r[1] = dpp_prev(v[1]); r[2] = dpp_prev(v[2]); r[3] = dpp_prev(v[3]); return r; }
__device__ __forceinline__ f32x4 rot_next(const f32x4 v) { f32x4 r; r[0] = dpp_next(v[0]); r[1] = dpp_next(v[1]); r[2] = dpp_next(v[2]); r[3] = dpp_next(v[3]); return r; }
struct EpiUpConv {
    static constexpr bool PERM = true, AFTER_DRAIN = false;
    bf16_t* FG; bf16_t* SB; const float* ss; const float* cw; const float* cb;
    __device__ __forceinline__ void operator()(const f32x4 (&acc_)[2][2][4][2], const Unit& u, int wr, int wc, int fr, int fq) const {
        f32x4 (&acc)[2][2][4][2] = const_cast<f32x4 (&)[2][2][4][2]>(acc_);
        float rsv[2][4]; rows_rs(ss, u.pm * BM + wr * 64 + fr, fq, rsv);
        const int f0 = u.pn * 128 + wc * 32 + 8 * fq;
        const bool first = fr == 0, last = fr == 15;
#pragma unroll
        for (int ai = 0; ai < 2; ++ai) {
#pragma unroll
            for (int m = 0; m < 4; ++m)
#pragma unroll
                for (int h = 0; h < 2; ++h) { acc[ai][h][m][0] = acc[ai][h][m][0] * rsv[ai][m]; acc[ai][h][m][1] = acc[ai][h][m][1] * rsv[ai][m]; }
            const int blk = (u.pm * BM + ai * HALF + wr * 64) >> 6;
            if (fr <= 1) { bf16_t* sp = SB + ((size_t)blk * 4 + fr) * 5632 + f0;
                *(u32x4*)sp = pack8(acc[ai][0][0][0], acc[ai][0][0][1]); *(u32x4*)(sp + 2816) = pack8(acc[ai][1][0][0], acc[ai][1][0][1]); }
            if (fr >= 14) { bf16_t* sp = SB + ((size_t)blk * 4 + (fr - 12)) * 5632 + f0;
                *(u32x4*)sp = pack8(acc[ai][0][3][0], acc[ai][0][3][1]); *(u32x4*)(sp + 2816) = pack8(acc[ai][1][3][0], acc[ai][1][3][1]); }
        }
#pragma unroll
        for (int n = 0; n < 2; ++n) {
            f32x4 w[2][4];
#pragma unroll
            for (int h = 0; h < 2; ++h) {
#pragma unroll
                for (int k = 0; k < 3; ++k) w[h][k] = *(const f32x4*)(cw + k * 5632 + h * 2816 + f0 + 4 * n);
                w[h][3] = *(const f32x4*)(cb + h * 2816 + f0 + 4 * n);
            }
#pragma unroll
            for (int ai = 0; ai < 2; ++ai) {
#pragma unroll
                for (int m = 0; m < 4; ++m) {
                    const int row = u.pm * BM + ai * HALF + wr * 64 + m * 16 + fr;
                    f32x4 cv[2];
#pragma unroll
                    for (int h = 0; h < 2; ++h) {
                        const f32x4 cur = acc[ai][h][m][n];
                        f32x4 pv = rot_prev(cur), nx = rot_next(cur);
                        if (m > 0) { const f32x4 pw = rot_prev(acc[ai][h][m - 1][n]);
#pragma unroll
                            for (int e = 0; e < 4; ++e) pv[e] = first ? pw[e] : pv[e]; }
                        if (m < 3) { const f32x4 nw = rot_next(acc[ai][h][m + 1][n]);
#pragma unroll
                            for (int e = 0; e < 4; ++e) nx[e] = last ? nw[e] : nx[e]; }
                        cv[h] = pv * w[h][0] + cur * w[h][1] + nx * w[h][2] + w[h][3];
                    }
                    f32x4 o;
#pragma unroll
                    for (int e = 0; e < 4; ++e) o[e] = gelu_tanh(cv[0][e]) * cv[1][e];
                    const bool brow = (m == 0 && first) || (m == 3 && last);
                    if (!brow) { typedef unsigned u32x2e __attribute__((ext_vector_type(2))); u32x2e ow; ow.x = cvt_pk_bf16(o[0], o[1]); ow.y = cvt_pk_bf16(o[2], o[3]); *(u32x2e*)(FG + (size_t)row * 2816 + f0 + 4 * n) = ow; }
                }
                asm volatile("" ::: "memory");
            }
        }
    }
};

template <class Epi, class Sched, bool ALIGN_EPI = false, bool SP2 = false>
__device__ __forceinline__ void gemm_phase(PG8_LAS unsigned char* lds, const Gemm g, const Sched& S, const Epi& E, const int tid) {
    const int wid = __builtin_amdgcn_readfirstlane(tid >> 6), lane = tid & 63, wr = wid >> 2, wc = wid & 3, fr = lane & 15, fq = lane >> 4;
    const int K = g.K, nt = K / BK;
    unsigned voffA[2], voffB[2];
#pragma unroll
    for (int i = 0; i < 2; ++i) { int R, C; stage_rc(tid * 16 + i * 8192, R, C); const int Rb = Epi::PERM ? ((R & ~31) + perm32(R & 31)) : R;
        voffA[i] = (unsigned)(R * K + C) * 2u; voffB[i] = (unsigned)(Rb * K + C) * 2u; }
    const size_t kstep = (size_t)(BK * 2);
    const size_t hstep = (size_t)HALF * K * 2;
    const size_t tstep = 2 * hstep;
    const unsigned ldsw = (unsigned)wid * 1024u;
    const int aoff = lds_byte(wr * 64 + fr, fq * 8), boff = lds_byte(wc * 32 + fr, fq * 8);
#define PG8_SA(b, h) (((b) * 2 + (h)) * HTB)
#define PG8_SB(b, h) ((4 + (b) * 2 + (h)) * HTB)
#define PG8_STAGE(bufoff, gbase, voff) do { _Pragma("unroll") for (int _i = 0; _i < 2; ++_i) \
        __builtin_amdgcn_global_load_lds((const unsigned*)((const char*)(gbase) + (voff)[_i]), (PG8_LAS unsigned*)(lds + (bufoff) + ldsw + _i * 8192), 16, 0, 0); } while (0)
#define PG8_LDA(dst, b, h) do { _Pragma("unroll") for (int m = 0; m < 4; ++m) _Pragma("unroll") for (int k = 0; k < 2; ++k) dst[m][k] = *(const PG8_LAS bf16x8*)(lds + PG8_SA(b, h) + aoff + m * 2048 + k * 1024); } while (0)
#define PG8_LDB(dst, b, h) do { _Pragma("unroll") for (int n = 0; n < 2; ++n) _Pragma("unroll") for (int k = 0; k < 2; ++k) dst[n][k] = *(const PG8_LAS bf16x8*)(lds + PG8_SB(b, h) + boff + n * 2048 + k * 1024); } while (0)
#define PG8_MMA(ai, bj, At, Bt) do { __builtin_amdgcn_s_setprio(1); _Pragma("unroll") for (int m = 0; m < 4; ++m) _Pragma("unroll") for (int n = 0; n < 2; ++n) _Pragma("unroll") for (int k = 0; k < 2; ++k) \
        acc[ai][bj][m][n] = __builtin_amdgcn_mfma_f32_16x16x32_bf16(Bt[n][k], At[m][k], acc[ai][bj][m][n], 0, 0, 0); __builtin_amdgcn_s_setprio(0); } while (0)
#define PG8_WAIT_V(n) asm volatile("s_waitcnt vmcnt(" #n ")" ::: "memory")
#define PG8_WAIT_L(n) asm volatile("s_waitcnt lgkmcnt(" #n ")" ::: "memory")
#define PG8_BAR __builtin_amdgcn_s_barrier()
#define PG8_SCHED __builtin_amdgcn_sched_barrier(0)
    Unit cur, nxt; int ui = 0;
    if (!S.next(0, cur)) return;
    f32x4 acc[2][2][4][2];
#pragma unroll
    for (int a = 0; a < 2; ++a)
#pragma unroll
        for (int b = 0; b < 2; ++b)
#pragma unroll
            for (int m = 0; m < 4; ++m)
#pragma unroll
                for (int n = 0; n < 2; ++n) acc[a][b][m][n] = (f32x4){0.f, 0.f, 0.f, 0.f};
    bf16x8 At[4][2], B0[2][2], B1[2][2];
    const char* cA = (const char*)g.A + (size_t)cur.pm * tstep; const char* cB = (const char*)g.Bt + (size_t)cur.pn * tstep;
    S.a_ready(cur);
    if constexpr (SP2) {
        PG8_STAGE(PG8_SB(0, 0), cB, voffB); PG8_STAGE(PG8_SB(0, 1), cB + hstep, voffB); PG8_STAGE(PG8_SA(0, 0), cA, voffA); PG8_STAGE(PG8_SA(0, 1), cA + hstep, voffA);
        if (wr == 1) PG8_BAR;
        PG8_WAIT_V(2); PG8_BAR;
        PG8_STAGE(PG8_SB(1, 0), cB + kstep, voffB); PG8_STAGE(PG8_SA(1, 0), cA + kstep, voffA); PG8_STAGE(PG8_SB(1, 1), cB + hstep + kstep, voffB);
        PG8_WAIT_V(6); PG8_BAR;
    } else {
        PG8_STAGE(PG8_SB(0, 0), cB, voffB); PG8_STAGE(PG8_SA(0, 0), cA, voffA); PG8_STAGE(PG8_SB(0, 1), cB + hstep, voffB); PG8_STAGE(PG8_SA(0, 1), cA + hstep, voffA);
        if (wr == 1) PG8_BAR;
        PG8_WAIT_V(4); PG8_BAR;
        PG8_STAGE(PG8_SB(1, 0), cB + kstep, voffB); PG8_STAGE(PG8_SA(1, 0), cA + kstep, voffA); PG8_STAGE(PG8_SB(1, 1), cB + hstep + kstep, voffB);
        PG8_WAIT_V(6); PG8_BAR;
    }
    for (;;) {
        const bool has_next = S.next(ui + 1, nxt);
        const char* nA = has_next ? (const char*)g.A + (size_t)nxt.pm * tstep : cA; const char* nB = has_next ? (const char*)g.Bt + (size_t)nxt.pn * tstep : cB;
        for (int t = 0; t < nt; t += 2) {
            const bool last = (t == nt - 2);
            const char* a1 = cA + (size_t)(t + 1) * kstep;
            const char* a2 = last ? nA : cA + (size_t)(t + 2) * kstep; const char* b2 = last ? nB : cB + (size_t)(t + 2) * kstep;
            const char* a3 = a2 + kstep; const char* b3 = b2 + kstep;
            if (last && has_next) S.a_ready(nxt);
            if constexpr (SP2) {
            PG8_LDB(B0, 0, 0); PG8_LDB(B1, 0, 1); PG8_SCHED; PG8_LDA(At, 0, 0); PG8_STAGE(PG8_SA(1, 1), a1 + hstep, voffA);
            PG8_WAIT_V(8); PG8_WAIT_L(0); PG8_BAR; PG8_MMA(0, 0, At, B0); PG8_MMA(0, 1, At, B1); PG8_BAR; PG8_SCHED;
            PG8_LDA(At, 0, 1); PG8_STAGE(PG8_SB(0, 0), b2, voffB); PG8_STAGE(PG8_SB(0, 1), b2 + hstep, voffB); PG8_STAGE(PG8_SA(0, 0), a2, voffA);
            PG8_WAIT_V(8); PG8_WAIT_L(0); PG8_BAR; PG8_MMA(1, 0, At, B0); PG8_MMA(1, 1, At, B1); PG8_BAR; PG8_SCHED;
            PG8_LDB(B0, 1, 0); PG8_LDB(B1, 1, 1); PG8_SCHED; PG8_LDA(At, 1, 0); PG8_STAGE(PG8_SA(0, 1), a2 + hstep, voffA);
            PG8_WAIT_V(8); PG8_WAIT_L(0); PG8_BAR; PG8_MMA(0, 0, At, B0); PG8_MMA(0, 1, At, B1); PG8_BAR; PG8_SCHED;
            PG8_LDA(At, 1, 1); PG8_STAGE(PG8_SB(1, 0), b3, voffB); PG8_STAGE(PG8_SB(1, 1), b3 + hstep, voffB); PG8_STAGE(PG8_SA(1, 0), a3, voffA);
            PG8_WAIT_V(8); PG8_WAIT_L(0); PG8_BAR; PG8_MMA(1, 0, At, B0); PG8_MMA(1, 1, At, B1); PG8_BAR; PG8_SCHED;
            } else {
            PG8_LDB(B0, 0, 0); PG8_SCHED; PG8_LDA(At, 0, 0); PG8_STAGE(PG8_SA(1, 1), a1 + hstep, voffA);
            PG8_WAIT_L(8); PG8_BAR; PG8_WAIT_L(0); PG8_MMA(0, 0, At, B0); PG8_BAR; PG8_SCHED;
            PG8_LDB(B1, 0, 1); PG8_STAGE(PG8_SB(0, 0), b2, voffB);
            PG8_BAR; PG8_WAIT_L(0); PG8_MMA(0, 1, At, B1); PG8_BAR;
            PG8_LDA(At, 0, 1); PG8_STAGE(PG8_SA(0, 0), a2, voffA);
            PG8_BAR; PG8_WAIT_L(0); PG8_MMA(1, 0, At, B0); PG8_BAR; PG8_SCHED;
            PG8_STAGE(PG8_SB(0, 1), b2 + hstep, voffB);
            PG8_WAIT_V(6); PG8_BAR; PG8_MMA(1, 1, At, B1); PG8_BAR;
            PG8_LDB(B0, 1, 0); PG8_SCHED; PG8_LDA(At, 1, 0); PG8_STAGE(PG8_SA(0, 1), a2 + hstep, voffA);
            PG8_WAIT_L(8); PG8_BAR; PG8_WAIT_L(0); PG8_MMA(0, 0, At, B0); PG8_BAR; PG8_SCHED;
            PG8_LDB(B1, 1, 1); PG8_STAGE(PG8_SB(1, 0), b3, voffB);
            PG8_BAR; PG8_WAIT_L(0); PG8_MMA(0, 1, At, B1); PG8_BAR;
            PG8_LDA(At, 1, 1); PG8_STAGE(PG8_SA(1, 0), a3, voffA);
            PG8_BAR; PG8_WAIT_L(0); PG8_MMA(1, 0, At, B0); PG8_BAR; PG8_SCHED;
            PG8_STAGE(PG8_SB(1, 1), b3 + hstep, voffB);
            PG8_WAIT_V(6); PG8_BAR; PG8_MMA(1, 1, At, B1); PG8_BAR;
            }
        }
        if constexpr (ALIGN_EPI) { if (wr == 0) PG8_BAR; }
        if constexpr (!Epi::AFTER_DRAIN) { E(acc, cur, wr, wc, fr, fq); S.done(cur); }
        if (!has_next) break;
#pragma unroll
        for (int a = 0; a < 2; ++a)
#pragma unroll
            for (int b = 0; b < 2; ++b)
#pragma unroll
                for (int m = 0; m < 4; ++m)
#pragma unroll
                    for (int n = 0; n < 2; ++n) acc[a][b][m][n] = (f32x4){0.f, 0.f, 0.f, 0.f};
        cur = nxt; cA = nA; cB = nB; ++ui;
        if constexpr (ALIGN_EPI) { if (wr == 1) PG8_BAR; }
    }
    PG8_WAIT_V(0);
    if constexpr (!ALIGN_EPI) { if (wr == 0) PG8_BAR; }
    PG8_BAR;
    if constexpr (Epi::AFTER_DRAIN) { E.fused(acc, cur, wr, wc, fr, fq, lds, wid, lane); S.done(cur); }
#undef PG8_SA
#undef PG8_SB
#undef PG8_STAGE
#undef PG8_LDA
#undef PG8_LDB
#undef PG8_MMA
#undef PG8_WAIT_V
#undef PG8_WAIT_L
#undef PG8_BAR
#undef PG8_SCHED
}
}


#define LAS __attribute__((address_space(3)))
#ifndef SKIPMASK
#define SKIPMASK 0
#endif
#ifndef PROBE_KIND
#define PROBE_KIND -1
#endif
typedef unsigned short bf16;
using pg8::f32x4; using pg8::u32x4; using pg8::bf16x8;
typedef float f32x16 __attribute__((ext_vector_type(16)));
typedef short v4i16_t __attribute__((ext_vector_type(4)));
typedef unsigned u32x2 __attribute__((ext_vector_type(2)));

constexpr int DM = 1024, DEPTH = 4, NTOK = 98304, NPROMPT = 32768, CH = 32768, NCHUNK = NTOK / CH;
constexpr int NIN = 6400, DFF = 2816, NUP = 5632;
constexpr int LDS_BYTES = 147456, NTHR = 512;
constexpr float EPS = 1e-6f, LOG2E = 1.4426950408889634f;
constexpr size_t OFF_IN = 0, OFF_PA = OFF_IN + (size_t)NIN * DM, OFF_PB = OFF_PA + (size_t)DM * 256, OFF_OUT = OFF_PB + (size_t)DM * DM, OFF_UP = OFF_OUT + (size_t)DM * DM,
                 OFF_DN = OFF_UP + (size_t)NUP * DM, OFF_WS = OFF_DN + (size_t)DM * DFF, W_LAYER = OFF_WS + 8 * 128 * 128;
constexpr size_t MiB = 1u << 20;
constexpr size_t WS_W = 0, WS_R1 = 144 * MiB, WS_R2 = WS_R1 + (size_t)CH * 12800, WS_XB = WS_R2 + (size_t)CH * 5632, WS_SS = WS_XB + (size_t)CH * 2048, WS_SSV = WS_SS + (size_t)CH * 64, WS_BAR = WS_SSV + (size_t)CH * 64, WS_SB = WS_BAR + 65536, WS_END = WS_SB + (size_t)(CH / 64) * 4 * 5632 * 2;
static_assert(W_LAYER * 2 * DEPTH <= WS_R1, "weights fit");
constexpr int PROBE_DUPK = (PROBE_KIND == 8) ? 1 : PROBE_KIND;
constexpr int KPL = (PROBE_DUPK >= 0 && PROBE_DUPK < 8) ? 9 : 8;
constexpr int PH_PER_CHUNK = 2 + KPL * DEPTH, N_PHASES = 1 + NCHUNK * PH_PER_CHUNK;

struct Args { const float* in[17]; float* out; unsigned char* ws; int ph_lo, ph_hi; };

__device__ __forceinline__ float wave_sum(float v) {
#pragma unroll
    for (int o = 1; o < 64; o <<= 1) v += __shfl_xor(v, o);
    return v;
}
__device__ __forceinline__ unsigned pk2(float lo, float hi) { return pg8::cvt_pk_bf16(lo, hi); }
#define LDS_WAIT() asm volatile("s_waitcnt lgkmcnt(0)" ::: "memory")

__device__ __forceinline__ void tr_item(const float* W, int K, int N, bf16* WT, const float* gain, LAS float* scr, int item, int lane, bool perm_up = false) {
    const int nblk = N / 32, kb = item / nblk, nb = item % nblk, k0 = 64 * kb, n0 = 32 * nb;
    const int dn0 = perm_up ? ((n0 % DFF) / 128) * 256 + (n0 / DFF) * 128 + (n0 % 128) : n0;
#pragma unroll 8
    for (int i = 0; i < 32; ++i) { const int kk = 2 * i + (lane >> 5); const float g = gain ? gain[k0 + kk] : 1.0f; scr[kk * 33 + (lane & 31)] = W[(size_t)(k0 + kk) * N + n0 + (lane & 31)] * g; }
    LDS_WAIT();
    const int c = lane & 7;
#pragma unroll
    for (int j = 0; j < 4; ++j) { const int n = (lane >> 3) + 8 * j; const LAS float* s = scr + (8 * c) * 33 + n;
        u32x4 o; o.x = pk2(s[0 * 33], s[1 * 33]); o.y = pk2(s[2 * 33], s[3 * 33]); o.z = pk2(s[4 * 33], s[5 * 33]); o.w = pk2(s[6 * 33], s[7 * 33]);
        *(u32x4*)(WT + (size_t)(dn0 + n) * K + k0 + 8 * c) = o; }
    LDS_WAIT();
}
__device__ __forceinline__ void p0_weights(const Args& a, LAS unsigned char* lds, int tid, int G, int bid) {
    const int wave = tid >> 6, lane = tid & 63;
    LAS float* scr = (LAS float*)(lds + wave * 16384);
    const int gw = bid * 8 + wave, NGW = G * 8;
    constexpr int I_IN = 16 * 200, I_PA = 4 * 32, I_PB = 16 * 32, I_OUT = 16 * 32, I_UP = 16 * 176, I_DN = 44 * 32, PER = I_IN + I_PA + I_PB + I_OUT + I_UP + I_DN;
    bf16* Wb = (bf16*)(a.ws + WS_W);
    for (int it = gw; it < DEPTH * PER; it += NGW) {
        const int l = it / PER; int r = it % PER; bf16* wl = Wb + (size_t)l * W_LAYER;
        if (r < I_IN) { tr_item(a.in[4] + (size_t)l * DM * NIN, DM, NIN, wl + OFF_IN, a.in[3] + l * DM, scr, r, lane); continue; } r -= I_IN;
        if (r < I_PA) { tr_item(a.in[8] + (size_t)l * 256 * DM, 256, DM, wl + OFF_PA, nullptr, scr, r, lane); continue; } r -= I_PA;
        if (r < I_PB) { tr_item(a.in[9] + (size_t)l * DM * DM, DM, DM, wl + OFF_PB, nullptr, scr, r, lane); continue; } r -= I_PB;
        if (r < I_OUT) { tr_item(a.in[10] + (size_t)l * DM * DM, DM, DM, wl + OFF_OUT, nullptr, scr, r, lane); continue; } r -= I_OUT;
        if (r < I_UP) { tr_item(a.in[12] + (size_t)l * DM * NUP, DM, NUP, wl + OFF_UP, a.in[11] + l * DM, scr, r, lane, true); continue; } r -= I_UP;
        tr_item(a.in[15] + (size_t)l * DFF * DM, DFF, DM, wl + OFF_DN, nullptr, scr, r, lane);
    }
    for (int i = bid * NTHR + tid; i < DEPTH * 131072 / 4; i += G * NTHR) {
        const int l = i / 32768, e = (i % 32768) * 4;
        const f32x4 v = *(const f32x4*)(a.in[6] + (size_t)l * 131072 + e);
        u32x2 o; o.x = pk2(v[0], v[1]); o.y = pk2(v[2], v[3]);
        *(u32x2*)(Wb + (size_t)l * W_LAYER + OFF_WS + e) = o;
    }
}
__device__ __forceinline__ void p0x(const Args& a, int chunk, int tid, int G, int bid) {
    const int wave = tid >> 6, lane = tid & 63, gw = bid * 8 + wave, NGW = G * 8;
    bf16* XB = (bf16*)(a.ws + WS_XB); float* SS = (float*)(a.ws + WS_SS);
    for (int m = gw; m < CH; m += NGW) {
        const size_t tok = (size_t)chunk * CH + m;
        const float* src = tok < NPROMPT ? a.in[0] + tok * DM : a.in[1] + (tok - NPROMPT) * DM;
        float* dst = a.out + tok * DM;
        float s = 0.f;
#pragma unroll
        for (int j = 0; j < 4; ++j) { const f32x4 v = *(const f32x4*)(src + (lane + 64 * j) * 4); s += (v[0] * v[0] + v[1] * v[1]) + (v[2] * v[2] + v[3] * v[3]);
            *(f32x4*)(dst + (lane + 64 * j) * 4) = v; u32x2 o; o.x = pk2(v[0], v[1]); o.y = pk2(v[2], v[3]); *(u32x2*)(XB + (size_t)m * DM + (lane + 64 * j) * 4) = o; }
        s = wave_sum(s);
        if (lane < 16) SS[(size_t)m * 16 + lane] = lane == 0 ? s : 0.f;
    }
}
__device__ __forceinline__ void pfinal(const Args& a, int chunk, int tid, int G, int bid) {
    const int wave = tid >> 6, lane = tid & 63, gw = bid * 8 + wave, NGW = G * 8;
    const float* SS = (const float*)(a.ws + WS_SS); const float* nf = a.in[16];
    for (int m = gw; m < CH; m += NGW) {
        float* x = a.out + ((size_t)chunk * CH + m) * DM;
        const float rs = pg8::row_rs(SS, m);
#pragma unroll
        for (int j = 0; j < 4; ++j) { const int c = (lane + 64 * j) * 4; const f32x4 v = *(const f32x4*)(x + c), g = *(const f32x4*)(nf + c); *(f32x4*)(x + c) = v * rs * g; }
    }
}
__device__ __forceinline__ int t5_bucket(int rel) {
    const int n = rel < 0 ? -rel : rel;
    const int b = n < 8 ? n : 8 + (n >= 15) + (n >= 27) + (n >= 50) + (n >= 91) + (n >= 166) + (n >= 305) + (n >= 559);
    return (rel > 0 ? 16 : 0) + b;
}
__device__ __forceinline__ void attn_unit(const bf16* QKV, bf16* OUTG, float* LSE, const float* rel_bias, LAS unsigned char* lds, int unit, int S, int tid) {
    const int wave = tid >> 6, lane = tid & 63;
    constexpr int upg = CH / 64;
    const int g = unit / upg, rem = unit % upg;
    const int ups = S / 64, seq = rem / ups, rem2 = rem % ups;
    const int d = 1 << (2 * g), L = S / d, nqb = L / 64, r = rem2 / nqb, qb = rem2 % nqb;
    const int tokbase = seq * S + r;
    const int h = wave & 3, qh = wave >> 2, n = lane & 31, hi = lane >> 5;
    const int qbase = 64 * qb + 32 * qh;
    const size_t tokq = (size_t)tokbase + (size_t)(qbase + n) * d;
    const bf16* qp = QKV + tokq * 2304 + g * 256 + h * 64 + 8 * hi;
    bf16x8 qf[4], kf[5][4];
#pragma unroll
    for (int s = 0; s < 4; ++s) qf[s] = *(const bf16x8*)(qp + 16 * s);
#pragma unroll
    for (int kt = 0; kt < 5; ++kt) {
        const int lk = qbase - 64 + 32 * kt + n, lkc = lk < 0 ? 0 : (lk > L - 1 ? L - 1 : lk);
        const bf16* kp = QKV + (size_t)(tokbase + lkc * d) * 2304 + 768 + g * 256 + h * 64 + 8 * hi;
#pragma unroll
        for (int s = 0; s < 4; ++s) kf[kt][s] = *(const bf16x8*)(kp + 16 * s);
    }
#pragma unroll
    for (int i = 0; i < 12; ++i) {
        const int idx = tid + i * NTHR, kk = idx >> 5, ch = idx & 31, lk = 64 * qb - 64 + kk;
        u32x4 v = (u32x4){0u, 0u, 0u, 0u};
        if (lk >= 0 && lk < L) v = *(const u32x4*)(QKV + (size_t)(tokbase + lk * d) * 2304 + 1536 + g * 256 + ch * 8);
        *(LAS u32x4*)(lds + kk * 576 + ch * 16) = v;
    }
    LAS float* bt = (LAS float*)(lds + 110592);
    for (int i = tid; i < 768; i += NTHR) { const int hh = i / 192, j = i % 192 - 96; bt[i] = (j >= -64 && j <= 64) ? LOG2E * rel_bias[t5_bucket(j * d) * 12 + g * 4 + hh] : -1e30f; }
    f32x16 st[5];
#pragma unroll
    for (int kt = 0; kt < 5; ++kt) {
        f32x16 acc;
#pragma unroll
        for (int e = 0; e < 16; ++e) acc[e] = 0.f;
#pragma unroll
        for (int s = 0; s < 4; ++s) acc = __builtin_amdgcn_mfma_f32_32x32x16_bf16(kf[kt][s], qf[s], acc, 0, 0, 0);
        st[kt] = acc;
    }
    __syncthreads();
    float mx = -3.0e38f;
    {
        const LAS float* btl = bt + h * 192 + 32 + 4 * hi - n;
        const bool edge = (qb == 0) || (64 * qb + 128 > L);
#pragma unroll
        for (int kt = 0; kt < 5; ++kt)
#pragma unroll
            for (int i = 0; i < 16; ++i) {
                float sv = st[kt][i] + btl[32 * kt + (i & 3) + 8 * (i >> 2)];
                if (edge) { const int lk2 = qbase - 64 + 32 * kt + (i & 3) + 8 * (i >> 2) + 4 * hi; sv = (lk2 >= 0 && lk2 < L) ? sv : -1e30f; }
                st[kt][i] = sv; mx = fmaxf(mx, sv);
            }
    }
    mx = fmaxf(mx, __shfl_xor(mx, 32));
    float sum = 0.f;
#pragma unroll
    for (int kt = 0; kt < 5; ++kt)
#pragma unroll
        for (int i = 0; i < 16; ++i) { const float pe = __builtin_amdgcn_exp2f(st[kt][i] - mx); st[kt][i] = pe; sum += pe; }
    sum += __shfl_xor(sum, 32);
    const float inv = 1.0f / sum, lse = (mx + __log2f(sum)) * 0.6931471805599453f;
    f32x16 o0, o1;
#pragma unroll
    for (int e = 0; e < 16; ++e) { o0[e] = 0.f; o1[e] = 0.f; }
    const int q4 = (lane & 15) >> 2, p4 = lane & 3, gsel = (lane >> 4) & 1;
    const unsigned vbase = (unsigned)((32 * qh + 4 * hi + q4) * 576 + h * 128 + (16 * gsel + 4 * p4) * 2);
#pragma unroll
    for (int kt = 0; kt < 5; ++kt)
#pragma unroll
        for (int s2 = 0; s2 < 2; ++s2) {
            u32x4 pw; pw.x = pk2(st[kt][8 * s2 + 0], st[kt][8 * s2 + 1]); pw.y = pk2(st[kt][8 * s2 + 2], st[kt][8 * s2 + 3]); pw.z = pk2(st[kt][8 * s2 + 4], st[kt][8 * s2 + 5]); pw.w = pk2(st[kt][8 * s2 + 6], st[kt][8 * s2 + 7]);
            const bf16x8 pf = __builtin_bit_cast(bf16x8, pw);
            const unsigned ro = vbase + (unsigned)((32 * kt + 16 * s2) * 576);
            {
                const v4i16_t r1 = __builtin_amdgcn_ds_read_tr16_b64_v4i16((LAS v4i16_t*)(lds + ro)), r2 = __builtin_amdgcn_ds_read_tr16_b64_v4i16((LAS v4i16_t*)(lds + ro + 8 * 576));
                const bf16x8 vf = (bf16x8){r1[0], r1[1], r1[2], r1[3], r2[0], r2[1], r2[2], r2[3]};
                o0 = __builtin_amdgcn_mfma_f32_32x32x16_bf16(vf, pf, o0, 0, 0, 0);
            }
            {
                const v4i16_t r1 = __builtin_amdgcn_ds_read_tr16_b64_v4i16((LAS v4i16_t*)(lds + ro + 64)), r2 = __builtin_amdgcn_ds_read_tr16_b64_v4i16((LAS v4i16_t*)(lds + ro + 64 + 8 * 576));
                const bf16x8 vf = (bf16x8){r1[0], r1[1], r1[2], r1[3], r2[0], r2[1], r2[2], r2[3]};
                o1 = __builtin_amdgcn_mfma_f32_32x32x16_bf16(vf, pf, o1, 0, 0, 0);
            }
        }
    bf16* op = OUTG + ((size_t)g * CH + tokq) * 256 + h * 64;
#pragma unroll
    for (int grp = 0; grp < 4; ++grp) {
        u32x2 w0, w1;
        w0.x = pk2(o0[4 * grp + 0] * inv, o0[4 * grp + 1] * inv); w0.y = pk2(o0[4 * grp + 2] * inv, o0[4 * grp + 3] * inv);
        w1.x = pk2(o1[4 * grp + 0] * inv, o1[4 * grp + 1] * inv); w1.y = pk2(o1[4 * grp + 2] * inv, o1[4 * grp + 3] * inv);
        *(u32x2*)(op + 8 * grp + 4 * hi) = w0; *(u32x2*)(op + 32 + 8 * grp + 4 * hi) = w1;
    }
    if (hi == 0) LSE[((size_t)g * CH + tokq) * 4 + h] = lse;
    __syncthreads();
}
constexpr int SG_WLDS = 17920;
__device__ __forceinline__ void sg_wave_unit(bf16* U, bf16* UO, const bf16* GV, const float* ssv, const bf16* WSb, const float* gain, const float* bs, LAS unsigned char* wl, int unit, int lane) {
    const int hf = unit & 1, gg = (unit >> 1) & 7, nch = unit >> 4, tok0 = nch * 128, cb = gg * 128 + hf * 64;
    LAS float* rvl = (LAS float*)(wl + 17408);
    rvl[lane] = pg8::row_rs(ssv, tok0 + lane); rvl[lane + 64] = pg8::row_rs(ssv, tok0 + lane + 64);
    LDS_WAIT();
    {
        const int c8 = lane & 7, q0 = lane >> 3;
#pragma unroll
        for (int i = 0; i < 16; ++i) {
            const int q = q0 + 8 * i;
            f32x4 a0, a1; pg8::unpack8(*(const u32x4*)(GV + (size_t)(tok0 + q) * 1024 + cb + c8 * 8), a0, a1);
            const float r = rvl[q];
            const u32x4 w = pg8::pack8(a0 * r, a1 * r);
            *(LAS u32x2*)(wl + q * 136 + c8 * 16) = (u32x2){w.x, w.y}; *(LAS u32x2*)(wl + q * 136 + c8 * 16 + 8) = (u32x2){w.z, w.w};
        }
    }
    LDS_WAIT();
    const int ln = lane & 15, kq = lane >> 4, qq = ln >> 2, pp = ln & 3;
    bf16x8 afr[4][4];
#pragma unroll
    for (int ct = 0; ct < 4; ++ct)
#pragma unroll
        for (int ks = 0; ks < 4; ++ks) {
            const unsigned ad = (unsigned)((32 * ks + 8 * kq + qq) * 136 + (32 * (ct >> 1) + 8 * pp + 4 * (ct & 1)) * 2);
            const v4i16_t r1 = __builtin_amdgcn_ds_read_tr16_b64_v4i16((LAS v4i16_t*)(wl + ad)), r2 = __builtin_amdgcn_ds_read_tr16_b64_v4i16((LAS v4i16_t*)(wl + ad + 4 * 136));
            afr[ct][ks] = (bf16x8){r1[0], r1[1], r1[2], r1[3], r2[0], r2[1], r2[2], r2[3]};
        }
    f32x4 gn[2][2];
#pragma unroll
    for (int t = 0; t < 2; ++t) { gn[t][0] = *(const f32x4*)(gain + cb + 32 * t + 8 * kq); gn[t][1] = *(const f32x4*)(gain + cb + 32 * t + 8 * kq + 4); }
#pragma unroll 2
    for (int pt = 0; pt < 8; ++pt) {
        const int pr = pt * 16 + ln;
        bf16x8 bfr[4];
#pragma unroll
        for (int ks = 0; ks < 4; ++ks) bfr[ks] = *(const bf16x8*)(WSb + (size_t)gg * 16384 + pr * 128 + 32 * ks + 8 * kq);
        bf16* up = U + (size_t)(tok0 + pr) * 1024 + cb + 8 * kq; bf16* uo = UO + (size_t)(tok0 + pr) * 1024 + cb + 8 * kq;
        const u32x4 uw0 = *(const u32x4*)up, uw1 = *(const u32x4*)(up + 32);
        const float bias = bs[gg * 128 + pr];
        f32x4 acc[4];
#pragma unroll
        for (int ct = 0; ct < 4; ++ct) {
            acc[ct] = (f32x4){0.f, 0.f, 0.f, 0.f};
#pragma unroll
            for (int ks = 0; ks < 4; ++ks) acc[ct] = __builtin_amdgcn_mfma_f32_16x16x32_bf16(afr[ct][ks], bfr[ks], acc[ct], 0, 0, 0);
        }
        f32x4 u0, u1;
        pg8::unpack8(uw0, u0, u1);
        *(u32x4*)uo = pg8::pack8(u0 * (gn[0][0] * acc[0] + bias), u1 * (gn[0][1] * acc[1] + bias));
        pg8::unpack8(uw1, u0, u1);
        *(u32x4*)(uo + 32) = pg8::pack8(u0 * (gn[1][0] * acc[2] + bias), u1 * (gn[1][1] * acc[3] + bias));
    }
    LDS_WAIT();
}
__device__ __forceinline__ void p_merge(const bf16* OUTG, const float* LSE, bf16* OA, int tid, int G, int bid) {
    for (int it = bid * NTHR + tid; it < CH * 32; it += G * NTHR) {
        const int tok = it >> 5, c8 = it & 31, h = c8 >> 3;
        const float l0 = LSE[(size_t)tok * 4 + h], l1 = LSE[((size_t)CH + tok) * 4 + h], l2 = LSE[((size_t)2 * CH + tok) * 4 + h];
        const float mx = fmaxf(l0, fmaxf(l1, l2));
        float w0 = __expf(l0 - mx), w1 = __expf(l1 - mx), w2 = __expf(l2 - mx);
        const float inv = 1.0f / (w0 + w1 + w2); w0 *= inv; w1 *= inv; w2 *= inv;
        f32x4 a0, a1, b0, b1, c0, c1;
        pg8::unpack8(*(const u32x4*)(OUTG + (size_t)tok * 256 + c8 * 8), a0, a1);
        pg8::unpack8(*(const u32x4*)(OUTG + ((size_t)CH + tok) * 256 + c8 * 8), b0, b1);
        pg8::unpack8(*(const u32x4*)(OUTG + ((size_t)2 * CH + tok) * 256 + c8 * 8), c0, c1);
        *(u32x4*)(OA + (size_t)tok * 256 + c8 * 8) = pg8::pack8(a0 * w0 + b0 * w1 + c0 * w2, a1 * w0 + b1 * w1 + c1 * w2);
    }
}
__device__ __forceinline__ void p_conv(const bf16* A, bf16* FG, const float* cw, const float* cb, int S, int tid, int G, int bid) {
    constexpr int RUN = 8, NFC = DFF / 8;
    for (int it = bid * NTHR + tid; it < (CH / RUN) * NFC; it += G * NTHR) {
        const int fc = it % NFC, t0 = (it / NFC) * RUN, f = fc * 8;
        f32x4 wg[3][2], wv[3][2], bg[2], bv[2];
#pragma unroll
        for (int k = 0; k < 3; ++k) { wg[k][0] = *(const f32x4*)(cw + k * NUP + f); wg[k][1] = *(const f32x4*)(cw + k * NUP + f + 4); wv[k][0] = *(const f32x4*)(cw + k * NUP + DFF + f); wv[k][1] = *(const f32x4*)(cw + k * NUP + DFF + f + 4); }
        bg[0] = *(const f32x4*)(cb + f); bg[1] = *(const f32x4*)(cb + f + 4); bv[0] = *(const f32x4*)(cb + DFF + f); bv[1] = *(const f32x4*)(cb + DFF + f + 4);
        const f32x4 z4 = (f32x4){0.f, 0.f, 0.f, 0.f};
        f32x4 pg0 = z4, pg1 = z4, pv0 = z4, pv1 = z4, cg0, cg1, cv0, cv1;
        if ((t0 & (S - 1)) != 0) { pg8::unpack8(*(const u32x4*)(A + (size_t)(t0 - 1) * NUP + f), pg0, pg1); pg8::unpack8(*(const u32x4*)(A + (size_t)(t0 - 1) * NUP + DFF + f), pv0, pv1); }
        pg8::unpack8(*(const u32x4*)(A + (size_t)t0 * NUP + f), cg0, cg1); pg8::unpack8(*(const u32x4*)(A + (size_t)t0 * NUP + DFF + f), cv0, cv1);
#pragma unroll
        for (int i = 0; i < RUN; ++i) {
            const int t = t0 + i;
            f32x4 ng0 = z4, ng1 = z4, nv0 = z4, nv1 = z4;
            if (((t + 1) & (S - 1)) != 0) { pg8::unpack8(*(const u32x4*)(A + (size_t)(t + 1) * NUP + f), ng0, ng1); pg8::unpack8(*(const u32x4*)(A + (size_t)(t + 1) * NUP + DFF + f), nv0, nv1); }
            f32x4 g0 = pg0 * wg[0][0] + cg0 * wg[1][0] + ng0 * wg[2][0] + bg[0], g1 = pg1 * wg[0][1] + cg1 * wg[1][1] + ng1 * wg[2][1] + bg[1];
            const f32x4 v0 = pv0 * wv[0][0] + cv0 * wv[1][0] + nv0 * wv[2][0] + bv[0], v1 = pv1 * wv[0][1] + cv1 * wv[1][1] + nv1 * wv[2][1] + bv[1];
#pragma unroll
            for (int e = 0; e < 4; ++e) { g0[e] = pg8::gelu_tanh(g0[e]) * v0[e]; g1[e] = pg8::gelu_tanh(g1[e]) * v1[e]; }
            *(u32x4*)(FG + (size_t)t * DFF + f) = pg8::pack8(g0, g1);
            pg0 = cg0; pg1 = cg1; pv0 = cv0; pv1 = cv1; cg0 = ng0; cg1 = ng1; cv0 = nv0; cv1 = nv1;
        }
    }
}

__device__ __forceinline__ void p_convfix(const bf16* SB, bf16* FG, const float* cw, const float* cb, int S, int tid, int G, int bid) {
    constexpr int NFC = DFF / 8, NB = CH / 64;
    for (int it = bid * NTHR + tid; it < NB * 2 * NFC; it += G * NTHR) {
        const int fc = it % NFC, r2 = it / NFC, which = r2 & 1, b = r2 >> 1, f = fc * 8, t = b * 64 + (which ? 63 : 0);
        const f32x4 z4 = (f32x4){0.f, 0.f, 0.f, 0.f};
        f32x4 pg0 = z4, pg1 = z4, pv0 = z4, pv1 = z4, cg0, cg1, cv0, cv1, ng0 = z4, ng1 = z4, nv0 = z4, nv1 = z4;
        const bf16* bp = SB + (size_t)b * 4 * NUP + f;
        if (which == 0) {
            if ((t & (S - 1)) != 0) { pg8::unpack8(*(const u32x4*)(bp - NUP), pg0, pg1); pg8::unpack8(*(const u32x4*)(bp - NUP + DFF), pv0, pv1); }
            pg8::unpack8(*(const u32x4*)bp, cg0, cg1); pg8::unpack8(*(const u32x4*)(bp + DFF), cv0, cv1);
            pg8::unpack8(*(const u32x4*)(bp + NUP), ng0, ng1); pg8::unpack8(*(const u32x4*)(bp + NUP + DFF), nv0, nv1);
        } else {
            pg8::unpack8(*(const u32x4*)(bp + 2 * NUP), pg0, pg1); pg8::unpack8(*(const u32x4*)(bp + 2 * NUP + DFF), pv0, pv1);
            pg8::unpack8(*(const u32x4*)(bp + 3 * NUP), cg0, cg1); pg8::unpack8(*(const u32x4*)(bp + 3 * NUP + DFF), cv0, cv1);
            if (((t + 1) & (S - 1)) != 0) { pg8::unpack8(*(const u32x4*)(bp + 4 * NUP), ng0, ng1); pg8::unpack8(*(const u32x4*)(bp + 4 * NUP + DFF), nv0, nv1); }
        }
        f32x4 g0 = *(const f32x4*)(cb + f), g1 = *(const f32x4*)(cb + f + 4), v0 = *(const f32x4*)(cb + DFF + f), v1 = *(const f32x4*)(cb + DFF + f + 4);
        g0 = g0 + pg0 * *(const f32x4*)(cw + f) + cg0 * *(const f32x4*)(cw + NUP + f) + ng0 * *(const f32x4*)(cw + 2 * NUP + f);
        g1 = g1 + pg1 * *(const f32x4*)(cw + f + 4) + cg1 * *(const f32x4*)(cw + NUP + f + 4) + ng1 * *(const f32x4*)(cw + 2 * NUP + f + 4);
        v0 = v0 + pv0 * *(const f32x4*)(cw + DFF + f) + cv0 * *(const f32x4*)(cw + NUP + DFF + f) + nv0 * *(const f32x4*)(cw + 2 * NUP + DFF + f);
        v1 = v1 + pv1 * *(const f32x4*)(cw + DFF + f + 4) + cv1 * *(const f32x4*)(cw + NUP + DFF + f + 4) + nv1 * *(const f32x4*)(cw + 2 * NUP + DFF + f + 4);
#pragma unroll
        for (int e = 0; e < 4; ++e) { g0[e] = pg8::gelu_tanh(g0[e]) * v0[e]; g1[e] = pg8::gelu_tanh(g1[e]) * v1[e]; }
        *(u32x4*)(FG + (size_t)t * DFF + f) = pg8::pack8(g0, g1);
    }
}
#define XB_TMO      128
#define XB_XCNT(j)  (256  + 64 * (j))
#define XB_XSUB(j)  (1280 + 64 * (j))
#define XB_XGEN(j)  (2304 + 64 * (j))
#define XB_TOP      3328
#define XB_TOPGEN   3392
#define XCD_BAR_WORDS 3456
#define XB_SPIN_CAP (1u << 18)

__device__ __forceinline__ unsigned xb_ld(unsigned* p)              { return __hip_atomic_load(p, __ATOMIC_RELAXED, __HIP_MEMORY_SCOPE_AGENT); }
__device__ __forceinline__ unsigned xb_add(unsigned* p, unsigned v) { return __hip_atomic_fetch_add(p, v, __ATOMIC_RELAXED, __HIP_MEMORY_SCOPE_AGENT); }
__device__ __forceinline__ unsigned xb_xcc_id() { return (unsigned)__builtin_amdgcn_s_getreg((3 << 11) | 20) & 0xFu; }
#define XB_SPIN(cond, bar) do { unsigned _sp = 0; while (cond) { __builtin_amdgcn_s_sleep(1); \
    if ((++_sp & 255u) == 0u) { if (xb_ld(&(bar)[XB_TMO])) break; if (_sp > XB_SPIN_CAP) { atomicAdd(&(bar)[XB_TMO], 1u); break; } } } } while (0)

struct XcdBarrier {
    unsigned* bar; unsigned x;
    volatile LAS unsigned* st;
};

__device__ __forceinline__ XcdBarrier xcd_barrier_post(unsigned* bar, volatile LAS unsigned* st, const int tid) {
    XcdBarrier b; b.bar = bar; b.x = xb_xcc_id(); b.st = st;
    if (tid == 0) (void)xb_add(&bar[XB_XCNT(b.x)], 1u);
    return b;
}
__device__ __forceinline__ void xcd_barrier_complete(unsigned* bar, unsigned x, unsigned& nloc, unsigned& nx) {
    const unsigned G = gridDim.x * gridDim.y * gridDim.z;
    unsigned sum, cnt, mine, sp = 0u;
    for (;;) {
        sum = 0u; cnt = 0u; mine = 0u;
#pragma unroll
        for (unsigned j = 0; j < 16; ++j) { const unsigned c = xb_ld(&bar[XB_XCNT(j)]); sum += c; cnt += (c > 0u) ? 1u : 0u; mine = (j == x) ? c : mine; }
        if (sum == G) break;
        __builtin_amdgcn_s_sleep(1);
        if ((++sp & 255u) == 0u) { if (xb_ld(&bar[XB_TMO])) break; if (sp > XB_SPIN_CAP) { atomicAdd(&bar[XB_TMO], 1u); break; } }
    }
    nloc = mine > 0u ? mine : 1u; nx = cnt > 0u ? cnt : 1u;
}

__device__ __forceinline__ void xcd_barrier(const XcdBarrier& b, const int tid) {
    asm volatile("s_waitcnt vmcnt(0)" ::: "memory");
    __syncthreads();
    if (tid == 0) {
        unsigned* bar = b.bar;
        __builtin_amdgcn_s_waitcnt(0);
        unsigned nloc = b.st[0], nx = b.st[1];
        if (nloc == 0u) { xcd_barrier_complete(bar, b.x, nloc, nx); b.st[0] = nloc; b.st[1] = nx; }
        const unsigned old = xb_add(&bar[XB_XSUB(b.x)], 1u);
        const unsigned gen = old / nloc;
        if (old + 1u == (gen + 1u) * nloc) {
            __builtin_amdgcn_fence(__ATOMIC_RELEASE, "agent");
            asm volatile("s_waitcnt vmcnt(0)" ::: "memory");
            const unsigned og = xb_add(&bar[XB_TOP], 1u);
            const unsigned tg = og / nx;
            if (og + 1u == (tg + 1u) * nx) xb_add(&bar[XB_TOPGEN], 1u);
            else XB_SPIN(xb_ld(&bar[XB_TOPGEN]) == tg, bar);
            __builtin_amdgcn_fence(__ATOMIC_ACQUIRE, "agent");
            xb_add(&bar[XB_XGEN(b.x)], 1u);
            asm volatile("s_waitcnt vmcnt(0)" ::: "memory");
        } else {
            XB_SPIN(xb_ld(&bar[XB_XGEN(b.x)]) == gen, bar);
            __builtin_amdgcn_fence(__ATOMIC_ACQUIRE, "agent");
            asm volatile("s_waitcnt vmcnt(0)" ::: "memory");
        }
    }
    __syncthreads();
}


__global__ void __launch_bounds__(NTHR, 2) fwd_kernel(Args a_in) {
    extern __shared__ __attribute__((aligned(16))) unsigned char lds_raw[];
    LAS unsigned char* lds = (LAS unsigned char*)lds_raw;
    cg::grid_group grid = cg::this_grid();
    const int ph_lo = a_in.ph_lo, ph_hi = a_in.ph_hi;
    volatile LAS unsigned* xst = (volatile LAS unsigned*)(lds + LDS_BYTES - 16);
    if (threadIdx.x < 2) xst[threadIdx.x] = 0u;
    __syncthreads();
    const unsigned xcc = xcd_barrier_post((unsigned*)(a_in.ws + WS_BAR), xst, (int)threadIdx.x).x;
    for (int ph = ph_lo; ph < ph_hi; ++ph) {
#if defined(__HIP_DEVICE_COMPILE__)
        typedef const __attribute__((address_space(4))) unsigned long long* cu64p4;
        cu64p4 ap = (cu64p4)__builtin_amdgcn_kernarg_segment_ptr();
        asm volatile("" : "+s"(ap));
        Args a;
#pragma unroll
        for (int i = 0; i < 17; ++i) a.in[i] = (const float*)ap[i];
        a.out = (float*)ap[17]; a.ws = (unsigned char*)ap[18]; a.ph_lo = ph_lo; a.ph_hi = ph_hi;
#else
        const Args a = a_in;
#endif
        int tid = threadIdx.x, G = gridDim.x, bid = blockIdx.x;
        asm volatile("" : "+v"(tid)); asm volatile("" : "+s"(G)); asm volatile("" : "+s"(bid));
        unsigned char* ws = a.ws;
        bf16* Wb = (bf16*)(ws + WS_W);
        bf16* QKV = (bf16*)(ws + WS_R1); bf16* U = QKV + (size_t)CH * 2304; bf16* GV = U + (size_t)CH * 1024; bf16* GT = GV + (size_t)CH * 1024;
        bf16* AF = (bf16*)(ws + WS_R1);
        bf16* MG = GV;
        bf16* OUTG = (bf16*)(ws + WS_R2); bf16* OA = OUTG + (size_t)3 * CH * 256; float* LSE = (float*)(OA + (size_t)CH * 256);
        bf16* FG = (bf16*)(ws + WS_R2);
        bf16* XB = (bf16*)(ws + WS_XB); float* SS = (float*)(ws + WS_SS); float* SSV = (float*)(ws + WS_SSV);
        if (ph == 0 && !(SKIPMASK & 256)) p0_weights(a, lds, tid, G, bid);
        else {
            const int chunk = (ph - 1) / PH_PER_CHUNK, sub = (ph - 1) % PH_PER_CHUNK;
            const int S = chunk == 0 ? 8192 : 2048;
            if (sub == 0 && !(SKIPMASK & 512)) p0x(a, chunk, tid, G, bid);
            else if (sub == PH_PER_CHUNK - 1) pfinal(a, chunk, tid, G, bid);
            else {
                const int l = (sub - 1) / KPL, ki = (sub - 1) % KPL, k = (KPL == 9 && ki > PROBE_DUPK) ? ki - 1 : ki; const bool dup = (KPL == 9 && ki == PROBE_DUPK + 1);
                const bf16* wl = Wb + (size_t)l * W_LAYER;
                float* X = a.out + (size_t)chunk * CH * DM;
                if (k == 0 && !(SKIPMASK & 1)) {
                    pg8::Gemm g{XB, wl + OFF_IN, CH, NIN, DM}; pg8::StaticOrder So; So.init(CH, NIN, G, bid);
                    pg8::EpiIn E{QKV, U, GV, GT, SS, SSV};
                    pg8::gemm_phase<pg8::EpiIn, pg8::StaticOrder, true, true>(lds, g, So, E, tid);
                } else if (k == 1 && !(SKIPMASK & 2)) {
                    constexpr int NATT = 3 * (CH / 64), NSGW = (CH / 128) * 16;
                    if (!(SKIPMASK & 1024) && !(dup && PROBE_KIND == 8)) for (int it = bid; it < NATT; it += G) attn_unit(QKV, OUTG, LSE, a.in[2], lds, it, S, tid);
                    if (!(SKIPMASK & 2048) && (!dup || PROBE_KIND == 8)) {
                        bf16* UO = dup ? (bf16*)(ws + WS_R2 + (size_t)CH * 2096) : U;
                        const int wave = __builtin_amdgcn_readfirstlane(tid >> 6);
                        for (int wu = bid * 8 + wave; wu < NSGW; wu += G * 8) sg_wave_unit(U, UO, GV, SSV, wl + OFF_WS, a.in[5] + l * 1024, a.in[7] + l * 1024, lds + wave * SG_WLDS, wu, tid & 63);
                    }
                } else if (k == 2 && !(SKIPMASK & 4)) p_merge(OUTG, LSE, OA, tid, G, bid);
                else if (k == 3 && !(SKIPMASK & 8)) {
                    if (!(SKIPMASK & 4096)) { int kpa = 256; asm volatile("" : "+s"(kpa)); pg8::Gemm g{OA, wl + OFF_PA, CH, DM, kpa}; pg8::StaticOrder So; So.init(CH, DM, G, bid);
                      pg8::EpiGate<0> E{MG, GT, 0};
                      pg8::gemm_phase<pg8::EpiGate<0>, pg8::StaticOrder, true, true>(lds, g, So, E, tid); }
                    if (!(SKIPMASK & 8192)) { pg8::Gemm g{U, wl + OFF_PB, CH, DM, DM}; pg8::StaticOrder So; So.init(CH, DM, G, bid);
                      pg8::EpiGate<1> E{MG, GT, 1024};
                      pg8::gemm_phase<pg8::EpiGate<1>, pg8::StaticOrder, true, true>(lds, g, So, E, tid); }
                } else if (k == 4 && !(SKIPMASK & 16)) {
                    pg8::Gemm g{MG, wl + OFF_OUT, CH, DM, DM}; pg8::StaticOrder So; So.init(CH, DM, G, bid);
                    pg8::EpiRes E{X, XB, SS};
                    pg8::gemm_phase<pg8::EpiRes, pg8::StaticOrder, true, true>(lds, g, So, E, tid);
                } else if (k == 5 && !(SKIPMASK & 32)) {
                    pg8::Gemm g{XB, wl + OFF_UP, CH, NUP, DM}; pg8::StaticOrder So; So.init(CH, NUP, G, bid);
                    pg8::EpiUpConv E{FG, (bf16*)(ws + WS_SB), SS, a.in[13] + (size_t)l * 3 * NUP, a.in[14] + (size_t)l * NUP};
                    pg8::gemm_phase<pg8::EpiUpConv, pg8::StaticOrder, true, true>(lds, g, So, E, tid);
                } else if (k == 6 && !(SKIPMASK & 64)) p_convfix((const bf16*)(ws + WS_SB), FG, a.in[13] + (size_t)l * 3 * NUP, a.in[14] + (size_t)l * NUP, S, tid, G, bid);
                else if (!(SKIPMASK & 128)) {
                    pg8::Gemm g{FG, wl + OFF_DN, CH, DM, DFF}; pg8::StaticOrder So; So.init(CH, DM, G, bid);
                    pg8::EpiRes E{X, XB, SS};
                    pg8::gemm_phase<pg8::EpiRes, pg8::StaticOrder, true, true>(lds, g, So, E, tid);
                }
            }
        }
        if (ph + 1 < ph_hi) {
            if (ph == ph_lo) grid.sync();
            XcdBarrier xb; xb.bar = (unsigned*)(a.ws + WS_BAR); xb.x = xcc; xb.st = xst;
            xcd_barrier(xb, tid);
            if (PROBE_KIND == 100) xcd_barrier(xb, tid);
        }
    }
}

extern "C" void kernel_launch(void* const* d_in, const int* in_sizes, int n_in, void* d_out, int out_size, void* d_ws, size_t ws_size, hipStream_t stream) {
    static int grid = 0;
    if (grid == 0) {
        if (n_in != 17 || out_size != NTOK * DM || ws_size < WS_END) { fprintf(stderr, "kernel_launch: unexpected shapes: n_in %d out %d ws %zu (need %zu)\n", n_in, out_size, ws_size, (size_t)WS_END); grid = -1; return; }
        int dev = 0, cus = 0, per_cu = 0;
        (void)hipGetDevice(&dev); (void)hipDeviceGetAttribute(&cus, hipDeviceAttributeMultiprocessorCount, dev);
        if (hipFuncSetAttribute((const void*)fwd_kernel, hipFuncAttributeMaxDynamicSharedMemorySize, LDS_BYTES) != hipSuccess) { fprintf(stderr, "kernel_launch: hipFuncSetAttribute failed\n"); grid = -1; return; }
        if (hipOccupancyMaxActiveBlocksPerMultiprocessor(&per_cu, (const void*)fwd_kernel, NTHR, LDS_BYTES) != hipSuccess || per_cu < 1) { fprintf(stderr, "kernel_launch: occupancy query says %d\n", per_cu); per_cu = 1; }
        (void)hipGetLastError();
        grid = cus * per_cu;
        if (grid <= 0) grid = 256;
    }
    if (grid < 0) return;
    if (hipMemsetAsync((char*)d_ws + WS_BAR, 0, 65536, stream) != hipSuccess) { fprintf(stderr, "kernel_launch: memset failed\n"); return; }
    Args a{};
    for (int i = 0; i < 17; ++i) a.in[i] = (const float*)d_in[i];
    a.out = (float*)d_out; a.ws = (unsigned char*)d_ws;
#if ONE_LAUNCH
    a.ph_lo = 0; a.ph_hi = N_PHASES;
    void* args[] = {&a};
    hipError_t e = hipLaunchCooperativeKernel((const void*)fwd_kernel, dim3(grid), dim3(NTHR), args, LDS_BYTES, stream);
    if (e != hipSuccess) fprintf(stderr, "cooperative launch failed: %s (grid %d)\n", hipGetErrorString(e), grid);
#else
    for (int ph = 0; ph < N_PHASES; ++ph) {
        a.ph_lo = ph; a.ph_hi = ph + 1;
        hipLaunchKernelGGL(fwd_kernel, dim3(grid), dim3(NTHR), LDS_BYTES, stream, a);
    }
#endif
}
```

```cpp
#include <hip/hip_runtime.h>
#include <hip/hip_cooperative_groups.h>
#include <cstdio>
#include <cstdint>
namespace cg = cooperative_groups;

#ifndef ONE_LAUNCH
#define ONE_LAUNCH 1
#endif

namespace pg8 {
#define PG8_LAS __attribute__((address_space(3)))
typedef unsigned short bf16_t;
typedef short bf16x8 __attribute__((ext_vector_type(8)));
typedef float f32x4 __attribute__((ext_vector_type(4)));
typedef unsigned u32x4 __attribute__((ext_vector_type(4)));
constexpr int BM = 256, BK = 64, HALF = 128, HTB = HALF * BK * 2  , STAGE_BYTES = 8 * HTB, NXCD = 8, WGM = 8;

__host__ __device__ __forceinline__ int lds_byte(int r, int c) { const int st = (r >> 4) * 2 + (c >> 5), rr = r & 15, cc = c & 31, ob = rr * 64 + cc * 2; return st * 1024 + (ob ^ (((ob >> 9) & 1) << 5)); }
__host__ __device__ __forceinline__ void stage_rc(int b, int& R, int& C) { const int st = b / 1024, sb = b % 1024, swz = sb ^ (((sb >> 9) & 1) << 5); R = (st >> 1) * 16 + swz / 64; C = (st & 1) * 32 + (swz % 64) / 2; }
__host__ __device__ __forceinline__ int perm32(int rho) { const int n = rho >> 4, i = rho & 15; return 8 * (i >> 2) + 4 * n + (i & 3); }

struct Unit { int pm, pn; };
struct Gemm { const bf16_t* A; const bf16_t* Bt; int M, N, K; };

struct StaticOrder {
    int nM, nN, nwg, G, c;
    __host__ __device__ void init(int M, int N, int G_, int c_) { nM = M / BM; nN = N / BM; nwg = nM * nN; G = G_; c = c_; }
    __host__ __device__ bool next(int i, Unit& u) const {
        const long L = (long)i * G + c; if (L >= nwg) return false;
        int wgid = (int)L; { const int q = nwg / NXCD, r = nwg % NXCD, xcd = wgid % NXCD, off = wgid / NXCD; wgid = (xcd < r ? xcd * (q + 1) : r * (q + 1) + (xcd - r) * q) + off; }
        const int nig = WGM * nN, gid = wgid / nig, fm = gid * WGM, gsz = (nM - fm) < WGM ? (nM - fm) : WGM;
        u.pm = fm + ((wgid % nig) % gsz); u.pn = (wgid % nig) / gsz; return true;
    }
    __device__ __forceinline__ void a_ready(const Unit&) const {}
    __device__ __forceinline__ void done(const Unit&) const {}
};

__device__ __forceinline__ unsigned cvt_pk_bf16(float lo, float hi) { unsigned r; asm volatile("v_cvt_pk_bf16_f32 %0, %1, %2" : "=v"(r) : "v"(lo), "v"(hi)); return r; }

__device__ __forceinline__ float fast_sigmoid(float x) { return __builtin_amdgcn_rcpf(1.0f + __builtin_amdgcn_exp2f(-1.4426950408889634f * x)); }
__device__ __forceinline__ float gelu_tanh(float x) {
    const float y = x * (1.0f + 0.044715f * x * x) * (2.0f * 0.7978845608028654f);
    return x * __builtin_amdgcn_rcpf(1.0f + __builtin_amdgcn_exp2f(-1.4426950408889634f * y));
}
__device__ __forceinline__ float bf2f(unsigned short b) { return __uint_as_float(((unsigned)b) << 16); }
__device__ __forceinline__ u32x4 pack8(const f32x4 a, const f32x4 b) { u32x4 w; w.x = cvt_pk_bf16(a[0], a[1]); w.y = cvt_pk_bf16(a[2], a[3]); w.z = cvt_pk_bf16(b[0], b[1]); w.w = cvt_pk_bf16(b[2], b[3]); return w; }
__device__ __forceinline__ void unpack8(const u32x4 w, f32x4& a, f32x4& b) {
    a[0] = __uint_as_float(w.x << 16); a[1] = __uint_as_float(w.x & 0xffff0000u); a[2] = __uint_as_float(w.y << 16); a[3] = __uint_as_float(w.y & 0xffff0000u);
    b[0] = __uint_as_float(w.z << 16); b[1] = __uint_as_float(w.z & 0xffff0000u); b[2] = __uint_as_float(w.w << 16); b[3] = __uint_as_float(w.w & 0xffff0000u);
}
__device__ __forceinline__ float row_rs(const float* ss, int row) {
    const f32x4* sp = (const f32x4*)(ss + (size_t)row * 16);
    const f32x4 s = (sp[0] + sp[1]) + (sp[2] + sp[3]);
    return rsqrtf(((s[0] + s[1]) + (s[2] + s[3])) * (1.0f / 1024.0f) + 1e-6f);
}

__device__ __forceinline__ void rows_rs(const float* ss, int row0, int fq, float (&rsv)[2][4]) {
    f32x4 part[2][4];
#pragma unroll
    for (int ai = 0; ai < 2; ++ai)
#pragma unroll
        for (int m = 0; m < 4; ++m) part[ai][m] = *(const f32x4*)(ss + (size_t)(row0 + ai * HALF + m * 16) * 16 + fq * 4);
#pragma unroll
    for (int ai = 0; ai < 2; ++ai)
#pragma unroll
        for (int m = 0; m < 4; ++m) { float t = (part[ai][m][0] + part[ai][m][1]) + (part[ai][m][2] + part[ai][m][3]); t += __shfl_xor(t, 16); t += __shfl_xor(t, 32); rsv[ai][m] = rsqrtf(t * (1.0f / 1024.0f) + 1e-6f); }
}

struct EpiIn {
    static constexpr bool PERM = true, AFTER_DRAIN = false;
    bf16_t* QKV; bf16_t* U; bf16_t* GV; bf16_t* G; const float* ss; float* ssv;
    __device__ __forceinline__ void operator()(const f32x4 (&acc)[2][2][4][2], const Unit& u, int wr, int wc, int fr, int fq) const {
        const int pn = u.pn;
        float rsv[2][4]; rows_rs(ss, u.pm * BM + wr * 64 + fr, fq, rsv);
#pragma unroll
        for (int ai = 0; ai < 2; ++ai)
#pragma unroll
            for (int m = 0; m < 4; ++m) {
                const int row = u.pm * BM + ai * HALF + wr * 64 + m * 16 + fr;
                const float rs = rsv[ai][m];
                float q = 0.f;
#pragma unroll
                for (int bj = 0; bj < 2; ++bj) {
                    const int col = pn * BM + bj * HALF + wc * 32 + 8 * fq;
                    f32x4 v0 = acc[ai][bj][m][0] * rs, v1 = acc[ai][bj][m][1] * rs;
                    bf16_t* dst;
                    if (pn < 9) { if (pn < 3) { v0 = v0 * (0.125f * 1.4426950408889634f); v1 = v1 * (0.125f * 1.4426950408889634f); }     dst = QKV + (size_t)row * 2304 + col; }
                    else if (pn < 17) {
#pragma unroll
                        for (int e = 0; e < 4; ++e) { v0[e] = gelu_tanh(v0[e]); v1[e] = gelu_tanh(v1[e]); }
                        if (pn < 13) dst = U + (size_t)row * 1024 + (col - 2304);
                        else { dst = GV + (size_t)row * 1024 + (col - 3328);
#pragma unroll
                            for (int e = 0; e < 4; ++e) q += v0[e] * v0[e] + v1[e] * v1[e]; }
                    } else {
#pragma unroll
                        for (int e = 0; e < 4; ++e) { v0[e] = fast_sigmoid(v0[e]); v1[e] = fast_sigmoid(v1[e]); }
                        dst = G + (size_t)row * 2048 + (col - 4352);
                    }
                    *(u32x4*)dst = pack8(v0, v1);
                }
                if (pn >= 13 && pn < 17) { q += __shfl_xor(q, 16); q += __shfl_xor(q, 32); if (fq == 0) ssv[(size_t)row * 16 + (pn - 13) * 4 + wc] = q; }
                asm volatile("" ::: "memory");
            }
    }
};
template <int MODE> struct EpiGate {
    static constexpr bool PERM = true, AFTER_DRAIN = false;
    bf16_t* O; const bf16_t* G; int goff;
    __device__ __forceinline__ void operator()(const f32x4 (&acc)[2][2][4][2], const Unit& u, int wr, int wc, int fr, int fq) const {
#pragma unroll
        for (int ai = 0; ai < 2; ++ai) {
            u32x4 gw[4][2], pw[4][2];
#pragma unroll
            for (int m = 0; m < 4; ++m)
#pragma unroll
                for (int bj = 0; bj < 2; ++bj) {
                    const int row = u.pm * BM + ai * HALF + wr * 64 + m * 16 + fr, col = u.pn * BM + bj * HALF + wc * 32 + 8 * fq;
                    gw[m][bj] = *(const u32x4*)(G + (size_t)row * 2048 + goff + col);
                    if (MODE == 1) pw[m][bj] = *(const u32x4*)(O + (size_t)row * 1024 + col);
                }
#pragma unroll
            for (int m = 0; m < 4; ++m)
#pragma unroll
                for (int bj = 0; bj < 2; ++bj) {
                    const int row = u.pm * BM + ai * HALF + wr * 64 + m * 16 + fr, col = u.pn * BM + bj * HALF + wc * 32 + 8 * fq;
                    f32x4 g0, g1; unpack8(gw[m][bj], g0, g1);
                    f32x4 v0 = acc[ai][bj][m][0] * g0, v1 = acc[ai][bj][m][1] * g1;
                    if (MODE == 1) { f32x4 p0, p1; unpack8(pw[m][bj], p0, p1); v0 = v0 + p0; v1 = v1 + p1; }
                    *(u32x4*)(O + (size_t)row * 1024 + col) = pack8(v0, v1);
                }
            asm volatile("" ::: "memory");
        }
    }
};
struct EpiRes {
    static constexpr bool PERM = true, AFTER_DRAIN = false;
    bf16_t* XL; bf16_t* XB; float* ss;
    __device__ __forceinline__ void operator()(const f32x4 (&acc)[2][2][4][2], const Unit& u, int wr, int wc, int fr, int fq) const {
#pragma unroll
        for (int ai = 0; ai < 2; ++ai)
#pragma unroll
        for (int mp = 0; mp < 2; ++mp) {
            u32x4 hv[2][2], lv[2][2];
#pragma unroll
            for (int mi = 0; mi < 2; ++mi)
#pragma unroll
                for (int bj = 0; bj < 2; ++bj) {
                    const size_t off = (size_t)(u.pm * BM + ai * HALF + wr * 64 + (2 * mp + mi) * 16 + fr) * 1024 + u.pn * BM + bj * HALF + wc * 32 + 8 * fq;
                    hv[mi][bj] = *(const u32x4*)(XB + off); lv[mi][bj] = *(const u32x4*)(XL + off);
                }
#pragma unroll
            for (int mi = 0; mi < 2; ++mi) {
                const int m = 2 * mp + mi, row = u.pm * BM + ai * HALF + wr * 64 + m * 16 + fr;
                float q = 0.f;
#pragma unroll
                for (int bj = 0; bj < 2; ++bj) {
                    const size_t off = (size_t)row * 1024 + u.pn * BM + bj * HALF + wc * 32 + 8 * fq;
                    f32x4 h0, h1, l0, l1; unpack8(hv[mi][bj], h0, h1); unpack8(lv[mi][bj], l0, l1);
                    const f32x4 x0 = (h0 + l0) + acc[ai][bj][m][0], x1 = (h1 + l1) + acc[ai][bj][m][1];
                    const u32x4 hw = pack8(x0, x1);
                    unpack8(hw, h0, h1);
                    *(u32x4*)(XB + off) = hw; *(u32x4*)(XL + off) = pack8(x0 - h0, x1 - h1);
#pragma unroll
                    for (int e = 0; e < 4; ++e) q += x0[e] * x0[e] + x1[e] * x1[e];
                }
                q += __shfl_xor(q, 16); q += __shfl_xor(q, 32);
                if (fq == 0) ss[(size_t)row * 16 + u.pn * 4 + wc] = q;
            }
            asm volatile("" ::: "memory");
        }
    }
};
struct EpiUp {
    static constexpr bool PERM = true, AFTER_DRAIN = false;
    bf16_t* A; const float* ss;
    __device__ __forceinline__ void operator()(const f32x4 (&acc)[2][2][4][2], const Unit& u, int wr, int wc, int fr, int fq) const {
        float rsv[2][4]; rows_rs(ss, u.pm * BM + wr * 64 + fr, fq, rsv);
#pragma unroll
        for (int ai = 0; ai < 2; ++ai)
#pragma unroll
            for (int m = 0; m < 4; ++m) {
                const int row = u.pm * BM + ai * HALF + wr * 64 + m * 16 + fr;
                const float rs = rsv[ai][m];
#pragma unroll
                for (int bj = 0; bj < 2; ++bj) {
                    const int col = u.pn * BM + bj * HALF + wc * 32 + 8 * fq;
                    *(u32x4*)(A + (size_t)row * 5632 + col) = pack8(acc[ai][bj][m][0] * rs, acc[ai][bj][m][1] * rs);
                }
                asm volatile("" ::: "memory");
            }
    }
};

__device__ __forceinline__ float dpp_prev(float x) { return __int_as_float(__builtin_amdgcn_update_dpp(0, __float_as_int(x), 0x121, 0xf, 0xf, false)); }
__device__ __forceinline__ float dpp_next(float x) { return __int_as_float(__builtin_amdgcn_update_dpp(0, __float_as_int(x), 0x12F, 0xf, 0xf, false)); }
__device__ __forceinline__ f32x4 rot_prev(const f32x4 v) { f32x4 r; r[0] = dpp_prev(v[0]); r[1] = dpp_prev(v[1]); r[2] = dpp_prev(v[2]); r[3] = dpp_prev(v[3]); return r; }
__device__ __forceinline__ f32x4 rot_next(const f32x4 v) { f32x4 r; r[0] = dpp_next(v[0]); r[1] = dpp_next(v[1]); r[2] = dpp_next(v[2]); r[3] = dpp_next(v[3]); return r; }
struct EpiUpConv {
    static constexpr bool PERM = true, AFTER_DRAIN = false;
    bf16_t* FG; bf16_t* SB; const float* ss; const float* cw; const float* cb;
    __device__ __forceinline__ void operator()(const f32x4 (&acc_)[2][2][4][2], const Unit& u, int wr, int wc, int fr, int fq) const {
        f32x4 (&acc)[2][2][4][2] = const_cast<f32x4 (&)[2][2][4][2]>(acc_);
        float rsv[2][4]; rows_rs(ss, u.pm * BM + wr * 64 + fr, fq, rsv);
        const int f0 = u.pn * 128 + wc * 32 + 8 * fq;
        const bool first = fr == 0, last = fr == 15;
#pragma unroll
        for (int ai = 0; ai < 2; ++ai) {
#pragma unroll
            for (int m = 0; m < 4; ++m)
#pragma unroll
                for (int h = 0; h < 2; ++h) { acc[ai][h][m][0] = acc[ai][h][m][0] * rsv[ai][m]; acc[ai][h][m][1] = acc[ai][h][m][1] * rsv[ai][m]; }
            const int blk = (u.pm * BM + ai * HALF + wr * 64) >> 6;
            if (fr <= 1) { bf16_t* sp = SB + ((size_t)blk * 4 + fr) * 5632 + f0;
                *(u32x4*)sp = pack8(acc[ai][0][0][0], acc[ai][0][0][1]); *(u32x4*)(sp + 2816) = pack8(acc[ai][1][0][0], acc[ai][1][0][1]); }
            if (fr >= 14) { bf16_t* sp = SB + ((size_t)blk * 4 + (fr - 12)) * 5632 + f0;
                *(u32x4*)sp = pack8(acc[ai][0][3][0], acc[ai][0][3][1]); *(u32x4*)(sp + 2816) = pack8(acc[ai][1][3][0], acc[ai][1][3][1]); }
        }
#pragma unroll
        for (int n = 0; n < 2; ++n) {
            f32x4 w[2][4];
#pragma unroll
            for (int h = 0; h < 2; ++h) {
#pragma unroll
                for (int k = 0; k < 3; ++k) w[h][k] = *(const f32x4*)(cw + k * 5632 + h * 2816 + f0 + 4 * n);
                w[h][3] = *(const f32x4*)(cb + h * 2816 + f0 + 4 * n);
            }
#pragma unroll
            for (int ai = 0; ai < 2; ++ai) {
#pragma unroll
                for (int m = 0; m < 4; ++m) {
                    const int row = u.pm * BM + ai * HALF + wr * 64 + m * 16 + fr;
                    f32x4 cv[2];
#pragma unroll
                    for (int h = 0; h < 2; ++h) {
                        const f32x4 cur = acc[ai][h][m][n];
                        f32x4 pv = rot_prev(cur), nx = rot_next(cur);
                        if (m > 0) { const f32x4 pw = rot_prev(acc[ai][h][m - 1][n]);
#pragma unroll
                            for (int e = 0; e < 4; ++e) pv[e] = first ? pw[e] : pv[e]; }
                        if (m < 3) { const f32x4 nw = rot_next(acc[ai][h][m + 1][n]);
#pragma unroll
                            for (int e = 0; e < 4; ++e) nx[e] = last ? nw[e] : nx[e]; }
                        cv[h] = pv * w[h][0] + cur * w[h][1] + nx * w[h][2] + w[h][3];
                    }
                    f32x4 o;
#pragma unroll
                    for (int e = 0; e < 4; ++e) o[e] = gelu_tanh(cv[0][e]) * cv[1][e];
                    const bool brow = (m == 0 && first) || (m == 3 && last);
                    if (!brow) { typedef unsigned u32x2e __attribute__((ext_vector_type(2))); u32x2e ow; ow.x = cvt_pk_bf16(o[0], o[1]); ow.y = cvt_pk_bf16(o[2], o[3]); *(u32x2e*)(FG + (size_t)row * 2816 + f0 + 4 * n) = ow; }
                }
                asm volatile("" ::: "memory");
            }
        }
    }
};

template <class Epi, class Sched, bool ALIGN_EPI = false, bool SP2 = false>
__device__ __forceinline__ void gemm_phase(PG8_LAS unsigned char* lds, const Gemm g, const Sched& S, const Epi& E, const int tid) {
    const int wid = __builtin_amdgcn_readfirstlane(tid >> 6), lane = tid & 63, wr = wid >> 2, wc = wid & 3, fr = lane & 15, fq = lane >> 4;
    const int K = g.K, nt = K / BK;
    unsigned voffA[2], voffB[2];
#pragma unroll
    for (int i = 0; i < 2; ++i) { int R, C; stage_rc(tid * 16 + i * 8192, R, C); const int Rb = Epi::PERM ? ((R & ~31) + perm32(R & 31)) : R;
        voffA[i] = (unsigned)(R * K + C) * 2u; voffB[i] = (unsigned)(Rb * K + C) * 2u; }
    const size_t kstep = (size_t)(BK * 2);
    const size_t hstep = (size_t)HALF * K * 2;
    const size_t tstep = 2 * hstep;
    const unsigned ldsw = (unsigned)wid * 1024u;
    const int aoff = lds_byte(wr * 64 + fr, fq * 8), boff = lds_byte(wc * 32 + fr, fq * 8);
#define PG8_SA(b, h) (((b) * 2 + (h)) * HTB)
#define PG8_SB(b, h) ((4 + (b) * 2 + (h)) * HTB)
#define PG8_STAGE(bufoff, gbase, voff) do { _Pragma("unroll") for (int _i = 0; _i < 2; ++_i) \
        __builtin_amdgcn_global_load_lds((const unsigned*)((const char*)(gbase) + (voff)[_i]), (PG8_LAS unsigned*)(lds + (bufoff) + ldsw + _i * 8192), 16, 0, 0); } while (0)
#define PG8_LDA(dst, b, h) do { _Pragma("unroll") for (int m = 0; m < 4; ++m) _Pragma("unroll") for (int k = 0; k < 2; ++k) dst[m][k] = *(const PG8_LAS bf16x8*)(lds + PG8_SA(b, h) + aoff + m * 2048 + k * 1024); } while (0)
#define PG8_LDB(dst, b, h) do { _Pragma("unroll") for (int n = 0; n < 2; ++n) _Pragma("unroll") for (int k = 0; k < 2; ++k) dst[n][k] = *(const PG8_LAS bf16x8*)(lds + PG8_SB(b, h) + boff + n * 2048 + k * 1024); } while (0)
#define PG8_MMA(ai, bj, At, Bt) do { __builtin_amdgcn_s_setprio(1); _Pragma("unroll") for (int m = 0; m < 4; ++m) _Pragma("unroll") for (int n = 0; n < 2; ++n) _Pragma("unroll") for (int k = 0; k < 2; ++k) \
        acc[ai][bj][m][n] = __builtin_amdgcn_mfma_f32_16x16x32_bf16(Bt[n][k], At[m][k], acc[ai][bj][m][n], 0, 0, 0); __builtin_amdgcn_s_setprio(0); } while (0)
#define PG8_WAIT_V(n) asm volatile("s_waitcnt vmcnt(" #n ")" ::: "memory")
#define PG8_WAIT_L(n) asm volatile("s_waitcnt lgkmcnt(" #n ")" ::: "memory")
#define PG8_BAR __builtin_amdgcn_s_barrier()
#define PG8_SCHED __builtin_amdgcn_sched_barrier(0)
    Unit cur, nxt; int ui = 0;
    if (!S.next(0, cur)) return;
    f32x4 acc[2][2][4][2];
#pragma unroll
    for (int a = 0; a < 2; ++a)
#pragma unroll
        for (int b = 0; b < 2; ++b)
#pragma unroll
            for (int m = 0; m < 4; ++m)
#pragma unroll
                for (int n = 0; n < 2; ++n) acc[a][b][m][n] = (f32x4){0.f, 0.f, 0.f, 0.f};
    bf16x8 At[4][2], B0[2][2], B1[2][2];
    const char* cA = (const char*)g.A + (size_t)cur.pm * tstep; const char* cB = (const char*)g.Bt + (size_t)cur.pn * tstep;
    S.a_ready(cur);
    if constexpr (SP2) {
        PG8_STAGE(PG8_SB(0, 0), cB, voffB); PG8_STAGE(PG8_SB(0, 1), cB + hstep, voffB); PG8_STAGE(PG8_SA(0, 0), cA, voffA); PG8_STAGE(PG8_SA(0, 1), cA + hstep, voffA);
        if (wr == 1) PG8_BAR;
        PG8_WAIT_V(2); PG8_BAR;
        PG8_STAGE(PG8_SB(1, 0), cB + kstep, voffB); PG8_STAGE(PG8_SA(1, 0), cA + kstep, voffA); PG8_STAGE(PG8_SB(1, 1), cB + hstep + kstep, voffB);
        PG8_WAIT_V(6); PG8_BAR;
    } else {
        PG8_STAGE(PG8_SB(0, 0), cB, voffB); PG8_STAGE(PG8_SA(0, 0), cA, voffA); PG8_STAGE(PG8_SB(0, 1), cB + hstep, voffB); PG8_STAGE(PG8_SA(0, 1), cA + hstep, voffA);
        if (wr == 1) PG8_BAR;
        PG8_WAIT_V(4); PG8_BAR;
        PG8_STAGE(PG8_SB(1, 0), cB + kstep, voffB); PG8_STAGE(PG8_SA(1, 0), cA + kstep, voffA); PG8_STAGE(PG8_SB(1, 1), cB + hstep + kstep, voffB);
        PG8_WAIT_V(6); PG8_BAR;
    }
    for (;;) {
        const bool has_next = S.next(ui + 1, nxt);
        const char* nA = has_next ? (const char*)g.A + (size_t)nxt.pm * tstep : cA; const char* nB = has_next ? (const char*)g.Bt + (size_t)nxt.pn * tstep : cB;
        for (int t = 0; t < nt; t += 2) {
            const bool last = (t == nt - 2);
            const char* a1 = cA + (size_t)(t + 1) * kstep;
            const char* a2 = last ? nA : cA + (size_t)(t + 2) * kstep; const char* b2 = last ? nB : cB + (size_t)(t + 2) * kstep;
            const char* a3 = a2 + kstep; const char* b3 = b2 + kstep;
            if (last && has_next) S.a_ready(nxt);
            if constexpr (SP2) {
            PG8_LDB(B0, 0, 0); PG8_LDB(B1, 0, 1); PG8_SCHED; PG8_LDA(At, 0, 0); PG8_STAGE(PG8_SA(1, 1), a1 + hstep, voffA);
            PG8_WAIT_V(8); PG8_WAIT_L(0); PG8_BAR; PG8_MMA(0, 0, At, B0); PG8_MMA(0, 1, At, B1); PG8_BAR; PG8_SCHED;
            PG8_LDA(At, 0, 1); PG8_STAGE(PG8_SB(0, 0), b2, voffB); PG8_STAGE(PG8_SB(0, 1), b2 + hstep, voffB); PG8_STAGE(PG8_SA(0, 0), a2, voffA);
            PG8_WAIT_V(8); PG8_WAIT_L(0); PG8_BAR; PG8_MMA(1, 0, At, B0); PG8_MMA(1, 1, At, B1); PG8_BAR; PG8_SCHED;
            PG8_LDB(B0, 1, 0); PG8_LDB(B1, 1, 1); PG8_SCHED; PG8_LDA(At, 1, 0); PG8_STAGE(PG8_SA(0, 1), a2 + hstep, voffA);
            PG8_WAIT_V(8); PG8_WAIT_L(0); PG8_BAR; PG8_MMA(0, 0, At, B0); PG8_MMA(0, 1, At, B1); PG8_BAR; PG8_SCHED;
            PG8_LDA(At, 1, 1); PG8_STAGE(PG8_SB(1, 0), b3, voffB); PG8_STAGE(PG8_SB(1, 1), b3 + hstep, voffB); PG8_STAGE(PG8_SA(1, 0), a3, voffA);
            PG8_WAIT_V(8); PG8_WAIT_L(0); PG8_BAR; PG8_MMA(1, 0, At, B0); PG8_MMA(1, 1, At, B1); PG8_BAR; PG8_SCHED;
            } else {
            PG8_LDB(B0, 0, 0); PG8_SCHED; PG8_LDA(At, 0, 0); PG8_STAGE(PG8_SA(1, 1), a1 + hstep, voffA);
            PG8_WAIT_L(8); PG8_BAR; PG8_WAIT_L(0); PG8_MMA(0, 0, At, B0); PG8_BAR; PG8_SCHED;
            PG8_LDB(B1, 0, 1); PG8_STAGE(PG8_SB(0, 0), b2, voffB);
            PG8_BAR; PG8_WAIT_L(0); PG8_MMA(0, 1, At, B1); PG8_BAR;
            PG8_LDA(At, 0, 1); PG8_STAGE(PG8_SA(0, 0), a2, voffA);
            PG8_BAR; PG8_WAIT_L(0); PG8_MMA(1, 0, At, B0); PG8_BAR; PG8_SCHED;
            PG8_STAGE(PG8_SB(0, 1), b2 + hstep, voffB);
            PG8_WAIT_V(6); PG8_BAR; PG8_MMA(1, 1, At, B1); PG8_BAR;
            PG8_LDB(B0, 1, 0); PG8_SCHED; PG8_LDA(At, 1, 0); PG8_STAGE(PG8_SA(0, 1), a2 + hstep, voffA);
            PG8_WAIT_L(8); PG8_BAR; PG8_WAIT_L(0); PG8_MMA(0, 0, At, B0); PG8_BAR; PG8_SCHED;
            PG8_LDB(B1, 1, 1); PG8_STAGE(PG8_SB(1, 0), b3, voffB);
            PG8_BAR; PG8_WAIT_L(0); PG8_MMA(0, 1, At, B1); PG8_BAR;
            PG8_LDA(At, 1, 1); PG8_STAGE(PG8_SA(1, 0), a3, voffA);
            PG8_BAR; PG8_WAIT_L(0); PG8_MMA(1, 0, At, B0); PG8_BAR; PG8_SCHED;
            PG8_STAGE(PG8_SB(1, 1), b3 + hstep, voffB);
            PG8_WAIT_V(6); PG8_BAR; PG8_MMA(1, 1, At, B1); PG8_BAR;
            }
        }
        if constexpr (ALIGN_EPI) { if (wr == 0) PG8_BAR; }
        if constexpr (!Epi::AFTER_DRAIN) { E(acc, cur, wr, wc, fr, fq); S.done(cur); }
        if (!has_next) break;
#pragma unroll
        for (int a = 0; a < 2; ++a)
#pragma unroll
            for (int b = 0; b < 2; ++b)
#pragma unroll
                for (int m = 0; m < 4; ++m)
#pragma unroll
                    for (int n = 0; n < 2; ++n) acc[a][b][m][n] = (f32x4){0.f, 0.f, 0.f, 0.f};
        cur = nxt; cA = nA; cB = nB; ++ui;
        if constexpr (ALIGN_EPI) { if (wr == 1) PG8_BAR; }
    }
    PG8_WAIT_V(0);
    if constexpr (!ALIGN_EPI) { if (wr == 0) PG8_BAR; }
    PG8_BAR;
    if constexpr (Epi::AFTER_DRAIN) { E.fused(acc, cur, wr, wc, fr, fq, lds, wid, lane); S.done(cur); }
#undef PG8_SA
#undef PG8_SB
#undef PG8_STAGE
#undef PG8_LDA
#undef PG8_LDB
#undef PG8_MMA
#undef PG8_WAIT_V
#undef PG8_WAIT_L
#undef PG8_BAR
#undef PG8_SCHED
}
}


#define LAS __attribute__((address_space(3)))
#ifndef SKIPMASK
#define SKIPMASK 0
#endif
#ifndef PROBE_KIND
#define PROBE_KIND -1
#endif
typedef unsigned short bf16;
using pg8::f32x4; using pg8::u32x4; using pg8::bf16x8;
typedef float f32x16 __attribute__((ext_vector_type(16)));
typedef short v4i16_t __attribute__((ext_vector_type(4)));
typedef unsigned u32x2 __attribute__((ext_vector_type(2)));

constexpr int DM = 1024, DEPTH = 4, NTOK = 98304, NPROMPT = 32768, CH = 32768, NCHUNK = NTOK / CH;
constexpr int NIN = 6400, DFF = 2816, NUP = 5632;
constexpr int LDS_BYTES = 147456, NTHR = 512;
constexpr float EPS = 1e-6f, LOG2E = 1.4426950408889634f;
constexpr size_t OFF_IN = 0, OFF_PA = OFF_IN + (size_t)NIN * DM, OFF_PB = OFF_PA + (size_t)DM * 256, OFF_OUT = OFF_PB + (size_t)DM * DM, OFF_UP = OFF_OUT + (size_t)DM * DM,
                 OFF_DN = OFF_UP + (size_t)NUP * DM, OFF_WS = OFF_DN + (size_t)DM * DFF, W_LAYER = OFF_WS + 8 * 128 * 128;
constexpr size_t MiB = 1u << 20;
constexpr size_t WS_W = 0, WS_R1 = 144 * MiB, WS_R2 = WS_R1 + (size_t)CH * 12800, WS_XB = WS_R2 + (size_t)CH * 5632, WS_SS = WS_XB + (size_t)CH * 2048, WS_SSV = WS_SS + (size_t)CH * 64, WS_BAR = WS_SSV + (size_t)CH * 64, WS_SB = WS_BAR + 65536, WS_XL = WS_SB + (size_t)(CH / 64) * 4 * 5632 * 2, WS_END = WS_XL + (size_t)CH * 2048;
static_assert(W_LAYER * 2 * DEPTH <= WS_R1, "weights fit");
constexpr int PROBE_DUPK = (PROBE_KIND == 8) ? 1 : PROBE_KIND;
constexpr int KPL = (PROBE_DUPK >= 0 && PROBE_DUPK < 8) ? 9 : 8;
constexpr int NP0 = (PROBE_KIND == 9) ? 2 : 1;
constexpr int PH_PER_CHUNK = 2 + KPL * DEPTH, N_PHASES = NP0 + NCHUNK * PH_PER_CHUNK;

struct Args { const float* in[17]; float* out; unsigned char* ws; int ph_lo, ph_hi; };

__device__ __forceinline__ float wave_sum(float v) {
#pragma unroll
    for (int o = 1; o < 64; o <<= 1) v += __shfl_xor(v, o);
    return v;
}
__device__ __forceinline__ unsigned pk2(float lo, float hi) { return pg8::cvt_pk_bf16(lo, hi); }
#define LDS_WAIT() asm volatile("s_waitcnt lgkmcnt(0)" ::: "memory")

__device__ __forceinline__ void tr_item(const float* W, int K, int N, bf16* WT, const float* gain, LAS float* scr, int item, int lane, bool perm_up = false) {
    const int nblk = N / 32, kb = item / nblk, nb = item % nblk, k0 = 64 * kb, n0 = 32 * nb;
    const int dn0 = perm_up ? ((n0 % DFF) / 128) * 256 + (n0 / DFF) * 128 + (n0 % 128) : n0;
#pragma unroll 8
    for (int i = 0; i < 32; ++i) { const int kk = 2 * i + (lane >> 5); const float g = gain ? gain[k0 + kk] : 1.0f; scr[kk * 33 + (lane & 31)] = W[(size_t)(k0 + kk) * N + n0 + (lane & 31)] * g; }
    LDS_WAIT();
    const int c = lane & 7;
#pragma unroll
    for (int j = 0; j < 4; ++j) { const int n = (lane >> 3) + 8 * j; const LAS float* s = scr + (8 * c) * 33 + n;
        u32x4 o; o.x = pk2(s[0 * 33], s[1 * 33]); o.y = pk2(s[2 * 33], s[3 * 33]); o.z = pk2(s[4 * 33], s[5 * 33]); o.w = pk2(s[6 * 33], s[7 * 33]);
        *(u32x4*)(WT + (size_t)(dn0 + n) * K + k0 + 8 * c) = o; }
    LDS_WAIT();
}
__device__ __forceinline__ void p0_weights(const Args& a, LAS unsigned char* lds, int tid, int G, int bid) {
    const int wave = tid >> 6, lane = tid & 63;
    LAS float* scr = (LAS float*)(lds + wave * 16384);
    const int gw = bid * 8 + wave, NGW = G * 8;
    constexpr int I_IN = 16 * 200, I_PA = 4 * 32, I_PB = 16 * 32, I_OUT = 16 * 32, I_UP = 16 * 176, I_DN = 44 * 32, PER = I_IN + I_PA + I_PB + I_OUT + I_UP + I_DN;
    bf16* Wb = (bf16*)(a.ws + WS_W);
    for (int it = gw; it < DEPTH * PER; it += NGW) {
        const int l = it / PER; int r = it % PER; bf16* wl = Wb + (size_t)l * W_LAYER;
        if (r < I_IN) { tr_item(a.in[4] + (size_t)l * DM * NIN, DM, NIN, wl + OFF_IN, a.in[3] + l * DM, scr, r, lane); continue; } r -= I_IN;
        if (r < I_PA) { tr_item(a.in[8] + (size_t)l * 256 * DM, 256, DM, wl + OFF_PA, nullptr, scr, r, lane); continue; } r -= I_PA;
        if (r < I_PB) { tr_item(a.in[9] + (size_t)l * DM * DM, DM, DM, wl + OFF_PB, nullptr, scr, r, lane); continue; } r -= I_PB;
        if (r < I_OUT) { tr_item(a.in[10] + (size_t)l * DM * DM, DM, DM, wl + OFF_OUT, nullptr, scr, r, lane); continue; } r -= I_OUT;
        if (r < I_UP) { tr_item(a.in[12] + (size_t)l * DM * NUP, DM, NUP, wl + OFF_UP, a.in[11] + l * DM, scr, r, lane, true); continue; } r -= I_UP;
        tr_item(a.in[15] + (size_t)l * DFF * DM, DFF, DM, wl + OFF_DN, nullptr, scr, r, lane);
    }
    for (int i = bid * NTHR + tid; i < DEPTH * 131072 / 4; i += G * NTHR) {
        const int l = i / 32768, e = (i % 32768) * 4;
        const f32x4 v = *(const f32x4*)(a.in[6] + (size_t)l * 131072 + e);
        u32x2 o; o.x = pk2(v[0], v[1]); o.y = pk2(v[2], v[3]);
        *(u32x2*)(Wb + (size_t)l * W_LAYER + OFF_WS + e) = o;
    }
}
__device__ __forceinline__ void p0x(const Args& a, int chunk, int tid, int G, int bid) {
    const int wave = tid >> 6, lane = tid & 63, gw = bid * 8 + wave, NGW = G * 8;
    bf16* XB = (bf16*)(a.ws + WS_XB); bf16* XL = (bf16*)(a.ws + WS_XL); float* SS = (float*)(a.ws + WS_SS);
    for (int m = gw; m < CH; m += NGW) {
        const size_t tok = (size_t)chunk * CH + m;
        const float* src = tok < NPROMPT ? a.in[0] + tok * DM : a.in[1] + (tok - NPROMPT) * DM;
        float s = 0.f;
#pragma unroll
        for (int j = 0; j < 4; ++j) { const f32x4 v = *(const f32x4*)(src + (lane + 64 * j) * 4); s += (v[0] * v[0] + v[1] * v[1]) + (v[2] * v[2] + v[3] * v[3]);
            u32x2 o; o.x = pk2(v[0], v[1]); o.y = pk2(v[2], v[3]); *(u32x2*)(XB + (size_t)m * DM + (lane + 64 * j) * 4) = o;
            u32x2 lo; lo.x = pk2(v[0] - __uint_as_float(o.x << 16), v[1] - __uint_as_float(o.x & 0xffff0000u)); lo.y = pk2(v[2] - __uint_as_float(o.y << 16), v[3] - __uint_as_float(o.y & 0xffff0000u));
            *(u32x2*)(XL + (size_t)m * DM + (lane + 64 * j) * 4) = lo; }
        s = wave_sum(s);
        if (lane < 16) SS[(size_t)m * 16 + lane] = lane == 0 ? s : 0.f;
    }
}
__device__ __forceinline__ void pfinal(const Args& a, int chunk, int tid, int G, int bid) {
    const int wave = tid >> 6, lane = tid & 63, gw = bid * 8 + wave, NGW = G * 8;
    const bf16* XB = (const bf16*)(a.ws + WS_XB); const bf16* XL = (const bf16*)(a.ws + WS_XL);
    const float* SS = (const float*)(a.ws + WS_SS); const float* nf = a.in[16];
    for (int m = gw; m < CH; m += NGW) {
        float* x = a.out + ((size_t)chunk * CH + m) * DM;
        const float rs = pg8::row_rs(SS, m);
#pragma unroll
        for (int j = 0; j < 2; ++j) { const int c = (lane + 64 * j) * 8; f32x4 h0, h1, l0, l1;
            pg8::unpack8(*(const u32x4*)(XB + (size_t)m * DM + c), h0, h1); pg8::unpack8(*(const u32x4*)(XL + (size_t)m * DM + c), l0, l1);
            *(f32x4*)(x + c) = (h0 + l0) * rs * *(const f32x4*)(nf + c); *(f32x4*)(x + c + 4) = (h1 + l1) * rs * *(const f32x4*)(nf + c + 4); }
    }
}
__device__ __forceinline__ int t5_bucket(int rel) {
    const int n = rel < 0 ? -rel : rel;
    const int b = n < 8 ? n : 8 + (n >= 15) + (n >= 27) + (n >= 50) + (n >= 91) + (n >= 166) + (n >= 305) + (n >= 559);
    return (rel > 0 ? 16 : 0) + b;
}
__device__ __forceinline__ void attn_unit(const bf16* QKV, bf16* OUTG, float* LSE, const float* rel_bias, LAS unsigned char* lds, int unit, int S, int tid) {
    const int wave = tid >> 6, lane = tid & 63;
    constexpr int upg = CH / 64;
    const int g = unit / upg, rem = unit % upg;
    const int ups = S / 64, seq = rem / ups, rem2 = rem % ups;
    const int d = 1 << (2 * g), L = S / d, nqb = L / 64, r = rem2 / nqb, qb = rem2 % nqb;
    const int tokbase = seq * S + r;
    const int h = wave & 3, qh = wave >> 2, n = lane & 31, hi = lane >> 5;
    const int qbase = 64 * qb + 32 * qh;
    const size_t tokq = (size_t)tokbase + (size_t)(qbase + n) * d;
    const bf16* qp = QKV + tokq * 2304 + g * 256 + h * 64 + 8 * hi;
    bf16x8 qf[4], kf[5][4];
#pragma unroll
    for (int s = 0; s < 4; ++s) qf[s] = *(const bf16x8*)(qp + 16 * s);
#pragma unroll
    for (int kt = 0; kt < 5; ++kt) {
        const int lk = qbase - 64 + 32 * kt + n, lkc = lk < 0 ? 0 : (lk > L - 1 ? L - 1 : lk);
        const bf16* kp = QKV + (size_t)(tokbase + lkc * d) * 2304 + 768 + g * 256 + h * 64 + 8 * hi;
#pragma unroll
        for (int s = 0; s < 4; ++s) kf[kt][s] = *(const bf16x8*)(kp + 16 * s);
    }
#pragma unroll
    for (int i = 0; i < 12; ++i) {
        const int idx = tid + i * NTHR, kk = idx >> 5, ch = idx & 31, lk = 64 * qb - 64 + kk;
        u32x4 v = (u32x4){0u, 0u, 0u, 0u};
        if (lk >= 0 && lk < L) v = *(const u32x4*)(QKV + (size_t)(tokbase + lk * d) * 2304 + 1536 + g * 256 + ch * 8);
        *(LAS u32x4*)(lds + kk * 576 + ch * 16) = v;
    }
    LAS float* bt = (LAS float*)(lds + 110592);
    for (int i = tid; i < 768; i += NTHR) { const int hh = i / 192, j = i % 192 - 96; bt[i] = (j >= -64 && j <= 64) ? LOG2E * rel_bias[t5_bucket(j * d) * 12 + g * 4 + hh] : -1e30f; }
    f32x16 st[5];
#pragma unroll
    for (int kt = 0; kt < 5; ++kt) {
        f32x16 acc;
#pragma unroll
        for (int e = 0; e < 16; ++e) acc[e] = 0.f;
#pragma unroll
        for (int s = 0; s < 4; ++s) acc = __builtin_amdgcn_mfma_f32_32x32x16_bf16(kf[kt][s], qf[s], acc, 0, 0, 0);
        st[kt] = acc;
    }
    __syncthreads();
    float mx = -3.0e38f;
    {
        const LAS float* btl = bt + h * 192 + 32 + 4 * hi - n;
        const bool edge = (qb == 0) || (64 * qb + 128 > L);
#pragma unroll
        for (int kt = 0; kt < 5; ++kt)
#pragma unroll
            for (int i = 0; i < 16; ++i) {
                float sv = st[kt][i] + btl[32 * kt + (i & 3) + 8 * (i >> 2)];
                if (edge) { const int lk2 = qbase - 64 + 32 * kt + (i & 3) + 8 * (i >> 2) + 4 * hi; sv = (lk2 >= 0 && lk2 < L) ? sv : -1e30f; }
                st[kt][i] = sv; mx = fmaxf(mx, sv);
            }
    }
    mx = fmaxf(mx, __shfl_xor(mx, 32));
    float sum = 0.f;
#pragma unroll
    for (int kt = 0; kt < 5; ++kt)
#pragma unroll
        for (int i = 0; i < 16; ++i) { const float pe = __builtin_amdgcn_exp2f(st[kt][i] - mx); st[kt][i] = pe; sum += pe; }
    sum += __shfl_xor(sum, 32);
    const float inv = 1.0f / sum, lse = (mx + __log2f(sum)) * 0.6931471805599453f;
    f32x16 o0, o1;
#pragma unroll
    for (int e = 0; e < 16; ++e) { o0[e] = 0.f; o1[e] = 0.f; }
    const int q4 = (lane & 15) >> 2, p4 = lane & 3, gsel = (lane >> 4) & 1;
    const unsigned vbase = (unsigned)((32 * qh + 4 * hi + q4) * 576 + h * 128 + (16 * gsel + 4 * p4) * 2);
#pragma unroll
    for (int kt = 0; kt < 5; ++kt)
#pragma unroll
        for (int s2 = 0; s2 < 2; ++s2) {
            u32x4 pw; pw.x = pk2(st[kt][8 * s2 + 0], st[kt][8 * s2 + 1]); pw.y = pk2(st[kt][8 * s2 + 2], st[kt][8 * s2 + 3]); pw.z = pk2(st[kt][8 * s2 + 4], st[kt][8 * s2 + 5]); pw.w = pk2(st[kt][8 * s2 + 6], st[kt][8 * s2 + 7]);
            const bf16x8 pf = __builtin_bit_cast(bf16x8, pw);
            const unsigned ro = vbase + (unsigned)((32 * kt + 16 * s2) * 576);
            {
                const v4i16_t r1 = __builtin_amdgcn_ds_read_tr16_b64_v4i16((LAS v4i16_t*)(lds + ro)), r2 = __builtin_amdgcn_ds_read_tr16_b64_v4i16((LAS v4i16_t*)(lds + ro + 8 * 576));
                const bf16x8 vf = (bf16x8){r1[0], r1[1], r1[2], r1[3], r2[0], r2[1], r2[2], r2[3]};
                o0 = __builtin_amdgcn_mfma_f32_32x32x16_bf16(vf, pf, o0, 0, 0, 0);
            }
            {
                const v4i16_t r1 = __builtin_amdgcn_ds_read_tr16_b64_v4i16((LAS v4i16_t*)(lds + ro + 64)), r2 = __builtin_amdgcn_ds_read_tr16_b64_v4i16((LAS v4i16_t*)(lds + ro + 64 + 8 * 576));
                const bf16x8 vf = (bf16x8){r1[0], r1[1], r1[2], r1[3], r2[0], r2[1], r2[2], r2[3]};
                o1 = __builtin_amdgcn_mfma_f32_32x32x16_bf16(vf, pf, o1, 0, 0, 0);
            }
        }
    bf16* op = OUTG + ((size_t)g * CH + tokq) * 256 + h * 64;
#pragma unroll
    for (int grp = 0; grp < 4; ++grp) {
        u32x2 w0, w1;
        w0.x = pk2(o0[4 * grp + 0] * inv, o0[4 * grp + 1] * inv); w0.y = pk2(o0[4 * grp + 2] * inv, o0[4 * grp + 3] * inv);
        w1.x = pk2(o1[4 * grp + 0] * inv, o1[4 * grp + 1] * inv); w1.y = pk2(o1[4 * grp + 2] * inv, o1[4 * grp + 3] * inv);
        *(u32x2*)(op + 8 * grp + 4 * hi) = w0; *(u32x2*)(op + 32 + 8 * grp + 4 * hi) = w1;
    }
    if (hi == 0) LSE[((size_t)g * CH + tokq) * 4 + h] = lse;
    __syncthreads();
}
constexpr int SG_WLDS = 17920;
__device__ __forceinline__ void sg_wave_unit(bf16* U, bf16* UO, const bf16* GV, const float* ssv, const bf16* WSb, const float* gain, const float* bs, LAS unsigned char* wl, int unit, int lane) {
    const int hf = unit & 1, gg = (unit >> 1) & 7, nch = unit >> 4, tok0 = nch * 128, cb = gg * 128 + hf * 64;
    LAS float* rvl = (LAS float*)(wl + 17408);
    rvl[lane] = pg8::row_rs(ssv, tok0 + lane); rvl[lane + 64] = pg8::row_rs(ssv, tok0 + lane + 64);
    LDS_WAIT();
    {
        const int c8 = lane & 7, q0 = lane >> 3;
#pragma unroll
        for (int i = 0; i < 16; ++i) {
            const int q = q0 + 8 * i;
            f32x4 a0, a1; pg8::unpack8(*(const u32x4*)(GV + (size_t)(tok0 + q) * 1024 + cb + c8 * 8), a0, a1);
            const float r = rvl[q];
            const u32x4 w = pg8::pack8(a0 * r, a1 * r);
            *(LAS u32x2*)(wl + q * 136 + c8 * 16) = (u32x2){w.x, w.y}; *(LAS u32x2*)(wl + q * 136 + c8 * 16 + 8) = (u32x2){w.z, w.w};
        }
    }
    LDS_WAIT();
    const int ln = lane & 15, kq = lane >> 4, qq = ln >> 2, pp = ln & 3;
    bf16x8 afr[4][4];
#pragma unroll
    for (int ct = 0; ct < 4; ++ct)
#pragma unroll
        for (int ks = 0; ks < 4; ++ks) {
            const unsigned ad = (unsigned)((32 * ks + 8 * kq + qq) * 136 + (32 * (ct >> 1) + 8 * pp + 4 * (ct & 1)) * 2);
            const v4i16_t r1 = __builtin_amdgcn_ds_read_tr16_b64_v4i16((LAS v4i16_t*)(wl + ad)), r2 = __builtin_amdgcn_ds_read_tr16_b64_v4i16((LAS v4i16_t*)(wl + ad + 4 * 136));
            afr[ct][ks] = (bf16x8){r1[0], r1[1], r1[2], r1[3], r2[0], r2[1], r2[2], r2[3]};
        }
    f32x4 gn[2][2];
#pragma unroll
    for (int t = 0; t < 2; ++t) { gn[t][0] = *(const f32x4*)(gain + cb + 32 * t + 8 * kq); gn[t][1] = *(const f32x4*)(gain + cb + 32 * t + 8 * kq + 4); }
#pragma unroll 2
    for (int pt = 0; pt < 8; ++pt) {
        const int pr = pt * 16 + ln;
        bf16x8 bfr[4];
#pragma unroll
        for (int ks = 0; ks < 4; ++ks) bfr[ks] = *(const bf16x8*)(WSb + (size_t)gg * 16384 + pr * 128 + 32 * ks + 8 * kq);
        bf16* up = U + (size_t)(tok0 + pr) * 1024 + cb + 8 * kq; bf16* uo = UO + (size_t)(tok0 + pr) * 1024 + cb + 8 * kq;
        const u32x4 uw0 = *(const u32x4*)up, uw1 = *(const u32x4*)(up + 32);
        const float bias = bs[gg * 128 + pr];
        f32x4 acc[4];
#pragma unroll
        for (int ct = 0; ct < 4; ++ct) {
            acc[ct] = (f32x4){0.f, 0.f, 0.f, 0.f};
#pragma unroll
            for (int ks = 0; ks < 4; ++ks) acc[ct] = __builtin_amdgcn_mfma_f32_16x16x32_bf16(afr[ct][ks], bfr[ks], acc[ct], 0, 0, 0);
        }
        f32x4 u0, u1;
        pg8::unpack8(uw0, u0, u1);
        *(u32x4*)uo = pg8::pack8(u0 * (gn[0][0] * acc[0] + bias), u1 * (gn[0][1] * acc[1] + bias));
        pg8::unpack8(uw1, u0, u1);
        *(u32x4*)(uo + 32) = pg8::pack8(u0 * (gn[1][0] * acc[2] + bias), u1 * (gn[1][1] * acc[3] + bias));
    }
    LDS_WAIT();
}
__device__ __forceinline__ void p_merge(const bf16* OUTG, const float* LSE, bf16* OA, int tid, int G, int bid) {
    for (int it = bid * NTHR + tid; it < CH * 32; it += G * NTHR) {
        const int tok = it >> 5, c8 = it & 31, h = c8 >> 3;
        const float l0 = LSE[(size_t)tok * 4 + h], l1 = LSE[((size_t)CH + tok) * 4 + h], l2 = LSE[((size_t)2 * CH + tok) * 4 + h];
        const float mx = fmaxf(l0, fmaxf(l1, l2));
        float w0 = __expf(l0 - mx), w1 = __expf(l1 - mx), w2 = __expf(l2 - mx);
        const float inv = 1.0f / (w0 + w1 + w2); w0 *= inv; w1 *= inv; w2 *= inv;
        f32x4 a0, a1, b0, b1, c0, c1;
        pg8::unpack8(*(const u32x4*)(OUTG + (size_t)tok * 256 + c8 * 8), a0, a1);
        pg8::unpack8(*(const u32x4*)(OUTG + ((size_t)CH + tok) * 256 + c8 * 8), b0, b1);
        pg8::unpack8(*(const u32x4*)(OUTG + ((size_t)2 * CH + tok) * 256 + c8 * 8), c0, c1);
        *(u32x4*)(OA + (size_t)tok * 256 + c8 * 8) = pg8::pack8(a0 * w0 + b0 * w1 + c0 * w2, a1 * w0 + b1 * w1 + c1 * w2);
    }
}
__device__ __forceinline__ void p_conv(const bf16* A, bf16* FG, const float* cw, const float* cb, int S, int tid, int G, int bid) {
    constexpr int RUN = 8, NFC = DFF / 8;
    for (int it = bid * NTHR + tid; it < (CH / RUN) * NFC; it += G * NTHR) {
        const int fc = it % NFC, t0 = (it / NFC) * RUN, f = fc * 8;
        f32x4 wg[3][2], wv[3][2], bg[2], bv[2];
#pragma unroll
        for (int k = 0; k < 3; ++k) { wg[k][0] = *(const f32x4*)(cw + k * NUP + f); wg[k][1] = *(const f32x4*)(cw + k * NUP + f + 4); wv[k][0] = *(const f32x4*)(cw + k * NUP + DFF + f); wv[k][1] = *(const f32x4*)(cw + k * NUP + DFF + f + 4); }
        bg[0] = *(const f32x4*)(cb + f); bg[1] = *(const f32x4*)(cb + f + 4); bv[0] = *(const f32x4*)(cb + DFF + f); bv[1] = *(const f32x4*)(cb + DFF + f + 4);
        const f32x4 z4 = (f32x4){0.f, 0.f, 0.f, 0.f};
        f32x4 pg0 = z4, pg1 = z4, pv0 = z4, pv1 = z4, cg0, cg1, cv0, cv1;
        if ((t0 & (S - 1)) != 0) { pg8::unpack8(*(const u32x4*)(A + (size_t)(t0 - 1) * NUP + f), pg0, pg1); pg8::unpack8(*(const u32x4*)(A + (size_t)(t0 - 1) * NUP + DFF + f), pv0, pv1); }
        pg8::unpack8(*(const u32x4*)(A + (size_t)t0 * NUP + f), cg0, cg1); pg8::unpack8(*(const u32x4*)(A + (size_t)t0 * NUP + DFF + f), cv0, cv1);
#pragma unroll
        for (int i = 0; i < RUN; ++i) {
            const int t = t0 + i;
            f32x4 ng0 = z4, ng1 = z4, nv0 = z4, nv1 = z4;
            if (((t + 1) & (S - 1)) != 0) { pg8::unpack8(*(const u32x4*)(A + (size_t)(t + 1) * NUP + f), ng0, ng1); pg8::unpack8(*(const u32x4*)(A + (size_t)(t + 1) * NUP + DFF + f), nv0, nv1); }
            f32x4 g0 = pg0 * wg[0][0] + cg0 * wg[1][0] + ng0 * wg[2][0] + bg[0], g1 = pg1 * wg[0][1] + cg1 * wg[1][1] + ng1 * wg[2][1] + bg[1];
            const f32x4 v0 = pv0 * wv[0][0] + cv0 * wv[1][0] + nv0 * wv[2][0] + bv[0], v1 = pv1 * wv[0][1] + cv1 * wv[1][1] + nv1 * wv[2][1] + bv[1];
#pragma unroll
            for (int e = 0; e < 4; ++e) { g0[e] = pg8::gelu_tanh(g0[e]) * v0[e]; g1[e] = pg8::gelu_tanh(g1[e]) * v1[e]; }
            *(u32x4*)(FG + (size_t)t * DFF + f) = pg8::pack8(g0, g1);
            pg0 = cg0; pg1 = cg1; pv0 = cv0; pv1 = cv1; cg0 = ng0; cg1 = ng1; cv0 = nv0; cv1 = nv1;
        }
    }
}

__device__ __forceinline__ void p_convfix(const bf16* SB, bf16* FG, const float* cw, const float* cb, int S, int tid, int G, int bid) {
    constexpr int NFC = DFF / 8, NB = CH / 64;
    for (int it = bid * NTHR + tid; it < NB * 2 * NFC; it += G * NTHR) {
        const int fc = it % NFC, r2 = it / NFC, which = r2 & 1, b = r2 >> 1, f = fc * 8, t = b * 64 + (which ? 63 : 0);
        const f32x4 z4 = (f32x4){0.f, 0.f, 0.f, 0.f};
        f32x4 pg0 = z4, pg1 = z4, pv0 = z4, pv1 = z4, cg0, cg1, cv0, cv1, ng0 = z4, ng1 = z4, nv0 = z4, nv1 = z4;
        const bf16* bp = SB + (size_t)b * 4 * NUP + f;
        if (which == 0) {
            if ((t & (S - 1)) != 0) { pg8::unpack8(*(const u32x4*)(bp - NUP), pg0, pg1); pg8::unpack8(*(const u32x4*)(bp - NUP + DFF), pv0, pv1); }
            pg8::unpack8(*(const u32x4*)bp, cg0, cg1); pg8::unpack8(*(const u32x4*)(bp + DFF), cv0, cv1);
            pg8::unpack8(*(const u32x4*)(bp + NUP), ng0, ng1); pg8::unpack8(*(const u32x4*)(bp + NUP + DFF), nv0, nv1);
        } else {
            pg8::unpack8(*(const u32x4*)(bp + 2 * NUP), pg0, pg1); pg8::unpack8(*(const u32x4*)(bp + 2 * NUP + DFF), pv0, pv1);
            pg8::unpack8(*(const u32x4*)(bp + 3 * NUP), cg0, cg1); pg8::unpack8(*(const u32x4*)(bp + 3 * NUP + DFF), cv0, cv1);
            if (((t + 1) & (S - 1)) != 0) { pg8::unpack8(*(const u32x4*)(bp + 4 * NUP), ng0, ng1); pg8::unpack8(*(const u32x4*)(bp + 4 * NUP + DFF), nv0, nv1); }
        }
        f32x4 g0 = *(const f32x4*)(cb + f), g1 = *(const f32x4*)(cb + f + 4), v0 = *(const f32x4*)(cb + DFF + f), v1 = *(const f32x4*)(cb + DFF + f + 4);
        g0 = g0 + pg0 * *(const f32x4*)(cw + f) + cg0 * *(const f32x4*)(cw + NUP + f) + ng0 * *(const f32x4*)(cw + 2 * NUP + f);
        g1 = g1 + pg1 * *(const f32x4*)(cw + f + 4) + cg1 * *(const f32x4*)(cw + NUP + f + 4) + ng1 * *(const f32x4*)(cw + 2 * NUP + f + 4);
        v0 = v0 + pv0 * *(const f32x4*)(cw + DFF + f) + cv0 * *(const f32x4*)(cw + NUP + DFF + f) + nv0 * *(const f32x4*)(cw + 2 * NUP + DFF + f);
        v1 = v1 + pv1 * *(const f32x4*)(cw + DFF + f + 4) + cv1 * *(const f32x4*)(cw + NUP + DFF + f + 4) + nv1 * *(const f32x4*)(cw + 2 * NUP + DFF + f + 4);
#pragma unroll
        for (int e = 0; e < 4; ++e) { g0[e] = pg8::gelu_tanh(g0[e]) * v0[e]; g1[e] = pg8::gelu_tanh(g1[e]) * v1[e]; }
        *(u32x4*)(FG + (size_t)t * DFF + f) = pg8::pack8(g0, g1);
    }
}
#define XB_TMO      128
#define XB_XCNT(j)  (256  + 64 * (j))
#define XB_XSUB(j)  (1280 + 64 * (j))
#define XB_XGEN(j)  (2304 + 64 * (j))
#define XB_TOP      3328
#define XB_TOPGEN   3392
#define XCD_BAR_WORDS 3456
#define XB_SPIN_CAP (1u << 18)

__device__ __forceinline__ unsigned xb_ld(unsigned* p)              { return __hip_atomic_load(p, __ATOMIC_RELAXED, __HIP_MEMORY_SCOPE_AGENT); }
__device__ __forceinline__ unsigned xb_add(unsigned* p, unsigned v) { return __hip_atomic_fetch_add(p, v, __ATOMIC_RELAXED, __HIP_MEMORY_SCOPE_AGENT); }
__device__ __forceinline__ unsigned xb_xcc_id() { return (unsigned)__builtin_amdgcn_s_getreg((3 << 11) | 20) & 0xFu; }
#define XB_SPIN(cond, bar) do { unsigned _sp = 0; while (cond) { __builtin_amdgcn_s_sleep(1); \
    if ((++_sp & 255u) == 0u) { if (xb_ld(&(bar)[XB_TMO])) break; if (_sp > XB_SPIN_CAP) { atomicAdd(&(bar)[XB_TMO], 1u); break; } } } } while (0)

struct XcdBarrier {
    unsigned* bar; unsigned x;
    volatile LAS unsigned* st;
};

__device__ __forceinline__ XcdBarrier xcd_barrier_post(unsigned* bar, volatile LAS unsigned* st, const int tid) {
    XcdBarrier b; b.bar = bar; b.x = xb_xcc_id(); b.st = st;
    if (tid == 0) (void)xb_add(&bar[XB_XCNT(b.x)], 1u);
    return b;
}
__device__ __forceinline__ void xcd_barrier_complete(unsigned* bar, unsigned x, unsigned& nloc, unsigned& nx) {
    const unsigned G = gridDim.x * gridDim.y * gridDim.z;
    unsigned sum, cnt, mine, sp = 0u;
    for (;;) {
        sum = 0u; cnt = 0u; mine = 0u;
#pragma unroll
        for (unsigned j = 0; j < 16; ++j) { const unsigned c = xb_ld(&bar[XB_XCNT(j)]); sum += c; cnt += (c > 0u) ? 1u : 0u; mine = (j == x) ? c : mine; }
        if (sum == G) break;
        __builtin_amdgcn_s_sleep(1);
        if ((++sp & 255u) == 0u) { if (xb_ld(&bar[XB_TMO])) break; if (sp > XB_SPIN_CAP) { atomicAdd(&bar[XB_TMO], 1u); break; } }
    }
    nloc = mine > 0u ? mine : 1u; nx = cnt > 0u ? cnt : 1u;
}

__device__ __forceinline__ void xcd_barrier(const XcdBarrier& b, const int tid) {
    asm volatile("s_waitcnt vmcnt(0)" ::: "memory");
    __syncthreads();
    if (tid == 0) {
        unsigned* bar = b.bar;
        __builtin_amdgcn_s_waitcnt(0);
        unsigned nloc = b.st[0], nx = b.st[1];
        if (nloc == 0u) { xcd_barrier_complete(bar, b.x, nloc, nx); b.st[0] = nloc; b.st[1] = nx; }
        const unsigned old = xb_add(&bar[XB_XSUB(b.x)], 1u);
        const unsigned gen = old / nloc;
        if (old + 1u == (gen + 1u) * nloc) {
            __builtin_amdgcn_fence(__ATOMIC_RELEASE, "agent");
            asm volatile("s_waitcnt vmcnt(0)" ::: "memory");
            const unsigned og = xb_add(&bar[XB_TOP], 1u);
            const unsigned tg = og / nx;
            if (og + 1u == (tg + 1u) * nx) xb_add(&bar[XB_TOPGEN], 1u);
            else XB_SPIN(xb_ld(&bar[XB_TOPGEN]) == tg, bar);
            __builtin_amdgcn_fence(__ATOMIC_ACQUIRE, "agent");
            xb_add(&bar[XB_XGEN(b.x)], 1u);
            asm volatile("s_waitcnt vmcnt(0)" ::: "memory");
        } else {
            XB_SPIN(xb_ld(&bar[XB_XGEN(b.x)]) == gen, bar);
            __builtin_amdgcn_fence(__ATOMIC_ACQUIRE, "agent");
            asm volatile("s_waitcnt vmcnt(0)" ::: "memory");
        }
    }
    __syncthreads();
}


__global__ void __launch_bounds__(NTHR, 2) fwd_kernel(Args a_in) {
    extern __shared__ __attribute__((aligned(16))) unsigned char lds_raw[];
    LAS unsigned char* lds = (LAS unsigned char*)lds_raw;
    cg::grid_group grid = cg::this_grid();
    const int ph_lo = a_in.ph_lo, ph_hi = a_in.ph_hi;
    volatile LAS unsigned* xst = (volatile LAS unsigned*)(lds + LDS_BYTES - 16);
    if (threadIdx.x < 2) xst[threadIdx.x] = 0u;
    __syncthreads();
    const unsigned xcc = xcd_barrier_post((unsigned*)(a_in.ws + WS_BAR), xst, (int)threadIdx.x).x;
    for (int ph = ph_lo; ph < ph_hi; ++ph) {
#if defined(__HIP_DEVICE_COMPILE__)
        typedef const __attribute__((address_space(4))) unsigned long long* cu64p4;
        cu64p4 ap = (cu64p4)__builtin_amdgcn_kernarg_segment_ptr();
        asm volatile("" : "+s"(ap));
        Args a;
#pragma unroll
        for (int i = 0; i < 17; ++i) a.in[i] = (const float*)ap[i];
        a.out = (float*)ap[17]; a.ws = (unsigned char*)ap[18]; a.ph_lo = ph_lo; a.ph_hi = ph_hi;
#else
        const Args a = a_in;
#endif
        int tid = threadIdx.x, G = gridDim.x, bid = blockIdx.x;
        asm volatile("" : "+v"(tid)); asm volatile("" : "+s"(G)); asm volatile("" : "+s"(bid));
        unsigned char* ws = a.ws;
        bf16* Wb = (bf16*)(ws + WS_W);
        bf16* QKV = (bf16*)(ws + WS_R1); bf16* U = QKV + (size_t)CH * 2304; bf16* GV = U + (size_t)CH * 1024; bf16* GT = GV + (size_t)CH * 1024;
        bf16* AF = (bf16*)(ws + WS_R1);
        bf16* MG = GV;
        bf16* OUTG = (bf16*)(ws + WS_R2); bf16* OA = OUTG + (size_t)3 * CH * 256; float* LSE = (float*)(OA + (size_t)CH * 256);
        bf16* FG = (bf16*)(ws + WS_R2);
        bf16* XB = (bf16*)(ws + WS_XB); float* SS = (float*)(ws + WS_SS); float* SSV = (float*)(ws + WS_SSV);
        if (ph < NP0) p0_weights(a, lds, tid, G, bid);
        else {
            const int chunk = (ph - NP0) / PH_PER_CHUNK, sub = (ph - NP0) % PH_PER_CHUNK;
            const int S = chunk == 0 ? 8192 : 2048;
            if (sub == 0) { p0x(a, chunk, tid, G, bid); if (PROBE_KIND == 10) p0x(a, chunk, tid, G, bid); }
            else if (sub == PH_PER_CHUNK - 1) pfinal(a, chunk, tid, G, bid);
            else {
                const int l = (sub - 1) / KPL, ki = (sub - 1) % KPL, k = (KPL == 9 && ki > PROBE_DUPK) ? ki - 1 : ki; const bool dup = (KPL == 9 && ki == PROBE_DUPK + 1);
                const bf16* wl = Wb + (size_t)l * W_LAYER;
                float* X = a.out + (size_t)chunk * CH * DM;
                if (k == 0 && !(SKIPMASK & 1)) {
                    pg8::Gemm g{XB, wl + OFF_IN, CH, NIN, DM}; pg8::StaticOrder So; So.init(CH, NIN, G, bid);
                    pg8::EpiIn E{QKV, U, GV, GT, SS, SSV};
                    pg8::gemm_phase<pg8::EpiIn, pg8::StaticOrder, true, true>(lds, g, So, E, tid);
                } else if (k == 1 && !(SKIPMASK & 2)) {
                    constexpr int NATT = 3 * (CH / 64), NSGW = (CH / 128) * 16;
                    if (!(SKIPMASK & 1024) && !(dup && PROBE_KIND == 8)) for (int it = bid; it < NATT; it += G) attn_unit(QKV, OUTG, LSE, a.in[2], lds, it, S, tid);
                    if (!(SKIPMASK & 2048) && (!dup || PROBE_KIND == 8)) {
                        bf16* UO = dup ? (bf16*)(ws + WS_R2 + (size_t)CH * 2096) : U;
                        const int wave = __builtin_amdgcn_readfirstlane(tid >> 6);
                        for (int wu = bid * 8 + wave; wu < NSGW; wu += G * 8) sg_wave_unit(U, UO, GV, SSV, wl + OFF_WS, a.in[5] + l * 1024, a.in[7] + l * 1024, lds + wave * SG_WLDS, wu, tid & 63);
                    }
                } else if (k == 2 && !(SKIPMASK & 4)) p_merge(OUTG, LSE, OA, tid, G, bid);
                else if (k == 3 && !(SKIPMASK & 8)) {
                    if (!(SKIPMASK & 4096)) { int kpa = 256; asm volatile("" : "+s"(kpa)); pg8::Gemm g{OA, wl + OFF_PA, CH, DM, kpa}; pg8::StaticOrder So; So.init(CH, DM, G, bid);
                      pg8::EpiGate<0> E{MG, GT, 0};
                      pg8::gemm_phase<pg8::EpiGate<0>, pg8::StaticOrder, true, true>(lds, g, So, E, tid); }
                    if (!(SKIPMASK & 8192)) { pg8::Gemm g{U, wl + OFF_PB, CH, DM, DM}; pg8::StaticOrder So; So.init(CH, DM, G, bid);
                      pg8::EpiGate<1> E{MG, GT, 1024};
                      pg8::gemm_phase<pg8::EpiGate<1>, pg8::StaticOrder, true, true>(lds, g, So, E, tid); }
                } else if (k == 4 && !(SKIPMASK & 16)) {
                    pg8::Gemm g{MG, wl + OFF_OUT, CH, DM, DM}; pg8::StaticOrder So; So.init(CH, DM, G, bid);
                    pg8::EpiRes E{(bf16*)(ws + WS_XL), XB, SS};
                    pg8::gemm_phase<pg8::EpiRes, pg8::StaticOrder, true, true>(lds, g, So, E, tid);
                } else if (k == 5 && !(SKIPMASK & 32)) {
                    pg8::Gemm g{XB, wl + OFF_UP, CH, NUP, DM}; pg8::StaticOrder So; So.init(CH, NUP, G, bid);
                    pg8::EpiUpConv E{FG, (bf16*)(ws + WS_SB), SS, a.in[13] + (size_t)l * 3 * NUP, a.in[14] + (size_t)l * NUP};
                    pg8::gemm_phase<pg8::EpiUpConv, pg8::StaticOrder, true, true>(lds, g, So, E, tid);
                } else if (k == 6 && !(SKIPMASK & 64)) p_convfix((const bf16*)(ws + WS_SB), FG, a.in[13] + (size_t)l * 3 * NUP, a.in[14] + (size_t)l * NUP, S, tid, G, bid);
                else if (!(SKIPMASK & 128)) {
                    pg8::Gemm g{FG, wl + OFF_DN, CH, DM, DFF}; pg8::StaticOrder So; So.init(CH, DM, G, bid);
                    pg8::EpiRes E{(bf16*)(ws + WS_XL), XB, SS};
                    pg8::gemm_phase<pg8::EpiRes, pg8::StaticOrder, true, true>(lds, g, So, E, tid);
                }
            }
        }
        if (ph + 1 < ph_hi) {
            if (ph == ph_lo) grid.sync();
            XcdBarrier xb; xb.bar = (unsigned*)(a.ws + WS_BAR); xb.x = xcc; xb.st = xst;
            xcd_barrier(xb, tid);
            if (PROBE_KIND == 100) xcd_barrier(xb, tid);
        }
    }
}

extern "C" void kernel_launch(void* const* d_in, const int* in_sizes, int n_in, void* d_out, int out_size, void* d_ws, size_t ws_size, hipStream_t stream) {
    static int grid = 0;
    if (grid == 0) {
        if (n_in != 17 || out_size != NTOK * DM || ws_size < WS_END) { fprintf(stderr, "kernel_launch: unexpected shapes: n_in %d out %d ws %zu (need %zu)\n", n_in, out_size, ws_size, (size_t)WS_END); grid = -1; return; }
        int dev = 0, cus = 0, per_cu = 0;
        (void)hipGetDevice(&dev); (void)hipDeviceGetAttribute(&cus, hipDeviceAttributeMultiprocessorCount, dev);
        if (hipFuncSetAttribute((const void*)fwd_kernel, hipFuncAttributeMaxDynamicSharedMemorySize, LDS_BYTES) != hipSuccess) { fprintf(stderr, "kernel_launch: hipFuncSetAttribute failed\n"); grid = -1; return; }
        if (hipOccupancyMaxActiveBlocksPerMultiprocessor(&per_cu, (const void*)fwd_kernel, NTHR, LDS_BYTES) != hipSuccess || per_cu < 1) { fprintf(stderr, "kernel_launch: occupancy query says %d\n", per_cu); per_cu = 1; }
        (void)hipGetLastError();
        grid = cus * per_cu;
        if (grid <= 0) grid = 256;
    }
    if (grid < 0) return;
    if (hipMemsetAsync((char*)d_ws + WS_BAR, 0, 65536, stream) != hipSuccess) { fprintf(stderr, "kernel_launch: memset failed\n"); return; }
    Args a{};
    for (int i = 0; i < 17; ++i) a.in[i] = (const float*)d_in[i];
    a.out = (float*)d_out; a.ws = (unsigned char*)d_ws;
#if ONE_LAUNCH
    a.ph_lo = 0; a.ph_hi = N_PHASES;
    void* args[] = {&a};
    hipError_t e = hipLaunchCooperativeKernel((const void*)fwd_kernel, dim3(grid), dim3(NTHR), args, LDS_BYTES, stream);
    if (e != hipSuccess) fprintf(stderr, "cooperative launch failed: %s (grid %d)\n", hipGetErrorString(e), grid);
#else
    for (int ph = 0; ph < N_PHASES; ++ph) {
        a.ph_lo = ph; a.ph_hi = ph + 1;
        hipLaunchKernelGGL(fwd_kernel, dim3(grid), dim3(NTHR), LDS_BYTES, stream, a);
    }
#endif
}
```

```cpp
#include <hip/hip_runtime.h>
#include <hip/hip_cooperative_groups.h>
#include <cstdio>
#include <cstdint>
namespace cg = cooperative_groups;

#ifndef ONE_LAUNCH
#define ONE_LAUNCH 1
#endif

namespace pg8 {
#define PG8_LAS __attribute__((address_space(3)))
typedef unsigned short bf16_t;
typedef short bf16x8 __attribute__((ext_vector_type(8)));
typedef float f32x4 __attribute__((ext_vector_type(4)));
typedef unsigned u32x4 __attribute__((ext_vector_type(4)));
constexpr int BM = 256, BK = 64, HALF = 128, HTB = HALF * BK * 2  , STAGE_BYTES = 8 * HTB, NXCD = 8, WGM = 8;

__host__ __device__ __forceinline__ int lds_byte(int r, int c) { const int st = (r >> 4) * 2 + (c >> 5), rr = r & 15, cc = c & 31, ob = rr * 64 + cc * 2; return st * 1024 + (ob ^ (((ob >> 9) & 1) << 5)); }
__host__ __device__ __forceinline__ void stage_rc(int b, int& R, int& C) { const int st = b / 1024, sb = b % 1024, swz = sb ^ (((sb >> 9) & 1) << 5); R = (st >> 1) * 16 + swz / 64; C = (st & 1) * 32 + (swz % 64) / 2; }
__host__ __device__ __forceinline__ int perm32(int rho) { const int n = rho >> 4, i = rho & 15; return 8 * (i >> 2) + 4 * n + (i & 3); }

struct Unit { int pm, pn; };
struct Gemm { const bf16_t* A; const bf16_t* Bt; int M, N, K; };

struct StaticOrder {
    int nM, nN, nwg, G, c;
    __host__ __device__ void init(int M, int N, int G_, int c_) { nM = M / BM; nN = N / BM; nwg = nM * nN; G = G_; c = c_; }
    __host__ __device__ bool next(int i, Unit& u) const {
        const long L = (long)i * G + c; if (L >= nwg) return false;
        int wgid = (int)L; { const int q = nwg / NXCD, r = nwg % NXCD, xcd = wgid % NXCD, off = wgid / NXCD; wgid = (xcd < r ? xcd * (q + 1) : r * (q + 1) + (xcd - r) * q) + off; }
        const int nig = WGM * nN, gid = wgid / nig, fm = gid * WGM, gsz = (nM - fm) < WGM ? (nM - fm) : WGM;
        u.pm = fm + ((wgid % nig) % gsz); u.pn = (wgid % nig) / gsz; return true;
    }
    __device__ __forceinline__ void a_ready(const Unit&) const {}
    __device__ __forceinline__ void done(const Unit&) const {}
};

__device__ __forceinline__ unsigned cvt_pk_bf16(float lo, float hi) { unsigned r; asm volatile("v_cvt_pk_bf16_f32 %0, %1, %2" : "=v"(r) : "v"(lo), "v"(hi)); return r; }

__device__ __forceinline__ float fast_sigmoid(float x) { return __builtin_amdgcn_rcpf(1.0f + __builtin_amdgcn_exp2f(-1.4426950408889634f * x)); }
__device__ __forceinline__ float gelu_tanh(float x) {
    const float y = x * (1.0f + 0.044715f * x * x) * (2.0f * 0.7978845608028654f);
    return x * __builtin_amdgcn_rcpf(1.0f + __builtin_amdgcn_exp2f(-1.4426950408889634f * y));
}
__device__ __forceinline__ float bf2f(unsigned short b) { return __uint_as_float(((unsigned)b) << 16); }
__device__ __forceinline__ u32x4 pack8(const f32x4 a, const f32x4 b) { u32x4 w; w.x = cvt_pk_bf16(a[0], a[1]); w.y = cvt_pk_bf16(a[2], a[3]); w.z = cvt_pk_bf16(b[0], b[1]); w.w = cvt_pk_bf16(b[2], b[3]); return w; }
__device__ __forceinline__ void unpack8(const u32x4 w, f32x4& a, f32x4& b) {
    a[0] = __uint_as_float(w.x << 16); a[1] = __uint_as_float(w.x & 0xffff0000u); a[2] = __uint_as_float(w.y << 16); a[3] = __uint_as_float(w.y & 0xffff0000u);
    b[0] = __uint_as_float(w.z << 16); b[1] = __uint_as_float(w.z & 0xffff0000u); b[2] = __uint_as_float(w.w << 16); b[3] = __uint_as_float(w.w & 0xffff0000u);
}
__device__ __forceinline__ float row_rs(const float* ss, int row) {
    const f32x4* sp = (const f32x4*)(ss + (size_t)row * 16);
    const f32x4 s = (sp[0] + sp[1]) + (sp[2] + sp[3]);
    return rsqrtf(((s[0] + s[1]) + (s[2] + s[3])) * (1.0f / 1024.0f) + 1e-6f);
}

__device__ __forceinline__ void rows_rs(const float* ss, int row0, int fq, float (&rsv)[2][4]) {
    f32x4 part[2][4];
#pragma unroll
    for (int ai = 0; ai < 2; ++ai)
#pragma unroll
        for (int m = 0; m < 4; ++m) part[ai][m] = *(const f32x4*)(ss + (size_t)(row0 + ai * HALF + m * 16) * 16 + fq * 4);
#pragma unroll
    for (int ai = 0; ai < 2; ++ai)
#pragma unroll
        for (int m = 0; m < 4; ++m) { float t = (part[ai][m][0] + part[ai][m][1]) + (part[ai][m][2] + part[ai][m][3]); t += __shfl_xor(t, 16); t += __shfl_xor(t, 32); rsv[ai][m] = rsqrtf(t * (1.0f / 1024.0f) + 1e-6f); }
}

struct EpiIn {
    static constexpr bool PERM = true, AFTER_DRAIN = false;
    bf16_t* QKV; bf16_t* U; bf16_t* GV; bf16_t* G; const float* ss; float* ssv;
    __device__ __forceinline__ void operator()(const f32x4 (&acc)[2][2][4][2], const Unit& u, int wr, int wc, int fr, int fq) const {
        const int pn = u.pn;
        float rsv[2][4]; rows_rs(ss, u.pm * BM + wr * 64 + fr, fq, rsv);
#pragma unroll
        for (int ai = 0; ai < 2; ++ai)
#pragma unroll
            for (int m = 0; m < 4; ++m) {
                const int row = u.pm * BM + ai * HALF + wr * 64 + m * 16 + fr;
                const float rs = rsv[ai][m];
                float q = 0.f;
#pragma unroll
                for (int bj = 0; bj < 2; ++bj) {
                    const int col = pn * BM + bj * HALF + wc * 32 + 8 * fq;
                    f32x4 v0 = acc[ai][bj][m][0] * rs, v1 = acc[ai][bj][m][1] * rs;
                    bf16_t* dst;
                    if (pn < 9) { if (pn < 3) { v0 = v0 * (0.125f * 1.4426950408889634f); v1 = v1 * (0.125f * 1.4426950408889634f); }     dst = QKV + (size_t)row * 2304 + col; }
                    else if (pn < 17) {
#pragma unroll
                        for (int e = 0; e < 4; ++e) { v0[e] = gelu_tanh(v0[e]); v1[e] = gelu_tanh(v1[e]); }
                        if (pn < 13) dst = U + (size_t)row * 1024 + (col - 2304);
                        else { dst = GV + (size_t)row * 1024 + (col - 3328);
#pragma unroll
                            for (int e = 0; e < 4; ++e) q += v0[e] * v0[e] + v1[e] * v1[e]; }
                    } else {
#pragma unroll
                        for (int e = 0; e < 4; ++e) { v0[e] = fast_sigmoid(v0[e]); v1[e] = fast_sigmoid(v1[e]); }
                        dst = G + (size_t)row * 2048 + (col - 4352);
                    }
                    *(u32x4*)dst = pack8(v0, v1);
                }
                if (pn >= 13 && pn < 17) { q += __shfl_xor(q, 16); q += __shfl_xor(q, 32); if (fq == 0) ssv[(size_t)row * 16 + (pn - 13) * 4 + wc] = q; }
                asm volatile("" ::: "memory");
            }
    }
};
template <int MODE> struct EpiGate {
    static constexpr bool PERM = true, AFTER_DRAIN = false;
    bf16_t* O; const bf16_t* G; int goff;
    __device__ __forceinline__ void operator()(const f32x4 (&acc)[2][2][4][2], const Unit& u, int wr, int wc, int fr, int fq) const {
#pragma unroll
        for (int ai = 0; ai < 2; ++ai) {
            u32x4 gw[4][2], pw[4][2];
#pragma unroll
            for (int m = 0; m < 4; ++m)
#pragma unroll
                for (int bj = 0; bj < 2; ++bj) {
                    const int row = u.pm * BM + ai * HALF + wr * 64 + m * 16 + fr, col = u.pn * BM + bj * HALF + wc * 32 + 8 * fq;
                    gw[m][bj] = *(const u32x4*)(G + (size_t)row * 2048 + goff + col);
                    if (MODE == 1) pw[m][bj] = *(const u32x4*)(O + (size_t)row * 1024 + col);
                }
#pragma unroll
            for (int m = 0; m < 4; ++m)
#pragma unroll
                for (int bj = 0; bj < 2; ++bj) {
                    const int row = u.pm * BM + ai * HALF + wr * 64 + m * 16 + fr, col = u.pn * BM + bj * HALF + wc * 32 + 8 * fq;
                    f32x4 g0, g1; unpack8(gw[m][bj], g0, g1);
                    f32x4 v0 = acc[ai][bj][m][0] * g0, v1 = acc[ai][bj][m][1] * g1;
                    if (MODE == 1) { f32x4 p0, p1; unpack8(pw[m][bj], p0, p1); v0 = v0 + p0; v1 = v1 + p1; }
                    *(u32x4*)(O + (size_t)row * 1024 + col) = pack8(v0, v1);
                }
            asm volatile("" ::: "memory");
        }
    }
};
struct EpiRes {
    static constexpr bool PERM = true, AFTER_DRAIN = false;
    bf16_t* XL; bf16_t* XB; float* ss;
    __device__ __forceinline__ void operator()(const f32x4 (&acc)[2][2][4][2], const Unit& u, int wr, int wc, int fr, int fq) const {
#pragma unroll
        for (int ai = 0; ai < 2; ++ai)
#pragma unroll
        for (int mp = 0; mp < 2; ++mp) {
            u32x4 hv[2][2], lv[2][2];
#pragma unroll
            for (int mi = 0; mi < 2; ++mi)
#pragma unroll
                for (int bj = 0; bj < 2; ++bj) {
                    const size_t off = (size_t)(u.pm * BM + ai * HALF + wr * 64 + (2 * mp + mi) * 16 + fr) * 1024 + u.pn * BM + bj * HALF + wc * 32 + 8 * fq;
                    hv[mi][bj] = *(const u32x4*)(XB + off); lv[mi][bj] = *(const u32x4*)(XL + off);
                }
#pragma unroll
            for (int mi = 0; mi < 2; ++mi) {
                const int m = 2 * mp + mi, row = u.pm * BM + ai * HALF + wr * 64 + m * 16 + fr;
                float q = 0.f;
#pragma unroll
                for (int bj = 0; bj < 2; ++bj) {
                    const size_t off = (size_t)row * 1024 + u.pn * BM + bj * HALF + wc * 32 + 8 * fq;
                    f32x4 h0, h1, l0, l1; unpack8(hv[mi][bj], h0, h1); unpack8(lv[mi][bj], l0, l1);
                    const f32x4 x0 = (h0 + l0) + acc[ai][bj][m][0], x1 = (h1 + l1) + acc[ai][bj][m][1];
                    const u32x4 hw = pack8(x0, x1);
                    unpack8(hw, h0, h1);
                    *(u32x4*)(XB + off) = hw; *(u32x4*)(XL + off) = pack8(x0 - h0, x1 - h1);
#pragma unroll
                    for (int e = 0; e < 4; ++e) q += x0[e] * x0[e] + x1[e] * x1[e];
                }
                q += __shfl_xor(q, 16); q += __shfl_xor(q, 32);
                if (fq == 0) ss[(size_t)row * 16 + u.pn * 4 + wc] = q;
            }
            asm volatile("" ::: "memory");
        }
    }
};
struct EpiUp {
    static constexpr bool PERM = true, AFTER_DRAIN = false;
    bf16_t* A; const float* ss;
    __device__ __forceinline__ void operator()(const f32x4 (&acc)[2][2][4][2], const Unit& u, int wr, int wc, int fr, int fq) const {
        float rsv[2][4]; rows_rs(ss, u.pm * BM + wr * 64 + fr, fq, rsv);
#pragma unroll
        for (int ai = 0; ai < 2; ++ai)
#pragma unroll
            for (int m = 0; m < 4; ++m) {
                const int row = u.pm * BM + ai * HALF + wr * 64 + m * 16 + fr;
                const float rs = rsv[ai][m];
#pragma unroll
                for (int bj = 0; bj < 2; ++bj) {
                    const int col = u.pn * BM + bj * HALF + wc * 32 + 8 * fq;
                    *(u32x4*)(A + (size_t)row * 5632 + col) = pack8(acc[ai][bj][m][0] * rs, acc[ai][bj][m][1] * rs);
                }
                asm volatile("" ::: "memory");
            }
    }
};

__device__ __forceinline__ float dpp_prev(float x) { return __int_as_float(__builtin_amdgcn_update_dpp(0, __float_as_int(x), 0x121, 0xf, 0xf, false)); }
__device__ __forceinline__ float dpp_next(float x) { return __int_as_float(__builtin_amdgcn_update_dpp(0, __float_as_int(x), 0x12F, 0xf, 0xf, false)); }
__device__ __forceinline__ f32x4 rot_prev(const f32x4 v) { f32x4 r; r[0] = dpp_prev(v[0]); r[1] = dpp_prev(v[1]); r[2] = dpp_prev(v[2]); r[3] = dpp_prev(v[3]); return r; }
__device__ __forceinline__ f32x4 rot_next(const f32x4 v) { f32x4 r; r[0] = dpp_next(v[0]); r[1] = dpp_next(v[1]); r[2] = dpp_next(v[2]); r[3] = dpp_next(v[3]); return r; }
struct EpiUpConv {
    static constexpr bool PERM = true, AFTER_DRAIN = false;
    bf16_t* FG; bf16_t* SB; const float* ss; const float* cw; const float* cb;
    __device__ __forceinline__ void operator()(const f32x4 (&acc_)[2][2][4][2], const Unit& u, int wr, int wc, int fr, int fq) const {
        f32x4 (&acc)[2][2][4][2] = const_cast<f32x4 (&)[2][2][4][2]>(acc_);
        float rsv[2][4]; rows_rs(ss, u.pm * BM + wr * 64 + fr, fq, rsv);
        const int f0 = u.pn * 128 + wc * 32 + 8 * fq;
        const bool first = fr == 0, last = fr == 15;
#pragma unroll
        for (int ai = 0; ai < 2; ++ai) {
#pragma unroll
            for (int m = 0; m < 4; ++m)
#pragma unroll
                for (int h = 0; h < 2; ++h) { acc[ai][h][m][0] = acc[ai][h][m][0] * rsv[ai][m]; acc[ai][h][m][1] = acc[ai][h][m][1] * rsv[ai][m]; }
            const int blk = (u.pm * BM + ai * HALF + wr * 64) >> 6;
            if (fr <= 1) { bf16_t* sp = SB + ((size_t)blk * 4 + fr) * 5632 + f0;
                *(u32x4*)sp = pack8(acc[ai][0][0][0], acc[ai][0][0][1]); *(u32x4*)(sp + 2816) = pack8(acc[ai][1][0][0], acc[ai][1][0][1]); }
            if (fr >= 14) { bf16_t* sp = SB + ((size_t)blk * 4 + (fr - 12)) * 5632 + f0;
                *(u32x4*)sp = pack8(acc[ai][0][3][0], acc[ai][0][3][1]); *(u32x4*)(sp + 2816) = pack8(acc[ai][1][3][0], acc[ai][1][3][1]); }
        }
#pragma unroll
        for (int n = 0; n < 2; ++n) {
            f32x4 w[2][4];
#pragma unroll
            for (int h = 0; h < 2; ++h) {
#pragma unroll
                for (int k = 0; k < 3; ++k) w[h][k] = *(const f32x4*)(cw + k * 5632 + h * 2816 + f0 + 4 * n);
                w[h][3] = *(const f32x4*)(cb + h * 2816 + f0 + 4 * n);
            }
#pragma unroll
            for (int ai = 0; ai < 2; ++ai) {
#pragma unroll
                for (int m = 0; m < 4; ++m) {
                    const int row = u.pm * BM + ai * HALF + wr * 64 + m * 16 + fr;
                    f32x4 cv[2];
#pragma unroll
                    for (int h = 0; h < 2; ++h) {
                        const f32x4 cur = acc[ai][h][m][n];
                        f32x4 pv = rot_prev(cur), nx = rot_next(cur);
                        if (m > 0) { const f32x4 pw = rot_prev(acc[ai][h][m - 1][n]);
#pragma unroll
                            for (int e = 0; e < 4; ++e) pv[e] = first ? pw[e] : pv[e]; }
                        if (m < 3) { const f32x4 nw = rot_next(acc[ai][h][m + 1][n]);
#pragma unroll
                            for (int e = 0; e < 4; ++e) nx[e] = last ? nw[e] : nx[e]; }
                        cv[h] = pv * w[h][0] + cur * w[h][1] + nx * w[h][2] + w[h][3];
                    }
                    f32x4 o;
#pragma unroll
                    for (int e = 0; e < 4; ++e) o[e] = gelu_tanh(cv[0][e]) * cv[1][e];
                    const bool brow = (m == 0 && first) || (m == 3 && last);
                    if (!brow) { typedef unsigned u32x2e __attribute__((ext_vector_type(2))); u32x2e ow; ow.x = cvt_pk_bf16(o[0], o[1]); ow.y = cvt_pk_bf16(o[2], o[3]); *(u32x2e*)(FG + (size_t)row * 2816 + f0 + 4 * n) = ow; }
                }
                asm volatile("" ::: "memory");
            }
        }
    }
};

template <class Epi, class Sched, bool ALIGN_EPI = false, bool SP2 = false>
__device__ __forceinline__ void gemm_phase(PG8_LAS unsigned char* lds, const Gemm g, const Sched& S, const Epi& E, const int tid) {
    const int wid = __builtin_amdgcn_readfirstlane(tid >> 6), lane = tid & 63, wr = wid >> 2, wc = wid & 3, fr = lane & 15, fq = lane >> 4;
    const int K = g.K, nt = K / BK;
    unsigned voffA[2], voffB[2];
#pragma unroll
    for (int i = 0; i < 2; ++i) { int R, C; stage_rc(tid * 16 + i * 8192, R, C); const int Rb = Epi::PERM ? ((R & ~31) + perm32(R & 31)) : R;
        voffA[i] = (unsigned)(R * K + C) * 2u; voffB[i] = (unsigned)(Rb * K + C) * 2u; }
    const size_t kstep = (size_t)(BK * 2);
    const size_t hstep = (size_t)HALF * K * 2;
    const size_t tstep = 2 * hstep;
    const unsigned ldsw = (unsigned)wid * 1024u;
    const int aoff = lds_byte(wr * 64 + fr, fq * 8), boff = lds_byte(wc * 32 + fr, fq * 8);
#define PG8_SA(b, h) (((b) * 2 + (h)) * HTB)
#define PG8_SB(b, h) ((4 + (b) * 2 + (h)) * HTB)
#define PG8_STAGE(bufoff, gbase, voff) do { _Pragma("unroll") for (int _i = 0; _i < 2; ++_i) \
        __builtin_amdgcn_global_load_lds((const unsigned*)((const char*)(gbase) + (voff)[_i]), (PG8_LAS unsigned*)(lds + (bufoff) + ldsw + _i * 8192), 16, 0, 0); } while (0)
#define PG8_LDA(dst, b, h) do { _Pragma("unroll") for (int m = 0; m < 4; ++m) _Pragma("unroll") for (int k = 0; k < 2; ++k) dst[m][k] = *(const PG8_LAS bf16x8*)(lds + PG8_SA(b, h) + aoff + m * 2048 + k * 1024); } while (0)
#define PG8_LDB(dst, b, h) do { _Pragma("unroll") for (int n = 0; n < 2; ++n) _Pragma("unroll") for (int k = 0; k < 2; ++k) dst[n][k] = *(const PG8_LAS bf16x8*)(lds + PG8_SB(b, h) + boff + n * 2048 + k * 1024); } while (0)
#define PG8_MMA(ai, bj, At, Bt) do { __builtin_amdgcn_s_setprio(1); _Pragma("unroll") for (int m = 0; m < 4; ++m) _Pragma("unroll") for (int n = 0; n < 2; ++n) _Pragma("unroll") for (int k = 0; k < 2; ++k) \
        acc[ai][bj][m][n] = __builtin_amdgcn_mfma_f32_16x16x32_bf16(Bt[n][k], At[m][k], acc[ai][bj][m][n], 0, 0, 0); __builtin_amdgcn_s_setprio(0); } while (0)
#define PG8_WAIT_V(n) asm volatile("s_waitcnt vmcnt(" #n ")" ::: "memory")
#define PG8_WAIT_L(n) asm volatile("s_waitcnt lgkmcnt(" #n ")" ::: "memory")
#define PG8_BAR __builtin_amdgcn_s_barrier()
#define PG8_SCHED __builtin_amdgcn_sched_barrier(0)
    Unit cur, nxt; int ui = 0;
    if (!S.next(0, cur)) return;
    f32x4 acc[2][2][4][2];
#pragma unroll
    for (int a = 0; a < 2; ++a)
#pragma unroll
        for (int b = 0; b < 2; ++b)
#pragma unroll
            for (int m = 0; m < 4; ++m)
#pragma unroll
                for (int n = 0; n < 2; ++n) acc[a][b][m][n] = (f32x4){0.f, 0.f, 0.f, 0.f};
    bf16x8 At[4][2], B0[2][2], B1[2][2];
    const char* cA = (const char*)g.A + (size_t)cur.pm * tstep; const char* cB = (const char*)g.Bt + (size_t)cur.pn * tstep;
    S.a_ready(cur);
    if constexpr (SP2) {
        PG8_STAGE(PG8_SB(0, 0), cB, voffB); PG8_STAGE(PG8_SB(0, 1), cB + hstep, voffB); PG8_STAGE(PG8_SA(0, 0), cA, voffA); PG8_STAGE(PG8_SA(0, 1), cA + hstep, voffA);
        if (wr == 1) PG8_BAR;
        PG8_WAIT_V(2); PG8_BAR;
        PG8_STAGE(PG8_SB(1, 0), cB + kstep, voffB); PG8_STAGE(PG8_SA(1, 0), cA + kstep, voffA); PG8_STAGE(PG8_SB(1, 1), cB + hstep + kstep, voffB);
        PG8_WAIT_V(6); PG8_BAR;
    } else {
        PG8_STAGE(PG8_SB(0, 0), cB, voffB); PG8_STAGE(PG8_SA(0, 0), cA, voffA); PG8_STAGE(PG8_SB(0, 1), cB + hstep, voffB); PG8_STAGE(PG8_SA(0, 1), cA + hstep, voffA);
        if (wr == 1) PG8_BAR;
        PG8_WAIT_V(4); PG8_BAR;
        PG8_STAGE(PG8_SB(1, 0), cB + kstep, voffB); PG8_STAGE(PG8_SA(1, 0), cA + kstep, voffA); PG8_STAGE(PG8_SB(1, 1), cB + hstep + kstep, voffB);
        PG8_WAIT_V(6); PG8_BAR;
    }
    for (;;) {
        const bool has_next = S.next(ui + 1, nxt);
        const char* nA = has_next ? (const char*)g.A + (size_t)nxt.pm * tstep : cA; const char* nB = has_next ? (const char*)g.Bt + (size_t)nxt.pn * tstep : cB;
        for (int t = 0; t < nt; t += 2) {
            const bool last = (t == nt - 2);
            const char* a1 = cA + (size_t)(t + 1) * kstep;
            const char* a2 = last ? nA : cA + (size_t)(t + 2) * kstep; const char* b2 = last ? nB : cB + (size_t)(t + 2) * kstep;
            const char* a3 = a2 + kstep; const char* b3 = b2 + kstep;
            if (last && has_next) S.a_ready(nxt);
            if constexpr (SP2) {
            PG8_LDB(B0, 0, 0); PG8_LDB(B1, 0, 1); PG8_SCHED; PG8_LDA(At, 0, 0); PG8_STAGE(PG8_SA(1, 1), a1 + hstep, voffA);
            PG8_WAIT_V(8); PG8_WAIT_L(0); PG8_BAR; PG8_MMA(0, 0, At, B0); PG8_MMA(0, 1, At, B1); PG8_BAR; PG8_SCHED;
            PG8_LDA(At, 0, 1); PG8_STAGE(PG8_SB(0, 0), b2, voffB); PG8_STAGE(PG8_SB(0, 1), b2 + hstep, voffB); PG8_STAGE(PG8_SA(0, 0), a2, voffA);
            PG8_WAIT_V(8); PG8_WAIT_L(0); PG8_BAR; PG8_MMA(1, 0, At, B0); PG8_MMA(1, 1, At, B1); PG8_BAR; PG8_SCHED;
            PG8_LDB(B0, 1, 0); PG8_LDB(B1, 1, 1); PG8_SCHED; PG8_LDA(At, 1, 0); PG8_STAGE(PG8_SA(0, 1), a2 + hstep, voffA);
            PG8_WAIT_V(8); PG8_WAIT_L(0); PG8_BAR; PG8_MMA(0, 0, At, B0); PG8_MMA(0, 1, At, B1); PG8_BAR; PG8_SCHED;
            PG8_LDA(At, 1, 1); PG8_STAGE(PG8_SB(1, 0), b3, voffB); PG8_STAGE(PG8_SB(1, 1), b3 + hstep, voffB); PG8_STAGE(PG8_SA(1, 0), a3, voffA);
            PG8_WAIT_V(8); PG8_WAIT_L(0); PG8_BAR; PG8_MMA(1, 0, At, B0); PG8_MMA(1, 1, At, B1); PG8_BAR; PG8_SCHED;
            } else {
            PG8_LDB(B0, 0, 0); PG8_SCHED; PG8_LDA(At, 0, 0); PG8_STAGE(PG8_SA(1, 1), a1 + hstep, voffA);
            PG8_WAIT_L(8); PG8_BAR; PG8_WAIT_L(0); PG8_MMA(0, 0, At, B0); PG8_BAR; PG8_SCHED;
            PG8_LDB(B1, 0, 1); PG8_STAGE(PG8_SB(0, 0), b2, voffB);
            PG8_BAR; PG8_WAIT_L(0); PG8_MMA(0, 1, At, B1); PG8_BAR;
            PG8_LDA(At, 0, 1); PG8_STAGE(PG8_SA(0, 0), a2, voffA);
            PG8_BAR; PG8_WAIT_L(0); PG8_MMA(1, 0, At, B0); PG8_BAR; PG8_SCHED;
            PG8_STAGE(PG8_SB(0, 1), b2 + hstep, voffB);
            PG8_WAIT_V(6); PG8_BAR; PG8_MMA(1, 1, At, B1); PG8_BAR;
            PG8_LDB(B0, 1, 0); PG8_SCHED; PG8_LDA(At, 1, 0); PG8_STAGE(PG8_SA(0, 1), a2 + hstep, voffA);
            PG8_WAIT_L(8); PG8_BAR; PG8_WAIT_L(0); PG8_MMA(0, 0, At, B0); PG8_BAR; PG8_SCHED;
            PG8_LDB(B1, 1, 1); PG8_STAGE(PG8_SB(1, 0), b3, voffB);
            PG8_BAR; PG8_WAIT_L(0); PG8_MMA(0, 1, At, B1); PG8_BAR;
            PG8_LDA(At, 1, 1); PG8_STAGE(PG8_SA(1, 0), a3, voffA);
            PG8_BAR; PG8_WAIT_L(0); PG8_MMA(1, 0, At, B0); PG8_BAR; PG8_SCHED;
            PG8_STAGE(PG8_SB(1, 1), b3 + hstep, voffB);
            PG8_WAIT_V(6); PG8_BAR; PG8_MMA(1, 1, At, B1); PG8_BAR;
            }
        }
        if constexpr (ALIGN_EPI) { if (wr == 0) PG8_BAR; }
        if constexpr (!Epi::AFTER_DRAIN) { E(acc, cur, wr, wc, fr, fq); S.done(cur); }
        if (!has_next) break;
#pragma unroll
        for (int a = 0; a < 2; ++a)
#pragma unroll
            for (int b = 0; b < 2; ++b)
#pragma unroll
                for (int m = 0; m < 4; ++m)
#pragma unroll
                    for (int n = 0; n < 2; ++n) acc[a][b][m][n] = (f32x4){0.f, 0.f, 0.f, 0.f};
        cur = nxt; cA = nA; cB = nB; ++ui;
        if constexpr (ALIGN_EPI) { if (wr == 1) PG8_BAR; }
    }
    PG8_WAIT_V(0);
    if constexpr (!ALIGN_EPI) { if (wr == 0) PG8_BAR; }
    PG8_BAR;
    if constexpr (Epi::AFTER_DRAIN) { E.fused(acc, cur, wr, wc, fr, fq, lds, wid, lane); S.done(cur); }
#undef PG8_SA
#undef PG8_SB
#undef PG8_STAGE
#undef PG8_LDA
#undef PG8_LDB
#undef PG8_MMA
#undef PG8_WAIT_V
#undef PG8_WAIT_L
#undef PG8_BAR
#undef PG8_SCHED
}
}


#define LAS __attribute__((address_space(3)))
#ifndef SKIPMASK
#define SKIPMASK 0
#endif
#ifndef PROBE_KIND
#define PROBE_KIND -1
#endif
typedef unsigned short bf16;
using pg8::f32x4; using pg8::u32x4; using pg8::bf16x8;
typedef float f32x16 __attribute__((ext_vector_type(16)));
typedef short v4i16_t __attribute__((ext_vector_type(4)));
typedef unsigned u32x2 __attribute__((ext_vector_type(2)));

constexpr int DM = 1024, DEPTH = 4, NTOK = 98304, NPROMPT = 32768, CH = 32768, NCHUNK = NTOK / CH;
constexpr int NIN = 6400, DFF = 2816, NUP = 5632;
constexpr int LDS_BYTES = 147456, NTHR = 512;
constexpr float EPS = 1e-6f, LOG2E = 1.4426950408889634f;
constexpr size_t OFF_IN = 0, OFF_PA = OFF_IN + (size_t)NIN * DM, OFF_PB = OFF_PA + (size_t)DM * 256, OFF_OUT = OFF_PB + (size_t)DM * DM, OFF_UP = OFF_OUT + (size_t)DM * DM,
                 OFF_DN = OFF_UP + (size_t)NUP * DM, OFF_WS = OFF_DN + (size_t)DM * DFF, W_LAYER = OFF_WS + 8 * 128 * 128;
constexpr size_t MiB = 1u << 20;
constexpr size_t WS_W = 0, WS_R1 = 144 * MiB, WS_R2 = WS_R1 + (size_t)CH * 12800, WS_XB = WS_R2 + (size_t)CH * 5632, WS_SS = WS_XB + (size_t)CH * 2048, WS_SSV = WS_SS + (size_t)CH * 64, WS_BAR = WS_SSV + (size_t)CH * 64, WS_SB = WS_BAR + 65536, WS_XL = WS_SB + (size_t)(CH / 64) * 4 * 5632 * 2, WS_BT = WS_XL + (size_t)CH * 2048, WS_END = WS_BT + 16384;
static_assert(W_LAYER * 2 * DEPTH <= WS_R1, "weights fit");
constexpr int PROBE_DUPK = (PROBE_KIND == 8) ? 1 : PROBE_KIND;
constexpr int KPL = (PROBE_DUPK >= 0 && PROBE_DUPK < 8) ? 9 : 8;
constexpr int NP0 = (PROBE_KIND == 9) ? 2 : 1;
constexpr int PH_PER_CHUNK = 2 + KPL * DEPTH, N_PHASES = NP0 + NCHUNK * PH_PER_CHUNK;

struct Args { const float* in[17]; float* out; unsigned char* ws; int ph_lo, ph_hi; };

__device__ __forceinline__ float wave_sum(float v) {
#pragma unroll
    for (int o = 1; o < 64; o <<= 1) v += __shfl_xor(v, o);
    return v;
}
__device__ __forceinline__ unsigned pk2(float lo, float hi) { return pg8::cvt_pk_bf16(lo, hi); }
#define LDS_WAIT() asm volatile("s_waitcnt lgkmcnt(0)" ::: "memory")

__device__ __forceinline__ int t5_bucket(int rel) {
    const int n = rel < 0 ? -rel : rel;
    const int b = n < 8 ? n : 8 + (n >= 15) + (n >= 27) + (n >= 50) + (n >= 91) + (n >= 166) + (n >= 305) + (n >= 559);
    return (rel > 0 ? 16 : 0) + b;
}
__device__ __forceinline__ void tr_item(const float* W, int K, int N, bf16* WT, const float* gain, LAS float* scr, int item, int lane, bool perm_up = false) {
    const int nblk = N / 32, kb = item / nblk, nb = item % nblk, k0 = 64 * kb, n0 = 32 * nb;
    const int dn0 = perm_up ? ((n0 % DFF) / 128) * 256 + (n0 / DFF) * 128 + (n0 % 128) : n0;
#pragma unroll 8
    for (int i = 0; i < 32; ++i) { const int kk = 2 * i + (lane >> 5); const float g = gain ? gain[k0 + kk] : 1.0f; scr[kk * 33 + (lane & 31)] = W[(size_t)(k0 + kk) * N + n0 + (lane & 31)] * g; }
    LDS_WAIT();
    const int c = lane & 7;
#pragma unroll
    for (int j = 0; j < 4; ++j) { const int n = (lane >> 3) + 8 * j; const LAS float* s = scr + (8 * c) * 33 + n;
        u32x4 o; o.x = pk2(s[0 * 33], s[1 * 33]); o.y = pk2(s[2 * 33], s[3 * 33]); o.z = pk2(s[4 * 33], s[5 * 33]); o.w = pk2(s[6 * 33], s[7 * 33]);
        *(u32x4*)(WT + (size_t)(dn0 + n) * K + k0 + 8 * c) = o; }
    LDS_WAIT();
}
__device__ __forceinline__ void p0_weights(const Args& a, LAS unsigned char* lds, int tid, int G, int bid) {
    const int wave = tid >> 6, lane = tid & 63;
    LAS float* scr = (LAS float*)(lds + wave * 16384);
    const int gw = bid * 8 + wave, NGW = G * 8;
    constexpr int I_IN = 16 * 200, I_PA = 4 * 32, I_PB = 16 * 32, I_OUT = 16 * 32, I_UP = 16 * 176, I_DN = 44 * 32, PER = I_IN + I_PA + I_PB + I_OUT + I_UP + I_DN;
    bf16* Wb = (bf16*)(a.ws + WS_W);
    for (int it = gw; it < DEPTH * PER; it += NGW) {
        const int l = it / PER; int r = it % PER; bf16* wl = Wb + (size_t)l * W_LAYER;
        if (r < I_IN) { tr_item(a.in[4] + (size_t)l * DM * NIN, DM, NIN, wl + OFF_IN, a.in[3] + l * DM, scr, r, lane); continue; } r -= I_IN;
        if (r < I_PA) { tr_item(a.in[8] + (size_t)l * 256 * DM, 256, DM, wl + OFF_PA, nullptr, scr, r, lane); continue; } r -= I_PA;
        if (r < I_PB) { tr_item(a.in[9] + (size_t)l * DM * DM, DM, DM, wl + OFF_PB, nullptr, scr, r, lane); continue; } r -= I_PB;
        if (r < I_OUT) { tr_item(a.in[10] + (size_t)l * DM * DM, DM, DM, wl + OFF_OUT, nullptr, scr, r, lane); continue; } r -= I_OUT;
        if (r < I_UP) { tr_item(a.in[12] + (size_t)l * DM * NUP, DM, NUP, wl + OFF_UP, a.in[11] + l * DM, scr, r, lane, true); continue; } r -= I_UP;
        tr_item(a.in[15] + (size_t)l * DFF * DM, DFF, DM, wl + OFF_DN, nullptr, scr, r, lane);
    }
    if (bid == 0) {
        float* BT = (float*)(a.ws + WS_BT);
        for (int i = tid; i < 3 * 768; i += NTHR) { const int g = i / 768, hh = (i % 768) / 192, j = i % 192 - 96;
            BT[i] = (j >= -64 && j <= 64) ? LOG2E * a.in[2][t5_bucket(j << (2 * g)) * 12 + g * 4 + hh] : -1e30f; }
    }
    for (int i = bid * NTHR + tid; i < DEPTH * 131072 / 4; i += G * NTHR) {
        const int l = i / 32768, e = (i % 32768) * 4;
        const f32x4 v = *(const f32x4*)(a.in[6] + (size_t)l * 131072 + e);
        u32x2 o; o.x = pk2(v[0], v[1]); o.y = pk2(v[2], v[3]);
        *(u32x2*)(Wb + (size_t)l * W_LAYER + OFF_WS + e) = o;
    }
}
__device__ __forceinline__ void p0x(const Args& a, int chunk, int tid, int G, int bid) {
    const int wave = tid >> 6, lane = tid & 63, gw = bid * 8 + wave, NGW = G * 8;
    bf16* XB = (bf16*)(a.ws + WS_XB); bf16* XL = (bf16*)(a.ws + WS_XL); float* SS = (float*)(a.ws + WS_SS);
    for (int m = gw; m < CH; m += NGW) {
        const size_t tok = (size_t)chunk * CH + m;
        const float* src = tok < NPROMPT ? a.in[0] + tok * DM : a.in[1] + (tok - NPROMPT) * DM;
        float s = 0.f;
#pragma unroll
        for (int j = 0; j < 4; ++j) { const f32x4 v = *(const f32x4*)(src + (lane + 64 * j) * 4); s += (v[0] * v[0] + v[1] * v[1]) + (v[2] * v[2] + v[3] * v[3]);
            u32x2 o; o.x = pk2(v[0], v[1]); o.y = pk2(v[2], v[3]); *(u32x2*)(XB + (size_t)m * DM + (lane + 64 * j) * 4) = o;
            u32x2 lo; lo.x = pk2(v[0] - __uint_as_float(o.x << 16), v[1] - __uint_as_float(o.x & 0xffff0000u)); lo.y = pk2(v[2] - __uint_as_float(o.y << 16), v[3] - __uint_as_float(o.y & 0xffff0000u));
            *(u32x2*)(XL + (size_t)m * DM + (lane + 64 * j) * 4) = lo; }
        s = wave_sum(s);
        if (lane < 16) SS[(size_t)m * 16 + lane] = lane == 0 ? s : 0.f;
    }
}
__device__ __forceinline__ void pfinal(const Args& a, int chunk, int tid, int G, int bid) {
    const int wave = tid >> 6, lane = tid & 63, gw = bid * 8 + wave, NGW = G * 8;
    const bf16* XB = (const bf16*)(a.ws + WS_XB); const bf16* XL = (const bf16*)(a.ws + WS_XL);
    const float* SS = (const float*)(a.ws + WS_SS); const float* nf = a.in[16];
    for (int m = gw; m < CH; m += NGW) {
        float* x = a.out + ((size_t)chunk * CH + m) * DM;
        const float rs = pg8::row_rs(SS, m);
#pragma unroll
        for (int j = 0; j < 2; ++j) { const int c = (lane + 64 * j) * 8; f32x4 h0, h1, l0, l1;
            pg8::unpack8(*(const u32x4*)(XB + (size_t)m * DM + c), h0, h1); pg8::unpack8(*(const u32x4*)(XL + (size_t)m * DM + c), l0, l1);
            *(f32x4*)(x + c) = (h0 + l0) * rs * *(const f32x4*)(nf + c); *(f32x4*)(x + c + 4) = (h1 + l1) * rs * *(const f32x4*)(nf + c + 4); }
    }
}
struct AttU { int g, d, L, tokbase, qb; };
__device__ __forceinline__ AttU att_decode(int unit, int S) {
    constexpr int upg = CH / 64;
    AttU u; u.g = unit / upg; const int rem = unit % upg, ups = S / 64, seq = rem / ups, rem2 = rem % ups;
    u.d = 1 << (2 * u.g); u.L = S / u.d; const int nqb = u.L / 64, r = rem2 / nqb; u.qb = rem2 % nqb; u.tokbase = seq * S + r;
    return u;
}
template <int KT0, int KT1, bool WITHQ>
__device__ __forceinline__ void att_load_qk(const bf16* QKV, const AttU& u, int h, int qh, int n, int hi, bf16x8 (&qf)[4], bf16x8 (&kf)[5][4]) {
    const int qbase = 64 * u.qb + 32 * qh;
    if (WITHQ) {
        const bf16* qp = QKV + ((size_t)u.tokbase + (size_t)(qbase + n) * u.d) * 2304 + u.g * 256 + h * 64 + 8 * hi;
#pragma unroll
        for (int s = 0; s < 4; ++s) qf[s] = *(const bf16x8*)(qp + 16 * s);
    }
#pragma unroll
    for (int kt = KT0; kt < KT1; ++kt) {
        const int lk = qbase - 64 + 32 * kt + n, lkc = lk < 0 ? 0 : (lk > u.L - 1 ? u.L - 1 : lk);
        const bf16* kp = QKV + (size_t)(u.tokbase + lkc * u.d) * 2304 + 768 + u.g * 256 + h * 64 + 8 * hi;
#pragma unroll
        for (int s = 0; s < 4; ++s) kf[kt][s] = *(const bf16x8*)(kp + 16 * s);
    }
}
__device__ __forceinline__ void attn_phase(const bf16* QKV, bf16* OUTG, float* LSE, const float* BT, LAS unsigned char* lds, int S, int tid, int G, int bid) {
    constexpr int NATT = 3 * (CH / 64);
    const int wave = tid >> 6, lane = tid & 63;
    const int h = wave & 3, qh = wave >> 2, n = lane & 31, hi = lane >> 5;
    int it = bid;
    if (it >= NATT) return;
    AttU u = att_decode(it, S);
    bf16x8 qf[4], kf[5][4];
    att_load_qk<0, 4, false>(QKV, u, h, qh, n, hi, qf, kf);
    for (; it < NATT; it += G) {
        const int g = u.g, d = u.d, L = u.L, tokbase = u.tokbase, qb = u.qb, qbase = 64 * qb + 32 * qh;
        const size_t tokq = (size_t)tokbase + (size_t)(qbase + n) * d;
        att_load_qk<4, 5, true>(QKV, u, h, qh, n, hi, qf, kf);
        u32x4 vv[12];
        int tl = tid; asm volatile("" : "+v"(tl));
#pragma unroll
        for (int i = 0; i < 12; ++i) {
            const int idx = tl + i * NTHR, kk = idx >> 5, ch = idx & 31, lk = 64 * qb - 64 + kk;
            vv[i] = (u32x4){0u, 0u, 0u, 0u};
            if (lk >= 0 && lk < L) vv[i] = *(const u32x4*)(QKV + (size_t)(tokbase + lk * d) * 2304 + 1536 + g * 256 + ch * 8);
        }
        const float bt0 = BT[g * 768 + tid], bt1 = tid < 256 ? BT[g * 768 + 512 + tid] : 0.f;
        f32x16 st[5];
#pragma unroll
        for (int kt = 0; kt < 5; ++kt) {
            f32x16 acc;
#pragma unroll
            for (int e = 0; e < 16; ++e) acc[e] = 0.f;
#pragma unroll
            for (int s = 0; s < 4; ++s) acc = __builtin_amdgcn_mfma_f32_32x32x16_bf16(kf[kt][s], qf[s], acc, 0, 0, 0);
            st[kt] = acc;
        }
#pragma unroll
        for (int i = 0; i < 12; ++i) { const int idx = tl + i * NTHR, kk = idx >> 5, ch = idx & 31; *(LAS u32x4*)(lds + kk * 576 + ch * 16) = vv[i]; }
        LAS float* bt = (LAS float*)(lds + 110592);
        bt[tid] = bt0; if (tid < 256) bt[512 + tid] = bt1;
        asm volatile("" :: "v"(st[4][15]) : "memory");
        AttU un = u;
        if (it + G < NATT) { un = att_decode(it + G, S); att_load_qk<0, 4, false>(QKV, un, h, qh, n, hi, qf, kf); }
        __syncthreads();
        float mx = -3.0e38f;
        {
            const LAS float* btl = bt + h * 192 + 32 + 4 * hi - n;
            const bool edge = (qb == 0) || (64 * qb + 128 > L);
#pragma unroll
            for (int kt = 0; kt < 5; ++kt)
#pragma unroll
                for (int i = 0; i < 16; ++i) {
                    float sv = st[kt][i] + btl[32 * kt + (i & 3) + 8 * (i >> 2)];
                    if (edge) { const int lk2 = qbase - 64 + 32 * kt + (i & 3) + 8 * (i >> 2) + 4 * hi; sv = (lk2 >= 0 && lk2 < L) ? sv : -1e30f; }
                    st[kt][i] = sv; mx = fmaxf(mx, sv);
                }
        }
        mx = fmaxf(mx, __shfl_xor(mx, 32));
        float sum = 0.f;
#pragma unroll
        for (int kt = 0; kt < 5; ++kt)
#pragma unroll
            for (int i = 0; i < 16; ++i) { const float pe = __builtin_amdgcn_exp2f(st[kt][i] - mx); st[kt][i] = pe; sum += pe; }
        sum += __shfl_xor(sum, 32);
        const float inv = 1.0f / sum, lse = (mx + __log2f(sum)) * 0.6931471805599453f;
        f32x16 o0, o1;
#pragma unroll
        for (int e = 0; e < 16; ++e) { o0[e] = 0.f; o1[e] = 0.f; }
        const int q4 = (lane & 15) >> 2, p4 = lane & 3, gsel = (lane >> 4) & 1;
        const unsigned vbase = (unsigned)((32 * qh + 4 * hi + q4) * 576 + h * 128 + (16 * gsel + 4 * p4) * 2);
#pragma unroll
        for (int kt = 0; kt < 5; ++kt)
#pragma unroll
            for (int s2 = 0; s2 < 2; ++s2) {
                u32x4 pw; pw.x = pk2(st[kt][8 * s2 + 0], st[kt][8 * s2 + 1]); pw.y = pk2(st[kt][8 * s2 + 2], st[kt][8 * s2 + 3]); pw.z = pk2(st[kt][8 * s2 + 4], st[kt][8 * s2 + 5]); pw.w = pk2(st[kt][8 * s2 + 6], st[kt][8 * s2 + 7]);
                const bf16x8 pf = __builtin_bit_cast(bf16x8, pw);
                const unsigned ro = vbase + (unsigned)((32 * kt + 16 * s2) * 576);
                {
                    const v4i16_t r1 = __builtin_amdgcn_ds_read_tr16_b64_v4i16((LAS v4i16_t*)(lds + ro)), r2 = __builtin_amdgcn_ds_read_tr16_b64_v4i16((LAS v4i16_t*)(lds + ro + 8 * 576));
                    const bf16x8 vf = (bf16x8){r1[0], r1[1], r1[2], r1[3], r2[0], r2[1], r2[2], r2[3]};
                    o0 = __builtin_amdgcn_mfma_f32_32x32x16_bf16(vf, pf, o0, 0, 0, 0);
                }
                {
                    const v4i16_t r1 = __builtin_amdgcn_ds_read_tr16_b64_v4i16((LAS v4i16_t*)(lds + ro + 64)), r2 = __builtin_amdgcn_ds_read_tr16_b64_v4i16((LAS v4i16_t*)(lds + ro + 64 + 8 * 576));
                    const bf16x8 vf = (bf16x8){r1[0], r1[1], r1[2], r1[3], r2[0], r2[1], r2[2], r2[3]};
                    o1 = __builtin_amdgcn_mfma_f32_32x32x16_bf16(vf, pf, o1, 0, 0, 0);
                }
            }
        bf16* op = OUTG + ((size_t)g * CH + tokq) * 256 + h * 64;
#pragma unroll
        for (int grp = 0; grp < 4; ++grp) {
            u32x2 w0, w1;
            w0.x = pk2(o0[4 * grp + 0] * inv, o0[4 * grp + 1] * inv); w0.y = pk2(o0[4 * grp + 2] * inv, o0[4 * grp + 3] * inv);
            w1.x = pk2(o1[4 * grp + 0] * inv, o1[4 * grp + 1] * inv); w1.y = pk2(o1[4 * grp + 2] * inv, o1[4 * grp + 3] * inv);
            *(u32x2*)(op + 8 * grp + 4 * hi) = w0; *(u32x2*)(op + 32 + 8 * grp + 4 * hi) = w1;
        }
        if (hi == 0) LSE[((size_t)g * CH + tokq) * 4 + h] = lse;
        __syncthreads();
        u = un;
    }
}
constexpr int SG_WLDS = 17920;
__device__ __forceinline__ void sg_wave_unit(bf16* U, bf16* UO, const bf16* GV, const float* ssv, const bf16* WSb, const float* gain, const float* bs, LAS unsigned char* wl, int unit, int lane) {
    const int hf = unit & 1, gg = (unit >> 1) & 7, nch = unit >> 4, tok0 = nch * 128, cb = gg * 128 + hf * 64;
    LAS float* rvl = (LAS float*)(wl + 17408);
    rvl[lane] = pg8::row_rs(ssv, tok0 + lane); rvl[lane + 64] = pg8::row_rs(ssv, tok0 + lane + 64);
    LDS_WAIT();
    {
        const int c8 = lane & 7, q0 = lane >> 3;
#pragma unroll
        for (int i = 0; i < 16; ++i) {
            const int q = q0 + 8 * i;
            f32x4 a0, a1; pg8::unpack8(*(const u32x4*)(GV + (size_t)(tok0 + q) * 1024 + cb + c8 * 8), a0, a1);
            const float r = rvl[q];
            const u32x4 w = pg8::pack8(a0 * r, a1 * r);
            *(LAS u32x2*)(wl + q * 136 + c8 * 16) = (u32x2){w.x, w.y}; *(LAS u32x2*)(wl + q * 136 + c8 * 16 + 8) = (u32x2){w.z, w.w};
        }
    }
    LDS_WAIT();
    const int ln = lane & 15, kq = lane >> 4, qq = ln >> 2, pp = ln & 3;
    bf16x8 afr[4][4];
#pragma unroll
    for (int ct = 0; ct < 4; ++ct)
#pragma unroll
        for (int ks = 0; ks < 4; ++ks) {
            const unsigned ad = (unsigned)((32 * ks + 8 * kq + qq) * 136 + (32 * (ct >> 1) + 8 * pp + 4 * (ct & 1)) * 2);
            const v4i16_t r1 = __builtin_amdgcn_ds_read_tr16_b64_v4i16((LAS v4i16_t*)(wl + ad)), r2 = __builtin_amdgcn_ds_read_tr16_b64_v4i16((LAS v4i16_t*)(wl + ad + 4 * 136));
            afr[ct][ks] = (bf16x8){r1[0], r1[1], r1[2], r1[3], r2[0], r2[1], r2[2], r2[3]};
        }
    f32x4 gn[2][2];
#pragma unroll
    for (int t = 0; t < 2; ++t) { gn[t][0] = *(const f32x4*)(gain + cb + 32 * t + 8 * kq); gn[t][1] = *(const f32x4*)(gain + cb + 32 * t + 8 * kq + 4); }
#pragma unroll 2
    for (int pt = 0; pt < 8; ++pt) {
        const int pr = pt * 16 + ln;
        bf16x8 bfr[4];
#pragma unroll
        for (int ks = 0; ks < 4; ++ks) bfr[ks] = *(const bf16x8*)(WSb + (size_t)gg * 16384 + pr * 128 + 32 * ks + 8 * kq);
        bf16* up = U + (size_t)(tok0 + pr) * 1024 + cb + 8 * kq; bf16* uo = UO + (size_t)(tok0 + pr) * 1024 + cb + 8 * kq;
        const u32x4 uw0 = *(const u32x4*)up, uw1 = *(const u32x4*)(up + 32);
        const float bias = bs[gg * 128 + pr];
        f32x4 acc[4];
#pragma unroll
        for (int ct = 0; ct < 4; ++ct) {
            acc[ct] = (f32x4){0.f, 0.f, 0.f, 0.f};
#pragma unroll
            for (int ks = 0; ks < 4; ++ks) acc[ct] = __builtin_amdgcn_mfma_f32_16x16x32_bf16(afr[ct][ks], bfr[ks], acc[ct], 0, 0, 0);
        }
        f32x4 u0, u1;
        pg8::unpack8(uw0, u0, u1);
        *(u32x4*)uo = pg8::pack8(u0 * (gn[0][0] * acc[0] + bias), u1 * (gn[0][1] * acc[1] + bias));
        pg8::unpack8(uw1, u0, u1);
        *(u32x4*)(uo + 32) = pg8::pack8(u0 * (gn[1][0] * acc[2] + bias), u1 * (gn[1][1] * acc[3] + bias));
    }
    LDS_WAIT();
}
__device__ __forceinline__ void p_merge(const bf16* OUTG, const float* LSE, bf16* OA, int tid, int G, int bid) {
    for (int it = bid * NTHR + tid; it < CH * 32; it += G * NTHR) {
        const int tok = it >> 5, c8 = it & 31, h = c8 >> 3;
        const float l0 = LSE[(size_t)tok * 4 + h], l1 = LSE[((size_t)CH + tok) * 4 + h], l2 = LSE[((size_t)2 * CH + tok) * 4 + h];
        const float mx = fmaxf(l0, fmaxf(l1, l2));
        float w0 = __expf(l0 - mx), w1 = __expf(l1 - mx), w2 = __expf(l2 - mx);
        const float inv = 1.0f / (w0 + w1 + w2); w0 *= inv; w1 *= inv; w2 *= inv;
        f32x4 a0, a1, b0, b1, c0, c1;
        pg8::unpack8(*(const u32x4*)(OUTG + (size_t)tok * 256 + c8 * 8), a0, a1);
        pg8::unpack8(*(const u32x4*)(OUTG + ((size_t)CH + tok) * 256 + c8 * 8), b0, b1);
        pg8::unpack8(*(const u32x4*)(OUTG + ((size_t)2 * CH + tok) * 256 + c8 * 8), c0, c1);
        *(u32x4*)(OA + (size_t)tok * 256 + c8 * 8) = pg8::pack8(a0 * w0 + b0 * w1 + c0 * w2, a1 * w0 + b1 * w1 + c1 * w2);
    }
}
__device__ __forceinline__ void p_conv(const bf16* A, bf16* FG, const float* cw, const float* cb, int S, int tid, int G, int bid) {
    constexpr int RUN = 8, NFC = DFF / 8;
    for (int it = bid * NTHR + tid; it < (CH / RUN) * NFC; it += G * NTHR) {
        const int fc = it % NFC, t0 = (it / NFC) * RUN, f = fc * 8;
        f32x4 wg[3][2], wv[3][2], bg[2], bv[2];
#pragma unroll
        for (int k = 0; k < 3; ++k) { wg[k][0] = *(const f32x4*)(cw + k * NUP + f); wg[k][1] = *(const f32x4*)(cw + k * NUP + f + 4); wv[k][0] = *(const f32x4*)(cw + k * NUP + DFF + f); wv[k][1] = *(const f32x4*)(cw + k * NUP + DFF + f + 4); }
        bg[0] = *(const f32x4*)(cb + f); bg[1] = *(const f32x4*)(cb + f + 4); bv[0] = *(const f32x4*)(cb + DFF + f); bv[1] = *(const f32x4*)(cb + DFF + f + 4);
        const f32x4 z4 = (f32x4){0.f, 0.f, 0.f, 0.f};
        f32x4 pg0 = z4, pg1 = z4, pv0 = z4, pv1 = z4, cg0, cg1, cv0, cv1;
        if ((t0 & (S - 1)) != 0) { pg8::unpack8(*(const u32x4*)(A + (size_t)(t0 - 1) * NUP + f), pg0, pg1); pg8::unpack8(*(const u32x4*)(A + (size_t)(t0 - 1) * NUP + DFF + f), pv0, pv1); }
        pg8::unpack8(*(const u32x4*)(A + (size_t)t0 * NUP + f), cg0, cg1); pg8::unpack8(*(const u32x4*)(A + (size_t)t0 * NUP + DFF + f), cv0, cv1);
#pragma unroll
        for (int i = 0; i < RUN; ++i) {
            const int t = t0 + i;
            f32x4 ng0 = z4, ng1 = z4, nv0 = z4, nv1 = z4;
            if (((t + 1) & (S - 1)) != 0) { pg8::unpack8(*(const u32x4*)(A + (size_t)(t + 1) * NUP + f), ng0, ng1); pg8::unpack8(*(const u32x4*)(A + (size_t)(t + 1) * NUP + DFF + f), nv0, nv1); }
            f32x4 g0 = pg0 * wg[0][0] + cg0 * wg[1][0] + ng0 * wg[2][0] + bg[0], g1 = pg1 * wg[0][1] + cg1 * wg[1][1] + ng1 * wg[2][1] + bg[1];
            const f32x4 v0 = pv0 * wv[0][0] + cv0 * wv[1][0] + nv0 * wv[2][0] + bv[0], v1 = pv1 * wv[0][1] + cv1 * wv[1][1] + nv1 * wv[2][1] + bv[1];
#pragma unroll
            for (int e = 0; e < 4; ++e) { g0[e] = pg8::gelu_tanh(g0[e]) * v0[e]; g1[e] = pg8::gelu_tanh(g1[e]) * v1[e]; }
            *(u32x4*)(FG + (size_t)t * DFF + f) = pg8::pack8(g0, g1);
            pg0 = cg0; pg1 = cg1; pv0 = cv0; pv1 = cv1; cg0 = ng0; cg1 = ng1; cv0 = nv0; cv1 = nv1;
        }
    }
}

__device__ __forceinline__ void p_convfix(const bf16* SB, bf16* FG, const float* cw, const float* cb, int S, int tid, int G, int bid) {
    constexpr int NFC = DFF / 8, NB = CH / 64;
    for (int it = bid * NTHR + tid; it < NB * 2 * NFC; it += G * NTHR) {
        const int fc = it % NFC, r2 = it / NFC, which = r2 & 1, b = r2 >> 1, f = fc * 8, t = b * 64 + (which ? 63 : 0);
        const f32x4 z4 = (f32x4){0.f, 0.f, 0.f, 0.f};
        f32x4 pg0 = z4, pg1 = z4, pv0 = z4, pv1 = z4, cg0, cg1, cv0, cv1, ng0 = z4, ng1 = z4, nv0 = z4, nv1 = z4;
        const bf16* bp = SB + (size_t)b * 4 * NUP + f;
        if (which == 0) {
            if ((t & (S - 1)) != 0) { pg8::unpack8(*(const u32x4*)(bp - NUP), pg0, pg1); pg8::unpack8(*(const u32x4*)(bp - NUP + DFF), pv0, pv1); }
            pg8::unpack8(*(const u32x4*)bp, cg0, cg1); pg8::unpack8(*(const u32x4*)(bp + DFF), cv0, cv1);
            pg8::unpack8(*(const u32x4*)(bp + NUP), ng0, ng1); pg8::unpack8(*(const u32x4*)(bp + NUP + DFF), nv0, nv1);
        } else {
            pg8::unpack8(*(const u32x4*)(bp + 2 * NUP), pg0, pg1); pg8::unpack8(*(const u32x4*)(bp + 2 * NUP + DFF), pv0, pv1);
            pg8::unpack8(*(const u32x4*)(bp + 3 * NUP), cg0, cg1); pg8::unpack8(*(const u32x4*)(bp + 3 * NUP + DFF), cv0, cv1);
            if (((t + 1) & (S - 1)) != 0) { pg8::unpack8(*(const u32x4*)(bp + 4 * NUP), ng0, ng1); pg8::unpack8(*(const u32x4*)(bp + 4 * NUP + DFF), nv0, nv1); }
        }
        f32x4 g0 = *(const f32x4*)(cb + f), g1 = *(const f32x4*)(cb + f + 4), v0 = *(const f32x4*)(cb + DFF + f), v1 = *(const f32x4*)(cb + DFF + f + 4);
        g0 = g0 + pg0 * *(const f32x4*)(cw + f) + cg0 * *(const f32x4*)(cw + NUP + f) + ng0 * *(const f32x4*)(cw + 2 * NUP + f);
        g1 = g1 + pg1 * *(const f32x4*)(cw + f + 4) + cg1 * *(const f32x4*)(cw + NUP + f + 4) + ng1 * *(const f32x4*)(cw + 2 * NUP + f + 4);
        v0 = v0 + pv0 * *(const f32x4*)(cw + DFF + f) + cv0 * *(const f32x4*)(cw + NUP + DFF + f) + nv0 * *(const f32x4*)(cw + 2 * NUP + DFF + f);
        v1 = v1 + pv1 * *(const f32x4*)(cw + DFF + f + 4) + cv1 * *(const f32x4*)(cw + NUP + DFF + f + 4) + nv1 * *(const f32x4*)(cw + 2 * NUP + DFF + f + 4);
#pragma unroll
        for (int e = 0; e < 4; ++e) { g0[e] = pg8::gelu_tanh(g0[e]) * v0[e]; g1[e] = pg8::gelu_tanh(g1[e]) * v1[e]; }
        *(u32x4*)(FG + (size_t)t * DFF + f) = pg8::pack8(g0, g1);
    }
}
#define XB_TMO      128
#define XB_XCNT(j)  (256  + 64 * (j))
#define XB_XSUB(j)  (1280 + 64 * (j))
#define XB_XGEN(j)  (2304 + 64 * (j))
#define XB_TOP      3328
#define XB_TOPGEN   3392
#define XCD_BAR_WORDS 3456
#define XB_SPIN_CAP (1u << 18)

__device__ __forceinline__ unsigned xb_ld(unsigned* p)              { return __hip_atomic_load(p, __ATOMIC_RELAXED, __HIP_MEMORY_SCOPE_AGENT); }
__device__ __forceinline__ unsigned xb_add(unsigned* p, unsigned v) { return __hip_atomic_fetch_add(p, v, __ATOMIC_RELAXED, __HIP_MEMORY_SCOPE_AGENT); }
__device__ __forceinline__ unsigned xb_xcc_id() { return (unsigned)__builtin_amdgcn_s_getreg((3 << 11) | 20) & 0xFu; }
#define XB_SPIN(cond, bar) do { unsigned _sp = 0; while (cond) { __builtin_amdgcn_s_sleep(1); \
    if ((++_sp & 255u) == 0u) { if (xb_ld(&(bar)[XB_TMO])) break; if (_sp > XB_SPIN_CAP) { atomicAdd(&(bar)[XB_TMO], 1u); break; } } } } while (0)

struct XcdBarrier {
    unsigned* bar; unsigned x;
    volatile LAS unsigned* st;
};

__device__ __forceinline__ XcdBarrier xcd_barrier_post(unsigned* bar, volatile LAS unsigned* st, const int tid) {
    XcdBarrier b; b.bar = bar; b.x = xb_xcc_id(); b.st = st;
    if (tid == 0) (void)xb_add(&bar[XB_XCNT(b.x)], 1u);
    return b;
}
__device__ __forceinline__ void xcd_barrier_complete(unsigned* bar, unsigned x, unsigned& nloc, unsigned& nx) {
    const unsigned G = gridDim.x * gridDim.y * gridDim.z;
    unsigned sum, cnt, mine, sp = 0u;
    for (;;) {
        sum = 0u; cnt = 0u; mine = 0u;
#pragma unroll
        for (unsigned j = 0; j < 16; ++j) { const unsigned c = xb_ld(&bar[XB_XCNT(j)]); sum += c; cnt += (c > 0u) ? 1u : 0u; mine = (j == x) ? c : mine; }
        if (sum == G) break;
        __builtin_amdgcn_s_sleep(1);
        if ((++sp & 255u) == 0u) { if (xb_ld(&bar[XB_TMO])) break; if (sp > XB_SPIN_CAP) { atomicAdd(&bar[XB_TMO], 1u); break; } }
    }
    nloc = mine > 0u ? mine : 1u; nx = cnt > 0u ? cnt : 1u;
}

__device__ __forceinline__ void xcd_barrier(const XcdBarrier& b, const int tid) {
    asm volatile("s_waitcnt vmcnt(0)" ::: "memory");
    __syncthreads();
    if (tid == 0) {
        unsigned* bar = b.bar;
        __builtin_amdgcn_s_waitcnt(0);
        unsigned nloc = b.st[0], nx = b.st[1];
        if (nloc == 0u) { xcd_barrier_complete(bar, b.x, nloc, nx); b.st[0] = nloc; b.st[1] = nx; }
        const unsigned old = xb_add(&bar[XB_XSUB(b.x)], 1u);
        const unsigned gen = old / nloc;
        if (old + 1u == (gen + 1u) * nloc) {
            __builtin_amdgcn_fence(__ATOMIC_RELEASE, "agent");
            asm volatile("s_waitcnt vmcnt(0)" ::: "memory");
            const unsigned og = xb_add(&bar[XB_TOP], 1u);
            const unsigned tg = og / nx;
            if (og + 1u == (tg + 1u) * nx) xb_add(&bar[XB_TOPGEN], 1u);
            else XB_SPIN(xb_ld(&bar[XB_TOPGEN]) == tg, bar);
            __builtin_amdgcn_fence(__ATOMIC_ACQUIRE, "agent");
            xb_add(&bar[XB_XGEN(b.x)], 1u);
            asm volatile("s_waitcnt vmcnt(0)" ::: "memory");
        } else {
            XB_SPIN(xb_ld(&bar[XB_XGEN(b.x)]) == gen, bar);
            __builtin_amdgcn_fence(__ATOMIC_ACQUIRE, "agent");
            asm volatile("s_waitcnt vmcnt(0)" ::: "memory");
        }
    }
    __syncthreads();
}


__global__ void __launch_bounds__(NTHR, 2) fwd_kernel(Args a_in) {
    extern __shared__ __attribute__((aligned(16))) unsigned char lds_raw[];
    LAS unsigned char* lds = (LAS unsigned char*)lds_raw;
    cg::grid_group grid = cg::this_grid();
    const int ph_lo = a_in.ph_lo, ph_hi = a_in.ph_hi;
    volatile LAS unsigned* xst = (volatile LAS unsigned*)(lds + LDS_BYTES - 16);
    if (threadIdx.x < 2) xst[threadIdx.x] = 0u;
    __syncthreads();
    const unsigned xcc = xcd_barrier_post((unsigned*)(a_in.ws + WS_BAR), xst, (int)threadIdx.x).x;
    for (int ph = ph_lo; ph < ph_hi; ++ph) {
#if defined(__HIP_DEVICE_COMPILE__)
        typedef const __attribute__((address_space(4))) unsigned long long* cu64p4;
        cu64p4 ap = (cu64p4)__builtin_amdgcn_kernarg_segment_ptr();
        asm volatile("" : "+s"(ap));
        Args a;
#pragma unroll
        for (int i = 0; i < 17; ++i) a.in[i] = (const float*)ap[i];
        a.out = (float*)ap[17]; a.ws = (unsigned char*)ap[18]; a.ph_lo = ph_lo; a.ph_hi = ph_hi;
#else
        const Args a = a_in;
#endif
        int tid = threadIdx.x, G = gridDim.x, bid = blockIdx.x;
        asm volatile("" : "+v"(tid)); asm volatile("" : "+s"(G)); asm volatile("" : "+s"(bid));
        unsigned char* ws = a.ws;
        bf16* Wb = (bf16*)(ws + WS_W);
        bf16* QKV = (bf16*)(ws + WS_R1); bf16* U = QKV + (size_t)CH * 2304; bf16* GV = U + (size_t)CH * 1024; bf16* GT = GV + (size_t)CH * 1024;
        bf16* AF = (bf16*)(ws + WS_R1);
        bf16* MG = GV;
        bf16* OUTG = (bf16*)(ws + WS_R2); bf16* OA = OUTG + (size_t)3 * CH * 256; float* LSE = (float*)(OA + (size_t)CH * 256);
        bf16* FG = (bf16*)(ws + WS_R2);
        bf16* XB = (bf16*)(ws + WS_XB); float* SS = (float*)(ws + WS_SS); float* SSV = (float*)(ws + WS_SSV);
        if (ph < NP0) p0_weights(a, lds, tid, G, bid);
        else {
            const int chunk = (ph - NP0) / PH_PER_CHUNK, sub = (ph - NP0) % PH_PER_CHUNK;
            const int S = chunk == 0 ? 8192 : 2048;
            if (sub == 0) { p0x(a, chunk, tid, G, bid); if (PROBE_KIND == 10) p0x(a, chunk, tid, G, bid); }
            else if (sub == PH_PER_CHUNK - 1) pfinal(a, chunk, tid, G, bid);
            else {
                const int l = (sub - 1) / KPL, ki = (sub - 1) % KPL, k = (KPL == 9 && ki > PROBE_DUPK) ? ki - 1 : ki; const bool dup = (KPL == 9 && ki == PROBE_DUPK + 1);
                const bf16* wl = Wb + (size_t)l * W_LAYER;
                float* X = a.out + (size_t)chunk * CH * DM;
                if (k == 0 && !(SKIPMASK & 1)) {
                    pg8::Gemm g{XB, wl + OFF_IN, CH, NIN, DM}; pg8::StaticOrder So; So.init(CH, NIN, G, bid);
                    pg8::EpiIn E{QKV, U, GV, GT, SS, SSV};
                    pg8::gemm_phase<pg8::EpiIn, pg8::StaticOrder, true, true>(lds, g, So, E, tid);
                } else if (k == 1 && !(SKIPMASK & 2)) {
                    constexpr int NATT = 3 * (CH / 64), NSGW = (CH / 128) * 16;
                    if (!(SKIPMASK & 1024) && !(dup && PROBE_KIND == 8)) attn_phase(QKV, OUTG, LSE, (const float*)(ws + WS_BT), lds, S, tid, G, bid);
                    if (!(SKIPMASK & 2048) && (!dup || PROBE_KIND == 8)) {
                        bf16* UO = dup ? (bf16*)(ws + WS_R2 + (size_t)CH * 2096) : U;
                        const int wave = __builtin_amdgcn_readfirstlane(tid >> 6);
                        for (int wu = bid * 8 + wave; wu < NSGW; wu += G * 8) sg_wave_unit(U, UO, GV, SSV, wl + OFF_WS, a.in[5] + l * 1024, a.in[7] + l * 1024, lds + wave * SG_WLDS, wu, tid & 63);
                    }
                } else if (k == 2 && !(SKIPMASK & 4)) p_merge(OUTG, LSE, OA, tid, G, bid);
                else if (k == 3 && !(SKIPMASK & 8)) {
                    if (!(SKIPMASK & 4096)) { int kpa = 256; asm volatile("" : "+s"(kpa)); pg8::Gemm g{OA, wl + OFF_PA, CH, DM, kpa}; pg8::StaticOrder So; So.init(CH, DM, G, bid);
                      pg8::EpiGate<0> E{MG, GT, 0};
                      pg8::gemm_phase<pg8::EpiGate<0>, pg8::StaticOrder, true, true>(lds, g, So, E, tid); }
                    if (!(SKIPMASK & 8192)) { pg8::Gemm g{U, wl + OFF_PB, CH, DM, DM}; pg8::StaticOrder So; So.init(CH, DM, G, bid);
                      pg8::EpiGate<1> E{MG, GT, 1024};
                      pg8::gemm_phase<pg8::EpiGate<1>, pg8::StaticOrder, true, true>(lds, g, So, E, tid); }
                } else if (k == 4 && !(SKIPMASK & 16)) {
                    pg8::Gemm g{MG, wl + OFF_OUT, CH, DM, DM}; pg8::StaticOrder So; So.init(CH, DM, G, bid);
                    pg8::EpiRes E{(bf16*)(ws + WS_XL), XB, SS};
                    pg8::gemm_phase<pg8::EpiRes, pg8::StaticOrder, true, true>(lds, g, So, E, tid);
                } else if (k == 5 && !(SKIPMASK & 32)) {
                    pg8::Gemm g{XB, wl + OFF_UP, CH, NUP, DM}; pg8::StaticOrder So; So.init(CH, NUP, G, bid);
                    pg8::EpiUpConv E{FG, (bf16*)(ws + WS_SB), SS, a.in[13] + (size_t)l * 3 * NUP, a.in[14] + (size_t)l * NUP};
                    pg8::gemm_phase<pg8::EpiUpConv, pg8::StaticOrder, true, true>(lds, g, So, E, tid);
                } else if (k == 6 && !(SKIPMASK & 64)) p_convfix((const bf16*)(ws + WS_SB), FG, a.in[13] + (size_t)l * 3 * NUP, a.in[14] + (size_t)l * NUP, S, tid, G, bid);
                else if (!(SKIPMASK & 128)) {
                    pg8::Gemm g{FG, wl + OFF_DN, CH, DM, DFF}; pg8::StaticOrder So; So.init(CH, DM, G, bid);
                    pg8::EpiRes E{(bf16*)(ws + WS_XL), XB, SS};
                    pg8::gemm_phase<pg8::EpiRes, pg8::StaticOrder, true, true>(lds, g, So, E, tid);
                }
            }
        }
        if (ph + 1 < ph_hi) {
            if (ph == ph_lo) grid.sync();
            XcdBarrier xb; xb.bar = (unsigned*)(a.ws + WS_BAR); xb.x = xcc; xb.st = xst;
            xcd_barrier(xb, tid);
            if (PROBE_KIND == 100) xcd_barrier(xb, tid);
        }
    }
}

extern "C" void kernel_launch(void* const* d_in, const int* in_sizes, int n_in, void* d_out, int out_size, void* d_ws, size_t ws_size, hipStream_t stream) {
    static int grid = 0;
    if (grid == 0) {
        if (n_in != 17 || out_size != NTOK * DM || ws_size < WS_END) { fprintf(stderr, "kernel_launch: unexpected shapes: n_in %d out %d ws %zu (need %zu)\n", n_in, out_size, ws_size, (size_t)WS_END); grid = -1; return; }
        int dev = 0, cus = 0, per_cu = 0;
        (void)hipGetDevice(&dev); (void)hipDeviceGetAttribute(&cus, hipDeviceAttributeMultiprocessorCount, dev);
        if (hipFuncSetAttribute((const void*)fwd_kernel, hipFuncAttributeMaxDynamicSharedMemorySize, LDS_BYTES) != hipSuccess) { fprintf(stderr, "kernel_launch: hipFuncSetAttribute failed\n"); grid = -1; return; }
        if (hipOccupancyMaxActiveBlocksPerMultiprocessor(&per_cu, (const void*)fwd_kernel, NTHR, LDS_BYTES) != hipSuccess || per_cu < 1) { fprintf(stderr, "kernel_launch: occupancy query says %d\n", per_cu); per_cu = 1; }
        (void)hipGetLastError();
        grid = cus * per_cu;
        if (grid <= 0) grid = 256;
    }
    if (grid < 0) return;
    if (hipMemsetAsync((char*)d_ws + WS_BAR, 0, 65536, stream) != hipSuccess) { fprintf(stderr, "kernel_launch: memset failed\n"); return; }
    Args a{};
    for (int i = 0; i < 17; ++i) a.in[i] = (const float*)d_in[i];
    a.out = (float*)d_out; a.ws = (unsigned char*)d_ws;
#if ONE_LAUNCH
    a.ph_lo = 0; a.ph_hi = N_PHASES;
    void* args[] = {&a};
    hipError_t e = hipLaunchCooperativeKernel((const void*)fwd_kernel, dim3(grid), dim3(NTHR), args, LDS_BYTES, stream);
    if (e != hipSuccess) fprintf(stderr, "cooperative launch failed: %s (grid %d)\n", hipGetErrorString(e), grid);
#else
    for (int ph = 0; ph < N_PHASES; ++ph) {
        a.ph_lo = ph; a.ph_hi = ph + 1;
        hipLaunchKernelGGL(fwd_kernel, dim3(grid), dim3(NTHR), LDS_BYTES, stream, a);
    }
#endif
}
```

```cpp
#include <hip/hip_runtime.h>
#include <hip/hip_cooperative_groups.h>
#include <cstdio>
#include <cstdint>
namespace cg = cooperative_groups;

#ifndef ONE_LAUNCH
#define ONE_LAUNCH 1
#endif

namespace pg8 {
#define PG8_LAS __attribute__((address_space(3)))
typedef unsigned short bf16_t;
typedef short bf16x8 __attribute__((ext_vector_type(8)));
typedef float f32x4 __attribute__((ext_vector_type(4)));
typedef unsigned u32x4 __attribute__((ext_vector_type(4)));
constexpr int BM = 256, BK = 64, HALF = 128, HTB = HALF * BK * 2  , STAGE_BYTES = 8 * HTB, NXCD = 8, WGM = 8;

__host__ __device__ __forceinline__ int lds_byte(int r, int c) { const int st = (r >> 4) * 2 + (c >> 5), rr = r & 15, cc = c & 31, ob = rr * 64 + cc * 2; return st * 1024 + (ob ^ (((ob >> 9) & 1) << 5)); }
__host__ __device__ __forceinline__ void stage_rc(int b, int& R, int& C) { const int st = b / 1024, sb = b % 1024, swz = sb ^ (((sb >> 9) & 1) << 5); R = (st >> 1) * 16 + swz / 64; C = (st & 1) * 32 + (swz % 64) / 2; }
__host__ __device__ __forceinline__ int perm32(int rho) { const int n = rho >> 4, i = rho & 15; return 8 * (i >> 2) + 4 * n + (i & 3); }

struct Unit { int pm, pn; };
struct Gemm { const bf16_t* A; const bf16_t* Bt; int M, N, K; };

struct StaticOrder {
    int nM, nN, nwg, G, c;
    __host__ __device__ void init(int M, int N, int G_, int c_) { nM = M / BM; nN = N / BM; nwg = nM * nN; G = G_; c = c_; }
    __host__ __device__ bool next(int i, Unit& u) const {
        const long L = (long)i * G + c; if (L >= nwg) return false;
        int wgid = (int)L; { const int q = nwg / NXCD, r = nwg % NXCD, xcd = wgid % NXCD, off = wgid / NXCD; wgid = (xcd < r ? xcd * (q + 1) : r * (q + 1) + (xcd - r) * q) + off; }
        const int nig = WGM * nN, gid = wgid / nig, fm = gid * WGM, gsz = (nM - fm) < WGM ? (nM - fm) : WGM;
        u.pm = fm + ((wgid % nig) % gsz); u.pn = (wgid % nig) / gsz; return true;
    }
    __device__ __forceinline__ void a_ready(const Unit&) const {}
    __device__ __forceinline__ void done(const Unit&) const {}
};

__device__ __forceinline__ unsigned cvt_pk_bf16(float lo, float hi) { unsigned r; asm volatile("v_cvt_pk_bf16_f32 %0, %1, %2" : "=v"(r) : "v"(lo), "v"(hi)); return r; }

__device__ __forceinline__ float fast_sigmoid(float x) { return __builtin_amdgcn_rcpf(1.0f + __builtin_amdgcn_exp2f(-1.4426950408889634f * x)); }
__device__ __forceinline__ float gelu_tanh(float x) {
    const float y = x * (1.0f + 0.044715f * x * x) * (2.0f * 0.7978845608028654f);
    return x * __builtin_amdgcn_rcpf(1.0f + __builtin_amdgcn_exp2f(-1.4426950408889634f * y));
}
__device__ __forceinline__ float bf2f(unsigned short b) { return __uint_as_float(((unsigned)b) << 16); }
__device__ __forceinline__ u32x4 pack8(const f32x4 a, const f32x4 b) { u32x4 w; w.x = cvt_pk_bf16(a[0], a[1]); w.y = cvt_pk_bf16(a[2], a[3]); w.z = cvt_pk_bf16(b[0], b[1]); w.w = cvt_pk_bf16(b[2], b[3]); return w; }
__device__ __forceinline__ void unpack8(const u32x4 w, f32x4& a, f32x4& b) {
    a[0] = __uint_as_float(w.x << 16); a[1] = __uint_as_float(w.x & 0xffff0000u); a[2] = __uint_as_float(w.y << 16); a[3] = __uint_as_float(w.y & 0xffff0000u);
    b[0] = __uint_as_float(w.z << 16); b[1] = __uint_as_float(w.z & 0xffff0000u); b[2] = __uint_as_float(w.w << 16); b[3] = __uint_as_float(w.w & 0xffff0000u);
}
__device__ __forceinline__ float row_rs(const float* ss, int row) {
    const f32x4* sp = (const f32x4*)(ss + (size_t)row * 16);
    const f32x4 s = (sp[0] + sp[1]) + (sp[2] + sp[3]);
    return rsqrtf(((s[0] + s[1]) + (s[2] + s[3])) * (1.0f / 1024.0f) + 1e-6f);
}

__device__ __forceinline__ void rows_rs(const float* ss, int row0, int fq, float (&rsv)[2][4]) {
    f32x4 part[2][4];
#pragma unroll
    for (int ai = 0; ai < 2; ++ai)
#pragma unroll
        for (int m = 0; m < 4; ++m) part[ai][m] = *(const f32x4*)(ss + (size_t)(row0 + ai * HALF + m * 16) * 16 + fq * 4);
#pragma unroll
    for (int ai = 0; ai < 2; ++ai)
#pragma unroll
        for (int m = 0; m < 4; ++m) { float t = (part[ai][m][0] + part[ai][m][1]) + (part[ai][m][2] + part[ai][m][3]); t += __shfl_xor(t, 16); t += __shfl_xor(t, 32); rsv[ai][m] = rsqrtf(t * (1.0f / 1024.0f) + 1e-6f); }
}

struct EpiIn {
    static constexpr bool PERM = true, AFTER_DRAIN = false;
    bf16_t* QKV; bf16_t* U; bf16_t* GV; bf16_t* G; const float* ss; float* ssv;
    __device__ __forceinline__ void operator()(const f32x4 (&acc)[2][2][4][2], const Unit& u, int wr, int wc, int fr, int fq) const {
        const int pn = u.pn;
        float rsv[2][4]; rows_rs(ss, u.pm * BM + wr * 64 + fr, fq, rsv);
#pragma unroll
        for (int ai = 0; ai < 2; ++ai)
#pragma unroll
            for (int m = 0; m < 4; ++m) {
                const int row = u.pm * BM + ai * HALF + wr * 64 + m * 16 + fr;
                const float rs = rsv[ai][m];
                float q = 0.f;
#pragma unroll
                for (int bj = 0; bj < 2; ++bj) {
                    const int col = pn * BM + bj * HALF + wc * 32 + 8 * fq;
                    f32x4 v0 = acc[ai][bj][m][0] * rs, v1 = acc[ai][bj][m][1] * rs;
                    bf16_t* dst;
                    if (pn < 9) { if (pn < 3) { v0 = v0 * (0.125f * 1.4426950408889634f); v1 = v1 * (0.125f * 1.4426950408889634f); }     dst = QKV + (size_t)row * 2304 + col; }
                    else if (pn < 17) {
#pragma unroll
                        for (int e = 0; e < 4; ++e) { v0[e] = gelu_tanh(v0[e]); v1[e] = gelu_tanh(v1[e]); }
                        if (pn < 13) dst = U + (size_t)row * 1024 + (col - 2304);
                        else { dst = GV + (size_t)row * 1024 + (col - 3328);
#pragma unroll
                            for (int e = 0; e < 4; ++e) q += v0[e] * v0[e] + v1[e] * v1[e]; }
                    } else {
#pragma unroll
                        for (int e = 0; e < 4; ++e) { v0[e] = fast_sigmoid(v0[e]); v1[e] = fast_sigmoid(v1[e]); }
                        dst = G + (size_t)row * 2048 + (col - 4352);
                    }
                    *(u32x4*)dst = pack8(v0, v1);
                }
                if (pn >= 13 && pn < 17) { q += __shfl_xor(q, 16); q += __shfl_xor(q, 32); if (fq == 0) ssv[(size_t)row * 16 + (pn - 13) * 4 + wc] = q; }
                asm volatile("" ::: "memory");
            }
    }
};
template <int MODE> struct EpiGate {
    static constexpr bool PERM = true, AFTER_DRAIN = false;
    bf16_t* O; const bf16_t* G; int goff;
    __device__ __forceinline__ void operator()(const f32x4 (&acc)[2][2][4][2], const Unit& u, int wr, int wc, int fr, int fq) const {
#pragma unroll
        for (int ai = 0; ai < 2; ++ai) {
            u32x4 gw[4][2], pw[4][2];
#pragma unroll
            for (int m = 0; m < 4; ++m)
#pragma unroll
                for (int bj = 0; bj < 2; ++bj) {
                    const int row = u.pm * BM + ai * HALF + wr * 64 + m * 16 + fr, col = u.pn * BM + bj * HALF + wc * 32 + 8 * fq;
                    gw[m][bj] = *(const u32x4*)(G + (size_t)row * 2048 + goff + col);
                    if (MODE == 1) pw[m][bj] = *(const u32x4*)(O + (size_t)row * 1024 + col);
                }
#pragma unroll
            for (int m = 0; m < 4; ++m)
#pragma unroll
                for (int bj = 0; bj < 2; ++bj) {
                    const int row = u.pm * BM + ai * HALF + wr * 64 + m * 16 + fr, col = u.pn * BM + bj * HALF + wc * 32 + 8 * fq;
                    f32x4 g0, g1; unpack8(gw[m][bj], g0, g1);
                    f32x4 v0 = acc[ai][bj][m][0] * g0, v1 = acc[ai][bj][m][1] * g1;
                    if (MODE == 1) { f32x4 p0, p1; unpack8(pw[m][bj], p0, p1); v0 = v0 + p0; v1 = v1 + p1; }
                    *(u32x4*)(O + (size_t)row * 1024 + col) = pack8(v0, v1);
                }
            asm volatile("" ::: "memory");
        }
    }
};
struct EpiRes {
    static constexpr bool PERM = true, AFTER_DRAIN = false;
    bf16_t* XL; bf16_t* XB; float* ss;
    __device__ __forceinline__ void operator()(const f32x4 (&acc)[2][2][4][2], const Unit& u, int wr, int wc, int fr, int fq) const {
#pragma unroll
        for (int ai = 0; ai < 2; ++ai)
#pragma unroll
        for (int mp = 0; mp < 2; ++mp) {
            u32x4 hv[2][2], lv[2][2];
#pragma unroll
            for (int mi = 0; mi < 2; ++mi)
#pragma unroll
                for (int bj = 0; bj < 2; ++bj) {
                    const size_t off = (size_t)(u.pm * BM + ai * HALF + wr * 64 + (2 * mp + mi) * 16 + fr) * 1024 + u.pn * BM + bj * HALF + wc * 32 + 8 * fq;
                    hv[mi][bj] = *(const u32x4*)(XB + off); lv[mi][bj] = *(const u32x4*)(XL + off);
                }
#pragma unroll
            for (int mi = 0; mi < 2; ++mi) {
                const int m = 2 * mp + mi, row = u.pm * BM + ai * HALF + wr * 64 + m * 16 + fr;
                float q = 0.f;
#pragma unroll
                for (int bj = 0; bj < 2; ++bj) {
                    const size_t off = (size_t)row * 1024 + u.pn * BM + bj * HALF + wc * 32 + 8 * fq;
                    f32x4 h0, h1, l0, l1; unpack8(hv[mi][bj], h0, h1); unpack8(lv[mi][bj], l0, l1);
                    const f32x4 x0 = (h0 + l0) + acc[ai][bj][m][0], x1 = (h1 + l1) + acc[ai][bj][m][1];
                    const u32x4 hw = pack8(x0, x1);
                    unpack8(hw, h0, h1);
                    *(u32x4*)(XB + off) = hw; *(u32x4*)(XL + off) = pack8(x0 - h0, x1 - h1);
#pragma unroll
                    for (int e = 0; e < 4; ++e) q += x0[e] * x0[e] + x1[e] * x1[e];
                }
                q += __shfl_xor(q, 16); q += __shfl_xor(q, 32);
                if (fq == 0) ss[(size_t)row * 16 + u.pn * 4 + wc] = q;
            }
            asm volatile("" ::: "memory");
        }
    }
};
struct EpiUp {
    static constexpr bool PERM = true, AFTER_DRAIN = false;
    bf16_t* A; const float* ss;
    __device__ __forceinline__ void operator()(const f32x4 (&acc)[2][2][4][2], const Unit& u, int wr, int wc, int fr, int fq) const {
        float rsv[2][4]; rows_rs(ss, u.pm * BM + wr * 64 + fr, fq, rsv);
#pragma unroll
        for (int ai = 0; ai < 2; ++ai)
#pragma unroll
            for (int m = 0; m < 4; ++m) {
                const int row = u.pm * BM + ai * HALF + wr * 64 + m * 16 + fr;
                const float rs = rsv[ai][m];
#pragma unroll
                for (int bj = 0; bj < 2; ++bj) {
                    const int col = u.pn * BM + bj * HALF + wc * 32 + 8 * fq;
                    *(u32x4*)(A + (size_t)row * 5632 + col) = pack8(acc[ai][bj][m][0] * rs, acc[ai][bj][m][1] * rs);
                }
                asm volatile("" ::: "memory");
            }
    }
};

__device__ __forceinline__ float dpp_prev(float x) { return __int_as_float(__builtin_amdgcn_update_dpp(0, __float_as_int(x), 0x121, 0xf, 0xf, false)); }
__device__ __forceinline__ float dpp_next(float x) { return __int_as_float(__builtin_amdgcn_update_dpp(0, __float_as_int(x), 0x12F, 0xf, 0xf, false)); }
__device__ __forceinline__ f32x4 rot_prev(const f32x4 v) { f32x4 r; r[0] = dpp_prev(v[0]); r[1] = dpp_prev(v[1]); r[2] = dpp_prev(v[2]); r[3] = dpp_prev(v[3]); return r; }
__device__ __forceinline__ f32x4 rot_next(const f32x4 v) { f32x4 r; r[0] = dpp_next(v[0]); r[1] = dpp_next(v[1]); r[2] = dpp_next(v[2]); r[3] = dpp_next(v[3]); return r; }
struct EpiUpConv {
    static constexpr bool PERM = true, AFTER_DRAIN = false;
    bf16_t* FG; bf16_t* SB; const float* ss; const float* cw; const float* cb;
    __device__ __forceinline__ void operator()(const f32x4 (&acc_)[2][2][4][2], const Unit& u, int wr, int wc, int fr, int fq) const {
        f32x4 (&acc)[2][2][4][2] = const_cast<f32x4 (&)[2][2][4][2]>(acc_);
        float rsv[2][4]; rows_rs(ss, u.pm * BM + wr * 64 + fr, fq, rsv);
        const int f0 = u.pn * 128 + wc * 32 + 8 * fq;
        const bool first = fr == 0, last = fr == 15;
#pragma unroll
        for (int ai = 0; ai < 2; ++ai) {
#pragma unroll
            for (int m = 0; m < 4; ++m)
#pragma unroll
                for (int h = 0; h < 2; ++h) { acc[ai][h][m][0] = acc[ai][h][m][0] * rsv[ai][m]; acc[ai][h][m][1] = acc[ai][h][m][1] * rsv[ai][m]; }
            const int blk = (u.pm * BM + ai * HALF + wr * 64) >> 6;
            if (fr <= 1) { bf16_t* sp = SB + ((size_t)blk * 4 + fr) * 5632 + f0;
                *(u32x4*)sp = pack8(acc[ai][0][0][0], acc[ai][0][0][1]); *(u32x4*)(sp + 2816) = pack8(acc[ai][1][0][0], acc[ai][1][0][1]); }
            if (fr >= 14) { bf16_t* sp = SB + ((size_t)blk * 4 + (fr - 12)) * 5632 + f0;
                *(u32x4*)sp = pack8(acc[ai][0][3][0], acc[ai][0][3][1]); *(u32x4*)(sp + 2816) = pack8(acc[ai][1][3][0], acc[ai][1][3][1]); }
        }
#pragma unroll
        for (int n = 0; n < 2; ++n) {
            f32x4 w[2][4];
#pragma unroll
            for (int h = 0; h < 2; ++h) {
#pragma unroll
                for (int k = 0; k < 3; ++k) w[h][k] = *(const f32x4*)(cw + k * 5632 + h * 2816 + f0 + 4 * n);
                w[h][3] = *(const f32x4*)(cb + h * 2816 + f0 + 4 * n);
            }
#pragma unroll
            for (int ai = 0; ai < 2; ++ai) {
#pragma unroll
                for (int m = 0; m < 4; ++m) {
                    const int row = u.pm * BM + ai * HALF + wr * 64 + m * 16 + fr;
                    f32x4 cv[2];
#pragma unroll
                    for (int h = 0; h < 2; ++h) {
                        const f32x4 cur = acc[ai][h][m][n];
                        f32x4 pv = rot_prev(cur), nx = rot_next(cur);
                        if (m > 0) { const f32x4 pw = rot_prev(acc[ai][h][m - 1][n]);
#pragma unroll
                            for (int e = 0; e < 4; ++e) pv[e] = first ? pw[e] : pv[e]; }
                        if (m < 3) { const f32x4 nw = rot_next(acc[ai][h][m + 1][n]);
#pragma unroll
                            for (int e = 0; e < 4; ++e) nx[e] = last ? nw[e] : nx[e]; }
                        cv[h] = pv * w[h][0] + cur * w[h][1] + nx * w[h][2] + w[h][3];
                    }
                    f32x4 o;
#pragma unroll
                    for (int e = 0; e < 4; ++e) o[e] = gelu_tanh(cv[0][e]) * cv[1][e];
                    const bool brow = (m == 0 && first) || (m == 3 && last);
                    if (!brow) { typedef unsigned u32x2e __attribute__((ext_vector_type(2))); u32x2e ow; ow.x = cvt_pk_bf16(o[0], o[1]); ow.y = cvt_pk_bf16(o[2], o[3]); *(u32x2e*)(FG + (size_t)row * 2816 + f0 + 4 * n) = ow; }
                }
                asm volatile("" ::: "memory");
            }
        }
    }
};

template <class Epi, class Sched, bool ALIGN_EPI = false, bool SP2 = false>
__device__ __forceinline__ void gemm_phase(PG8_LAS unsigned char* lds, const Gemm g, const Sched& S, const Epi& E, const int tid) {
    const int wid = __builtin_amdgcn_readfirstlane(tid >> 6), lane = tid & 63, wr = wid >> 2, wc = wid & 3, fr = lane & 15, fq = lane >> 4;
    const int K = g.K, nt = K / BK;
    unsigned voffA[2], voffB[2];
#pragma unroll
    for (int i = 0; i < 2; ++i) { int R, C; stage_rc(tid * 16 + i * 8192, R, C); const int Rb = Epi::PERM ? ((R & ~31) + perm32(R & 31)) : R;
        voffA[i] = (unsigned)(R * K + C) * 2u; voffB[i] = (unsigned)(Rb * K + C) * 2u; }
    const size_t kstep = (size_t)(BK * 2);
    const size_t hstep = (size_t)HALF * K * 2;
    const size_t tstep = 2 * hstep;
    const unsigned ldsw = (unsigned)wid * 1024u;
    const int aoff = lds_byte(wr * 64 + fr, fq * 8), boff = lds_byte(wc * 32 + fr, fq * 8);
#define PG8_SA(b, h) (((b) * 2 + (h)) * HTB)
#define PG8_SB(b, h) ((4 + (b) * 2 + (h)) * HTB)
#define PG8_STAGE(bufoff, gbase, voff) do { _Pragma("unroll") for (int _i = 0; _i < 2; ++_i) \
        __builtin_amdgcn_global_load_lds((const unsigned*)((const char*)(gbase) + (voff)[_i]), (PG8_LAS unsigned*)(lds + (bufoff) + ldsw + _i * 8192), 16, 0, 0); } while (0)
#define PG8_LDA(dst, b, h) do { _Pragma("unroll") for (int m = 0; m < 4; ++m) _Pragma("unroll") for (int k = 0; k < 2; ++k) dst[m][k] = *(const PG8_LAS bf16x8*)(lds + PG8_SA(b, h) + aoff + m * 2048 + k * 1024); } while (0)
#define PG8_LDB(dst, b, h) do { _Pragma("unroll") for (int n = 0; n < 2; ++n) _Pragma("unroll") for (int k = 0; k < 2; ++k) dst[n][k] = *(const PG8_LAS bf16x8*)(lds + PG8_SB(b, h) + boff + n * 2048 + k * 1024); } while (0)
#define PG8_MMA(ai, bj, At, Bt) do { __builtin_amdgcn_s_setprio(1); _Pragma("unroll") for (int m = 0; m < 4; ++m) _Pragma("unroll") for (int n = 0; n < 2; ++n) _Pragma("unroll") for (int k = 0; k < 2; ++k) \
        acc[ai][bj][m][n] = __builtin_amdgcn_mfma_f32_16x16x32_bf16(Bt[n][k], At[m][k], acc[ai][bj][m][n], 0, 0, 0); __builtin_amdgcn_s_setprio(0); } while (0)
#define PG8_WAIT_V(n) asm volatile("s_waitcnt vmcnt(" #n ")" ::: "memory")
#define PG8_WAIT_L(n) asm volatile("s_waitcnt lgkmcnt(" #n ")" ::: "memory")
#define PG8_BAR __builtin_amdgcn_s_barrier()
#define PG8_SCHED __builtin_amdgcn_sched_barrier(0)
    Unit cur, nxt; int ui = 0;
    if (!S.next(0, cur)) return;
    f32x4 acc[2][2][4][2];
#pragma unroll
    for (int a = 0; a < 2; ++a)
#pragma unroll
        for (int b = 0; b < 2; ++b)
#pragma unroll
            for (int m = 0; m < 4; ++m)
#pragma unroll
                for (int n = 0; n < 2; ++n) acc[a][b][m][n] = (f32x4){0.f, 0.f, 0.f, 0.f};
    bf16x8 At[4][2], B0[2][2], B1[2][2];
    const char* cA = (const char*)g.A + (size_t)cur.pm * tstep; const char* cB = (const char*)g.Bt + (size_t)cur.pn * tstep;
    S.a_ready(cur);
    if constexpr (SP2) {
        PG8_STAGE(PG8_SB(0, 0), cB, voffB); PG8_STAGE(PG8_SB(0, 1), cB + hstep, voffB); PG8_STAGE(PG8_SA(0, 0), cA, voffA); PG8_STAGE(PG8_SA(0, 1), cA + hstep, voffA);
        if (wr == 1) PG8_BAR;
        PG8_WAIT_V(2); PG8_BAR;
        PG8_STAGE(PG8_SB(1, 0), cB + kstep, voffB); PG8_STAGE(PG8_SA(1, 0), cA + kstep, voffA); PG8_STAGE(PG8_SB(1, 1), cB + hstep + kstep, voffB);
        PG8_WAIT_V(6); PG8_BAR;
    } else {
        PG8_STAGE(PG8_SB(0, 0), cB, voffB); PG8_STAGE(PG8_SA(0, 0), cA, voffA); PG8_STAGE(PG8_SB(0, 1), cB + hstep, voffB); PG8_STAGE(PG8_SA(0, 1), cA + hstep, voffA);
        if (wr == 1) PG8_BAR;
        PG8_WAIT_V(4); PG8_BAR;
        PG8_STAGE(PG8_SB(1, 0), cB + kstep, voffB); PG8_STAGE(PG8_SA(1, 0), cA + kstep, voffA); PG8_STAGE(PG8_SB(1, 1), cB + hstep + kstep, voffB);
        PG8_WAIT_V(6); PG8_BAR;
    }
    for (;;) {
        const bool has_next = S.next(ui + 1, nxt);
        const char* nA = has_next ? (const char*)g.A + (size_t)nxt.pm * tstep : cA; const char* nB = has_next ? (const char*)g.Bt + (size_t)nxt.pn * tstep : cB;
        for (int t = 0; t < nt; t += 2) {
            const bool last = (t == nt - 2);
            const char* a1 = cA + (size_t)(t + 1) * kstep;
            const char* a2 = last ? nA : cA + (size_t)(t + 2) * kstep; const char* b2 = last ? nB : cB + (size_t)(t + 2) * kstep;
            const char* a3 = a2 + kstep; const char* b3 = b2 + kstep;
            if (last && has_next) S.a_ready(nxt);
            if constexpr (SP2) {
            PG8_LDB(B0, 0, 0); PG8_LDB(B1, 0, 1); PG8_SCHED; PG8_LDA(At, 0, 0); PG8_STAGE(PG8_SA(1, 1), a1 + hstep, voffA);
            PG8_WAIT_V(8); PG8_WAIT_L(0); PG8_BAR; PG8_MMA(0, 0, At, B0); PG8_MMA(0, 1, At, B1); PG8_BAR; PG8_SCHED;
            PG8_LDA(At, 0, 1); PG8_STAGE(PG8_SB(0, 0), b2, voffB); PG8_STAGE(PG8_SB(0, 1), b2 + hstep, voffB); PG8_STAGE(PG8_SA(0, 0), a2, voffA);
            PG8_WAIT_V(8); PG8_WAIT_L(0); PG8_BAR; PG8_MMA(1, 0, At, B0); PG8_MMA(1, 1, At, B1); PG8_BAR; PG8_SCHED;
            PG8_LDB(B0, 1, 0); PG8_LDB(B1, 1, 1); PG8_SCHED; PG8_LDA(At, 1, 0); PG8_STAGE(PG8_SA(0, 1), a2 + hstep, voffA);
            PG8_WAIT_V(8); PG8_WAIT_L(0); PG8_BAR; PG8_MMA(0, 0, At, B0); PG8_MMA(0, 1, At, B1); PG8_BAR; PG8_SCHED;
            PG8_LDA(At, 1, 1); PG8_STAGE(PG8_SB(1, 0), b3, voffB); PG8_STAGE(PG8_SB(1, 1), b3 + hstep, voffB); PG8_STAGE(PG8_SA(1, 0), a3, voffA);
            PG8_WAIT_V(8); PG8_WAIT_L(0); PG8_BAR; PG8_MMA(1, 0, At, B0); PG8_MMA(1, 1, At, B1); PG8_BAR; PG8_SCHED;
            } else {
            PG8_LDB(B0, 0, 0); PG8_SCHED; PG8_LDA(At, 0, 0); PG8_STAGE(PG8_SA(1, 1), a1 + hstep, voffA);
            PG8_WAIT_L(8); PG8_BAR; PG8_WAIT_L(0); PG8_MMA(0, 0, At, B0); PG8_BAR; PG8_SCHED;
            PG8_LDB(B1, 0, 1); PG8_STAGE(PG8_SB(0, 0), b2, voffB);
            PG8_BAR; PG8_WAIT_L(0); PG8_MMA(0, 1, At, B1); PG8_BAR;
            PG8_LDA(At, 0, 1); PG8_STAGE(PG8_SA(0, 0), a2, voffA);
            PG8_BAR; PG8_WAIT_L(0); PG8_MMA(1, 0, At, B0); PG8_BAR; PG8_SCHED;
            PG8_STAGE(PG8_SB(0, 1), b2 + hstep, voffB);
            PG8_WAIT_V(6); PG8_BAR; PG8_MMA(1, 1, At, B1); PG8_BAR;
            PG8_LDB(B0, 1, 0); PG8_SCHED; PG8_LDA(At, 1, 0); PG8_STAGE(PG8_SA(0, 1), a2 + hstep, voffA);
            PG8_WAIT_L(8); PG8_BAR; PG8_WAIT_L(0); PG8_MMA(0, 0, At, B0); PG8_BAR; PG8_SCHED;
            PG8_LDB(B1, 1, 1); PG8_STAGE(PG8_SB(1, 0), b3, voffB);
            PG8_BAR; PG8_WAIT_L(0); PG8_MMA(0, 1, At, B1); PG8_BAR;
            PG8_LDA(At, 1, 1); PG8_STAGE(PG8_SA(1, 0), a3, voffA);
            PG8_BAR; PG8_WAIT_L(0); PG8_MMA(1, 0, At, B0); PG8_BAR; PG8_SCHED;
            PG8_STAGE(PG8_SB(1, 1), b3 + hstep, voffB);
            PG8_WAIT_V(6); PG8_BAR; PG8_MMA(1, 1, At, B1); PG8_BAR;
            }
        }
        if constexpr (ALIGN_EPI) { if (wr == 0) PG8_BAR; }
        if constexpr (!Epi::AFTER_DRAIN) { E(acc, cur, wr, wc, fr, fq); S.done(cur); }
        if (!has_next) break;
#pragma unroll
        for (int a = 0; a < 2; ++a)
#pragma unroll
            for (int b = 0; b < 2; ++b)
#pragma unroll
                for (int m = 0; m < 4; ++m)
#pragma unroll
                    for (int n = 0; n < 2; ++n) acc[a][b][m][n] = (f32x4){0.f, 0.f, 0.f, 0.f};
        cur = nxt; cA = nA; cB = nB; ++ui;
        if constexpr (ALIGN_EPI) { if (wr == 1) PG8_BAR; }
    }
    PG8_WAIT_V(0);
    if constexpr (!ALIGN_EPI) { if (wr == 0) PG8_BAR; }
    PG8_BAR;
    if constexpr (Epi::AFTER_DRAIN) { E.fused(acc, cur, wr, wc, fr, fq, lds, wid, lane); S.done(cur); }
#undef PG8_SA
#undef PG8_SB
#undef PG8_STAGE
#undef PG8_LDA
#undef PG8_LDB
#undef PG8_MMA
#undef PG8_WAIT_V
#undef PG8_WAIT_L
#undef PG8_BAR
#undef PG8_SCHED
}
}


#define LAS __attribute__((address_space(3)))
#ifndef SKIPMASK
#define SKIPMASK 0
#endif
#ifndef PROBE_KIND
#define PROBE_KIND -1
#endif
typedef unsigned short bf16;
using pg8::f32x4; using pg8::u32x4; using pg8::bf16x8;
typedef float f32x16 __attribute__((ext_vector_type(16)));
typedef short v4i16_t __attribute__((ext_vector_type(4)));
typedef unsigned u32x2 __attribute__((ext_vector_type(2)));

constexpr int DM = 1024, DEPTH = 4, NTOK = 98304, NPROMPT = 32768, CH = 32768, NCHUNK = NTOK / CH;
constexpr int NIN = 6400, DFF = 2816, NUP = 5632;
constexpr int LDS_BYTES = 147456, NTHR = 512;
constexpr float EPS = 1e-6f, LOG2E = 1.4426950408889634f;
constexpr size_t OFF_IN = 0, OFF_PA = OFF_IN + (size_t)NIN * DM, OFF_PB = OFF_PA + (size_t)DM * 256, OFF_OUT = OFF_PB + (size_t)DM * DM, OFF_UP = OFF_OUT + (size_t)DM * DM,
                 OFF_DN = OFF_UP + (size_t)NUP * DM, OFF_WS = OFF_DN + (size_t)DM * DFF, W_LAYER = OFF_WS + 8 * 128 * 128;
constexpr size_t MiB = 1u << 20;
constexpr size_t WS_W = 0, WS_R1 = 144 * MiB, WS_R2 = WS_R1 + (size_t)CH * 12800, WS_XB = WS_R2 + (size_t)CH * 5632, WS_SS = WS_XB + (size_t)CH * 2048, WS_SSV = WS_SS + (size_t)CH * 64, WS_BAR = WS_SSV + (size_t)CH * 64, WS_SB = WS_BAR + 65536, WS_XL = WS_SB + (size_t)(CH / 64) * 4 * 5632 * 2, WS_BT = WS_XL + (size_t)CH * 2048, WS_END = WS_BT + 16384;
static_assert(W_LAYER * 2 * DEPTH <= WS_R1, "weights fit");
constexpr int PROBE_DUPK = (PROBE_KIND == 8) ? 1 : PROBE_KIND;
constexpr int KPL = (PROBE_DUPK >= 0 && PROBE_DUPK < 8) ? 9 : 8;
constexpr int NP0 = (PROBE_KIND == 9) ? 2 : 1;
constexpr int PH_PER_CHUNK = 2 + KPL * DEPTH, N_PHASES = NP0 + NCHUNK * PH_PER_CHUNK;

struct Args { const float* in[17]; float* out; unsigned char* ws; int ph_lo, ph_hi; };

__device__ __forceinline__ float wave_sum(float v) {
#pragma unroll
    for (int o = 1; o < 64; o <<= 1) v += __shfl_xor(v, o);
    return v;
}
__device__ __forceinline__ unsigned pk2(float lo, float hi) { return pg8::cvt_pk_bf16(lo, hi); }
#define LDS_WAIT() asm volatile("s_waitcnt lgkmcnt(0)" ::: "memory")

__device__ __forceinline__ int t5_bucket(int rel) {
    const int n = rel < 0 ? -rel : rel;
    const int b = n < 8 ? n : 8 + (n >= 15) + (n >= 27) + (n >= 50) + (n >= 91) + (n >= 166) + (n >= 305) + (n >= 559);
    return (rel > 0 ? 16 : 0) + b;
}
__device__ __forceinline__ void tr_item(const float* W, int K, int N, bf16* WT, const float* gain, LAS float* scr, int item, int lane, bool perm_up = false) {
    const int nblk = N / 32, kb = item / nblk, nb = item % nblk, k0 = 64 * kb, n0 = 32 * nb;
    const int dn0 = perm_up ? ((n0 % DFF) / 128) * 256 + (n0 / DFF) * 128 + (n0 % 128) : n0;
#pragma unroll 8
    for (int i = 0; i < 32; ++i) { const int kk = 2 * i + (lane >> 5); const float g = gain ? gain[k0 + kk] : 1.0f; scr[kk * 33 + (lane & 31)] = W[(size_t)(k0 + kk) * N + n0 + (lane & 31)] * g; }
    LDS_WAIT();
    const int c = lane & 7;
#pragma unroll
    for (int j = 0; j < 4; ++j) { const int n = (lane >> 3) + 8 * j; const LAS float* s = scr + (8 * c) * 33 + n;
        u32x4 o; o.x = pk2(s[0 * 33], s[1 * 33]); o.y = pk2(s[2 * 33], s[3 * 33]); o.z = pk2(s[4 * 33], s[5 * 33]); o.w = pk2(s[6 * 33], s[7 * 33]);
        *(u32x4*)(WT + (size_t)(dn0 + n) * K + k0 + 8 * c) = o; }
    LDS_WAIT();
}
__device__ __forceinline__ void p0_weights(const Args& a, LAS unsigned char* lds, int tid, int G, int bid) {
    const int wave = tid >> 6, lane = tid & 63;
    LAS float* scr = (LAS float*)(lds + wave * 16384);
    const int gw = bid * 8 + wave, NGW = G * 8;
    constexpr int I_IN = 16 * 200, I_PA = 4 * 32, I_PB = 16 * 32, I_OUT = 16 * 32, I_UP = 16 * 176, I_DN = 44 * 32, PER = I_IN + I_PA + I_PB + I_OUT + I_UP + I_DN;
    bf16* Wb = (bf16*)(a.ws + WS_W);
    for (int it = gw; it < DEPTH * PER; it += NGW) {
        const int l = it / PER; int r = it % PER; bf16* wl = Wb + (size_t)l * W_LAYER;
        if (r < I_IN) { tr_item(a.in[4] + (size_t)l * DM * NIN, DM, NIN, wl + OFF_IN, a.in[3] + l * DM, scr, r, lane); continue; } r -= I_IN;
        if (r < I_PA) { tr_item(a.in[8] + (size_t)l * 256 * DM, 256, DM, wl + OFF_PA, nullptr, scr, r, lane); continue; } r -= I_PA;
        if (r < I_PB) { tr_item(a.in[9] + (size_t)l * DM * DM, DM, DM, wl + OFF_PB, nullptr, scr, r, lane); continue; } r -= I_PB;
        if (r < I_OUT) { tr_item(a.in[10] + (size_t)l * DM * DM, DM, DM, wl + OFF_OUT, nullptr, scr, r, lane); continue; } r -= I_OUT;
        if (r < I_UP) { tr_item(a.in[12] + (size_t)l * DM * NUP, DM, NUP, wl + OFF_UP, a.in[11] + l * DM, scr, r, lane, true); continue; } r -= I_UP;
        tr_item(a.in[15] + (size_t)l * DFF * DM, DFF, DM, wl + OFF_DN, nullptr, scr, r, lane);
    }
    if (bid == 0) {
        float* BT = (float*)(a.ws + WS_BT);
        for (int i = tid; i < 3 * 768; i += NTHR) { const int g = i / 768, hh = (i % 768) / 192, j = i % 192 - 96;
            BT[i] = (j >= -64 && j <= 64) ? LOG2E * a.in[2][t5_bucket(j << (2 * g)) * 12 + g * 4 + hh] : -1e30f; }
    }
    for (int i = bid * NTHR + tid; i < DEPTH * 131072 / 4; i += G * NTHR) {
        const int l = i / 32768, e = (i % 32768) * 4;
        const f32x4 v = *(const f32x4*)(a.in[6] + (size_t)l * 131072 + e);
        u32x2 o; o.x = pk2(v[0], v[1]); o.y = pk2(v[2], v[3]);
        *(u32x2*)(Wb + (size_t)l * W_LAYER + OFF_WS + e) = o;
    }
}
__device__ __forceinline__ void p0x(const Args& a, int chunk, int tid, int G, int bid) {
    const int wave = tid >> 6, lane = tid & 63, gw = bid * 8 + wave, NGW = G * 8;
    bf16* XB = (bf16*)(a.ws + WS_XB); bf16* XL = (bf16*)(a.ws + WS_XL); float* SS = (float*)(a.ws + WS_SS);
    for (int m = gw; m < CH; m += NGW) {
        const size_t tok = (size_t)chunk * CH + m;
        const float* src = tok < NPROMPT ? a.in[0] + tok * DM : a.in[1] + (tok - NPROMPT) * DM;
        float s = 0.f;
#pragma unroll
        for (int j = 0; j < 4; ++j) { const f32x4 v = *(const f32x4*)(src + (lane + 64 * j) * 4); s += (v[0] * v[0] + v[1] * v[1]) + (v[2] * v[2] + v[3] * v[3]);
            u32x2 o; o.x = pk2(v[0], v[1]); o.y = pk2(v[2], v[3]); *(u32x2*)(XB + (size_t)m * DM + (lane + 64 * j) * 4) = o;
            u32x2 lo; lo.x = pk2(v[0] - __uint_as_float(o.x << 16), v[1] - __uint_as_float(o.x & 0xffff0000u)); lo.y = pk2(v[2] - __uint_as_float(o.y << 16), v[3] - __uint_as_float(o.y & 0xffff0000u));
            *(u32x2*)(XL + (size_t)m * DM + (lane + 64 * j) * 4) = lo; }
        s = wave_sum(s);
        if (lane < 16) SS[(size_t)m * 16 + lane] = lane == 0 ? s : 0.f;
    }
}
__device__ __forceinline__ void pfinal(const Args& a, int chunk, int tid, int G, int bid) {
    const int wave = tid >> 6, lane = tid & 63, gw = bid * 8 + wave, NGW = G * 8;
    const bf16* XB = (const bf16*)(a.ws + WS_XB); const bf16* XL = (const bf16*)(a.ws + WS_XL);
    const float* SS = (const float*)(a.ws + WS_SS); const float* nf = a.in[16];
    for (int m = gw; m < CH; m += NGW) {
        float* x = a.out + ((size_t)chunk * CH + m) * DM;
        const float rs = pg8::row_rs(SS, m);
#pragma unroll
        for (int j = 0; j < 2; ++j) { const int c = (lane + 64 * j) * 8; f32x4 h0, h1, l0, l1;
            pg8::unpack8(*(const u32x4*)(XB + (size_t)m * DM + c), h0, h1); pg8::unpack8(*(const u32x4*)(XL + (size_t)m * DM + c), l0, l1);
            *(f32x4*)(x + c) = (h0 + l0) * rs * *(const f32x4*)(nf + c); *(f32x4*)(x + c + 4) = (h1 + l1) * rs * *(const f32x4*)(nf + c + 4); }
    }
}
struct AttU { int g, d, L, tokbase, qb; };
__device__ __forceinline__ AttU att_decode(int unit, int S) {
    constexpr int upg = CH / 64;
    AttU u; u.g = unit / upg; const int rem = unit % upg, ups = S / 64, seq = rem / ups, rem2 = rem % ups;
    u.d = 1 << (2 * u.g); u.L = S / u.d; const int nqb = u.L / 64, r = rem2 / nqb; u.qb = rem2 % nqb; u.tokbase = seq * S + r;
    return u;
}
template <int KT0, int KT1, bool WITHQ>
__device__ __forceinline__ void att_load_qk(const bf16* QKV, const AttU& u, int h, int qh, int n, int hi, bf16x8 (&qf)[4], bf16x8 (&kf)[5][4]) {
    const int qbase = 64 * u.qb + 32 * qh;
    if (WITHQ) {
        const bf16* qp = QKV + ((size_t)u.tokbase + (size_t)(qbase + n) * u.d) * 2304 + u.g * 256 + h * 64 + 8 * hi;
#pragma unroll
        for (int s = 0; s < 4; ++s) qf[s] = *(const bf16x8*)(qp + 16 * s);
    }
#pragma unroll
    for (int kt = KT0; kt < KT1; ++kt) {
        const int lk = qbase - 64 + 32 * kt + n, lkc = lk < 0 ? 0 : (lk > u.L - 1 ? u.L - 1 : lk);
        const bf16* kp = QKV + (size_t)(u.tokbase + lkc * u.d) * 2304 + 768 + u.g * 256 + h * 64 + 8 * hi;
#pragma unroll
        for (int s = 0; s < 4; ++s) kf[kt][s] = *(const bf16x8*)(kp + 16 * s);
    }
}
__device__ __forceinline__ void attn_phase(const bf16* QKV, bf16* OUTG, float* LSE, const float* BT, LAS unsigned char* lds, int S, int tid, int G, int bid) {
    constexpr int NATT = 3 * (CH / 64);
    const int wave = tid >> 6, lane = tid & 63;
    const int h = wave & 3, qh = wave >> 2, n = lane & 31, hi = lane >> 5;
    int it = (G % 8 == 0) ? (bid & 7) * (G / 8) + (bid >> 3) : bid;
    if (it >= NATT) return;
    AttU u = att_decode(it, S);
    bf16x8 qf[4], kf[5][4];
    att_load_qk<0, 4, false>(QKV, u, h, qh, n, hi, qf, kf);
    for (; it < NATT; it += G) {
        const int g = u.g, d = u.d, L = u.L, tokbase = u.tokbase, qb = u.qb, qbase = 64 * qb + 32 * qh;
        const size_t tokq = (size_t)tokbase + (size_t)(qbase + n) * d;
        att_load_qk<4, 5, true>(QKV, u, h, qh, n, hi, qf, kf);
        u32x4 vv[12];
        int tl = tid; asm volatile("" : "+v"(tl));
#pragma unroll
        for (int i = 0; i < 12; ++i) {
            const int idx = tl + i * NTHR, kk = idx >> 5, ch = idx & 31, lk = 64 * qb - 64 + kk;
            vv[i] = (u32x4){0u, 0u, 0u, 0u};
            if (lk >= 0 && lk < L) vv[i] = *(const u32x4*)(QKV + (size_t)(tokbase + lk * d) * 2304 + 1536 + g * 256 + ch * 8);
        }
        const float bt0 = BT[g * 768 + tid], bt1 = tid < 256 ? BT[g * 768 + 512 + tid] : 0.f;
        f32x16 st[5];
#pragma unroll
        for (int kt = 0; kt < 5; ++kt) {
            f32x16 acc;
#pragma unroll
            for (int e = 0; e < 16; ++e) acc[e] = 0.f;
#pragma unroll
            for (int s = 0; s < 4; ++s) acc = __builtin_amdgcn_mfma_f32_32x32x16_bf16(kf[kt][s], qf[s], acc, 0, 0, 0);
            st[kt] = acc;
        }
#pragma unroll
        for (int i = 0; i < 12; ++i) { const int idx = tl + i * NTHR, kk = idx >> 5, ch = idx & 31; *(LAS u32x4*)(lds + kk * 576 + ch * 16) = vv[i]; }
        LAS float* bt = (LAS float*)(lds + 110592);
        bt[tid] = bt0; if (tid < 256) bt[512 + tid] = bt1;
        asm volatile("" :: "v"(st[4][15]) : "memory");
        AttU un = u;
        if (it + G < NATT) { un = att_decode(it + G, S); att_load_qk<0, 4, false>(QKV, un, h, qh, n, hi, qf, kf); }
        __syncthreads();
        float mx = -3.0e38f;
        {
            const LAS float* btl = bt + h * 192 + 32 + 4 * hi - n;
            const bool edge = (qb == 0) || (64 * qb + 128 > L);
#pragma unroll
            for (int kt = 0; kt < 5; ++kt)
#pragma unroll
                for (int i = 0; i < 16; ++i) {
                    float sv = st[kt][i] + btl[32 * kt + (i & 3) + 8 * (i >> 2)];
                    if (edge) { const int lk2 = qbase - 64 + 32 * kt + (i & 3) + 8 * (i >> 2) + 4 * hi; sv = (lk2 >= 0 && lk2 < L) ? sv : -1e30f; }
                    st[kt][i] = sv; mx = fmaxf(mx, sv);
                }
        }
        mx = fmaxf(mx, __shfl_xor(mx, 32));
        float sum = 0.f;
#pragma unroll
        for (int kt = 0; kt < 5; ++kt)
#pragma unroll
            for (int i = 0; i < 16; ++i) { const float pe = __builtin_amdgcn_exp2f(st[kt][i] - mx); st[kt][i] = pe; sum += pe; }
        sum += __shfl_xor(sum, 32);
        const float inv = 1.0f / sum, lse = (mx + __log2f(sum)) * 0.6931471805599453f;
        f32x16 o0, o1;
#pragma unroll
        for (int e = 0; e < 16; ++e) { o0[e] = 0.f; o1[e] = 0.f; }
        const int q4 = (lane & 15) >> 2, p4 = lane & 3, gsel = (lane >> 4) & 1;
        const unsigned vbase = (unsigned)((32 * qh + 4 * hi + q4) * 576 + h * 128 + (16 * gsel + 4 * p4) * 2);
#pragma unroll
        for (int kt = 0; kt < 5; ++kt)
#pragma unroll
            for (int s2 = 0; s2 < 2; ++s2) {
                u32x4 pw; pw.x = pk2(st[kt][8 * s2 + 0], st[kt][8 * s2 + 1]); pw.y = pk2(st[kt][8 * s2 + 2], st[kt][8 * s2 + 3]); pw.z = pk2(st[kt][8 * s2 + 4], st[kt][8 * s2 + 5]); pw.w = pk2(st[kt][8 * s2 + 6], st[kt][8 * s2 + 7]);
                const bf16x8 pf = __builtin_bit_cast(bf16x8, pw);
                const unsigned ro = vbase + (unsigned)((32 * kt + 16 * s2) * 576);
                {
                    const v4i16_t r1 = __builtin_amdgcn_ds_read_tr16_b64_v4i16((LAS v4i16_t*)(lds + ro)), r2 = __builtin_amdgcn_ds_read_tr16_b64_v4i16((LAS v4i16_t*)(lds + ro + 8 * 576));
                    const bf16x8 vf = (bf16x8){r1[0], r1[1], r1[2], r1[3], r2[0], r2[1], r2[2], r2[3]};
                    o0 = __builtin_amdgcn_mfma_f32_32x32x16_bf16(vf, pf, o0, 0, 0, 0);
                }
                {
                    const v4i16_t r1 = __builtin_amdgcn_ds_read_tr16_b64_v4i16((LAS v4i16_t*)(lds + ro + 64)), r2 = __builtin_amdgcn_ds_read_tr16_b64_v4i16((LAS v4i16_t*)(lds + ro + 64 + 8 * 576));
                    const bf16x8 vf = (bf16x8){r1[0], r1[1], r1[2], r1[3], r2[0], r2[1], r2[2], r2[3]};
                    o1 = __builtin_amdgcn_mfma_f32_32x32x16_bf16(vf, pf, o1, 0, 0, 0);
                }
            }
        bf16* op = OUTG + ((size_t)g * CH + tokq) * 256 + h * 64;
#pragma unroll
        for (int grp = 0; grp < 4; ++grp) {
            u32x2 w0, w1;
            w0.x = pk2(o0[4 * grp + 0] * inv, o0[4 * grp + 1] * inv); w0.y = pk2(o0[4 * grp + 2] * inv, o0[4 * grp + 3] * inv);
            w1.x = pk2(o1[4 * grp + 0] * inv, o1[4 * grp + 1] * inv); w1.y = pk2(o1[4 * grp + 2] * inv, o1[4 * grp + 3] * inv);
            *(u32x2*)(op + 8 * grp + 4 * hi) = w0; *(u32x2*)(op + 32 + 8 * grp + 4 * hi) = w1;
        }
        if (hi == 0) LSE[((size_t)g * CH + tokq) * 4 + h] = lse;
        __syncthreads();
        u = un;
    }
}
constexpr int SG_WLDS = 17920;
__device__ __forceinline__ void sg_wave_unit(bf16* U, bf16* UO, const bf16* GV, const float* ssv, const bf16* WSb, const float* gain, const float* bs, LAS unsigned char* wl, int unit, int lane) {
    const int hf = unit & 1, gg = (unit >> 1) & 7, nch = unit >> 4, tok0 = nch * 128, cb = gg * 128 + hf * 64;
    LAS float* rvl = (LAS float*)(wl + 17408);
    rvl[lane] = pg8::row_rs(ssv, tok0 + lane); rvl[lane + 64] = pg8::row_rs(ssv, tok0 + lane + 64);
    LDS_WAIT();
    {
        const int c8 = lane & 7, q0 = lane >> 3;
#pragma unroll
        for (int i = 0; i < 16; ++i) {
            const int q = q0 + 8 * i;
            f32x4 a0, a1; pg8::unpack8(*(const u32x4*)(GV + (size_t)(tok0 + q) * 1024 + cb + c8 * 8), a0, a1);
            const float r = rvl[q];
            const u32x4 w = pg8::pack8(a0 * r, a1 * r);
            *(LAS u32x2*)(wl + q * 136 + c8 * 16) = (u32x2){w.x, w.y}; *(LAS u32x2*)(wl + q * 136 + c8 * 16 + 8) = (u32x2){w.z, w.w};
        }
    }
    LDS_WAIT();
    const int ln = lane & 15, kq = lane >> 4, qq = ln >> 2, pp = ln & 3;
    bf16x8 afr[4][4];
#pragma unroll
    for (int ct = 0; ct < 4; ++ct)
#pragma unroll
        for (int ks = 0; ks < 4; ++ks) {
            const unsigned ad = (unsigned)((32 * ks + 8 * kq + qq) * 136 + (32 * (ct >> 1) + 8 * pp + 4 * (ct & 1)) * 2);
            const v4i16_t r1 = __builtin_amdgcn_ds_read_tr16_b64_v4i16((LAS v4i16_t*)(wl + ad)), r2 = __builtin_amdgcn_ds_read_tr16_b64_v4i16((LAS v4i16_t*)(wl + ad + 4 * 136));
            afr[ct][ks] = (bf16x8){r1[0], r1[1], r1[2], r1[3], r2[0], r2[1], r2[2], r2[3]};
        }
    f32x4 gn[2][2];
#pragma unroll
    for (int t = 0; t < 2; ++t) { gn[t][0] = *(const f32x4*)(gain + cb + 32 * t + 8 * kq); gn[t][1] = *(const f32x4*)(gain + cb + 32 * t + 8 * kq + 4); }
#pragma unroll 2
    for (int pt = 0; pt < 8; ++pt) {
        const int pr = pt * 16 + ln;
        bf16x8 bfr[4];
#pragma unroll
        for (int ks = 0; ks < 4; ++ks) bfr[ks] = *(const bf16x8*)(WSb + (size_t)gg * 16384 + pr * 128 + 32 * ks + 8 * kq);
        bf16* up = U + (size_t)(tok0 + pr) * 1024 + cb + 8 * kq; bf16* uo = UO + (size_t)(tok0 + pr) * 1024 + cb + 8 * kq;
        const u32x4 uw0 = *(const u32x4*)up, uw1 = *(const u32x4*)(up + 32);
        const float bias = bs[gg * 128 + pr];
        f32x4 acc[4];
#pragma unroll
        for (int ct = 0; ct < 4; ++ct) {
            acc[ct] = (f32x4){0.f, 0.f, 0.f, 0.f};
#pragma unroll
            for (int ks = 0; ks < 4; ++ks) acc[ct] = __builtin_amdgcn_mfma_f32_16x16x32_bf16(afr[ct][ks], bfr[ks], acc[ct], 0, 0, 0);
        }
        f32x4 u0, u1;
        pg8::unpack8(uw0, u0, u1);
        *(u32x4*)uo = pg8::pack8(u0 * (gn[0][0] * acc[0] + bias), u1 * (gn[0][1] * acc[1] + bias));
        pg8::unpack8(uw1, u0, u1);
        *(u32x4*)(uo + 32) = pg8::pack8(u0 * (gn[1][0] * acc[2] + bias), u1 * (gn[1][1] * acc[3] + bias));
    }
    LDS_WAIT();
}
__device__ __forceinline__ void p_merge(const bf16* OUTG, const float* LSE, bf16* OA, int tid, int G, int bid) {
    for (int it = bid * NTHR + tid; it < CH * 32; it += G * NTHR) {
        const int tok = it >> 5, c8 = it & 31, h = c8 >> 3;
        const float l0 = LSE[(size_t)tok * 4 + h], l1 = LSE[((size_t)CH + tok) * 4 + h], l2 = LSE[((size_t)2 * CH + tok) * 4 + h];
        const float mx = fmaxf(l0, fmaxf(l1, l2));
        float w0 = __expf(l0 - mx), w1 = __expf(l1 - mx), w2 = __expf(l2 - mx);
        const float inv = 1.0f / (w0 + w1 + w2); w0 *= inv; w1 *= inv; w2 *= inv;
        f32x4 a0, a1, b0, b1, c0, c1;
        pg8::unpack8(*(const u32x4*)(OUTG + (size_t)tok * 256 + c8 * 8), a0, a1);
        pg8::unpack8(*(const u32x4*)(OUTG + ((size_t)CH + tok) * 256 + c8 * 8), b0, b1);
        pg8::unpack8(*(const u32x4*)(OUTG + ((size_t)2 * CH + tok) * 256 + c8 * 8), c0, c1);
        *(u32x4*)(OA + (size_t)tok * 256 + c8 * 8) = pg8::pack8(a0 * w0 + b0 * w1 + c0 * w2, a1 * w0 + b1 * w1 + c1 * w2);
    }
}
__device__ __forceinline__ void p_conv(const bf16* A, bf16* FG, const float* cw, const float* cb, int S, int tid, int G, int bid) {
    constexpr int RUN = 8, NFC = DFF / 8;
    for (int it = bid * NTHR + tid; it < (CH / RUN) * NFC; it += G * NTHR) {
        const int fc = it % NFC, t0 = (it / NFC) * RUN, f = fc * 8;
        f32x4 wg[3][2], wv[3][2], bg[2], bv[2];
#pragma unroll
        for (int k = 0; k < 3; ++k) { wg[k][0] = *(const f32x4*)(cw + k * NUP + f); wg[k][1] = *(const f32x4*)(cw + k * NUP + f + 4); wv[k][0] = *(const f32x4*)(cw + k * NUP + DFF + f); wv[k][1] = *(const f32x4*)(cw + k * NUP + DFF + f + 4); }
        bg[0] = *(const f32x4*)(cb + f); bg[1] = *(const f32x4*)(cb + f + 4); bv[0] = *(const f32x4*)(cb + DFF + f); bv[1] = *(const f32x4*)(cb + DFF + f + 4);
        const f32x4 z4 = (f32x4){0.f, 0.f, 0.f, 0.f};
        f32x4 pg0 = z4, pg1 = z4, pv0 = z4, pv1 = z4, cg0, cg1, cv0, cv1;
        if ((t0 & (S - 1)) != 0) { pg8::unpack8(*(const u32x4*)(A + (size_t)(t0 - 1) * NUP + f), pg0, pg1); pg8::unpack8(*(const u32x4*)(A + (size_t)(t0 - 1) * NUP + DFF + f), pv0, pv1); }
        pg8::unpack8(*(const u32x4*)(A + (size_t)t0 * NUP + f), cg0, cg1); pg8::unpack8(*(const u32x4*)(A + (size_t)t0 * NUP + DFF + f), cv0, cv1);
#pragma unroll
        for (int i = 0; i < RUN; ++i) {
            const int t = t0 + i;
            f32x4 ng0 = z4, ng1 = z4, nv0 = z4, nv1 = z4;
            if (((t + 1) & (S - 1)) != 0) { pg8::unpack8(*(const u32x4*)(A + (size_t)(t + 1) * NUP + f), ng0, ng1); pg8::unpack8(*(const u32x4*)(A + (size_t)(t + 1) * NUP + DFF + f), nv0, nv1); }
            f32x4 g0 = pg0 * wg[0][0] + cg0 * wg[1][0] + ng0 * wg[2][0] + bg[0], g1 = pg1 * wg[0][1] + cg1 * wg[1][1] + ng1 * wg[2][1] + bg[1];
            const f32x4 v0 = pv0 * wv[0][0] + cv0 * wv[1][0] + nv0 * wv[2][0] + bv[0], v1 = pv1 * wv[0][1] + cv1 * wv[1][1] + nv1 * wv[2][1] + bv[1];
#pragma unroll
            for (int e = 0; e < 4; ++e) { g0[e] = pg8::gelu_tanh(g0[e]) * v0[e]; g1[e] = pg8::gelu_tanh(g1[e]) * v1[e]; }
            *(u32x4*)(FG + (size_t)t * DFF + f) = pg8::pack8(g0, g1);
            pg0 = cg0; pg1 = cg1; pv0 = cv0; pv1 = cv1; cg0 = ng0; cg1 = ng1; cv0 = nv0; cv1 = nv1;
        }
    }
}

__device__ __forceinline__ void p_convfix(const bf16* SB, bf16* FG, const float* cw, const float* cb, int S, int tid, int G, int bid) {
    constexpr int NFC = DFF / 8, NB = CH / 64;
    for (int it = bid * NTHR + tid; it < NB * 2 * NFC; it += G * NTHR) {
        const int fc = it % NFC, r2 = it / NFC, which = r2 & 1, b = r2 >> 1, f = fc * 8, t = b * 64 + (which ? 63 : 0);
        const f32x4 z4 = (f32x4){0.f, 0.f, 0.f, 0.f};
        f32x4 pg0 = z4, pg1 = z4, pv0 = z4, pv1 = z4, cg0, cg1, cv0, cv1, ng0 = z4, ng1 = z4, nv0 = z4, nv1 = z4;
        const bf16* bp = SB + (size_t)b * 4 * NUP + f;
        if (which == 0) {
            if ((t & (S - 1)) != 0) { pg8::unpack8(*(const u32x4*)(bp - NUP), pg0, pg1); pg8::unpack8(*(const u32x4*)(bp - NUP + DFF), pv0, pv1); }
            pg8::unpack8(*(const u32x4*)bp, cg0, cg1); pg8::unpack8(*(const u32x4*)(bp + DFF), cv0, cv1);
            pg8::unpack8(*(const u32x4*)(bp + NUP), ng0, ng1); pg8::unpack8(*(const u32x4*)(bp + NUP + DFF), nv0, nv1);
        } else {
            pg8::unpack8(*(const u32x4*)(bp + 2 * NUP), pg0, pg1); pg8::unpack8(*(const u32x4*)(bp + 2 * NUP + DFF), pv0, pv1);
            pg8::unpack8(*(const u32x4*)(bp + 3 * NUP), cg0, cg1); pg8::unpack8(*(const u32x4*)(bp + 3 * NUP + DFF), cv0, cv1);
            if (((t + 1) & (S - 1)) != 0) { pg8::unpack8(*(const u32x4*)(bp + 4 * NUP), ng0, ng1); pg8::unpack8(*(const u32x4*)(bp + 4 * NUP + DFF), nv0, nv1); }
        }
        f32x4 g0 = *(const f32x4*)(cb + f), g1 = *(const f32x4*)(cb + f + 4), v0 = *(const f32x4*)(cb + DFF + f), v1 = *(const f32x4*)(cb + DFF + f + 4);
        g0 = g0 + pg0 * *(const f32x4*)(cw + f) + cg0 * *(const f32x4*)(cw + NUP + f) + ng0 * *(const f32x4*)(cw + 2 * NUP + f);
        g1 = g1 + pg1 * *(const f32x4*)(cw + f + 4) + cg1 * *(const f32x4*)(cw + NUP + f + 4) + ng1 * *(const f32x4*)(cw + 2 * NUP + f + 4);
        v0 = v0 + pv0 * *(const f32x4*)(cw + DFF + f) + cv0 * *(const f32x4*)(cw + NUP + DFF + f) + nv0 * *(const f32x4*)(cw + 2 * NUP + DFF + f);
        v1 = v1 + pv1 * *(const f32x4*)(cw + DFF + f + 4) + cv1 * *(const f32x4*)(cw + NUP + DFF + f + 4) + nv1 * *(const f32x4*)(cw + 2 * NUP + DFF + f + 4);
#pragma unroll
        for (int e = 0; e < 4; ++e) { g0[e] = pg8::gelu_tanh(g0[e]) * v0[e]; g1[e] = pg8::gelu_tanh(g1[e]) * v1[e]; }
        *(u32x4*)(FG + (size_t)t * DFF + f) = pg8::pack8(g0, g1);
    }
}
#define XB_TMO      128
#define XB_XCNT(j)  (256  + 64 * (j))
#define XB_XSUB(j)  (1280 + 64 * (j))
#define XB_XGEN(j)  (2304 + 64 * (j))
#define XB_TOP      3328
#define XB_TOPGEN   3392
#define XCD_BAR_WORDS 3456
#define XB_SPIN_CAP (1u << 18)

__device__ __forceinline__ unsigned xb_ld(unsigned* p)              { return __hip_atomic_load(p, __ATOMIC_RELAXED, __HIP_MEMORY_SCOPE_AGENT); }
__device__ __forceinline__ unsigned xb_add(unsigned* p, unsigned v) { return __hip_atomic_fetch_add(p, v, __ATOMIC_RELAXED, __HIP_MEMORY_SCOPE_AGENT); }
__device__ __forceinline__ unsigned xb_xcc_id() { return (unsigned)__builtin_amdgcn_s_getreg((3 << 11) | 20) & 0xFu; }
#define XB_SPIN(cond, bar) do { unsigned _sp = 0; while (cond) { __builtin_amdgcn_s_sleep(1); \
    if ((++_sp & 255u) == 0u) { if (xb_ld(&(bar)[XB_TMO])) break; if (_sp > XB_SPIN_CAP) { atomicAdd(&(bar)[XB_TMO], 1u); break; } } } } while (0)

struct XcdBarrier {
    unsigned* bar; unsigned x;
    volatile LAS unsigned* st;
};

__device__ __forceinline__ XcdBarrier xcd_barrier_post(unsigned* bar, volatile LAS unsigned* st, const int tid) {
    XcdBarrier b; b.bar = bar; b.x = xb_xcc_id(); b.st = st;
    if (tid == 0) (void)xb_add(&bar[XB_XCNT(b.x)], 1u);
    return b;
}
__device__ __forceinline__ void xcd_barrier_complete(unsigned* bar, unsigned x, unsigned& nloc, unsigned& nx) {
    const unsigned G = gridDim.x * gridDim.y * gridDim.z;
    unsigned sum, cnt, mine, sp = 0u;
    for (;;) {
        sum = 0u; cnt = 0u; mine = 0u;
#pragma unroll
        for (unsigned j = 0; j < 16; ++j) { const unsigned c = xb_ld(&bar[XB_XCNT(j)]); sum += c; cnt += (c > 0u) ? 1u : 0u; mine = (j == x) ? c : mine; }
        if (sum == G) break;
        __builtin_amdgcn_s_sleep(1);
        if ((++sp & 255u) == 0u) { if (xb_ld(&bar[XB_TMO])) break; if (sp > XB_SPIN_CAP) { atomicAdd(&bar[XB_TMO], 1u); break; } }
    }
    nloc = mine > 0u ? mine : 1u; nx = cnt > 0u ? cnt : 1u;
}

__device__ __forceinline__ void xcd_barrier(const XcdBarrier& b, const int tid) {
    asm volatile("s_waitcnt vmcnt(0)" ::: "memory");
    __syncthreads();
    if (tid == 0) {
        unsigned* bar = b.bar;
        __builtin_amdgcn_s_waitcnt(0);
        unsigned nloc = b.st[0], nx = b.st[1];
        if (nloc == 0u) { xcd_barrier_complete(bar, b.x, nloc, nx); b.st[0] = nloc; b.st[1] = nx; }
        const unsigned old = xb_add(&bar[XB_XSUB(b.x)], 1u);
        const unsigned gen = old / nloc;
        if (old + 1u == (gen + 1u) * nloc) {
            __builtin_amdgcn_fence(__ATOMIC_RELEASE, "agent");
            asm volatile("s_waitcnt vmcnt(0)" ::: "memory");
            const unsigned og = xb_add(&bar[XB_TOP], 1u);
            const unsigned tg = og / nx;
            if (og + 1u == (tg + 1u) * nx) xb_add(&bar[XB_TOPGEN], 1u);
            else XB_SPIN(xb_ld(&bar[XB_TOPGEN]) == tg, bar);
            __builtin_amdgcn_fence(__ATOMIC_ACQUIRE, "agent");
            xb_add(&bar[XB_XGEN(b.x)], 1u);
            asm volatile("s_waitcnt vmcnt(0)" ::: "memory");
        } else {
            XB_SPIN(xb_ld(&bar[XB_XGEN(b.x)]) == gen, bar);
            __builtin_amdgcn_fence(__ATOMIC_ACQUIRE, "agent");
            asm volatile("s_waitcnt vmcnt(0)" ::: "memory");
        }
    }
    __syncthreads();
}


__global__ void __launch_bounds__(NTHR, 2) fwd_kernel(Args a_in) {
    extern __shared__ __attribute__((aligned(16))) unsigned char lds_raw[];
    LAS unsigned char* lds = (LAS unsigned char*)lds_raw;
    cg::grid_group grid = cg::this_grid();
    const int ph_lo = a_in.ph_lo, ph_hi = a_in.ph_hi;
    volatile LAS unsigned* xst = (volatile LAS unsigned*)(lds + LDS_BYTES - 16);
    if (threadIdx.x < 2) xst[threadIdx.x] = 0u;
    __syncthreads();
    const unsigned xcc = xcd_barrier_post((unsigned*)(a_in.ws + WS_BAR), xst, (int)threadIdx.x).x;
    for (int ph = ph_lo; ph < ph_hi; ++ph) {
#if defined(__HIP_DEVICE_COMPILE__)
        typedef const __attribute__((address_space(4))) unsigned long long* cu64p4;
        cu64p4 ap = (cu64p4)__builtin_amdgcn_kernarg_segment_ptr();
        asm volatile("" : "+s"(ap));
        Args a;
#pragma unroll
        for (int i = 0; i < 17; ++i) a.in[i] = (const float*)ap[i];
        a.out = (float*)ap[17]; a.ws = (unsigned char*)ap[18]; a.ph_lo = ph_lo; a.ph_hi = ph_hi;
#else
        const Args a = a_in;
#endif
        int tid = threadIdx.x, G = gridDim.x, bid = blockIdx.x;
        asm volatile("" : "+v"(tid)); asm volatile("" : "+s"(G)); asm volatile("" : "+s"(bid));
        unsigned char* ws = a.ws;
        bf16* Wb = (bf16*)(ws + WS_W);
        bf16* QKV = (bf16*)(ws + WS_R1); bf16* U = QKV + (size_t)CH * 2304; bf16* GV = U + (size_t)CH * 1024; bf16* GT = GV + (size_t)CH * 1024;
        bf16* AF = (bf16*)(ws + WS_R1);
        bf16* MG = GV;
        bf16* OUTG = (bf16*)(ws + WS_R2); bf16* OA = OUTG + (size_t)3 * CH * 256; float* LSE = (float*)(OA + (size_t)CH * 256);
        bf16* FG = (bf16*)(ws + WS_R2);
        bf16* XB = (bf16*)(ws + WS_XB); float* SS = (float*)(ws + WS_SS); float* SSV = (float*)(ws + WS_SSV);
        if (ph < NP0) p0_weights(a, lds, tid, G, bid);
        else {
            const int chunk = (ph - NP0) / PH_PER_CHUNK, sub = (ph - NP0) % PH_PER_CHUNK;
            const int S = chunk == 0 ? 8192 : 2048;
            if (sub == 0) { p0x(a, chunk, tid, G, bid); if (PROBE_KIND == 10) p0x(a, chunk, tid, G, bid); }
            else if (sub == PH_PER_CHUNK - 1) pfinal(a, chunk, tid, G, bid);
            else {
                const int l = (sub - 1) / KPL, ki = (sub - 1) % KPL, k = (KPL == 9 && ki > PROBE_DUPK) ? ki - 1 : ki; const bool dup = (KPL == 9 && ki == PROBE_DUPK + 1);
                const bf16* wl = Wb + (size_t)l * W_LAYER;
                float* X = a.out + (size_t)chunk * CH * DM;
                if (k == 0 && !(SKIPMASK & 1)) {
                    pg8::Gemm g{XB, wl + OFF_IN, CH, NIN, DM}; pg8::StaticOrder So; So.init(CH, NIN, G, bid);
                    pg8::EpiIn E{QKV, U, GV, GT, SS, SSV};
                    pg8::gemm_phase<pg8::EpiIn, pg8::StaticOrder, true, true>(lds, g, So, E, tid);
                } else if (k == 1 && !(SKIPMASK & 2)) {
                    constexpr int NATT = 3 * (CH / 64), NSGW = (CH / 128) * 16;
                    if (!(SKIPMASK & 1024) && !(dup && PROBE_KIND == 8)) attn_phase(QKV, OUTG, LSE, (const float*)(ws + WS_BT), lds, S, tid, G, bid);
                    if (!(SKIPMASK & 2048) && (!dup || PROBE_KIND == 8)) {
                        bf16* UO = dup ? (bf16*)(ws + WS_R2 + (size_t)CH * 2096) : U;
                        const int wave = __builtin_amdgcn_readfirstlane(tid >> 6);
                        for (int wu = bid * 8 + wave; wu < NSGW; wu += G * 8) sg_wave_unit(U, UO, GV, SSV, wl + OFF_WS, a.in[5] + l * 1024, a.in[7] + l * 1024, lds + wave * SG_WLDS, wu, tid & 63);
                    }
                } else if (k == 2 && !(SKIPMASK & 4)) p_merge(OUTG, LSE, OA, tid, G, bid);
                else if (k == 3 && !(SKIPMASK & 8)) {
                    if (!(SKIPMASK & 4096)) { int kpa = 256; asm volatile("" : "+s"(kpa)); pg8::Gemm g{OA, wl + OFF_PA, CH, DM, kpa}; pg8::StaticOrder So; So.init(CH, DM, G, bid);
                      pg8::EpiGate<0> E{MG, GT, 0};
                      pg8::gemm_phase<pg8::EpiGate<0>, pg8::StaticOrder, true, true>(lds, g, So, E, tid); }
                    if (!(SKIPMASK & 8192)) { pg8::Gemm g{U, wl + OFF_PB, CH, DM, DM}; pg8::StaticOrder So; So.init(CH, DM, G, bid);
                      pg8::EpiGate<1> E{MG, GT, 1024};
                      pg8::gemm_phase<pg8::EpiGate<1>, pg8::StaticOrder, true, true>(lds, g, So, E, tid); }
                } else if (k == 4 && !(SKIPMASK & 16)) {
                    pg8::Gemm g{MG, wl + OFF_OUT, CH, DM, DM}; pg8::StaticOrder So; So.init(CH, DM, G, bid);
                    pg8::EpiRes E{dup ? QKV + (size_t)CH * 1024 : (bf16*)(ws + WS_XL), dup ? QKV : XB, dup ? SSV : SS};
                    pg8::gemm_phase<pg8::EpiRes, pg8::StaticOrder, true, true>(lds, g, So, E, tid);
                } else if (k == 5 && !(SKIPMASK & 32)) {
                    pg8::Gemm g{XB, wl + OFF_UP, CH, NUP, DM}; pg8::StaticOrder So; So.init(CH, NUP, G, bid);
                    pg8::EpiUpConv E{FG, (bf16*)(ws + WS_SB), SS, a.in[13] + (size_t)l * 3 * NUP, a.in[14] + (size_t)l * NUP};
                    pg8::gemm_phase<pg8::EpiUpConv, pg8::StaticOrder, true, true>(lds, g, So, E, tid);
                } else if (k == 6 && !(SKIPMASK & 64)) p_convfix((const bf16*)(ws + WS_SB), FG, a.in[13] + (size_t)l * 3 * NUP, a.in[14] + (size_t)l * NUP, S, tid, G, bid);
                else if (!(SKIPMASK & 128)) {
                    pg8::Gemm g{FG, wl + OFF_DN, CH, DM, DFF}; pg8::StaticOrder So; So.init(CH, DM, G, bid);
                    pg8::EpiRes E{dup ? QKV + (size_t)CH * 1024 : (bf16*)(ws + WS_XL), dup ? QKV : XB, dup ? SSV : SS};
                    pg8::gemm_phase<pg8::EpiRes, pg8::StaticOrder, true, true>(lds, g, So, E, tid);
                }
            }
        }
        if (ph + 1 < ph_hi) {
            if (ph == ph_lo) grid.sync();
            XcdBarrier xb; xb.bar = (unsigned*)(a.ws + WS_BAR); xb.x = xcc; xb.st = xst;
            xcd_barrier(xb, tid);
            if (PROBE_KIND == 100) xcd_barrier(xb, tid);
        }
    }
}

extern "C" void kernel_launch(void* const* d_in, const int* in_sizes, int n_in, void* d_out, int out_size, void* d_ws, size_t ws_size, hipStream_t stream) {
    static int grid = 0;
    if (grid == 0) {
        if (n_in != 17 || out_size != NTOK * DM || ws_size < WS_END) { fprintf(stderr, "kernel_launch: unexpected shapes: n_in %d out %d ws %zu (need %zu)\n", n_in, out_size, ws_size, (size_t)WS_END); grid = -1; return; }
        int dev = 0, cus = 0, per_cu = 0;
        (void)hipGetDevice(&dev); (void)hipDeviceGetAttribute(&cus, hipDeviceAttributeMultiprocessorCount, dev);
        if (hipFuncSetAttribute((const void*)fwd_kernel, hipFuncAttributeMaxDynamicSharedMemorySize, LDS_BYTES) != hipSuccess) { fprintf(stderr, "kernel_launch: hipFuncSetAttribute failed\n"); grid = -1; return; }
        if (hipOccupancyMaxActiveBlocksPerMultiprocessor(&per_cu, (const void*)fwd_kernel, NTHR, LDS_BYTES) != hipSuccess || per_cu < 1) { fprintf(stderr, "kernel_launch: occupancy query says %d\n", per_cu); per_cu = 1; }
        (void)hipGetLastError();
        grid = cus * per_cu;
        if (grid <= 0) grid = 256;
    }
    if (grid < 0) return;
    if (hipMemsetAsync((char*)d_ws + WS_BAR, 0, 65536, stream) != hipSuccess) { fprintf(stderr, "kernel_launch: memset failed\n"); return; }
    Args a{};
    for (int i = 0; i < 17; ++i) a.in[i] = (const float*)d_in[i];
    a.out = (float*)d_out; a.ws = (unsigned char*)d_ws;
#if ONE_LAUNCH
    a.ph_lo = 0; a.ph_hi = N_PHASES;
    void* args[] = {&a};
    hipError_t e = hipLaunchCooperativeKernel((const void*)fwd_kernel, dim3(grid), dim3(NTHR), args, LDS_BYTES, stream);
    if (e != hipSuccess) fprintf(stderr, "cooperative launch failed: %s (grid %d)\n", hipGetErrorString(e), grid);
#else
    for (int ph = 0; ph < N_PHASES; ++ph) {
        a.ph_lo = ph; a.ph_hi = ph + 1;
        hipLaunchKernelGGL(fwd_kernel, dim3(grid), dim3(NTHR), LDS_BYTES, stream, a);
    }
#endif
}
```

```cpp
#include <hip/hip_runtime.h>
#include <hip/hip_cooperative_groups.h>
#include <cstdio>
#include <cstdint>
namespace cg = cooperative_groups;

#ifndef ONE_LAUNCH
#define ONE_LAUNCH 1
#endif

namespace pg8 {
#define PG8_LAS __attribute__((address_space(3)))
typedef unsigned short bf16_t;
typedef short bf16x8 __attribute__((ext_vector_type(8)));
typedef float f32x4 __attribute__((ext_vector_type(4)));
typedef unsigned u32x4 __attribute__((ext_vector_type(4)));
constexpr int BM = 256, BK = 64, HALF = 128, HTB = HALF * BK * 2  , STAGE_BYTES = 8 * HTB, NXCD = 8, WGM = 8;

__host__ __device__ __forceinline__ int lds_byte(int r, int c) { const int st = (r >> 4) * 2 + (c >> 5), rr = r & 15, cc = c & 31, ob = rr * 64 + cc * 2; return st * 1024 + (ob ^ (((ob >> 9) & 1) << 5)); }
__host__ __device__ __forceinline__ void stage_rc(int b, int& R, int& C) { const int st = b / 1024, sb = b % 1024, swz = sb ^ (((sb >> 9) & 1) << 5); R = (st >> 1) * 16 + swz / 64; C = (st & 1) * 32 + (swz % 64) / 2; }
__host__ __device__ __forceinline__ int perm32(int rho) { const int n = rho >> 4, i = rho & 15; return 8 * (i >> 2) + 4 * n + (i & 3); }

struct Unit { int pm, pn; };
struct Gemm { const bf16_t* A; const bf16_t* Bt; int M, N, K; };

struct StaticOrder {
    int nM, nN, nwg, G, c;
    __host__ __device__ void init(int M, int N, int G_, int c_) { nM = M / BM; nN = N / BM; nwg = nM * nN; G = G_; c = c_; }
    __host__ __device__ bool next(int i, Unit& u) const {
        const long L = (long)i * G + c; if (L >= nwg) return false;
        int wgid = (int)L; { const int q = nwg / NXCD, r = nwg % NXCD, xcd = wgid % NXCD, off = wgid / NXCD; wgid = (xcd < r ? xcd * (q + 1) : r * (q + 1) + (xcd - r) * q) + off; }
        const int nig = WGM * nN, gid = wgid / nig, fm = gid * WGM, gsz = (nM - fm) < WGM ? (nM - fm) : WGM;
        u.pm = fm + ((wgid % nig) % gsz); u.pn = (wgid % nig) / gsz; return true;
    }
    __device__ __forceinline__ void a_ready(const Unit&) const {}
    __device__ __forceinline__ void done(const Unit&) const {}
};

__device__ __forceinline__ unsigned cvt_pk_bf16(float lo, float hi) { unsigned r; asm volatile("v_cvt_pk_bf16_f32 %0, %1, %2" : "=v"(r) : "v"(lo), "v"(hi)); return r; }

__device__ __forceinline__ float fast_sigmoid(float x) { return __builtin_amdgcn_rcpf(1.0f + __builtin_amdgcn_exp2f(-1.4426950408889634f * x)); }
__device__ __forceinline__ float gelu_tanh(float x) {
    const float y = x * (1.0f + 0.044715f * x * x) * (2.0f * 0.7978845608028654f);
    return x * __builtin_amdgcn_rcpf(1.0f + __builtin_amdgcn_exp2f(-1.4426950408889634f * y));
}
__device__ __forceinline__ float bf2f(unsigned short b) { return __uint_as_float(((unsigned)b) << 16); }
__device__ __forceinline__ u32x4 pack8(const f32x4 a, const f32x4 b) { u32x4 w; w.x = cvt_pk_bf16(a[0], a[1]); w.y = cvt_pk_bf16(a[2], a[3]); w.z = cvt_pk_bf16(b[0], b[1]); w.w = cvt_pk_bf16(b[2], b[3]); return w; }
__device__ __forceinline__ void unpack8(const u32x4 w, f32x4& a, f32x4& b) {
    a[0] = __uint_as_float(w.x << 16); a[1] = __uint_as_float(w.x & 0xffff0000u); a[2] = __uint_as_float(w.y << 16); a[3] = __uint_as_float(w.y & 0xffff0000u);
    b[0] = __uint_as_float(w.z << 16); b[1] = __uint_as_float(w.z & 0xffff0000u); b[2] = __uint_as_float(w.w << 16); b[3] = __uint_as_float(w.w & 0xffff0000u);
}
__device__ __forceinline__ float row_rs(const float* ss, int row) {
    const f32x4* sp = (const f32x4*)(ss + (size_t)row * 16);
    const f32x4 s = (sp[0] + sp[1]) + (sp[2] + sp[3]);
    return rsqrtf(((s[0] + s[1]) + (s[2] + s[3])) * (1.0f / 1024.0f) + 1e-6f);
}

__device__ __forceinline__ void rows_rs(const float* ss, int row0, int fq, float (&rsv)[2][4]) {
    f32x4 part[2][4];
#pragma unroll
    for (int ai = 0; ai < 2; ++ai)
#pragma unroll
        for (int m = 0; m < 4; ++m) part[ai][m] = *(const f32x4*)(ss + (size_t)(row0 + ai * HALF + m * 16) * 16 + fq * 4);
#pragma unroll
    for (int ai = 0; ai < 2; ++ai)
#pragma unroll
        for (int m = 0; m < 4; ++m) { float t = (part[ai][m][0] + part[ai][m][1]) + (part[ai][m][2] + part[ai][m][3]); t += __shfl_xor(t, 16); t += __shfl_xor(t, 32); rsv[ai][m] = rsqrtf(t * (1.0f / 1024.0f) + 1e-6f); }
}

struct EpiIn {
    static constexpr bool PERM = true, AFTER_DRAIN = false;
    bf16_t* QKV; bf16_t* U; bf16_t* GV; bf16_t* G; const float* ss; float* ssv;
    __device__ __forceinline__ void operator()(const f32x4 (&acc)[2][2][4][2], const Unit& u, int wr, int wc, int fr, int fq) const {
        const int pn = u.pn;
        float rsv[2][4]; rows_rs(ss, u.pm * BM + wr * 64 + fr, fq, rsv);
#pragma unroll
        for (int ai = 0; ai < 2; ++ai)
#pragma unroll
            for (int m = 0; m < 4; ++m) {
                const int row = u.pm * BM + ai * HALF + wr * 64 + m * 16 + fr;
                const float rs = rsv[ai][m];
                float q = 0.f;
#pragma unroll
                for (int bj = 0; bj < 2; ++bj) {
                    const int col = pn * BM + bj * HALF + wc * 32 + 8 * fq;
                    f32x4 v0 = acc[ai][bj][m][0] * rs, v1 = acc[ai][bj][m][1] * rs;
                    bf16_t* dst;
                    if (pn < 9) { if (pn < 3) { v0 = v0 * (0.125f * 1.4426950408889634f); v1 = v1 * (0.125f * 1.4426950408889634f); }     dst = QKV + (size_t)row * 2304 + col; }
                    else if (pn < 17) {
#pragma unroll
                        for (int e = 0; e < 4; ++e) { v0[e] = gelu_tanh(v0[e]); v1[e] = gelu_tanh(v1[e]); }
                        if (pn < 13) dst = U + (size_t)row * 1024 + (col - 2304);
                        else { dst = GV + (size_t)row * 1024 + (col - 3328);
#pragma unroll
                            for (int e = 0; e < 4; ++e) q += v0[e] * v0[e] + v1[e] * v1[e]; }
                    } else {
#pragma unroll
                        for (int e = 0; e < 4; ++e) { v0[e] = fast_sigmoid(v0[e]); v1[e] = fast_sigmoid(v1[e]); }
                        dst = G + (size_t)row * 2048 + (col - 4352);
                    }
                    *(u32x4*)dst = pack8(v0, v1);
                }
                if (pn >= 13 && pn < 17) { q += __shfl_xor(q, 16); q += __shfl_xor(q, 32); if (fq == 0) ssv[(size_t)row * 16 + (pn - 13) * 4 + wc] = q; }
                asm volatile("" ::: "memory");
            }
    }
};
template <int MODE> struct EpiGate {
    static constexpr bool PERM = true, AFTER_DRAIN = false;
    bf16_t* O; const bf16_t* G; int goff;
    __device__ __forceinline__ void operator()(const f32x4 (&acc)[2][2][4][2], const Unit& u, int wr, int wc, int fr, int fq) const {
#pragma unroll
        for (int ai = 0; ai < 2; ++ai) {
            u32x4 gw[4][2], pw[4][2];
#pragma unroll
            for (int m = 0; m < 4; ++m)
#pragma unroll
                for (int bj = 0; bj < 2; ++bj) {
                    const int row = u.pm * BM + ai * HALF + wr * 64 + m * 16 + fr, col = u.pn * BM + bj * HALF + wc * 32 + 8 * fq;
                    gw[m][bj] = *(const u32x4*)(G + (size_t)row * 2048 + goff + col);
                    if (MODE == 1) pw[m][bj] = *(const u32x4*)(O + (size_t)row * 1024 + col);
                }
#pragma unroll
            for (int m = 0; m < 4; ++m)
#pragma unroll
                for (int bj = 0; bj < 2; ++bj) {
                    const int row = u.pm * BM + ai * HALF + wr * 64 + m * 16 + fr, col = u.pn * BM + bj * HALF + wc * 32 + 8 * fq;
                    f32x4 g0, g1; unpack8(gw[m][bj], g0, g1);
                    f32x4 v0 = acc[ai][bj][m][0] * g0, v1 = acc[ai][bj][m][1] * g1;
                    if (MODE == 1) { f32x4 p0, p1; unpack8(pw[m][bj], p0, p1); v0 = v0 + p0; v1 = v1 + p1; }
                    *(u32x4*)(O + (size_t)row * 1024 + col) = pack8(v0, v1);
                }
            asm volatile("" ::: "memory");
        }
    }
};
struct EpiRes {
    static constexpr bool PERM = true, AFTER_DRAIN = false;
    bf16_t* XL; bf16_t* XB; float* ss;
    __device__ __forceinline__ void operator()(const f32x4 (&acc)[2][2][4][2], const Unit& u, int wr, int wc, int fr, int fq) const {
#pragma unroll
        for (int ai = 0; ai < 2; ++ai)
#pragma unroll
        for (int mp = 0; mp < 2; ++mp) {
            u32x4 hv[2][2], lv[2][2];
#pragma unroll
            for (int mi = 0; mi < 2; ++mi)
#pragma unroll
                for (int bj = 0; bj < 2; ++bj) {
                    const size_t off = (size_t)(u.pm * BM + ai * HALF + wr * 64 + (2 * mp + mi) * 16 + fr) * 1024 + u.pn * BM + bj * HALF + wc * 32 + 8 * fq;
                    hv[mi][bj] = *(const u32x4*)(XB + off); lv[mi][bj] = *(const u32x4*)(XL + off);
                }
#pragma unroll
            for (int mi = 0; mi < 2; ++mi) {
                const int m = 2 * mp + mi, row = u.pm * BM + ai * HALF + wr * 64 + m * 16 + fr;
                float q = 0.f;
#pragma unroll
                for (int bj = 0; bj < 2; ++bj) {
                    const size_t off = (size_t)row * 1024 + u.pn * BM + bj * HALF + wc * 32 + 8 * fq;
                    f32x4 h0, h1, l0, l1; unpack8(hv[mi][bj], h0, h1); unpack8(lv[mi][bj], l0, l1);
                    const f32x4 x0 = (h0 + l0) + acc[ai][bj][m][0], x1 = (h1 + l1) + acc[ai][bj][m][1];
                    const u32x4 hw = pack8(x0, x1);
                    unpack8(hw, h0, h1);
                    *(u32x4*)(XB + off) = hw; *(u32x4*)(XL + off) = pack8(x0 - h0, x1 - h1);
#pragma unroll
                    for (int e = 0; e < 4; ++e) q += x0[e] * x0[e] + x1[e] * x1[e];
                }
                q += __shfl_xor(q, 16); q += __shfl_xor(q, 32);
                if (fq == 0) ss[(size_t)row * 16 + u.pn * 4 + wc] = q;
            }
            asm volatile("" ::: "memory");
        }
    }
};
struct EpiUp {
    static constexpr bool PERM = true, AFTER_DRAIN = false;
    bf16_t* A; const float* ss;
    __device__ __forceinline__ void operator()(const f32x4 (&acc)[2][2][4][2], const Unit& u, int wr, int wc, int fr, int fq) const {
        float rsv[2][4]; rows_rs(ss, u.pm * BM + wr * 64 + fr, fq, rsv);
#pragma unroll
        for (int ai = 0; ai < 2; ++ai)
#pragma unroll
            for (int m = 0; m < 4; ++m) {
                const int row = u.pm * BM + ai * HALF + wr * 64 + m * 16 + fr;
                const float rs = rsv[ai][m];
#pragma unroll
                for (int bj = 0; bj < 2; ++bj) {
                    const int col = u.pn * BM + bj * HALF + wc * 32 + 8 * fq;
                    *(u32x4*)(A + (size_t)row * 5632 + col) = pack8(acc[ai][bj][m][0] * rs, acc[ai][bj][m][1] * rs);
                }
                asm volatile("" ::: "memory");
            }
    }
};

__device__ __forceinline__ float dpp_prev(float x) { return __int_as_float(__builtin_amdgcn_update_dpp(0, __float_as_int(x), 0x121, 0xf, 0xf, false)); }
__device__ __forceinline__ float dpp_next(float x) { return __int_as_float(__builtin_amdgcn_update_dpp(0, __float_as_int(x), 0x12F, 0xf, 0xf, false)); }
__device__ __forceinline__ f32x4 rot_prev(const f32x4 v) { f32x4 r; r[0] = dpp_prev(v[0]); r[1] = dpp_prev(v[1]); r[2] = dpp_prev(v[2]); r[3] = dpp_prev(v[3]); return r; }
__device__ __forceinline__ f32x4 rot_next(const f32x4 v) { f32x4 r; r[0] = dpp_next(v[0]); r[1] = dpp_next(v[1]); r[2] = dpp_next(v[2]); r[3] = dpp_next(v[3]); return r; }
struct EpiUpConv {
    static constexpr bool PERM = true, AFTER_DRAIN = false;
    bf16_t* FG; bf16_t* SB; const float* ss; const float* cw; const float* cb;
    __device__ __forceinline__ void operator()(const f32x4 (&acc_)[2][2][4][2], const Unit& u, int wr, int wc, int fr, int fq) const {
        f32x4 (&acc)[2][2][4][2] = const_cast<f32x4 (&)[2][2][4][2]>(acc_);
        float rsv[2][4]; rows_rs(ss, u.pm * BM + wr * 64 + fr, fq, rsv);
        const int f0 = u.pn * 128 + wc * 32 + 8 * fq;
        const bool first = fr == 0, last = fr == 15;
#pragma unroll
        for (int ai = 0; ai < 2; ++ai) {
#pragma unroll
            for (int m = 0; m < 4; ++m)
#pragma unroll
                for (int h = 0; h < 2; ++h) { acc[ai][h][m][0] = acc[ai][h][m][0] * rsv[ai][m]; acc[ai][h][m][1] = acc[ai][h][m][1] * rsv[ai][m]; }
            const int blk = (u.pm * BM + ai * HALF + wr * 64) >> 6;
            if (fr <= 1) { bf16_t* sp = SB + ((size_t)blk * 4 + fr) * 5632 + f0;
                *(u32x4*)sp = pack8(acc[ai][0][0][0], acc[ai][0][0][1]); *(u32x4*)(sp + 2816) = pack8(acc[ai][1][0][0], acc[ai][1][0][1]); }
            if (fr >= 14) { bf16_t* sp = SB + ((size_t)blk * 4 + (fr - 12)) * 5632 + f0;
                *(u32x4*)sp = pack8(acc[ai][0][3][0], acc[ai][0][3][1]); *(u32x4*)(sp + 2816) = pack8(acc[ai][1][3][0], acc[ai][1][3][1]); }
        }
#pragma unroll
        for (int n = 0; n < 2; ++n) {
            f32x4 w[2][4];
#pragma unroll
            for (int h = 0; h < 2; ++h) {
#pragma unroll
                for (int k = 0; k < 3; ++k) w[h][k] = *(const f32x4*)(cw + k * 5632 + h * 2816 + f0 + 4 * n);
                w[h][3] = *(const f32x4*)(cb + h * 2816 + f0 + 4 * n);
            }
#pragma unroll
            for (int ai = 0; ai < 2; ++ai) {
#pragma unroll
                for (int m = 0; m < 4; ++m) {
                    const int row = u.pm * BM + ai * HALF + wr * 64 + m * 16 + fr;
                    f32x4 cv[2];
#pragma unroll
                    for (int h = 0; h < 2; ++h) {
                        const f32x4 cur = acc[ai][h][m][n];
                        f32x4 pv = rot_prev(cur), nx = rot_next(cur);
                        if (m > 0) { const f32x4 pw = rot_prev(acc[ai][h][m - 1][n]);
#pragma unroll
                            for (int e = 0; e < 4; ++e) pv[e] = first ? pw[e] : pv[e]; }
                        if (m < 3) { const f32x4 nw = rot_next(acc[ai][h][m + 1][n]);
#pragma unroll
                            for (int e = 0; e < 4; ++e) nx[e] = last ? nw[e] : nx[e]; }
                        cv[h] = pv * w[h][0] + cur * w[h][1] + nx * w[h][2] + w[h][3];
                    }
                    f32x4 o;
#pragma unroll
                    for (int e = 0; e < 4; ++e) o[e] = gelu_tanh(cv[0][e]) * cv[1][e];
                    const bool brow = (m == 0 && first) || (m == 3 && last);
                    if (!brow) { typedef unsigned u32x2e __attribute__((ext_vector_type(2))); u32x2e ow; ow.x = cvt_pk_bf16(o[0], o[1]); ow.y = cvt_pk_bf16(o[2], o[3]); *(u32x2e*)(FG + (size_t)row * 2816 + f0 + 4 * n) = ow; }
                }
                asm volatile("" ::: "memory");
            }
        }
    }
};

template <class Epi, class Sched, bool ALIGN_EPI = false, bool SP2 = false>
__device__ __forceinline__ void gemm_phase(PG8_LAS unsigned char* lds, const Gemm g, const Sched& S, const Epi& E, const int tid) {
    const int wid = __builtin_amdgcn_readfirstlane(tid >> 6), lane = tid & 63, wr = wid >> 2, wc = wid & 3, fr = lane & 15, fq = lane >> 4;
    const int K = g.K, nt = K / BK;
    unsigned voffA[2], voffB[2];
#pragma unroll
    for (int i = 0; i < 2; ++i) { int R, C; stage_rc(tid * 16 + i * 8192, R, C); const int Rb = Epi::PERM ? ((R & ~31) + perm32(R & 31)) : R;
        voffA[i] = (unsigned)(R * K + C) * 2u; voffB[i] = (unsigned)(Rb * K + C) * 2u; }
    const size_t kstep = (size_t)(BK * 2);
    const size_t hstep = (size_t)HALF * K * 2;
    const size_t tstep = 2 * hstep;
    const unsigned ldsw = (unsigned)wid * 1024u;
    const int aoff = lds_byte(wr * 64 + fr, fq * 8), boff = lds_byte(wc * 32 + fr, fq * 8);
#define PG8_SA(b, h) (((b) * 2 + (h)) * HTB)
#define PG8_SB(b, h) ((4 + (b) * 2 + (h)) * HTB)
#define PG8_STAGE(bufoff, gbase, voff) do { _Pragma("unroll") for (int _i = 0; _i < 2; ++_i) \
        __builtin_amdgcn_global_load_lds((const unsigned*)((const char*)(gbase) + (voff)[_i]), (PG8_LAS unsigned*)(lds + (bufoff) + ldsw + _i * 8192), 16, 0, 0); } while (0)
#define PG8_LDA(dst, b, h) do { _Pragma("unroll") for (int m = 0; m < 4; ++m) _Pragma("unroll") for (int k = 0; k < 2; ++k) dst[m][k] = *(const PG8_LAS bf16x8*)(lds + PG8_SA(b, h) + aoff + m * 2048 + k * 1024); } while (0)
#define PG8_LDB(dst, b, h) do { _Pragma("unroll") for (int n = 0; n < 2; ++n) _Pragma("unroll") for (int k = 0; k < 2; ++k) dst[n][k] = *(const PG8_LAS bf16x8*)(lds + PG8_SB(b, h) + boff + n * 2048 + k * 1024); } while (0)
#define PG8_MMA(ai, bj, At, Bt) do { __builtin_amdgcn_s_setprio(1); _Pragma("unroll") for (int m = 0; m < 4; ++m) _Pragma("unroll") for (int n = 0; n < 2; ++n) _Pragma("unroll") for (int k = 0; k < 2; ++k) \
        acc[ai][bj][m][n] = __builtin_amdgcn_mfma_f32_16x16x32_bf16(Bt[n][k], At[m][k], acc[ai][bj][m][n], 0, 0, 0); __builtin_amdgcn_s_setprio(0); } while (0)
#define PG8_WAIT_V(n) asm volatile("s_waitcnt vmcnt(" #n ")" ::: "memory")
#define PG8_WAIT_L(n) asm volatile("s_waitcnt lgkmcnt(" #n ")" ::: "memory")
#define PG8_BAR __builtin_amdgcn_s_barrier()
#define PG8_SCHED __builtin_amdgcn_sched_barrier(0)
    Unit cur, nxt; int ui = 0;
    if (!S.next(0, cur)) return;
    f32x4 acc[2][2][4][2];
#pragma unroll
    for (int a = 0; a < 2; ++a)
#pragma unroll
        for (int b = 0; b < 2; ++b)
#pragma unroll
            for (int m = 0; m < 4; ++m)
#pragma unroll
                for (int n = 0; n < 2; ++n) acc[a][b][m][n] = (f32x4){0.f, 0.f, 0.f, 0.f};
    bf16x8 At[4][2], B0[2][2], B1[2][2];
    const char* cA = (const char*)g.A + (size_t)cur.pm * tstep; const char* cB = (const char*)g.Bt + (size_t)cur.pn * tstep;
    S.a_ready(cur);
    if constexpr (SP2) {
        PG8_STAGE(PG8_SB(0, 0), cB, voffB); PG8_STAGE(PG8_SB(0, 1), cB + hstep, voffB); PG8_STAGE(PG8_SA(0, 0), cA, voffA); PG8_STAGE(PG8_SA(0, 1), cA + hstep, voffA);
        if (wr == 1) PG8_BAR;
        PG8_WAIT_V(2); PG8_BAR;
        PG8_STAGE(PG8_SB(1, 0), cB + kstep, voffB); PG8_STAGE(PG8_SA(1, 0), cA + kstep, voffA); PG8_STAGE(PG8_SB(1, 1), cB + hstep + kstep, voffB);
        PG8_WAIT_V(6); PG8_BAR;
    } else {
        PG8_STAGE(PG8_SB(0, 0), cB, voffB); PG8_STAGE(PG8_SA(0, 0), cA, voffA); PG8_STAGE(PG8_SB(0, 1), cB + hstep, voffB); PG8_STAGE(PG8_SA(0, 1), cA + hstep, voffA);
        if (wr == 1) PG8_BAR;
        PG8_WAIT_V(4); PG8_BAR;
        PG8_STAGE(PG8_SB(1, 0), cB + kstep, voffB); PG8_STAGE(PG8_SA(1, 0), cA + kstep, voffA); PG8_STAGE(PG8_SB(1, 1), cB + hstep + kstep, voffB);
        PG8_WAIT_V(6); PG8_BAR;
    }
    for (;;) {
        const bool has_next = S.next(ui + 1, nxt);
        const char* nA = has_next ? (const char*)g.A + (size_t)nxt.pm * tstep : cA; const char* nB = has_next ? (const char*)g.Bt + (size_t)nxt.pn * tstep : cB;
        for (int t = 0; t < nt; t += 2) {
            const bool last = (t == nt - 2);
            const char* a1 = cA + (size_t)(t + 1) * kstep;
            const char* a2 = last ? nA : cA + (size_t)(t + 2) * kstep; const char* b2 = last ? nB : cB + (size_t)(t + 2) * kstep;
            const char* a3 = a2 + kstep; const char* b3 = b2 + kstep;
            if (last && has_next) S.a_ready(nxt);
            if constexpr (SP2) {
            PG8_LDB(B0, 0, 0); PG8_LDB(B1, 0, 1); PG8_SCHED; PG8_LDA(At, 0, 0); PG8_STAGE(PG8_SA(1, 1), a1 + hstep, voffA);
            PG8_WAIT_V(8); PG8_WAIT_L(0); PG8_BAR; PG8_MMA(0, 0, At, B0); PG8_MMA(0, 1, At, B1); PG8_BAR; PG8_SCHED;
            PG8_LDA(At, 0, 1); PG8_STAGE(PG8_SB(0, 0), b2, voffB); PG8_STAGE(PG8_SB(0, 1), b2 + hstep, voffB); PG8_STAGE(PG8_SA(0, 0), a2, voffA);
            PG8_WAIT_V(8); PG8_WAIT_L(0); PG8_BAR; PG8_MMA(1, 0, At, B0); PG8_MMA(1, 1, At, B1); PG8_BAR; PG8_SCHED;
            PG8_LDB(B0, 1, 0); PG8_LDB(B1, 1, 1); PG8_SCHED; PG8_LDA(At, 1, 0); PG8_STAGE(PG8_SA(0, 1), a2 + hstep, voffA);
            PG8_WAIT_V(8); PG8_WAIT_L(0); PG8_BAR; PG8_MMA(0, 0, At, B0); PG8_MMA(0, 1, At, B1); PG8_BAR; PG8_SCHED;
            PG8_LDA(At, 1, 1); PG8_STAGE(PG8_SB(1, 0), b3, voffB); PG8_STAGE(PG8_SB(1, 1), b3 + hstep, voffB); PG8_STAGE(PG8_SA(1, 0), a3, voffA);
            PG8_WAIT_V(8); PG8_WAIT_L(0); PG8_BAR; PG8_MMA(1, 0, At, B0); PG8_MMA(1, 1, At, B1); PG8_BAR; PG8_SCHED;
            } else {
            PG8_LDB(B0, 0, 0); PG8_SCHED; PG8_LDA(At, 0, 0); PG8_STAGE(PG8_SA(1, 1), a1 + hstep, voffA);
            PG8_WAIT_L(8); PG8_BAR; PG8_WAIT_L(0); PG8_MMA(0, 0, At, B0); PG8_BAR; PG8_SCHED;
            PG8_LDB(B1, 0, 1); PG8_STAGE(PG8_SB(0, 0), b2, voffB);
            PG8_BAR; PG8_WAIT_L(0); PG8_MMA(0, 1, At, B1); PG8_BAR;
            PG8_LDA(At, 0, 1); PG8_STAGE(PG8_SA(0, 0), a2, voffA);
            PG8_BAR; PG8_WAIT_L(0); PG8_MMA(1, 0, At, B0); PG8_BAR; PG8_SCHED;
            PG8_STAGE(PG8_SB(0, 1), b2 + hstep, voffB);
            PG8_WAIT_V(6); PG8_BAR; PG8_MMA(1, 1, At, B1); PG8_BAR;
            PG8_LDB(B0, 1, 0); PG8_SCHED; PG8_LDA(At, 1, 0); PG8_STAGE(PG8_SA(0, 1), a2 + hstep, voffA);
            PG8_WAIT_L(8); PG8_BAR; PG8_WAIT_L(0); PG8_MMA(0, 0, At, B0); PG8_BAR; PG8_SCHED;
            PG8_LDB(B1, 1, 1); PG8_STAGE(PG8_SB(1, 0), b3, voffB);
            PG8_BAR; PG8_WAIT_L(0); PG8_MMA(0, 1, At, B1); PG8_BAR;
            PG8_LDA(At, 1, 1); PG8_STAGE(PG8_SA(1, 0), a3, voffA);
            PG8_BAR; PG8_WAIT_L(0); PG8_MMA(1, 0, At, B0); PG8_BAR; PG8_SCHED;
            PG8_STAGE(PG8_SB(1, 1), b3 + hstep, voffB);
            PG8_WAIT_V(6); PG8_BAR; PG8_MMA(1, 1, At, B1); PG8_BAR;
            }
        }
        if constexpr (ALIGN_EPI) { if (wr == 0) PG8_BAR; }
        if constexpr (!Epi::AFTER_DRAIN) { E(acc, cur, wr, wc, fr, fq); S.done(cur); }
        if (!has_next) break;
#pragma unroll
        for (int a = 0; a < 2; ++a)
#pragma unroll
            for (int b = 0; b < 2; ++b)
#pragma unroll
                for (int m = 0; m < 4; ++m)
#pragma unroll
                    for (int n = 0; n < 2; ++n) acc[a][b][m][n] = (f32x4){0.f, 0.f, 0.f, 0.f};
        cur = nxt; cA = nA; cB = nB; ++ui;
        if constexpr (ALIGN_EPI) { if (wr == 1) PG8_BAR; }
    }
    PG8_WAIT_V(0);
    if constexpr (!ALIGN_EPI) { if (wr == 0) PG8_BAR; }
    PG8_BAR;
    if constexpr (Epi::AFTER_DRAIN) { E.fused(acc, cur, wr, wc, fr, fq, lds, wid, lane); S.done(cur); }
#undef PG8_SA
#undef PG8_SB
#undef PG8_STAGE
#undef PG8_LDA
#undef PG8_LDB
#undef PG8_MMA
#undef PG8_WAIT_V
#undef PG8_WAIT_L
#undef PG8_BAR
#undef PG8_SCHED
}
}


#define LAS __attribute__((address_space(3)))
#ifndef SKIPMASK
#define SKIPMASK 0
#endif
#ifndef PROBE_KIND
#define PROBE_KIND -1
#endif
typedef unsigned short bf16;
using pg8::f32x4; using pg8::u32x4; using pg8::bf16x8;
typedef float f32x16 __attribute__((ext_vector_type(16)));
typedef short v4i16_t __attribute__((ext_vector_type(4)));
typedef unsigned u32x2 __attribute__((ext_vector_type(2)));

constexpr int DM = 1024, DEPTH = 4, NTOK = 98304, NPROMPT = 32768, CH = 32768, NCHUNK = NTOK / CH;
constexpr int NIN = 6400, DFF = 2816, NUP = 5632;
constexpr int LDS_BYTES = 147456, NTHR = 512;
constexpr float EPS = 1e-6f, LOG2E = 1.4426950408889634f;
constexpr size_t OFF_IN = 0, OFF_PA = OFF_IN + (size_t)NIN * DM, OFF_PB = OFF_PA + (size_t)DM * 256, OFF_OUT = OFF_PB + (size_t)DM * DM, OFF_UP = OFF_OUT + (size_t)DM * DM,
                 OFF_DN = OFF_UP + (size_t)NUP * DM, OFF_WS = OFF_DN + (size_t)DM * DFF, W_LAYER = OFF_WS + 8 * 128 * 128;
constexpr size_t MiB = 1u << 20;
constexpr size_t WS_W = 0, WS_R1 = 144 * MiB, WS_R2 = WS_R1 + (size_t)CH * 12800, WS_XB = WS_R2 + (size_t)CH * 5632, WS_SS = WS_XB + (size_t)CH * 2048, WS_SSV = WS_SS + (size_t)CH * 64, WS_BAR = WS_SSV + (size_t)CH * 64, WS_SB = WS_BAR + 65536, WS_XL = WS_SB + (size_t)(CH / 64) * 4 * 5632 * 2, WS_BT = WS_XL + (size_t)CH * 2048, WS_END = WS_BT + 16384;
static_assert(W_LAYER * 2 * DEPTH <= WS_R1, "weights fit");
constexpr int PROBE_DUPK = (PROBE_KIND == 8) ? 1 : PROBE_KIND;
constexpr int KPL = (PROBE_DUPK >= 0 && PROBE_DUPK < 8) ? 9 : 8;
constexpr int NP0 = (PROBE_KIND == 9) ? 2 : 1;
constexpr int PH_PER_CHUNK = 2 + KPL * DEPTH, N_PHASES = NP0 + NCHUNK * PH_PER_CHUNK;

struct Args { const float* in[17]; float* out; unsigned char* ws; int ph_lo, ph_hi; };

__device__ __forceinline__ float wave_sum(float v) {
#pragma unroll
    for (int o = 1; o < 64; o <<= 1) v += __shfl_xor(v, o);
    return v;
}
__device__ __forceinline__ unsigned pk2(float lo, float hi) { return pg8::cvt_pk_bf16(lo, hi); }
#define LDS_WAIT() asm volatile("s_waitcnt lgkmcnt(0)" ::: "memory")

__device__ __forceinline__ int t5_bucket(int rel) {
    const int n = rel < 0 ? -rel : rel;
    const int b = n < 8 ? n : 8 + (n >= 15) + (n >= 27) + (n >= 50) + (n >= 91) + (n >= 166) + (n >= 305) + (n >= 559);
    return (rel > 0 ? 16 : 0) + b;
}
__device__ __forceinline__ void tr_item(const float* W, int K, int N, bf16* WT, const float* gain, LAS float* scr, int item, int lane, bool perm_up = false) {
    const int nblk = N / 32, kb = item / nblk, nb = item % nblk, k0 = 64 * kb, n0 = 32 * nb;
    const int dn0 = perm_up ? ((n0 % DFF) / 128) * 256 + (n0 / DFF) * 128 + (n0 % 128) : n0;
#pragma unroll
    for (int i = 0; i < 8; ++i) {
        const int kk = (lane >> 3) + 8 * i, c4 = 4 * (lane & 7); const float g = gain ? gain[k0 + kk] : 1.0f;
        const f32x4 v = *(const f32x4*)(W + (size_t)(k0 + kk) * N + n0 + c4);
        scr[kk * 33 + c4 + 0] = v[0] * g; scr[kk * 33 + c4 + 1] = v[1] * g; scr[kk * 33 + c4 + 2] = v[2] * g; scr[kk * 33 + c4 + 3] = v[3] * g;
    }
    LDS_WAIT();
    const int c = lane & 7;
#pragma unroll
    for (int j = 0; j < 4; ++j) { const int n = (lane >> 3) + 8 * j; const LAS float* s = scr + (8 * c) * 33 + n;
        u32x4 o; o.x = pk2(s[0 * 33], s[1 * 33]); o.y = pk2(s[2 * 33], s[3 * 33]); o.z = pk2(s[4 * 33], s[5 * 33]); o.w = pk2(s[6 * 33], s[7 * 33]);
        *(u32x4*)(WT + (size_t)(dn0 + n) * K + k0 + 8 * c) = o; }
    LDS_WAIT();
}
__device__ __forceinline__ void p0_weights(const Args& a, LAS unsigned char* lds, int tid, int G, int bid) {
    const int wave = tid >> 6, lane = tid & 63;
    LAS float* scr = (LAS float*)(lds + wave * 16384);
    const int gw = bid * 8 + wave, NGW = G * 8;
    constexpr int I_IN = 16 * 200, I_PA = 4 * 32, I_PB = 16 * 32, I_OUT = 16 * 32, I_UP = 16 * 176, I_DN = 44 * 32, PER = I_IN + I_PA + I_PB + I_OUT + I_UP + I_DN;
    bf16* Wb = (bf16*)(a.ws + WS_W);
    for (int it = gw; it < DEPTH * PER; it += NGW) {
        const int l = it / PER; int r = it % PER; bf16* wl = Wb + (size_t)l * W_LAYER;
        if (r < I_IN) { tr_item(a.in[4] + (size_t)l * DM * NIN, DM, NIN, wl + OFF_IN, a.in[3] + l * DM, scr, r, lane); continue; } r -= I_IN;
        if (r < I_PA) { tr_item(a.in[8] + (size_t)l * 256 * DM, 256, DM, wl + OFF_PA, nullptr, scr, r, lane); continue; } r -= I_PA;
        if (r < I_PB) { tr_item(a.in[9] + (size_t)l * DM * DM, DM, DM, wl + OFF_PB, nullptr, scr, r, lane); continue; } r -= I_PB;
        if (r < I_OUT) { tr_item(a.in[10] + (size_t)l * DM * DM, DM, DM, wl + OFF_OUT, nullptr, scr, r, lane); continue; } r -= I_OUT;
        if (r < I_UP) { tr_item(a.in[12] + (size_t)l * DM * NUP, DM, NUP, wl + OFF_UP, a.in[11] + l * DM, scr, r, lane, true); continue; } r -= I_UP;
        tr_item(a.in[15] + (size_t)l * DFF * DM, DFF, DM, wl + OFF_DN, nullptr, scr, r, lane);
    }
    if (bid == 0) {
        float* BT = (float*)(a.ws + WS_BT);
        for (int i = tid; i < 3 * 768; i += NTHR) { const int g = i / 768, hh = (i % 768) / 192, j = i % 192 - 96;
            BT[i] = (j >= -64 && j <= 64) ? LOG2E * a.in[2][t5_bucket(j << (2 * g)) * 12 + g * 4 + hh] : -1e30f; }
    }
    for (int i = bid * NTHR + tid; i < DEPTH * 131072 / 4; i += G * NTHR) {
        const int l = i / 32768, e = (i % 32768) * 4;
        const f32x4 v = *(const f32x4*)(a.in[6] + (size_t)l * 131072 + e);
        u32x2 o; o.x = pk2(v[0], v[1]); o.y = pk2(v[2], v[3]);
        *(u32x2*)(Wb + (size_t)l * W_LAYER + OFF_WS + e) = o;
    }
}
__device__ __forceinline__ void p0x(const Args& a, int chunk, int tid, int G, int bid) {
    const int wave = tid >> 6, lane = tid & 63, gw = bid * 8 + wave, NGW = G * 8;
    bf16* XB = (bf16*)(a.ws + WS_XB); bf16* XL = (bf16*)(a.ws + WS_XL); float* SS = (float*)(a.ws + WS_SS);
    for (int m = gw; m < CH; m += NGW) {
        const size_t tok = (size_t)chunk * CH + m;
        const float* src = tok < NPROMPT ? a.in[0] + tok * DM : a.in[1] + (tok - NPROMPT) * DM;
        float s = 0.f;
#pragma unroll
        for (int j = 0; j < 4; ++j) { const f32x4 v = *(const f32x4*)(src + (lane + 64 * j) * 4); s += (v[0] * v[0] + v[1] * v[1]) + (v[2] * v[2] + v[3] * v[3]);
            u32x2 o; o.x = pk2(v[0], v[1]); o.y = pk2(v[2], v[3]); *(u32x2*)(XB + (size_t)m * DM + (lane + 64 * j) * 4) = o;
            u32x2 lo; lo.x = pk2(v[0] - __uint_as_float(o.x << 16), v[1] - __uint_as_float(o.x & 0xffff0000u)); lo.y = pk2(v[2] - __uint_as_float(o.y << 16), v[3] - __uint_as_float(o.y & 0xffff0000u));
            *(u32x2*)(XL + (size_t)m * DM + (lane + 64 * j) * 4) = lo; }
        s = wave_sum(s);
        if (lane < 16) SS[(size_t)m * 16 + lane] = lane == 0 ? s : 0.f;
    }
}
__device__ __forceinline__ void pfinal(const Args& a, int chunk, int tid, int G, int bid) {
    const int wave = tid >> 6, lane = tid & 63, gw = bid * 8 + wave, NGW = G * 8;
    const bf16* XB = (const bf16*)(a.ws + WS_XB); const bf16* XL = (const bf16*)(a.ws + WS_XL);
    const float* SS = (const float*)(a.ws + WS_SS); const float* nf = a.in[16];
    for (int m = gw; m < CH; m += NGW) {
        float* x = a.out + ((size_t)chunk * CH + m) * DM;
        const float rs = pg8::row_rs(SS, m);
#pragma unroll
        for (int j = 0; j < 2; ++j) { const int c = (lane + 64 * j) * 8; f32x4 h0, h1, l0, l1;
            pg8::unpack8(*(const u32x4*)(XB + (size_t)m * DM + c), h0, h1); pg8::unpack8(*(const u32x4*)(XL + (size_t)m * DM + c), l0, l1);
            *(f32x4*)(x + c) = (h0 + l0) * rs * *(const f32x4*)(nf + c); *(f32x4*)(x + c + 4) = (h1 + l1) * rs * *(const f32x4*)(nf + c + 4); }
    }
}
struct AttU { int g, d, L, tokbase, qb; };
__device__ __forceinline__ AttU att_decode(int unit, int S) {
    constexpr int upg = CH / 64;
    AttU u; u.g = unit / upg; const int rem = unit % upg, ups = S / 64, seq = rem / ups, rem2 = rem % ups;
    u.d = 1 << (2 * u.g); u.L = S / u.d; const int nqb = u.L / 64, r = rem2 / nqb; u.qb = rem2 % nqb; u.tokbase = seq * S + r;
    return u;
}
template <int KT0, int KT1, bool WITHQ>
__device__ __forceinline__ void att_load_qk(const bf16* QKV, const AttU& u, int h, int qh, int n, int hi, bf16x8 (&qf)[4], bf16x8 (&kf)[5][4]) {
    const int qbase = 64 * u.qb + 32 * qh;
    if (WITHQ) {
        const bf16* qp = QKV + ((size_t)u.tokbase + (size_t)(qbase + n) * u.d) * 2304 + u.g * 256 + h * 64 + 8 * hi;
#pragma unroll
        for (int s = 0; s < 4; ++s) qf[s] = *(const bf16x8*)(qp + 16 * s);
    }
#pragma unroll
    for (int kt = KT0; kt < KT1; ++kt) {
        const int lk = qbase - 64 + 32 * kt + n, lkc = lk < 0 ? 0 : (lk > u.L - 1 ? u.L - 1 : lk);
        const bf16* kp = QKV + (size_t)(u.tokbase + lkc * u.d) * 2304 + 768 + u.g * 256 + h * 64 + 8 * hi;
#pragma unroll
        for (int s = 0; s < 4; ++s) kf[kt][s] = *(const bf16x8*)(kp + 16 * s);
    }
}
__device__ __forceinline__ void attn_phase(const bf16* QKV, bf16* OUTG, float* LSE, const float* BT, LAS unsigned char* lds, int S, int tid, int G, int bid) {
    constexpr int NATT = 3 * (CH / 64);
    const int wave = tid >> 6, lane = tid & 63;
    const int h = wave & 3, qh = wave >> 2, n = lane & 31, hi = lane >> 5;
    int it = (G % 8 == 0) ? (bid & 7) * (G / 8) + (bid >> 3) : bid;
    if (it >= NATT) return;
    AttU u = att_decode(it, S);
    bf16x8 qf[4], kf[5][4];
    att_load_qk<0, 4, false>(QKV, u, h, qh, n, hi, qf, kf);
    for (; it < NATT; it += G) {
        const int g = u.g, d = u.d, L = u.L, tokbase = u.tokbase, qb = u.qb, qbase = 64 * qb + 32 * qh;
        const size_t tokq = (size_t)tokbase + (size_t)(qbase + n) * d;
        att_load_qk<4, 5, true>(QKV, u, h, qh, n, hi, qf, kf);
        u32x4 vv[12];
        int tl = tid; asm volatile("" : "+v"(tl));
#pragma unroll
        for (int i = 0; i < 12; ++i) {
            const int idx = tl + i * NTHR, kk = idx >> 5, ch = idx & 31, lk = 64 * qb - 64 + kk;
            vv[i] = (u32x4){0u, 0u, 0u, 0u};
            if (lk >= 0 && lk < L) vv[i] = *(const u32x4*)(QKV + (size_t)(tokbase + lk * d) * 2304 + 1536 + g * 256 + ch * 8);
        }
        const float bt0 = BT[g * 768 + tid], bt1 = tid < 256 ? BT[g * 768 + 512 + tid] : 0.f;
        f32x16 st[5];
#pragma unroll
        for (int kt = 0; kt < 5; ++kt) {
            f32x16 acc;
#pragma unroll
            for (int e = 0; e < 16; ++e) acc[e] = 0.f;
#pragma unroll
            for (int s = 0; s < 4; ++s) acc = __builtin_amdgcn_mfma_f32_32x32x16_bf16(kf[kt][s], qf[s], acc, 0, 0, 0);
            st[kt] = acc;
        }
#pragma unroll
        for (int i = 0; i < 12; ++i) { const int idx = tl + i * NTHR, kk = idx >> 5, ch = idx & 31; *(LAS u32x4*)(lds + kk * 576 + ch * 16) = vv[i]; }
        LAS float* bt = (LAS float*)(lds + 110592);
        bt[tid] = bt0; if (tid < 256) bt[512 + tid] = bt1;
        asm volatile("" :: "v"(st[4][15]) : "memory");
        AttU un = u;
        if (it + G < NATT) { un = att_decode(it + G, S); att_load_qk<0, 4, false>(QKV, un, h, qh, n, hi, qf, kf); }
        __syncthreads();
        float mx = -3.0e38f;
        {
            const LAS float* btl = bt + h * 192 + 32 + 4 * hi - n;
            const bool edge = (qb == 0) || (64 * qb + 128 > L);
#pragma unroll
            for (int kt = 0; kt < 5; ++kt)
#pragma unroll
                for (int i = 0; i < 16; ++i) {
                    float sv = st[kt][i] + btl[32 * kt + (i & 3) + 8 * (i >> 2)];
                    if (edge) { const int lk2 = qbase - 64 + 32 * kt + (i & 3) + 8 * (i >> 2) + 4 * hi; sv = (lk2 >= 0 && lk2 < L) ? sv : -1e30f; }
                    st[kt][i] = sv; mx = fmaxf(mx, sv);
                }
        }
        mx = fmaxf(mx, __shfl_xor(mx, 32));
        float sum = 0.f;
#pragma unroll
        for (int kt = 0; kt < 5; ++kt)
#pragma unroll
            for (int i = 0; i < 16; ++i) { const float pe = __builtin_amdgcn_exp2f(st[kt][i] - mx); st[kt][i] = pe; sum += pe; }
        sum += __shfl_xor(sum, 32);
        const float inv = 1.0f / sum, lse = (mx + __log2f(sum)) * 0.6931471805599453f;
        f32x16 o0, o1;
#pragma unroll
        for (int e = 0; e < 16; ++e) { o0[e] = 0.f; o1[e] = 0.f; }
        const int q4 = (lane & 15) >> 2, p4 = lane & 3, gsel = (lane >> 4) & 1;
        const unsigned vbase = (unsigned)((32 * qh + 4 * hi + q4) * 576 + h * 128 + (16 * gsel + 4 * p4) * 2);
#pragma unroll
        for (int kt = 0; kt < 5; ++kt)
#pragma unroll
            for (int s2 = 0; s2 < 2; ++s2) {
                u32x4 pw; pw.x = pk2(st[kt][8 * s2 + 0], st[kt][8 * s2 + 1]); pw.y = pk2(st[kt][8 * s2 + 2], st[kt][8 * s2 + 3]); pw.z = pk2(st[kt][8 * s2 + 4], st[kt][8 * s2 + 5]); pw.w = pk2(st[kt][8 * s2 + 6], st[kt][8 * s2 + 7]);
                const bf16x8 pf = __builtin_bit_cast(bf16x8, pw);
                const unsigned ro = vbase + (unsigned)((32 * kt + 16 * s2) * 576);
                {
                    const v4i16_t r1 = __builtin_amdgcn_ds_read_tr16_b64_v4i16((LAS v4i16_t*)(lds + ro)), r2 = __builtin_amdgcn_ds_read_tr16_b64_v4i16((LAS v4i16_t*)(lds + ro + 8 * 576));
                    const bf16x8 vf = (bf16x8){r1[0], r1[1], r1[2], r1[3], r2[0], r2[1], r2[2], r2[3]};
                    o0 = __builtin_amdgcn_mfma_f32_32x32x16_bf16(vf, pf, o0, 0, 0, 0);
                }
                {
                    const v4i16_t r1 = __builtin_amdgcn_ds_read_tr16_b64_v4i16((LAS v4i16_t*)(lds + ro + 64)), r2 = __builtin_amdgcn_ds_read_tr16_b64_v4i16((LAS v4i16_t*)(lds + ro + 64 + 8 * 576));
                    const bf16x8 vf = (bf16x8){r1[0], r1[1], r1[2], r1[3], r2[0], r2[1], r2[2], r2[3]};
                    o1 = __builtin_amdgcn_mfma_f32_32x32x16_bf16(vf, pf, o1, 0, 0, 0);
                }
            }
        bf16* op = OUTG + ((size_t)g * CH + tokq) * 256 + h * 64;
#pragma unroll
        for (int grp = 0; grp < 4; ++grp) {
            u32x2 w0, w1;
            w0.x = pk2(o0[4 * grp + 0] * inv, o0[4 * grp + 1] * inv); w0.y = pk2(o0[4 * grp + 2] * inv, o0[4 * grp + 3] * inv);
            w1.x = pk2(o1[4 * grp + 0] * inv, o1[4 * grp + 1] * inv); w1.y = pk2(o1[4 * grp + 2] * inv, o1[4 * grp + 3] * inv);
            *(u32x2*)(op + 8 * grp + 4 * hi) = w0; *(u32x2*)(op + 32 + 8 * grp + 4 * hi) = w1;
        }
        if (hi == 0) LSE[((size_t)g * CH + tokq) * 4 + h] = lse;
        __syncthreads();
        u = un;
    }
}
constexpr int SG_WLDS = 17920;
__device__ __forceinline__ void sg_wave_unit(bf16* U, bf16* UO, const bf16* GV, const float* ssv, const bf16* WSb, const float* gain, const float* bs, LAS unsigned char* wl, int unit, int lane) {
    const int hf = unit & 1, gg = (unit >> 1) & 7, nch = unit >> 4, tok0 = nch * 128, cb = gg * 128 + hf * 64;
    LAS float* rvl = (LAS float*)(wl + 17408);
    rvl[lane] = pg8::row_rs(ssv, tok0 + lane); rvl[lane + 64] = pg8::row_rs(ssv, tok0 + lane + 64);
    LDS_WAIT();
    {
        const int c8 = lane & 7, q0 = lane >> 3;
#pragma unroll
        for (int i = 0; i < 16; ++i) {
            const int q = q0 + 8 * i;
            f32x4 a0, a1; pg8::unpack8(*(const u32x4*)(GV + (size_t)(tok0 + q) * 1024 + cb + c8 * 8), a0, a1);
            const float r = rvl[q];
            const u32x4 w = pg8::pack8(a0 * r, a1 * r);
            *(LAS u32x2*)(wl + q * 136 + c8 * 16) = (u32x2){w.x, w.y}; *(LAS u32x2*)(wl + q * 136 + c8 * 16 + 8) = (u32x2){w.z, w.w};
        }
    }
    LDS_WAIT();
    const int ln = lane & 15, kq = lane >> 4, qq = ln >> 2, pp = ln & 3;
    bf16x8 afr[4][4];
#pragma unroll
    for (int ct = 0; ct < 4; ++ct)
#pragma unroll
        for (int ks = 0; ks < 4; ++ks) {
            const unsigned ad = (unsigned)((32 * ks + 8 * kq + qq) * 136 + (32 * (ct >> 1) + 8 * pp + 4 * (ct & 1)) * 2);
            const v4i16_t r1 = __builtin_amdgcn_ds_read_tr16_b64_v4i16((LAS v4i16_t*)(wl + ad)), r2 = __builtin_amdgcn_ds_read_tr16_b64_v4i16((LAS v4i16_t*)(wl + ad + 4 * 136));
            afr[ct][ks] = (bf16x8){r1[0], r1[1], r1[2], r1[3], r2[0], r2[1], r2[2], r2[3]};
        }
    f32x4 gn[2][2];
#pragma unroll
    for (int t = 0; t < 2; ++t) { gn[t][0] = *(const f32x4*)(gain + cb + 32 * t + 8 * kq); gn[t][1] = *(const f32x4*)(gain + cb + 32 * t + 8 * kq + 4); }
#pragma unroll 2
    for (int pt = 0; pt < 8; ++pt) {
        const int pr = pt * 16 + ln;
        bf16x8 bfr[4];
#pragma unroll
        for (int ks = 0; ks < 4; ++ks) bfr[ks] = *(const bf16x8*)(WSb + (size_t)gg * 16384 + pr * 128 + 32 * ks + 8 * kq);
        bf16* up = U + (size_t)(tok0 + pr) * 1024 + cb + 8 * kq; bf16* uo = UO + (size_t)(tok0 + pr) * 1024 + cb + 8 * kq;
        const u32x4 uw0 = *(const u32x4*)up, uw1 = *(const u32x4*)(up + 32);
        const float bias = bs[gg * 128 + pr];
        f32x4 acc[4];
#pragma unroll
        for (int ct = 0; ct < 4; ++ct) {
            acc[ct] = (f32x4){0.f, 0.f, 0.f, 0.f};
#pragma unroll
            for (int ks = 0; ks < 4; ++ks) acc[ct] = __builtin_amdgcn_mfma_f32_16x16x32_bf16(afr[ct][ks], bfr[ks], acc[ct], 0, 0, 0);
        }
        f32x4 u0, u1;
        pg8::unpack8(uw0, u0, u1);
        *(u32x4*)uo = pg8::pack8(u0 * (gn[0][0] * acc[0] + bias), u1 * (gn[0][1] * acc[1] + bias));
        pg8::unpack8(uw1, u0, u1);
        *(u32x4*)(uo + 32) = pg8::pack8(u0 * (gn[1][0] * acc[2] + bias), u1 * (gn[1][1] * acc[3] + bias));
    }
    LDS_WAIT();
}
__device__ __forceinline__ void p_merge(const bf16* OUTG, const float* LSE, bf16* OA, int tid, int G, int bid) {
    for (int it = bid * NTHR + tid; it < CH * 32; it += G * NTHR) {
        const int tok = it >> 5, c8 = it & 31, h = c8 >> 3;
        const float l0 = LSE[(size_t)tok * 4 + h], l1 = LSE[((size_t)CH + tok) * 4 + h], l2 = LSE[((size_t)2 * CH + tok) * 4 + h];
        const float mx = fmaxf(l0, fmaxf(l1, l2));
        float w0 = __expf(l0 - mx), w1 = __expf(l1 - mx), w2 = __expf(l2 - mx);
        const float inv = 1.0f / (w0 + w1 + w2); w0 *= inv; w1 *= inv; w2 *= inv;
        f32x4 a0, a1, b0, b1, c0, c1;
        pg8::unpack8(*(const u32x4*)(OUTG + (size_t)tok * 256 + c8 * 8), a0, a1);
        pg8::unpack8(*(const u32x4*)(OUTG + ((size_t)CH + tok) * 256 + c8 * 8), b0, b1);
        pg8::unpack8(*(const u32x4*)(OUTG + ((size_t)2 * CH + tok) * 256 + c8 * 8), c0, c1);
        *(u32x4*)(OA + (size_t)tok * 256 + c8 * 8) = pg8::pack8(a0 * w0 + b0 * w1 + c0 * w2, a1 * w0 + b1 * w1 + c1 * w2);
    }
}
__device__ __forceinline__ void p_conv(const bf16* A, bf16* FG, const float* cw, const float* cb, int S, int tid, int G, int bid) {
    constexpr int RUN = 8, NFC = DFF / 8;
    for (int it = bid * NTHR + tid; it < (CH / RUN) * NFC; it += G * NTHR) {
        const int fc = it % NFC, t0 = (it / NFC) * RUN, f = fc * 8;
        f32x4 wg[3][2], wv[3][2], bg[2], bv[2];
#pragma unroll
        for (int k = 0; k < 3; ++k) { wg[k][0] = *(const f32x4*)(cw + k * NUP + f); wg[k][1] = *(const f32x4*)(cw + k * NUP + f + 4); wv[k][0] = *(const f32x4*)(cw + k * NUP + DFF + f); wv[k][1] = *(const f32x4*)(cw + k * NUP + DFF + f + 4); }
        bg[0] = *(const f32x4*)(cb + f); bg[1] = *(const f32x4*)(cb + f + 4); bv[0] = *(const f32x4*)(cb + DFF + f); bv[1] = *(const f32x4*)(cb + DFF + f + 4);
        const f32x4 z4 = (f32x4){0.f, 0.f, 0.f, 0.f};
        f32x4 pg0 = z4, pg1 = z4, pv0 = z4, pv1 = z4, cg0, cg1, cv0, cv1;
        if ((t0 & (S - 1)) != 0) { pg8::unpack8(*(const u32x4*)(A + (size_t)(t0 - 1) * NUP + f), pg0, pg1); pg8::unpack8(*(const u32x4*)(A + (size_t)(t0 - 1) * NUP + DFF + f), pv0, pv1); }
        pg8::unpack8(*(const u32x4*)(A + (size_t)t0 * NUP + f), cg0, cg1); pg8::unpack8(*(const u32x4*)(A + (size_t)t0 * NUP + DFF + f), cv0, cv1);
#pragma unroll
        for (int i = 0; i < RUN; ++i) {
            const int t = t0 + i;
            f32x4 ng0 = z4, ng1 = z4, nv0 = z4, nv1 = z4;
            if (((t + 1) & (S - 1)) != 0) { pg8::unpack8(*(const u32x4*)(A + (size_t)(t + 1) * NUP + f), ng0, ng1); pg8::unpack8(*(const u32x4*)(A + (size_t)(t + 1) * NUP + DFF + f), nv0, nv1); }
            f32x4 g0 = pg0 * wg[0][0] + cg0 * wg[1][0] + ng0 * wg[2][0] + bg[0], g1 = pg1 * wg[0][1] + cg1 * wg[1][1] + ng1 * wg[2][1] + bg[1];
            const f32x4 v0 = pv0 * wv[0][0] + cv0 * wv[1][0] + nv0 * wv[2][0] + bv[0], v1 = pv1 * wv[0][1] + cv1 * wv[1][1] + nv1 * wv[2][1] + bv[1];
#pragma unroll
            for (int e = 0; e < 4; ++e) { g0[e] = pg8::gelu_tanh(g0[e]) * v0[e]; g1[e] = pg8::gelu_tanh(g1[e]) * v1[e]; }
            *(u32x4*)(FG + (size_t)t * DFF + f) = pg8::pack8(g0, g1);
            pg0 = cg0; pg1 = cg1; pv0 = cv0; pv1 = cv1; cg0 = ng0; cg1 = ng1; cv0 = nv0; cv1 = nv1;
        }
    }
}

__device__ __forceinline__ void p_convfix(const bf16* SB, bf16* FG, const float* cw, const float* cb, int S, int tid, int G, int bid) {
    constexpr int NFC = DFF / 8, NB = CH / 64;
    for (int it = bid * NTHR + tid; it < NB * 2 * NFC; it += G * NTHR) {
        const int fc = it % NFC, r2 = it / NFC, which = r2 & 1, b = r2 >> 1, f = fc * 8, t = b * 64 + (which ? 63 : 0);
        const f32x4 z4 = (f32x4){0.f, 0.f, 0.f, 0.f};
        f32x4 pg0 = z4, pg1 = z4, pv0 = z4, pv1 = z4, cg0, cg1, cv0, cv1, ng0 = z4, ng1 = z4, nv0 = z4, nv1 = z4;
        const bf16* bp = SB + (size_t)b * 4 * NUP + f;
        if (which == 0) {
            if ((t & (S - 1)) != 0) { pg8::unpack8(*(const u32x4*)(bp - NUP), pg0, pg1); pg8::unpack8(*(const u32x4*)(bp - NUP + DFF), pv0, pv1); }
            pg8::unpack8(*(const u32x4*)bp, cg0, cg1); pg8::unpack8(*(const u32x4*)(bp + DFF), cv0, cv1);
            pg8::unpack8(*(const u32x4*)(bp + NUP), ng0, ng1); pg8::unpack8(*(const u32x4*)(bp + NUP + DFF), nv0, nv1);
        } else {
            pg8::unpack8(*(const u32x4*)(bp + 2 * NUP), pg0, pg1); pg8::unpack8(*(const u32x4*)(bp + 2 * NUP + DFF), pv0, pv1);
            pg8::unpack8(*(const u32x4*)(bp + 3 * NUP), cg0, cg1); pg8::unpack8(*(const u32x4*)(bp + 3 * NUP + DFF), cv0, cv1);
            if (((t + 1) & (S - 1)) != 0) { pg8::unpack8(*(const u32x4*)(bp + 4 * NUP), ng0, ng1); pg8::unpack8(*(const u32x4*)(bp + 4 * NUP + DFF), nv0, nv1); }
        }
        f32x4 g0 = *(const f32x4*)(cb + f), g1 = *(const f32x4*)(cb + f + 4), v0 = *(const f32x4*)(cb + DFF + f), v1 = *(const f32x4*)(cb + DFF + f + 4);
        g0 = g0 + pg0 * *(const f32x4*)(cw + f) + cg0 * *(const f32x4*)(cw + NUP + f) + ng0 * *(const f32x4*)(cw + 2 * NUP + f);
        g1 = g1 + pg1 * *(const f32x4*)(cw + f + 4) + cg1 * *(const f32x4*)(cw + NUP + f + 4) + ng1 * *(const f32x4*)(cw + 2 * NUP + f + 4);
        v0 = v0 + pv0 * *(const f32x4*)(cw + DFF + f) + cv0 * *(const f32x4*)(cw + NUP + DFF + f) + nv0 * *(const f32x4*)(cw + 2 * NUP + DFF + f);
        v1 = v1 + pv1 * *(const f32x4*)(cw + DFF + f + 4) + cv1 * *(const f32x4*)(cw + NUP + DFF + f + 4) + nv1 * *(const f32x4*)(cw + 2 * NUP + DFF + f + 4);
#pragma unroll
        for (int e = 0; e < 4; ++e) { g0[e] = pg8::gelu_tanh(g0[e]) * v0[e]; g1[e] = pg8::gelu_tanh(g1[e]) * v1[e]; }
        *(u32x4*)(FG + (size_t)t * DFF + f) = pg8::pack8(g0, g1);
    }
}
#define XB_TMO      128
#define XB_XCNT(j)  (256  + 64 * (j))
#define XB_XSUB(j)  (1280 + 64 * (j))
#define XB_XGEN(j)  (2304 + 64 * (j))
#define XB_TOP      3328
#define XB_TOPGEN   3392
#define XCD_BAR_WORDS 3456
#define XB_SPIN_CAP (1u << 18)

__device__ __forceinline__ unsigned xb_ld(unsigned* p)              { return __hip_atomic_load(p, __ATOMIC_RELAXED, __HIP_MEMORY_SCOPE_AGENT); }
__device__ __forceinline__ unsigned xb_add(unsigned* p, unsigned v) { return __hip_atomic_fetch_add(p, v, __ATOMIC_RELAXED, __HIP_MEMORY_SCOPE_AGENT); }
__device__ __forceinline__ unsigned xb_xcc_id() { return (unsigned)__builtin_amdgcn_s_getreg((3 << 11) | 20) & 0xFu; }
#define XB_SPIN(cond, bar) do { unsigned _sp = 0; while (cond) { __builtin_amdgcn_s_sleep(1); \
    if ((++_sp & 255u) == 0u) { if (xb_ld(&(bar)[XB_TMO])) break; if (_sp > XB_SPIN_CAP) { atomicAdd(&(bar)[XB_TMO], 1u); break; } } } } while (0)

struct XcdBarrier {
    unsigned* bar; unsigned x;
    volatile LAS unsigned* st;
};

__device__ __forceinline__ XcdBarrier xcd_barrier_post(unsigned* bar, volatile LAS unsigned* st, const int tid) {
    XcdBarrier b; b.bar = bar; b.x = xb_xcc_id(); b.st = st;
    if (tid == 0) (void)xb_add(&bar[XB_XCNT(b.x)], 1u);
    return b;
}
__device__ __forceinline__ void xcd_barrier_complete(unsigned* bar, unsigned x, unsigned& nloc, unsigned& nx) {
    const unsigned G = gridDim.x * gridDim.y * gridDim.z;
    unsigned sum, cnt, mine, sp = 0u;
    for (;;) {
        sum = 0u; cnt = 0u; mine = 0u;
#pragma unroll
        for (unsigned j = 0; j < 16; ++j) { const unsigned c = xb_ld(&bar[XB_XCNT(j)]); sum += c; cnt += (c > 0u) ? 1u : 0u; mine = (j == x) ? c : mine; }
        if (sum == G) break;
        __builtin_amdgcn_s_sleep(1);
        if ((++sp & 255u) == 0u) { if (xb_ld(&bar[XB_TMO])) break; if (sp > XB_SPIN_CAP) { atomicAdd(&bar[XB_TMO], 1u); break; } }
    }
    nloc = mine > 0u ? mine : 1u; nx = cnt > 0u ? cnt : 1u;
}

__device__ __forceinline__ void xcd_barrier(const XcdBarrier& b, const int tid) {
    asm volatile("s_waitcnt vmcnt(0)" ::: "memory");
    __syncthreads();
    if (tid == 0) {
        unsigned* bar = b.bar;
        __builtin_amdgcn_s_waitcnt(0);
        unsigned nloc = b.st[0], nx = b.st[1];
        if (nloc == 0u) { xcd_barrier_complete(bar, b.x, nloc, nx); b.st[0] = nloc; b.st[1] = nx; }
        const unsigned old = xb_add(&bar[XB_XSUB(b.x)], 1u);
        const unsigned gen = old / nloc;
        if (old + 1u == (gen + 1u) * nloc) {
            __builtin_amdgcn_fence(__ATOMIC_RELEASE, "agent");
            asm volatile("s_waitcnt vmcnt(0)" ::: "memory");
            const unsigned og = xb_add(&bar[XB_TOP], 1u);
            const unsigned tg = og / nx;
            if (og + 1u == (tg + 1u) * nx) xb_add(&bar[XB_TOPGEN], 1u);
            else XB_SPIN(xb_ld(&bar[XB_TOPGEN]) == tg, bar);
            __builtin_amdgcn_fence(__ATOMIC_ACQUIRE, "agent");
            xb_add(&bar[XB_XGEN(b.x)], 1u);
            asm volatile("s_waitcnt vmcnt(0)" ::: "memory");
        } else {
            XB_SPIN(xb_ld(&bar[XB_XGEN(b.x)]) == gen, bar);
            __builtin_amdgcn_fence(__ATOMIC_ACQUIRE, "agent");
            asm volatile("s_waitcnt vmcnt(0)" ::: "memory");
        }
    }
    __syncthreads();
}


__global__ void __launch_bounds__(NTHR, 2) fwd_kernel(Args a_in) {
    extern __shared__ __attribute__((aligned(16))) unsigned char lds_raw[];
    LAS unsigned char* lds = (LAS unsigned char*)lds_raw;
    cg::grid_group grid = cg::this_grid();
    const int ph_lo = a_in.ph_lo, ph_hi = a_in.ph_hi;
    volatile LAS unsigned* xst = (volatile LAS unsigned*)(lds + LDS_BYTES - 16);
    if (threadIdx.x < 2) xst[threadIdx.x] = 0u;
    __syncthreads();
    const unsigned xcc = xcd_barrier_post((unsigned*)(a_in.ws + WS_BAR), xst, (int)threadIdx.x).x;
    for (int ph = ph_lo; ph < ph_hi; ++ph) {
#if defined(__HIP_DEVICE_COMPILE__)
        typedef const __attribute__((address_space(4))) unsigned long long* cu64p4;
        cu64p4 ap = (cu64p4)__builtin_amdgcn_kernarg_segment_ptr();
        asm volatile("" : "+s"(ap));
        Args a;
#pragma unroll
        for (int i = 0; i < 17; ++i) a.in[i] = (const float*)ap[i];
        a.out = (float*)ap[17]; a.ws = (unsigned char*)ap[18]; a.ph_lo = ph_lo; a.ph_hi = ph_hi;
#else
        const Args a = a_in;
#endif
        int tid = threadIdx.x, G = gridDim.x, bid = blockIdx.x;
        asm volatile("" : "+v"(tid)); asm volatile("" : "+s"(G)); asm volatile("" : "+s"(bid));
        unsigned char* ws = a.ws;
        bf16* Wb = (bf16*)(ws + WS_W);
        bf16* QKV = (bf16*)(ws + WS_R1); bf16* U = QKV + (size_t)CH * 2304; bf16* GV = U + (size_t)CH * 1024; bf16* GT = GV + (size_t)CH * 1024;
        bf16* AF = (bf16*)(ws + WS_R1);
        bf16* MG = GV;
        bf16* OUTG = (bf16*)(ws + WS_R2); bf16* OA = OUTG + (size_t)3 * CH * 256; float* LSE = (float*)(OA + (size_t)CH * 256);
        bf16* FG = (bf16*)(ws + WS_R2);
        bf16* XB = (bf16*)(ws + WS_XB); float* SS = (float*)(ws + WS_SS); float* SSV = (float*)(ws + WS_SSV);
        if (ph < NP0) p0_weights(a, lds, tid, G, bid);
        else {
            const int chunk = (ph - NP0) / PH_PER_CHUNK, sub = (ph - NP0) % PH_PER_CHUNK;
            const int S = chunk == 0 ? 8192 : 2048;
            if (sub == 0) { p0x(a, chunk, tid, G, bid); if (PROBE_KIND == 10) p0x(a, chunk, tid, G, bid); }
            else if (sub == PH_PER_CHUNK - 1) pfinal(a, chunk, tid, G, bid);
            else {
                const int l = (sub - 1) / KPL, ki = (sub - 1) % KPL, k = (KPL == 9 && ki > PROBE_DUPK) ? ki - 1 : ki; const bool dup = (KPL == 9 && ki == PROBE_DUPK + 1);
                const bf16* wl = Wb + (size_t)l * W_LAYER;
                float* X = a.out + (size_t)chunk * CH * DM;
                if (k == 0 && !(SKIPMASK & 1)) {
                    pg8::Gemm g{XB, wl + OFF_IN, CH, NIN, DM}; pg8::StaticOrder So; So.init(CH, NIN, G, bid);
                    pg8::EpiIn E{QKV, U, GV, GT, SS, SSV};
                    pg8::gemm_phase<pg8::EpiIn, pg8::StaticOrder, true, true>(lds, g, So, E, tid);
                } else if (k == 1 && !(SKIPMASK & 2)) {
                    constexpr int NATT = 3 * (CH / 64), NSGW = (CH / 128) * 16;
                    if (!(SKIPMASK & 1024) && !(dup && PROBE_KIND == 8)) attn_phase(QKV, OUTG, LSE, (const float*)(ws + WS_BT), lds, S, tid, G, bid);
                    if (!(SKIPMASK & 2048) && (!dup || PROBE_KIND == 8)) {
                        bf16* UO = dup ? (bf16*)(ws + WS_R2 + (size_t)CH * 2096) : U;
                        const int wave = __builtin_amdgcn_readfirstlane(tid >> 6);
                        for (int wu = bid * 8 + wave; wu < NSGW; wu += G * 8) sg_wave_unit(U, UO, GV, SSV, wl + OFF_WS, a.in[5] + l * 1024, a.in[7] + l * 1024, lds + wave * SG_WLDS, wu, tid & 63);
                    }
                } else if (k == 2 && !(SKIPMASK & 4)) p_merge(OUTG, LSE, OA, tid, G, bid);
                else if (k == 3 && !(SKIPMASK & 8)) {
                    if (!(SKIPMASK & 4096)) { int kpa = 256; asm volatile("" : "+s"(kpa)); pg8::Gemm g{OA, wl + OFF_PA, CH, DM, kpa}; pg8::StaticOrder So; So.init(CH, DM, G, bid);
                      pg8::EpiGate<0> E{MG, GT, 0};
                      pg8::gemm_phase<pg8::EpiGate<0>, pg8::StaticOrder, true, true>(lds, g, So, E, tid); }
                    if (!(SKIPMASK & 8192)) { pg8::Gemm g{U, wl + OFF_PB, CH, DM, DM}; pg8::StaticOrder So; So.init(CH, DM, G, bid);
                      pg8::EpiGate<1> E{MG, GT, 1024};
                      pg8::gemm_phase<pg8::EpiGate<1>, pg8::StaticOrder, true, true>(lds, g, So, E, tid); }
                } else if (k == 4 && !(SKIPMASK & 16)) {
                    pg8::Gemm g{MG, wl + OFF_OUT, CH, DM, DM}; pg8::StaticOrder So; So.init(CH, DM, G, bid);
                    pg8::EpiRes E{dup ? QKV + (size_t)CH * 1024 : (bf16*)(ws + WS_XL), dup ? QKV : XB, dup ? SSV : SS};
                    pg8::gemm_phase<pg8::EpiRes, pg8::StaticOrder, true, true>(lds, g, So, E, tid);
                } else if (k == 5 && !(SKIPMASK & 32)) {
                    pg8::Gemm g{XB, wl + OFF_UP, CH, NUP, DM}; pg8::StaticOrder So; So.init(CH, NUP, G, bid);
                    pg8::EpiUpConv E{FG, (bf16*)(ws + WS_SB), SS, a.in[13] + (size_t)l * 3 * NUP, a.in[14] + (size_t)l * NUP};
                    pg8::gemm_phase<pg8::EpiUpConv, pg8::StaticOrder, true, true>(lds, g, So, E, tid);
                } else if (k == 6 && !(SKIPMASK & 64)) p_convfix((const bf16*)(ws + WS_SB), FG, a.in[13] + (size_t)l * 3 * NUP, a.in[14] + (size_t)l * NUP, S, tid, G, bid);
                else if (!(SKIPMASK & 128)) {
                    pg8::Gemm g{FG, wl + OFF_DN, CH, DM, DFF}; pg8::StaticOrder So; So.init(CH, DM, G, bid);
                    pg8::EpiRes E{dup ? QKV + (size_t)CH * 1024 : (bf16*)(ws + WS_XL), dup ? QKV : XB, dup ? SSV : SS};
                    pg8::gemm_phase<pg8::EpiRes, pg8::StaticOrder, true, true>(lds, g, So, E, tid);
                }
            }
        }
        if (ph + 1 < ph_hi) {
            if (ph == ph_lo) grid.sync();
            XcdBarrier xb; xb.bar = (unsigned*)(a.ws + WS_BAR); xb.x = xcc; xb.st = xst;
            xcd_barrier(xb, tid);
            if (PROBE_KIND == 100) xcd_barrier(xb, tid);
        }
    }
}

extern "C" void kernel_launch(void* const* d_in, const int* in_sizes, int n_in, void* d_out, int out_size, void* d_ws, size_t ws_size, hipStream_t stream) {
    static int grid = 0;
    if (grid == 0) {
        if (n_in != 17 || out_size != NTOK * DM || ws_size < WS_END) { fprintf(stderr, "kernel_launch: unexpected shapes: n_in %d out %d ws %zu (need %zu)\n", n_in, out_size, ws_size, (size_t)WS_END); grid = -1; return; }
        int dev = 0, cus = 0, per_cu = 0;
        (void)hipGetDevice(&dev); (void)hipDeviceGetAttribute(&cus, hipDeviceAttributeMultiprocessorCount, dev);
        if (hipFuncSetAttribute((const void*)fwd_kernel, hipFuncAttributeMaxDynamicSharedMemorySize, LDS_BYTES) != hipSuccess) { fprintf(stderr, "kernel_launch: hipFuncSetAttribute failed\n"); grid = -1; return; }
        if (hipOccupancyMaxActiveBlocksPerMultiprocessor(&per_cu, (const void*)fwd_kernel, NTHR, LDS_BYTES) != hipSuccess || per_cu < 1) { fprintf(stderr, "kernel_launch: occupancy query says %d\n", per_cu); per_cu = 1; }
        (void)hipGetLastError();
        grid = cus * per_cu;
        if (grid <= 0) grid = 256;
    }
    if (grid < 0) return;
    if (hipMemsetAsync((char*)d_ws + WS_BAR, 0, 65536, stream) != hipSuccess) { fprintf(stderr, "kernel_launch: memset failed\n"); return; }
    Args a{};
    for (int i = 0; i < 17; ++i) a.in[i] = (const float*)d_in[i];
    a.out = (float*)d_out; a.ws = (unsigned char*)d_ws;
#if ONE_LAUNCH
    a.ph_lo = 0; a.ph_hi = N_PHASES;
    void* args[] = {&a};
    hipError_t e = hipLaunchCooperativeKernel((const void*)fwd_kernel, dim3(grid), dim3(NTHR), args, LDS_BYTES, stream);
    if (e != hipSuccess) fprintf(stderr, "cooperative launch failed: %s (grid %d)\n", hipGetErrorString(e), grid);
#else
    for (int ph = 0; ph < N_PHASES; ++ph) {
        a.ph_lo = ph; a.ph_hi = ph + 1;
        hipLaunchKernelGGL(fwd_kernel, dim3(grid), dim3(NTHR), LDS_BYTES, stream, a);
    }
#endif
}
```

```cpp
#include <hip/hip_runtime.h>
#include <hip/hip_cooperative_groups.h>
#include <cstdio>
#include <cstdint>
namespace cg = cooperative_groups;

#ifndef ONE_LAUNCH
#define ONE_LAUNCH 1
#endif

namespace pg8 {
#define PG8_LAS __attribute__((address_space(3)))
typedef unsigned short bf16_t;
typedef short bf16x8 __attribute__((ext_vector_type(8)));
typedef float f32x4 __attribute__((ext_vector_type(4)));
typedef unsigned u32x4 __attribute__((ext_vector_type(4)));
constexpr int BM = 256, BK = 64, HALF = 128, HTB = HALF * BK * 2  , STAGE_BYTES = 8 * HTB, NXCD = 8, WGM = 8;

__host__ __device__ __forceinline__ int lds_byte(int r, int c) { const int st = (r >> 4) * 2 + (c >> 5), rr = r & 15, cc = c & 31, ob = rr * 64 + cc * 2; return st * 1024 + (ob ^ (((ob >> 9) & 1) << 5)); }
__host__ __device__ __forceinline__ void stage_rc(int b, int& R, int& C) { const int st = b / 1024, sb = b % 1024, swz = sb ^ (((sb >> 9) & 1) << 5); R = (st >> 1) * 16 + swz / 64; C = (st & 1) * 32 + (swz % 64) / 2; }
__host__ __device__ __forceinline__ int perm32(int rho) { const int n = rho >> 4, i = rho & 15; return 8 * (i >> 2) + 4 * n + (i & 3); }

struct Unit { int pm, pn; };
struct Gemm { const bf16_t* A; const bf16_t* Bt; int M, N, K; };

struct StaticOrder {
    int nM, nN, nwg, G, c;
    __host__ __device__ void init(int M, int N, int G_, int c_) { nM = M / BM; nN = N / BM; nwg = nM * nN; G = G_; c = c_; }
    __host__ __device__ bool next(int i, Unit& u) const {
        const long L = (long)i * G + c; if (L >= nwg) return false;
        int wgid = (int)L; { const int q = nwg / NXCD, r = nwg % NXCD, xcd = wgid % NXCD, off = wgid / NXCD; wgid = (xcd < r ? xcd * (q + 1) : r * (q + 1) + (xcd - r) * q) + off; }
        const int nig = WGM * nN, gid = wgid / nig, fm = gid * WGM, gsz = (nM - fm) < WGM ? (nM - fm) : WGM;
        u.pm = fm + ((wgid % nig) % gsz); u.pn = (wgid % nig) / gsz; return true;
    }
    __device__ __forceinline__ void a_ready(const Unit&) const {}
    __device__ __forceinline__ void done(const Unit&) const {}
};

__device__ __forceinline__ unsigned cvt_pk_bf16(float lo, float hi) { unsigned r; asm volatile("v_cvt_pk_bf16_f32 %0, %1, %2" : "=v"(r) : "v"(lo), "v"(hi)); return r; }

__device__ __forceinline__ float fast_sigmoid(float x) { return __builtin_amdgcn_rcpf(1.0f + __builtin_amdgcn_exp2f(-1.4426950408889634f * x)); }
__device__ __forceinline__ float gelu_tanh(float x) {
    const float y = x * (1.0f + 0.044715f * x * x) * (2.0f * 0.7978845608028654f);
    return x * __builtin_amdgcn_rcpf(1.0f + __builtin_amdgcn_exp2f(-1.4426950408889634f * y));
}
__device__ __forceinline__ float bf2f(unsigned short b) { return __uint_as_float(((unsigned)b) << 16); }
__device__ __forceinline__ u32x4 pack8(const f32x4 a, const f32x4 b) { u32x4 w; w.x = cvt_pk_bf16(a[0], a[1]); w.y = cvt_pk_bf16(a[2], a[3]); w.z = cvt_pk_bf16(b[0], b[1]); w.w = cvt_pk_bf16(b[2], b[3]); return w; }
__device__ __forceinline__ void unpack8(const u32x4 w, f32x4& a, f32x4& b) {
    a[0] = __uint_as_float(w.x << 16); a[1] = __uint_as_float(w.x & 0xffff0000u); a[2] = __uint_as_float(w.y << 16); a[3] = __uint_as_float(w.y & 0xffff0000u);
    b[0] = __uint_as_float(w.z << 16); b[1] = __uint_as_float(w.z & 0xffff0000u); b[2] = __uint_as_float(w.w << 16); b[3] = __uint_as_float(w.w & 0xffff0000u);
}
__device__ __forceinline__ float row_rs(const float* ss, int row) {
    const f32x4* sp = (const f32x4*)(ss + (size_t)row * 16);
    const f32x4 s = (sp[0] + sp[1]) + (sp[2] + sp[3]);
    return rsqrtf(((s[0] + s[1]) + (s[2] + s[3])) * (1.0f / 1024.0f) + 1e-6f);
}

__device__ __forceinline__ void rows_rs(const float* ss, int row0, int fq, float (&rsv)[2][4]) {
    f32x4 part[2][4];
#pragma unroll
    for (int ai = 0; ai < 2; ++ai)
#pragma unroll
        for (int m = 0; m < 4; ++m) part[ai][m] = *(const f32x4*)(ss + (size_t)(row0 + ai * HALF + m * 16) * 16 + fq * 4);
#pragma unroll
    for (int ai = 0; ai < 2; ++ai)
#pragma unroll
        for (int m = 0; m < 4; ++m) { float t = (part[ai][m][0] + part[ai][m][1]) + (part[ai][m][2] + part[ai][m][3]); t += __shfl_xor(t, 16); t += __shfl_xor(t, 32); rsv[ai][m] = rsqrtf(t * (1.0f / 1024.0f) + 1e-6f); }
}

struct EpiIn {
    static constexpr bool PERM = true, AFTER_DRAIN = false;
    bf16_t* QKV; bf16_t* U; bf16_t* GV; bf16_t* G; const float* ss; float* ssv;
    __device__ __forceinline__ void operator()(const f32x4 (&acc)[2][2][4][2], const Unit& u, int wr, int wc, int fr, int fq) const {
        const int pn = u.pn;
        float rsv[2][4]; rows_rs(ss, u.pm * BM + wr * 64 + fr, fq, rsv);
#pragma unroll
        for (int ai = 0; ai < 2; ++ai)
#pragma unroll
            for (int m = 0; m < 4; ++m) {
                const int row = u.pm * BM + ai * HALF + wr * 64 + m * 16 + fr;
                const float rs = rsv[ai][m];
                float q = 0.f;
#pragma unroll
                for (int bj = 0; bj < 2; ++bj) {
                    const int col = pn * BM + bj * HALF + wc * 32 + 8 * fq;
                    f32x4 v0 = acc[ai][bj][m][0] * rs, v1 = acc[ai][bj][m][1] * rs;
                    bf16_t* dst;
                    if (pn < 9) { if (pn < 3) { v0 = v0 * (0.125f * 1.4426950408889634f); v1 = v1 * (0.125f * 1.4426950408889634f); }     dst = QKV + (size_t)row * 2304 + col; }
                    else if (pn < 17) {
#pragma unroll
                        for (int e = 0; e < 4; ++e) { v0[e] = gelu_tanh(v0[e]); v1[e] = gelu_tanh(v1[e]); }
                        if (pn < 13) dst = U + (size_t)row * 1024 + (col - 2304);
                        else { dst = GV + (size_t)row * 1024 + (col - 3328);
#pragma unroll
                            for (int e = 0; e < 4; ++e) q += v0[e] * v0[e] + v1[e] * v1[e]; }
                    } else {
#pragma unroll
                        for (int e = 0; e < 4; ++e) { v0[e] = fast_sigmoid(v0[e]); v1[e] = fast_sigmoid(v1[e]); }
                        dst = G + (size_t)row * 2048 + (col - 4352);
                    }
                    *(u32x4*)dst = pack8(v0, v1);
                }
                if (pn >= 13 && pn < 17) { q += __shfl_xor(q, 16); q += __shfl_xor(q, 32); if (fq == 0) ssv[(size_t)row * 16 + (pn - 13) * 4 + wc] = q; }
                asm volatile("" ::: "memory");
            }
    }
};
template <int MODE> struct EpiGate {
    static constexpr bool PERM = true, AFTER_DRAIN = false;
    bf16_t* O; const bf16_t* G; int goff;
    __device__ __forceinline__ void operator()(const f32x4 (&acc)[2][2][4][2], const Unit& u, int wr, int wc, int fr, int fq) const {
#pragma unroll
        for (int ai = 0; ai < 2; ++ai) {
            u32x4 gw[4][2], pw[4][2];
#pragma unroll
            for (int m = 0; m < 4; ++m)
#pragma unroll
                for (int bj = 0; bj < 2; ++bj) {
                    const int row = u.pm * BM + ai * HALF + wr * 64 + m * 16 + fr, col = u.pn * BM + bj * HALF + wc * 32 + 8 * fq;
                    gw[m][bj] = *(const u32x4*)(G + (size_t)row * 2048 + goff + col);
                    if (MODE == 1) pw[m][bj] = *(const u32x4*)(O + (size_t)row * 1024 + col);
                }
#pragma unroll
            for (int m = 0; m < 4; ++m)
#pragma unroll
                for (int bj = 0; bj < 2; ++bj) {
                    const int row = u.pm * BM + ai * HALF + wr * 64 + m * 16 + fr, col = u.pn * BM + bj * HALF + wc * 32 + 8 * fq;
                    f32x4 g0, g1; unpack8(gw[m][bj], g0, g1);
                    f32x4 v0 = acc[ai][bj][m][0] * g0, v1 = acc[ai][bj][m][1] * g1;
                    if (MODE == 1) { f32x4 p0, p1; unpack8(pw[m][bj], p0, p1); v0 = v0 + p0; v1 = v1 + p1; }
                    *(u32x4*)(O + (size_t)row * 1024 + col) = pack8(v0, v1);
                }
            asm volatile("" ::: "memory");
        }
    }
};
struct EpiRes {
    static constexpr bool PERM = true, AFTER_DRAIN = false;
    bf16_t* XL; bf16_t* XB; float* ss;
    __device__ __forceinline__ void operator()(const f32x4 (&acc)[2][2][4][2], const Unit& u, int wr, int wc, int fr, int fq) const {
#pragma unroll
        for (int ai = 0; ai < 2; ++ai)
#pragma unroll
        for (int mp = 0; mp < 2; ++mp) {
            u32x4 hv[2][2], lv[2][2];
#pragma unroll
            for (int mi = 0; mi < 2; ++mi)
#pragma unroll
                for (int bj = 0; bj < 2; ++bj) {
                    const size_t off = (size_t)(u.pm * BM + ai * HALF + wr * 64 + (2 * mp + mi) * 16 + fr) * 1024 + u.pn * BM + bj * HALF + wc * 32 + 8 * fq;
                    hv[mi][bj] = *(const u32x4*)(XB + off); lv[mi][bj] = *(const u32x4*)(XL + off);
                }
#pragma unroll
            for (int mi = 0; mi < 2; ++mi) {
                const int m = 2 * mp + mi, row = u.pm * BM + ai * HALF + wr * 64 + m * 16 + fr;
                float q = 0.f;
#pragma unroll
                for (int bj = 0; bj < 2; ++bj) {
                    const size_t off = (size_t)row * 1024 + u.pn * BM + bj * HALF + wc * 32 + 8 * fq;
                    f32x4 h0, h1, l0, l1; unpack8(hv[mi][bj], h0, h1); unpack8(lv[mi][bj], l0, l1);
                    const f32x4 x0 = (h0 + l0) + acc[ai][bj][m][0], x1 = (h1 + l1) + acc[ai][bj][m][1];
                    const u32x4 hw = pack8(x0, x1);
                    unpack8(hw, h0, h1);
                    *(u32x4*)(XB + off) = hw; *(u32x4*)(XL + off) = pack8(x0 - h0, x1 - h1);
#pragma unroll
                    for (int e = 0; e < 4; ++e) q += x0[e] * x0[e] + x1[e] * x1[e];
                }
                q += __shfl_xor(q, 16); q += __shfl_xor(q, 32);
                if (fq == 0) ss[(size_t)row * 16 + u.pn * 4 + wc] = q;
            }
            asm volatile("" ::: "memory");
        }
    }
};
struct EpiUp {
    static constexpr bool PERM = true, AFTER_DRAIN = false;
    bf16_t* A; const float* ss;
    __device__ __forceinline__ void operator()(const f32x4 (&acc)[2][2][4][2], const Unit& u, int wr, int wc, int fr, int fq) const {
        float rsv[2][4]; rows_rs(ss, u.pm * BM + wr * 64 + fr, fq, rsv);
#pragma unroll
        for (int ai = 0; ai < 2; ++ai)
#pragma unroll
            for (int m = 0; m < 4; ++m) {
                const int row = u.pm * BM + ai * HALF + wr * 64 + m * 16 + fr;
                const float rs = rsv[ai][m];
#pragma unroll
                for (int bj = 0; bj < 2; ++bj) {
                    const int col = u.pn * BM + bj * HALF + wc * 32 + 8 * fq;
                    *(u32x4*)(A + (size_t)row * 5632 + col) = pack8(acc[ai][bj][m][0] * rs, acc[ai][bj][m][1] * rs);
                }
                asm volatile("" ::: "memory");
            }
    }
};

__device__ __forceinline__ float dpp_prev(float x) { return __int_as_float(__builtin_amdgcn_update_dpp(0, __float_as_int(x), 0x121, 0xf, 0xf, false)); }
__device__ __forceinline__ float dpp_next(float x) { return __int_as_float(__builtin_amdgcn_update_dpp(0, __float_as_int(x), 0x12F, 0xf, 0xf, false)); }
__device__ __forceinline__ f32x4 rot_prev(const f32x4 v) { f32x4 r; r[0] = dpp_prev(v[0]); r[1] = dpp_prev(v[1]); r[2] = dpp_prev(v[2]); r[3] = dpp_prev(v[3]); return r; }
__device__ __forceinline__ f32x4 rot_next(const f32x4 v) { f32x4 r; r[0] = dpp_next(v[0]); r[1] = dpp_next(v[1]); r[2] = dpp_next(v[2]); r[3] = dpp_next(v[3]); return r; }
struct EpiUpConv {
    static constexpr bool PERM = true, AFTER_DRAIN = false;
    bf16_t* FG; bf16_t* SB; const float* ss; const float* cw; const float* cb;
    __device__ __forceinline__ void operator()(const f32x4 (&acc_)[2][2][4][2], const Unit& u, int wr, int wc, int fr, int fq) const {
        f32x4 (&acc)[2][2][4][2] = const_cast<f32x4 (&)[2][2][4][2]>(acc_);
        float rsv[2][4]; rows_rs(ss, u.pm * BM + wr * 64 + fr, fq, rsv);
        const int f0 = u.pn * 128 + wc * 32 + 8 * fq;
        const bool first = fr == 0, last = fr == 15;
#pragma unroll
        for (int ai = 0; ai < 2; ++ai) {
#pragma unroll
            for (int m = 0; m < 4; ++m)
#pragma unroll
                for (int h = 0; h < 2; ++h) { acc[ai][h][m][0] = acc[ai][h][m][0] * rsv[ai][m]; acc[ai][h][m][1] = acc[ai][h][m][1] * rsv[ai][m]; }
            const int blk = (u.pm * BM + ai * HALF + wr * 64) >> 6;
            if (fr <= 1) { bf16_t* sp = SB + ((size_t)blk * 4 + fr) * 5632 + f0;
                *(u32x4*)sp = pack8(acc[ai][0][0][0], acc[ai][0][0][1]); *(u32x4*)(sp + 2816) = pack8(acc[ai][1][0][0], acc[ai][1][0][1]); }
            if (fr >= 14) { bf16_t* sp = SB + ((size_t)blk * 4 + (fr - 12)) * 5632 + f0;
                *(u32x4*)sp = pack8(acc[ai][0][3][0], acc[ai][0][3][1]); *(u32x4*)(sp + 2816) = pack8(acc[ai][1][3][0], acc[ai][1][3][1]); }
        }
#pragma unroll
        for (int n = 0; n < 2; ++n) {
            f32x4 w[2][4];
#pragma unroll
            for (int h = 0; h < 2; ++h) {
#pragma unroll
                for (int k = 0; k < 3; ++k) w[h][k] = *(const f32x4*)(cw + k * 5632 + h * 2816 + f0 + 4 * n);
                w[h][3] = *(const f32x4*)(cb + h * 2816 + f0 + 4 * n);
            }
#pragma unroll
            for (int ai = 0; ai < 2; ++ai) {
#pragma unroll
                for (int m = 0; m < 4; ++m) {
                    const int row = u.pm * BM + ai * HALF + wr * 64 + m * 16 + fr;
                    f32x4 cv[2];
#pragma unroll
                    for (int h = 0; h < 2; ++h) {
                        const f32x4 cur = acc[ai][h][m][n];
                        f32x4 pv = rot_prev(cur), nx = rot_next(cur);
                        if (m > 0) { const f32x4 pw = rot_prev(acc[ai][h][m - 1][n]);
#pragma unroll
                            for (int e = 0; e < 4; ++e) pv[e] = first ? pw[e] : pv[e]; }
                        if (m < 3) { const f32x4 nw = rot_next(acc[ai][h][m + 1][n]);
#pragma unroll
                            for (int e = 0; e < 4; ++e) nx[e] = last ? nw[e] : nx[e]; }
                        cv[h] = pv * w[h][0] + cur * w[h][1] + nx * w[h][2] + w[h][3];
                    }
                    f32x4 o;
#pragma unroll
                    for (int e = 0; e < 4; ++e) o[e] = gelu_tanh(cv[0][e]) * cv[1][e];
                    const bool brow = (m == 0 && first) || (m == 3 && last);
                    if (!brow) { typedef unsigned u32x2e __attribute__((ext_vector_type(2))); u32x2e ow; ow.x = cvt_pk_bf16(o[0], o[1]); ow.y = cvt_pk_bf16(o[2], o[3]); *(u32x2e*)(FG + (size_t)row * 2816 + f0 + 4 * n) = ow; }
                }
                asm volatile("" ::: "memory");
            }
        }
    }
};

template <class Epi, class Sched, bool ALIGN_EPI = false, bool SP2 = false>
__device__ __forceinline__ void gemm_phase(PG8_LAS unsigned char* lds, const Gemm g, const Sched& S, const Epi& E, const int tid) {
    const int wid = __builtin_amdgcn_readfirstlane(tid >> 6), lane = tid & 63, wr = wid >> 2, wc = wid & 3, fr = lane & 15, fq = lane >> 4;
    const int K = g.K, nt = K / BK;
    unsigned voffA[2], voffB[2];
#pragma unroll
    for (int i = 0; i < 2; ++i) { int R, C; stage_rc(tid * 16 + i * 8192, R, C); const int Rb = Epi::PERM ? ((R & ~31) + perm32(R & 31)) : R;
        voffA[i] = (unsigned)(R * K + C) * 2u; voffB[i] = (unsigned)(Rb * K + C) * 2u; }
    const size_t kstep = (size_t)(BK * 2);
    const size_t hstep = (size_t)HALF * K * 2;
    const size_t tstep = 2 * hstep;
    const unsigned ldsw = (unsigned)wid * 1024u;
    const int aoff = lds_byte(wr * 64 + fr, fq * 8), boff = lds_byte(wc * 32 + fr, fq * 8);
#define PG8_SA(b, h) (((b) * 2 + (h)) * HTB)
#define PG8_SB(b, h) ((4 + (b) * 2 + (h)) * HTB)
#define PG8_STAGE(bufoff, gbase, voff) do { _Pragma("unroll") for (int _i = 0; _i < 2; ++_i) \
        __builtin_amdgcn_global_load_lds((const unsigned*)((const char*)(gbase) + (voff)[_i]), (PG8_LAS unsigned*)(lds + (bufoff) + ldsw + _i * 8192), 16, 0, 0); } while (0)
#define PG8_LDA(dst, b, h) do { _Pragma("unroll") for (int m = 0; m < 4; ++m) _Pragma("unroll") for (int k = 0; k < 2; ++k) dst[m][k] = *(const PG8_LAS bf16x8*)(lds + PG8_SA(b, h) + aoff + m * 2048 + k * 1024); } while (0)
#define PG8_LDB(dst, b, h) do { _Pragma("unroll") for (int n = 0; n < 2; ++n) _Pragma("unroll") for (int k = 0; k < 2; ++k) dst[n][k] = *(const PG8_LAS bf16x8*)(lds + PG8_SB(b, h) + boff + n * 2048 + k * 1024); } while (0)
#define PG8_MMA(ai, bj, At, Bt) do { __builtin_amdgcn_s_setprio(1); _Pragma("unroll") for (int m = 0; m < 4; ++m) _Pragma("unroll") for (int n = 0; n < 2; ++n) _Pragma("unroll") for (int k = 0; k < 2; ++k) \
        acc[ai][bj][m][n] = __builtin_amdgcn_mfma_f32_16x16x32_bf16(Bt[n][k], At[m][k], acc[ai][bj][m][n], 0, 0, 0); __builtin_amdgcn_s_setprio(0); } while (0)
#define PG8_WAIT_V(n) asm volatile("s_waitcnt vmcnt(" #n ")" ::: "memory")
#define PG8_WAIT_L(n) asm volatile("s_waitcnt lgkmcnt(" #n ")" ::: "memory")
#define PG8_BAR __builtin_amdgcn_s_barrier()
#define PG8_SCHED __builtin_amdgcn_sched_barrier(0)
    Unit cur, nxt; int ui = 0;
    if (!S.next(0, cur)) return;
    f32x4 acc[2][2][4][2];
#pragma unroll
    for (int a = 0; a < 2; ++a)
#pragma unroll
        for (int b = 0; b < 2; ++b)
#pragma unroll
            for (int m = 0; m < 4; ++m)
#pragma unroll
                for (int n = 0; n < 2; ++n) acc[a][b][m][n] = (f32x4){0.f, 0.f, 0.f, 0.f};
    bf16x8 At[4][2], B0[2][2], B1[2][2];
    const char* cA = (const char*)g.A + (size_t)cur.pm * tstep; const char* cB = (const char*)g.Bt + (size_t)cur.pn * tstep;
    S.a_ready(cur);
    if constexpr (SP2) {
        PG8_STAGE(PG8_SB(0, 0), cB, voffB); PG8_STAGE(PG8_SB(0, 1), cB + hstep, voffB); PG8_STAGE(PG8_SA(0, 0), cA, voffA); PG8_STAGE(PG8_SA(0, 1), cA + hstep, voffA);
        if (wr == 1) PG8_BAR;
        PG8_WAIT_V(2); PG8_BAR;
        PG8_STAGE(PG8_SB(1, 0), cB + kstep, voffB); PG8_STAGE(PG8_SA(1, 0), cA + kstep, voffA); PG8_STAGE(PG8_SB(1, 1), cB + hstep + kstep, voffB);
        PG8_WAIT_V(6); PG8_BAR;
    } else {
        PG8_STAGE(PG8_SB(0, 0), cB, voffB); PG8_STAGE(PG8_SA(0, 0), cA, voffA); PG8_STAGE(PG8_SB(0, 1), cB + hstep, voffB); PG8_STAGE(PG8_SA(0, 1), cA + hstep, voffA);
        if (wr == 1) PG8_BAR;
        PG8_WAIT_V(4); PG8_BAR;
        PG8_STAGE(PG8_SB(1, 0), cB + kstep, voffB); PG8_STAGE(PG8_SA(1, 0), cA + kstep, voffA); PG8_STAGE(PG8_SB(1, 1), cB + hstep + kstep, voffB);
        PG8_WAIT_V(6); PG8_BAR;
    }
    for (;;) {
        const bool has_next = S.next(ui + 1, nxt);
        const char* nA = has_next ? (const char*)g.A + (size_t)nxt.pm * tstep : cA; const char* nB = has_next ? (const char*)g.Bt + (size_t)nxt.pn * tstep : cB;
        for (int t = 0; t < nt; t += 2) {
            const bool last = (t == nt - 2);
            const char* a1 = cA + (size_t)(t + 1) * kstep;
            const char* a2 = last ? nA : cA + (size_t)(t + 2) * kstep; const char* b2 = last ? nB : cB + (size_t)(t + 2) * kstep;
            const char* a3 = a2 + kstep; const char* b3 = b2 + kstep;
            if (last && has_next) S.a_ready(nxt);
            if constexpr (SP2) {
            PG8_LDB(B0, 0, 0); PG8_LDB(B1, 0, 1); PG8_SCHED; PG8_LDA(At, 0, 0); PG8_STAGE(PG8_SA(1, 1), a1 + hstep, voffA);
            PG8_WAIT_V(8); PG8_WAIT_L(0); PG8_BAR; PG8_MMA(0, 0, At, B0); PG8_MMA(0, 1, At, B1); PG8_BAR; PG8_SCHED;
            PG8_LDA(At, 0, 1); PG8_STAGE(PG8_SB(0, 0), b2, voffB); PG8_STAGE(PG8_SB(0, 1), b2 + hstep, voffB); PG8_STAGE(PG8_SA(0, 0), a2, voffA);
            PG8_WAIT_V(8); PG8_WAIT_L(0); PG8_BAR; PG8_MMA(1, 0, At, B0); PG8_MMA(1, 1, At, B1); PG8_BAR; PG8_SCHED;
            PG8_LDB(B0, 1, 0); PG8_LDB(B1, 1, 1); PG8_SCHED; PG8_LDA(At, 1, 0); PG8_STAGE(PG8_SA(0, 1), a2 + hstep, voffA);
            PG8_WAIT_V(8); PG8_WAIT_L(0); PG8_BAR; PG8_MMA(0, 0, At, B0); PG8_MMA(0, 1, At, B1); PG8_BAR; PG8_SCHED;
            PG8_LDA(At, 1, 1); PG8_STAGE(PG8_SB(1, 0), b3, voffB); PG8_STAGE(PG8_SB(1, 1), b3 + hstep, voffB); PG8_STAGE(PG8_SA(1, 0), a3, voffA);
            PG8_WAIT_V(8); PG8_WAIT_L(0); PG8_BAR; PG8_MMA(1, 0, At, B0); PG8_MMA(1, 1, At, B1); PG8_BAR; PG8_SCHED;
            } else {
            PG8_LDB(B0, 0, 0); PG8_SCHED; PG8_LDA(At, 0, 0); PG8_STAGE(PG8_SA(1, 1), a1 + hstep, voffA);
            PG8_WAIT_L(8); PG8_BAR; PG8_WAIT_L(0); PG8_MMA(0, 0, At, B0); PG8_BAR; PG8_SCHED;
            PG8_LDB(B1, 0, 1); PG8_STAGE(PG8_SB(0, 0), b2, voffB);
            PG8_BAR; PG8_WAIT_L(0); PG8_MMA(0, 1, At, B1); PG8_BAR;
            PG8_LDA(At, 0, 1); PG8_STAGE(PG8_SA(0, 0), a2, voffA);
            PG8_BAR; PG8_WAIT_L(0); PG8_MMA(1, 0, At, B0); PG8_BAR; PG8_SCHED;
            PG8_STAGE(PG8_SB(0, 1), b2 + hstep, voffB);
            PG8_WAIT_V(6); PG8_BAR; PG8_MMA(1, 1, At, B1); PG8_BAR;
            PG8_LDB(B0, 1, 0); PG8_SCHED; PG8_LDA(At, 1, 0); PG8_STAGE(PG8_SA(0, 1), a2 + hstep, voffA);
            PG8_WAIT_L(8); PG8_BAR; PG8_WAIT_L(0); PG8_MMA(0, 0, At, B0); PG8_BAR; PG8_SCHED;
            PG8_LDB(B1, 1, 1); PG8_STAGE(PG8_SB(1, 0), b3, voffB);
            PG8_BAR; PG8_WAIT_L(0); PG8_MMA(0, 1, At, B1); PG8_BAR;
            PG8_LDA(At, 1, 1); PG8_STAGE(PG8_SA(1, 0), a3, voffA);
            PG8_BAR; PG8_WAIT_L(0); PG8_MMA(1, 0, At, B0); PG8_BAR; PG8_SCHED;
            PG8_STAGE(PG8_SB(1, 1), b3 + hstep, voffB);
            PG8_WAIT_V(6); PG8_BAR; PG8_MMA(1, 1, At, B1); PG8_BAR;
            }
        }
        if constexpr (ALIGN_EPI) { if (wr == 0) PG8_BAR; }
        if constexpr (!Epi::AFTER_DRAIN) { E(acc, cur, wr, wc, fr, fq); S.done(cur); }
        if (!has_next) break;
#pragma unroll
        for (int a = 0; a < 2; ++a)
#pragma unroll
            for (int b = 0; b < 2; ++b)
#pragma unroll
                for (int m = 0; m < 4; ++m)
#pragma unroll
                    for (int n = 0; n < 2; ++n) acc[a][b][m][n] = (f32x4){0.f, 0.f, 0.f, 0.f};
        cur = nxt; cA = nA; cB = nB; ++ui;
        if constexpr (ALIGN_EPI) { if (wr == 1) PG8_BAR; }
    }
    PG8_WAIT_V(0);
    if constexpr (!ALIGN_EPI) { if (wr == 0) PG8_BAR; }
    PG8_BAR;
    if constexpr (Epi::AFTER_DRAIN) { E.fused(acc, cur, wr, wc, fr, fq, lds, wid, lane); S.done(cur); }
#undef PG8_SA
#undef PG8_SB
#undef PG8_STAGE
#undef PG8_LDA
#undef PG8_LDB
#undef PG8_MMA
#undef PG8_WAIT_V
#undef PG8_WAIT_L
#undef PG8_BAR
#undef PG8_SCHED
}
}


#define LAS __attribute__((address_space(3)))
#ifndef SKIPMASK
#define SKIPMASK 0
#endif
#ifndef PROBE_KIND
#define PROBE_KIND -1
#endif
typedef unsigned short bf16;
using pg8::f32x4; using pg8::u32x4; using pg8::bf16x8;
typedef float f32x16 __attribute__((ext_vector_type(16)));
typedef short v4i16_t __attribute__((ext_vector_type(4)));
typedef unsigned u32x2 __attribute__((ext_vector_type(2)));

constexpr int DM = 1024, DEPTH = 4, NTOK = 98304, NPROMPT = 32768, CH = 32768, NCHUNK = NTOK / CH;
constexpr int NIN = 6400, DFF = 2816, NUP = 5632;
constexpr int LDS_BYTES = 147456, NTHR = 512;
constexpr float EPS = 1e-6f, LOG2E = 1.4426950408889634f;
constexpr size_t OFF_IN = 0, OFF_PA = OFF_IN + (size_t)NIN * DM, OFF_PB = OFF_PA + (size_t)DM * 256, OFF_OUT = OFF_PB + (size_t)DM * DM, OFF_UP = OFF_OUT + (size_t)DM * DM,
                 OFF_DN = OFF_UP + (size_t)NUP * DM, OFF_WS = OFF_DN + (size_t)DM * DFF, W_LAYER = OFF_WS + 8 * 128 * 128;
constexpr size_t MiB = 1u << 20;
constexpr size_t WS_W = 0, WS_R1 = 144 * MiB, WS_R2 = WS_R1 + (size_t)CH * 12800, WS_XB = WS_R2 + (size_t)CH * 5632, WS_SS = WS_XB + (size_t)CH * 2048, WS_SSV = WS_SS + (size_t)CH * 64, WS_BAR = WS_SSV + (size_t)CH * 64, WS_SB = WS_BAR + 65536, WS_XL = WS_SB + (size_t)(CH / 64) * 4 * 5632 * 2, WS_BT = WS_XL + (size_t)CH * 2048, WS_END = WS_BT + 16384;
static_assert(W_LAYER * 2 * DEPTH <= WS_R1, "weights fit");
constexpr int PROBE_DUPK = (PROBE_KIND == 8) ? 1 : PROBE_KIND;
constexpr int KPL = (PROBE_DUPK >= 0 && PROBE_DUPK < 8) ? 9 : 8;
constexpr int NP0 = (PROBE_KIND == 9) ? 2 : 1;
constexpr int PH_PER_CHUNK = 2 + KPL * DEPTH, N_PHASES = NP0 + NCHUNK * PH_PER_CHUNK;

struct Args { const float* in[17]; float* out; unsigned char* ws; int ph_lo, ph_hi; };

__device__ __forceinline__ float wave_sum(float v) {
#pragma unroll
    for (int o = 1; o < 64; o <<= 1) v += __shfl_xor(v, o);
    return v;
}
__device__ __forceinline__ unsigned pk2(float lo, float hi) { return pg8::cvt_pk_bf16(lo, hi); }
#define LDS_WAIT() asm volatile("s_waitcnt lgkmcnt(0)" ::: "memory")

__device__ __forceinline__ int t5_bucket(int rel) {
    const int n = rel < 0 ? -rel : rel;
    const int b = n < 8 ? n : 8 + (n >= 15) + (n >= 27) + (n >= 50) + (n >= 91) + (n >= 166) + (n >= 305) + (n >= 559);
    return (rel > 0 ? 16 : 0) + b;
}
__device__ __forceinline__ void tr_item(const float* W, int K, int N, bf16* WT, const float* gain, LAS float* scr, int item, int lane, bool perm_up = false) {
    const int nblk = N / 32, kb = item / nblk, nb = item % nblk, k0 = 64 * kb, n0 = 32 * nb;
    const int dn0 = perm_up ? ((n0 % DFF) / 128) * 256 + (n0 / DFF) * 128 + (n0 % 128) : n0;
#pragma unroll
    for (int i = 0; i < 8; ++i) {
        const int kk = (lane >> 3) + 8 * i, c4 = 4 * (lane & 7); const float g = gain ? gain[k0 + kk] : 1.0f;
        const f32x4 v = *(const f32x4*)(W + (size_t)(k0 + kk) * N + n0 + c4);
        scr[kk * 33 + c4 + 0] = v[0] * g; scr[kk * 33 + c4 + 1] = v[1] * g; scr[kk * 33 + c4 + 2] = v[2] * g; scr[kk * 33 + c4 + 3] = v[3] * g;
    }
    LDS_WAIT();
    const int c = lane & 7;
#pragma unroll
    for (int j = 0; j < 4; ++j) { const int n = (lane >> 3) + 8 * j; const LAS float* s = scr + (8 * c) * 33 + n;
        u32x4 o; o.x = pk2(s[0 * 33], s[1 * 33]); o.y = pk2(s[2 * 33], s[3 * 33]); o.z = pk2(s[4 * 33], s[5 * 33]); o.w = pk2(s[6 * 33], s[7 * 33]);
        *(u32x4*)(WT + (size_t)(dn0 + n) * K + k0 + 8 * c) = o; }
    LDS_WAIT();
}
__device__ __forceinline__ void p0_weights(const Args& a, LAS unsigned char* lds, int tid, int G, int bid) {
    const int wave = tid >> 6, lane = tid & 63;
    LAS float* scr = (LAS float*)(lds + wave * 16384);
    const int gw = bid * 8 + wave, NGW = G * 8;
    constexpr int I_IN = 16 * 200, I_PA = 4 * 32, I_PB = 16 * 32, I_OUT = 16 * 32, I_UP = 16 * 176, I_DN = 44 * 32, PER = I_IN + I_PA + I_PB + I_OUT + I_UP + I_DN;
    bf16* Wb = (bf16*)(a.ws + WS_W);
    for (int it = gw; it < DEPTH * PER; it += NGW) {
        const int l = it / PER; int r = it % PER; bf16* wl = Wb + (size_t)l * W_LAYER;
        if (r < I_IN) { tr_item(a.in[4] + (size_t)l * DM * NIN, DM, NIN, wl + OFF_IN, a.in[3] + l * DM, scr, r, lane); continue; } r -= I_IN;
        if (r < I_PA) { tr_item(a.in[8] + (size_t)l * 256 * DM, 256, DM, wl + OFF_PA, nullptr, scr, r, lane); continue; } r -= I_PA;
        if (r < I_PB) { tr_item(a.in[9] + (size_t)l * DM * DM, DM, DM, wl + OFF_PB, nullptr, scr, r, lane); continue; } r -= I_PB;
        if (r < I_OUT) { tr_item(a.in[10] + (size_t)l * DM * DM, DM, DM, wl + OFF_OUT, nullptr, scr, r, lane); continue; } r -= I_OUT;
        if (r < I_UP) { tr_item(a.in[12] + (size_t)l * DM * NUP, DM, NUP, wl + OFF_UP, a.in[11] + l * DM, scr, r, lane, true); continue; } r -= I_UP;
        tr_item(a.in[15] + (size_t)l * DFF * DM, DFF, DM, wl + OFF_DN, nullptr, scr, r, lane);
    }
    if (bid == 0) {
        float* BT = (float*)(a.ws + WS_BT);
        for (int i = tid; i < 3 * 768; i += NTHR) { const int g = i / 768, hh = (i % 768) / 192, j = i % 192 - 96;
            BT[i] = (j >= -64 && j <= 64) ? LOG2E * a.in[2][t5_bucket(j << (2 * g)) * 12 + g * 4 + hh] : -1e30f; }
    }
    for (int i = bid * NTHR + tid; i < DEPTH * 131072 / 4; i += G * NTHR) {
        const int l = i / 32768, e = (i % 32768) * 4;
        const f32x4 v = *(const f32x4*)(a.in[6] + (size_t)l * 131072 + e);
        u32x2 o; o.x = pk2(v[0], v[1]); o.y = pk2(v[2], v[3]);
        *(u32x2*)(Wb + (size_t)l * W_LAYER + OFF_WS + e) = o;
    }
}
__device__ __forceinline__ void p0x(const Args& a, int chunk, int tid, int G, int bid) {
    const int wave = tid >> 6, lane = tid & 63, gw = bid * 8 + wave, NGW = G * 8;
    bf16* XB = (bf16*)(a.ws + WS_XB); bf16* XL = (bf16*)(a.ws + WS_XL); float* SS = (float*)(a.ws + WS_SS);
    for (int m0 = gw; m0 < CH; m0 += 4 * NGW) {
        f32x4 v[4][4];
#pragma unroll
        for (int r = 0; r < 4; ++r) {
            const int m = m0 + r * NGW; const size_t tok = (size_t)chunk * CH + (m < CH ? m : m0);
            const float* src = tok < NPROMPT ? a.in[0] + tok * DM : a.in[1] + (tok - NPROMPT) * DM;
#pragma unroll
            for (int j = 0; j < 4; ++j) v[r][j] = *(const f32x4*)(src + (lane + 64 * j) * 4);
        }
#pragma unroll
        for (int r = 0; r < 4; ++r) {
            const int m = m0 + r * NGW;
            if (m < CH) {
                float s = 0.f;
#pragma unroll
                for (int j = 0; j < 4; ++j) { const f32x4 w = v[r][j]; s += (w[0] * w[0] + w[1] * w[1]) + (w[2] * w[2] + w[3] * w[3]);
                    u32x2 o; o.x = pk2(w[0], w[1]); o.y = pk2(w[2], w[3]); *(u32x2*)(XB + (size_t)m * DM + (lane + 64 * j) * 4) = o;
                    u32x2 lo; lo.x = pk2(w[0] - __uint_as_float(o.x << 16), w[1] - __uint_as_float(o.x & 0xffff0000u)); lo.y = pk2(w[2] - __uint_as_float(o.y << 16), w[3] - __uint_as_float(o.y & 0xffff0000u));
                    *(u32x2*)(XL + (size_t)m * DM + (lane + 64 * j) * 4) = lo; }
                s = wave_sum(s);
                if (lane < 16) SS[(size_t)m * 16 + lane] = lane == 0 ? s : 0.f;
            }
        }
    }
}
__device__ __forceinline__ void pfinal(const Args& a, int chunk, int tid, int G, int bid) {
    const int wave = tid >> 6, lane = tid & 63, gw = bid * 8 + wave, NGW = G * 8;
    const bf16* XB = (const bf16*)(a.ws + WS_XB); const bf16* XL = (const bf16*)(a.ws + WS_XL);
    const float* SS = (const float*)(a.ws + WS_SS); const float* nf = a.in[16];
    f32x4 g[2][2];
#pragma unroll
    for (int j = 0; j < 2; ++j) { g[j][0] = *(const f32x4*)(nf + (lane + 64 * j) * 8); g[j][1] = *(const f32x4*)(nf + (lane + 64 * j) * 8 + 4); }
    for (int m0 = gw; m0 < CH; m0 += 4 * NGW) {
        u32x4 hw[4][2], lw[4][2]; f32x4 sp[4];
#pragma unroll
        for (int r = 0; r < 4; ++r) {
            const int m = (m0 + r * NGW < CH) ? m0 + r * NGW : m0;
            sp[r] = *(const f32x4*)(SS + (size_t)m * 16 + 4 * (lane & 3));
#pragma unroll
            for (int j = 0; j < 2; ++j) { hw[r][j] = *(const u32x4*)(XB + (size_t)m * DM + (lane + 64 * j) * 8); lw[r][j] = *(const u32x4*)(XL + (size_t)m * DM + (lane + 64 * j) * 8); }
        }
#pragma unroll
        for (int r = 0; r < 4; ++r) {
            const int m = m0 + r * NGW;
            if (m < CH) {
                float t = (sp[r][0] + sp[r][1]) + (sp[r][2] + sp[r][3]); t += __shfl_xor(t, 1); t += __shfl_xor(t, 2);
                const float rs = rsqrtf(t * (1.0f / 1024.0f) + EPS);
                float* x = a.out + ((size_t)chunk * CH + m) * DM;
#pragma unroll
                for (int j = 0; j < 2; ++j) { const int c = (lane + 64 * j) * 8; f32x4 h0, h1, l0, l1; pg8::unpack8(hw[r][j], h0, h1); pg8::unpack8(lw[r][j], l0, l1);
                    *(f32x4*)(x + c) = (h0 + l0) * rs * g[j][0]; *(f32x4*)(x + c + 4) = (h1 + l1) * rs * g[j][1]; }
            }
        }
    }
}
struct AttU { int g, d, L, tokbase, qb; };
__device__ __forceinline__ AttU att_decode(int unit, int S) {
    constexpr int upg = CH / 64;
    AttU u; u.g = unit / upg; const int rem = unit % upg, ups = S / 64, seq = rem / ups, rem2 = rem % ups;
    u.d = 1 << (2 * u.g); u.L = S / u.d; const int nqb = u.L / 64, r = rem2 / nqb; u.qb = rem2 % nqb; u.tokbase = seq * S + r;
    return u;
}
template <int KT0, int KT1, bool WITHQ>
__device__ __forceinline__ void att_load_qk(const bf16* QKV, const AttU& u, int h, int qh, int n, int hi, bf16x8 (&qf)[4], bf16x8 (&kf)[5][4]) {
    const int qbase = 64 * u.qb + 32 * qh;
    if (WITHQ) {
        const bf16* qp = QKV + ((size_t)u.tokbase + (size_t)(qbase + n) * u.d) * 2304 + u.g * 256 + h * 64 + 8 * hi;
#pragma unroll
        for (int s = 0; s < 4; ++s) qf[s] = *(const bf16x8*)(qp + 16 * s);
    }
#pragma unroll
    for (int kt = KT0; kt < KT1; ++kt) {
        const int lk = qbase - 64 + 32 * kt + n, lkc = lk < 0 ? 0 : (lk > u.L - 1 ? u.L - 1 : lk);
        const bf16* kp = QKV + (size_t)(u.tokbase + lkc * u.d) * 2304 + 768 + u.g * 256 + h * 64 + 8 * hi;
#pragma unroll
        for (int s = 0; s < 4; ++s) kf[kt][s] = *(const bf16x8*)(kp + 16 * s);
    }
}
__device__ __forceinline__ void attn_phase(const bf16* QKV, bf16* OUTG, float* LSE, const float* BT, LAS unsigned char* lds, int S, int tid, int G, int bid) {
    constexpr int NATT = 3 * (CH / 64);
    int it = (G % 8 == 0) ? (bid & 7) * (G / 8) + (bid >> 3) : bid;
    if (it >= NATT) return;
    AttU u = att_decode(it, S);
    bf16x8 qf[4], kf[5][4];
    att_load_qk<0, 4, false>(QKV, u, (tid >> 6) & 3, tid >> 8, tid & 31, (tid >> 5) & 1, qf, kf);
    for (; it < NATT; it += G) {
        int tl = tid; asm volatile("" : "+v"(tl));
        const int h = (tl >> 6) & 3, qh = tl >> 8, n = tl & 31, hi = (tl >> 5) & 1, lane = tl & 63;
        const int g = u.g, d = u.d, L = u.L, tokbase = u.tokbase, qb = u.qb, qbase = 64 * qb + 32 * qh;
        att_load_qk<4, 5, true>(QKV, u, h, qh, n, hi, qf, kf);
        u32x4 vv[12];
#pragma unroll
        for (int i = 0; i < 12; ++i) {
            const int idx = tl + i * NTHR, kk = idx >> 5, ch = idx & 31, lk = 64 * qb - 64 + kk;
            vv[i] = (u32x4){0u, 0u, 0u, 0u};
            if (lk >= 0 && lk < L) vv[i] = *(const u32x4*)(QKV + (size_t)(tokbase + lk * d) * 2304 + 1536 + g * 256 + ch * 8);
        }
        const float bt0 = BT[g * 768 + tid], bt1 = tid < 256 ? BT[g * 768 + 512 + tid] : 0.f;
        f32x16 st[5];
#pragma unroll
        for (int kt = 0; kt < 5; ++kt) {
            f32x16 acc;
#pragma unroll
            for (int e = 0; e < 16; ++e) acc[e] = 0.f;
#pragma unroll
            for (int s = 0; s < 4; ++s) acc = __builtin_amdgcn_mfma_f32_32x32x16_bf16(kf[kt][s], qf[s], acc, 0, 0, 0);
            st[kt] = acc;
        }
#pragma unroll
        for (int i = 0; i < 12; ++i) { const int idx = tl + i * NTHR, kk = idx >> 5, ch = idx & 31; *(LAS u32x4*)(lds + kk * 576 + ch * 16) = vv[i]; }
        LAS float* bt = (LAS float*)(lds + 110592);
        bt[tid] = bt0; if (tid < 256) bt[512 + tid] = bt1;
        asm volatile("" :: "v"(st[4][15]) : "memory");
        AttU un = u;
        if (it + G < NATT) { un = att_decode(it + G, S); att_load_qk<0, 4, false>(QKV, un, h, qh, n, hi, qf, kf); }
        __syncthreads();
        float mx = -3.0e38f;
        {
            const LAS float* btl = bt + h * 192 + 32 + 4 * hi - n;
            const bool edge = (qb == 0) || (64 * qb + 128 > L);
#pragma unroll
            for (int kt = 0; kt < 5; ++kt)
#pragma unroll
                for (int i = 0; i < 16; ++i) {
                    float sv = st[kt][i] + btl[32 * kt + (i & 3) + 8 * (i >> 2)];
                    if (edge) { const int lk2 = qbase - 64 + 32 * kt + (i & 3) + 8 * (i >> 2) + 4 * hi; sv = (lk2 >= 0 && lk2 < L) ? sv : -1e30f; }
                    st[kt][i] = sv; mx = fmaxf(mx, sv);
                }
        }
        mx = fmaxf(mx, __shfl_xor(mx, 32));
        float sum = 0.f;
#pragma unroll
        for (int kt = 0; kt < 5; ++kt)
#pragma unroll
            for (int i = 0; i < 16; ++i) { const float pe = __builtin_amdgcn_exp2f(st[kt][i] - mx); st[kt][i] = pe; sum += pe; }
        sum += __shfl_xor(sum, 32);
        const float inv = 1.0f / sum, lse = (mx + __log2f(sum)) * 0.6931471805599453f;
        f32x16 o0, o1;
#pragma unroll
        for (int e = 0; e < 16; ++e) { o0[e] = 0.f; o1[e] = 0.f; }
        const int q4 = (lane & 15) >> 2, p4 = lane & 3, gsel = (lane >> 4) & 1;
        const unsigned vbase = (unsigned)((32 * qh + 4 * hi + q4) * 576 + h * 128 + (16 * gsel + 4 * p4) * 2);
#pragma unroll
        for (int kt = 0; kt < 5; ++kt)
#pragma unroll
            for (int s2 = 0; s2 < 2; ++s2) {
                u32x4 pw; pw.x = pk2(st[kt][8 * s2 + 0], st[kt][8 * s2 + 1]); pw.y = pk2(st[kt][8 * s2 + 2], st[kt][8 * s2 + 3]); pw.z = pk2(st[kt][8 * s2 + 4], st[kt][8 * s2 + 5]); pw.w = pk2(st[kt][8 * s2 + 6], st[kt][8 * s2 + 7]);
                const bf16x8 pf = __builtin_bit_cast(bf16x8, pw);
                const unsigned ro = vbase + (unsigned)((32 * kt + 16 * s2) * 576);
                {
                    const v4i16_t r1 = __builtin_amdgcn_ds_read_tr16_b64_v4i16((LAS v4i16_t*)(lds + ro)), r2 = __builtin_amdgcn_ds_read_tr16_b64_v4i16((LAS v4i16_t*)(lds + ro + 8 * 576));
                    const bf16x8 vf = (bf16x8){r1[0], r1[1], r1[2], r1[3], r2[0], r2[1], r2[2], r2[3]};
                    o0 = __builtin_amdgcn_mfma_f32_32x32x16_bf16(vf, pf, o0, 0, 0, 0);
                }
                {
                    const v4i16_t r1 = __builtin_amdgcn_ds_read_tr16_b64_v4i16((LAS v4i16_t*)(lds + ro + 64)), r2 = __builtin_amdgcn_ds_read_tr16_b64_v4i16((LAS v4i16_t*)(lds + ro + 64 + 8 * 576));
                    const bf16x8 vf = (bf16x8){r1[0], r1[1], r1[2], r1[3], r2[0], r2[1], r2[2], r2[3]};
                    o1 = __builtin_amdgcn_mfma_f32_32x32x16_bf16(vf, pf, o1, 0, 0, 0);
                }
            }
        const size_t tokq = (size_t)tokbase + (size_t)(qbase + n) * d;
        bf16* op = OUTG + ((size_t)g * CH + tokq) * 256 + h * 64;
#pragma unroll
        for (int grp = 0; grp < 4; ++grp) {
            u32x2 w0, w1;
            w0.x = pk2(o0[4 * grp + 0] * inv, o0[4 * grp + 1] * inv); w0.y = pk2(o0[4 * grp + 2] * inv, o0[4 * grp + 3] * inv);
            w1.x = pk2(o1[4 * grp + 0] * inv, o1[4 * grp + 1] * inv); w1.y = pk2(o1[4 * grp + 2] * inv, o1[4 * grp + 3] * inv);
            *(u32x2*)(op + 8 * grp + 4 * hi) = w0; *(u32x2*)(op + 32 + 8 * grp + 4 * hi) = w1;
        }
        if (hi == 0) LSE[((size_t)g * CH + tokq) * 4 + h] = lse;
        __syncthreads();
        u = un;
    }
}
constexpr int SG_WLDS = 17920;
__device__ __forceinline__ void sg_wave_unit(bf16* U, bf16* UO, const bf16* GV, const float* ssv, const bf16* WSb, const float* gain, const float* bs, LAS unsigned char* wl, int unit, int lane) {
    const int hf = unit & 1, gg = (unit >> 1) & 7, nch = unit >> 4, tok0 = nch * 128, cb = gg * 128 + hf * 64;
    LAS float* rvl = (LAS float*)(wl + 17408);
    rvl[lane] = pg8::row_rs(ssv, tok0 + lane); rvl[lane + 64] = pg8::row_rs(ssv, tok0 + lane + 64);
    LDS_WAIT();
    {
        const int c8 = lane & 7, q0 = lane >> 3;
#pragma unroll
        for (int i = 0; i < 16; ++i) {
            const int q = q0 + 8 * i;
            f32x4 a0, a1; pg8::unpack8(*(const u32x4*)(GV + (size_t)(tok0 + q) * 1024 + cb + c8 * 8), a0, a1);
            const float r = rvl[q];
            const u32x4 w = pg8::pack8(a0 * r, a1 * r);
            *(LAS u32x2*)(wl + q * 136 + c8 * 16) = (u32x2){w.x, w.y}; *(LAS u32x2*)(wl + q * 136 + c8 * 16 + 8) = (u32x2){w.z, w.w};
        }
    }
    LDS_WAIT();
    const int ln = lane & 15, kq = lane >> 4, qq = ln >> 2, pp = ln & 3;
    bf16x8 afr[4][4];
#pragma unroll
    for (int ct = 0; ct < 4; ++ct)
#pragma unroll
        for (int ks = 0; ks < 4; ++ks) {
            const unsigned ad = (unsigned)((32 * ks + 8 * kq + qq) * 136 + (32 * (ct >> 1) + 8 * pp + 4 * (ct & 1)) * 2);
            const v4i16_t r1 = __builtin_amdgcn_ds_read_tr16_b64_v4i16((LAS v4i16_t*)(wl + ad)), r2 = __builtin_amdgcn_ds_read_tr16_b64_v4i16((LAS v4i16_t*)(wl + ad + 4 * 136));
            afr[ct][ks] = (bf16x8){r1[0], r1[1], r1[2], r1[3], r2[0], r2[1], r2[2], r2[3]};
        }
    f32x4 gn[2][2];
#pragma unroll
    for (int t = 0; t < 2; ++t) { gn[t][0] = *(const f32x4*)(gain + cb + 32 * t + 8 * kq); gn[t][1] = *(const f32x4*)(gain + cb + 32 * t + 8 * kq + 4); }
#pragma unroll 2
    for (int pt = 0; pt < 8; ++pt) {
        const int pr = pt * 16 + ln;
        bf16x8 bfr[4];
#pragma unroll
        for (int ks = 0; ks < 4; ++ks) bfr[ks] = *(const bf16x8*)(WSb + (size_t)gg * 16384 + pr * 128 + 32 * ks + 8 * kq);
        bf16* up = U + (size_t)(tok0 + pr) * 1024 + cb + 8 * kq; bf16* uo = UO + (size_t)(tok0 + pr) * 1024 + cb + 8 * kq;
        const u32x4 uw0 = *(const u32x4*)up, uw1 = *(const u32x4*)(up + 32);
        const float bias = bs[gg * 128 + pr];
        f32x4 acc[4];
#pragma unroll
        for (int ct = 0; ct < 4; ++ct) {
            acc[ct] = (f32x4){0.f, 0.f, 0.f, 0.f};
#pragma unroll
            for (int ks = 0; ks < 4; ++ks) acc[ct] = __builtin_amdgcn_mfma_f32_16x16x32_bf16(afr[ct][ks], bfr[ks], acc[ct], 0, 0, 0);
        }
        f32x4 u0, u1;
        pg8::unpack8(uw0, u0, u1);
        *(u32x4*)uo = pg8::pack8(u0 * (gn[0][0] * acc[0] + bias), u1 * (gn[0][1] * acc[1] + bias));
        pg8::unpack8(uw1, u0, u1);
        *(u32x4*)(uo + 32) = pg8::pack8(u0 * (gn[1][0] * acc[2] + bias), u1 * (gn[1][1] * acc[3] + bias));
    }
    LDS_WAIT();
}
__device__ __forceinline__ void p_merge(const bf16* OUTG, const float* LSE, bf16* OA, int tid, int G, int bid) {
    for (int it = bid * NTHR + tid; it < CH * 32; it += G * NTHR) {
        const int tok = it >> 5, c8 = it & 31, h = c8 >> 3;
        const float l0 = LSE[(size_t)tok * 4 + h], l1 = LSE[((size_t)CH + tok) * 4 + h], l2 = LSE[((size_t)2 * CH + tok) * 4 + h];
        const float mx = fmaxf(l0, fmaxf(l1, l2));
        float w0 = __expf(l0 - mx), w1 = __expf(l1 - mx), w2 = __expf(l2 - mx);
        const float inv = 1.0f / (w0 + w1 + w2); w0 *= inv; w1 *= inv; w2 *= inv;
        f32x4 a0, a1, b0, b1, c0, c1;
        pg8::unpack8(*(const u32x4*)(OUTG + (size_t)tok * 256 + c8 * 8), a0, a1);
        pg8::unpack8(*(const u32x4*)(OUTG + ((size_t)CH + tok) * 256 + c8 * 8), b0, b1);
        pg8::unpack8(*(const u32x4*)(OUTG + ((size_t)2 * CH + tok) * 256 + c8 * 8), c0, c1);
        *(u32x4*)(OA + (size_t)tok * 256 + c8 * 8) = pg8::pack8(a0 * w0 + b0 * w1 + c0 * w2, a1 * w0 + b1 * w1 + c1 * w2);
    }
}
__device__ __forceinline__ void p_conv(const bf16* A, bf16* FG, const float* cw, const float* cb, int S, int tid, int G, int bid) {
    constexpr int RUN = 8, NFC = DFF / 8;
    for (int it = bid * NTHR + tid; it < (CH / RUN) * NFC; it += G * NTHR) {
        const int fc = it % NFC, t0 = (it / NFC) * RUN, f = fc * 8;
        f32x4 wg[3][2], wv[3][2], bg[2], bv[2];
#pragma unroll
        for (int k = 0; k < 3; ++k) { wg[k][0] = *(const f32x4*)(cw + k * NUP + f); wg[k][1] = *(const f32x4*)(cw + k * NUP + f + 4); wv[k][0] = *(const f32x4*)(cw + k * NUP + DFF + f); wv[k][1] = *(const f32x4*)(cw + k * NUP + DFF + f + 4); }
        bg[0] = *(const f32x4*)(cb + f); bg[1] = *(const f32x4*)(cb + f + 4); bv[0] = *(const f32x4*)(cb + DFF + f); bv[1] = *(const f32x4*)(cb + DFF + f + 4);
        const f32x4 z4 = (f32x4){0.f, 0.f, 0.f, 0.f};
        f32x4 pg0 = z4, pg1 = z4, pv0 = z4, pv1 = z4, cg0, cg1, cv0, cv1;
        if ((t0 & (S - 1)) != 0) { pg8::unpack8(*(const u32x4*)(A + (size_t)(t0 - 1) * NUP + f), pg0, pg1); pg8::unpack8(*(const u32x4*)(A + (size_t)(t0 - 1) * NUP + DFF + f), pv0, pv1); }
        pg8::unpack8(*(const u32x4*)(A + (size_t)t0 * NUP + f), cg0, cg1); pg8::unpack8(*(const u32x4*)(A + (size_t)t0 * NUP + DFF + f), cv0, cv1);
#pragma unroll
        for (int i = 0; i < RUN; ++i) {
            const int t = t0 + i;
            f32x4 ng0 = z4, ng1 = z4, nv0 = z4, nv1 = z4;
            if (((t + 1) & (S - 1)) != 0) { pg8::unpack8(*(const u32x4*)(A + (size_t)(t + 1) * NUP + f), ng0, ng1); pg8::unpack8(*(const u32x4*)(A + (size_t)(t + 1) * NUP + DFF + f), nv0, nv1); }
            f32x4 g0 = pg0 * wg[0][0] + cg0 * wg[1][0] + ng0 * wg[2][0] + bg[0], g1 = pg1 * wg[0][1] + cg1 * wg[1][1] + ng1 * wg[2][1] + bg[1];
            const f32x4 v0 = pv0 * wv[0][0] + cv0 * wv[1][0] + nv0 * wv[2][0] + bv[0], v1 = pv1 * wv[0][1] + cv1 * wv[1][1] + nv1 * wv[2][1] + bv[1];
#pragma unroll
            for (int e = 0; e < 4; ++e) { g0[e] = pg8::gelu_tanh(g0[e]) * v0[e]; g1[e] = pg8::gelu_tanh(g1[e]) * v1[e]; }
            *(u32x4*)(FG + (size_t)t * DFF + f) = pg8::pack8(g0, g1);
            pg0 = cg0; pg1 = cg1; pv0 = cv0; pv1 = cv1; cg0 = ng0; cg1 = ng1; cv0 = nv0; cv1 = nv1;
        }
    }
}

__device__ __forceinline__ void p_convfix(const bf16* SB, bf16* FG, const float* cw, const float* cb, int S, int tid, int G, int bid) {
    constexpr int NFC = DFF / 8, NB = CH / 64;
    for (int it = bid * NTHR + tid; it < NB * 2 * NFC; it += G * NTHR) {
        const int fc = it % NFC, r2 = it / NFC, which = r2 & 1, b = r2 >> 1, f = fc * 8, t = b * 64 + (which ? 63 : 0);
        const f32x4 z4 = (f32x4){0.f, 0.f, 0.f, 0.f};
        f32x4 pg0 = z4, pg1 = z4, pv0 = z4, pv1 = z4, cg0, cg1, cv0, cv1, ng0 = z4, ng1 = z4, nv0 = z4, nv1 = z4;
        const bf16* bp = SB + (size_t)b * 4 * NUP + f;
        if (which == 0) {
            if ((t & (S - 1)) != 0) { pg8::unpack8(*(const u32x4*)(bp - NUP), pg0, pg1); pg8::unpack8(*(const u32x4*)(bp - NUP + DFF), pv0, pv1); }
            pg8::unpack8(*(const u32x4*)bp, cg0, cg1); pg8::unpack8(*(const u32x4*)(bp + DFF), cv0, cv1);
            pg8::unpack8(*(const u32x4*)(bp + NUP), ng0, ng1); pg8::unpack8(*(const u32x4*)(bp + NUP + DFF), nv0, nv1);
        } else {
            pg8::unpack8(*(const u32x4*)(bp + 2 * NUP), pg0, pg1); pg8::unpack8(*(const u32x4*)(bp + 2 * NUP + DFF), pv0, pv1);
            pg8::unpack8(*(const u32x4*)(bp + 3 * NUP), cg0, cg1); pg8::unpack8(*(const u32x4*)(bp + 3 * NUP + DFF), cv0, cv1);
            if (((t + 1) & (S - 1)) != 0) { pg8::unpack8(*(const u32x4*)(bp + 4 * NUP), ng0, ng1); pg8::unpack8(*(const u32x4*)(bp + 4 * NUP + DFF), nv0, nv1); }
        }
        f32x4 g0 = *(const f32x4*)(cb + f), g1 = *(const f32x4*)(cb + f + 4), v0 = *(const f32x4*)(cb + DFF + f), v1 = *(const f32x4*)(cb + DFF + f + 4);
        g0 = g0 + pg0 * *(const f32x4*)(cw + f) + cg0 * *(const f32x4*)(cw + NUP + f) + ng0 * *(const f32x4*)(cw + 2 * NUP + f);
        g1 = g1 + pg1 * *(const f32x4*)(cw + f + 4) + cg1 * *(const f32x4*)(cw + NUP + f + 4) + ng1 * *(const f32x4*)(cw + 2 * NUP + f + 4);
        v0 = v0 + pv0 * *(const f32x4*)(cw + DFF + f) + cv0 * *(const f32x4*)(cw + NUP + DFF + f) + nv0 * *(const f32x4*)(cw + 2 * NUP + DFF + f);
        v1 = v1 + pv1 * *(const f32x4*)(cw + DFF + f + 4) + cv1 * *(const f32x4*)(cw + NUP + DFF + f + 4) + nv1 * *(const f32x4*)(cw + 2 * NUP + DFF + f + 4);
#pragma unroll
        for (int e = 0; e < 4; ++e) { g0[e] = pg8::gelu_tanh(g0[e]) * v0[e]; g1[e] = pg8::gelu_tanh(g1[e]) * v1[e]; }
        *(u32x4*)(FG + (size_t)t * DFF + f) = pg8::pack8(g0, g1);
    }
}
#define XB_TMO      128
#define XB_XCNT(j)  (256  + 64 * (j))
#define XB_XSUB(j)  (1280 + 64 * (j))
#define XB_XGEN(j)  (2304 + 64 * (j))
#define XB_TOP      3328
#define XB_TOPGEN   3392
#define XCD_BAR_WORDS 3456
#define XB_SPIN_CAP (1u << 18)

__device__ __forceinline__ unsigned xb_ld(unsigned* p)              { return __hip_atomic_load(p, __ATOMIC_RELAXED, __HIP_MEMORY_SCOPE_AGENT); }
__device__ __forceinline__ unsigned xb_add(unsigned* p, unsigned v) { return __hip_atomic_fetch_add(p, v, __ATOMIC_RELAXED, __HIP_MEMORY_SCOPE_AGENT); }
__device__ __forceinline__ unsigned xb_xcc_id() { return (unsigned)__builtin_amdgcn_s_getreg((3 << 11) | 20) & 0xFu; }
#define XB_SPIN(cond, bar) do { unsigned _sp = 0; while (cond) { __builtin_amdgcn_s_sleep(1); \
    if ((++_sp & 255u) == 0u) { if (xb_ld(&(bar)[XB_TMO])) break; if (_sp > XB_SPIN_CAP) { atomicAdd(&(bar)[XB_TMO], 1u); break; } } } } while (0)

struct XcdBarrier {
    unsigned* bar; unsigned x;
    volatile LAS unsigned* st;
};

__device__ __forceinline__ XcdBarrier xcd_barrier_post(unsigned* bar, volatile LAS unsigned* st, const int tid) {
    XcdBarrier b; b.bar = bar; b.x = xb_xcc_id(); b.st = st;
    if (tid == 0) (void)xb_add(&bar[XB_XCNT(b.x)], 1u);
    return b;
}
__device__ __forceinline__ void xcd_barrier_complete(unsigned* bar, unsigned x, unsigned& nloc, unsigned& nx) {
    const unsigned G = gridDim.x * gridDim.y * gridDim.z;
    unsigned sum, cnt, mine, sp = 0u;
    for (;;) {
        sum = 0u; cnt = 0u; mine = 0u;
#pragma unroll
        for (unsigned j = 0; j < 16; ++j) { const unsigned c = xb_ld(&bar[XB_XCNT(j)]); sum += c; cnt += (c > 0u) ? 1u : 0u; mine = (j == x) ? c : mine; }
        if (sum == G) break;
        __builtin_amdgcn_s_sleep(1);
        if ((++sp & 255u) == 0u) { if (xb_ld(&bar[XB_TMO])) break; if (sp > XB_SPIN_CAP) { atomicAdd(&bar[XB_TMO], 1u); break; } }
    }
    nloc = mine > 0u ? mine : 1u; nx = cnt > 0u ? cnt : 1u;
}

__device__ __forceinline__ void xcd_barrier(const XcdBarrier& b, const int tid) {
    asm volatile("s_waitcnt vmcnt(0)" ::: "memory");
    __syncthreads();
    if (tid == 0) {
        unsigned* bar = b.bar;
        __builtin_amdgcn_s_waitcnt(0);
        unsigned nloc = b.st[0], nx = b.st[1];
        if (nloc == 0u) { xcd_barrier_complete(bar, b.x, nloc, nx); b.st[0] = nloc; b.st[1] = nx; }
        const unsigned old = xb_add(&bar[XB_XSUB(b.x)], 1u);
        const unsigned gen = old / nloc;
        if (old + 1u == (gen + 1u) * nloc) {
            __builtin_amdgcn_fence(__ATOMIC_RELEASE, "agent");
            asm volatile("s_waitcnt vmcnt(0)" ::: "memory");
            const unsigned og = xb_add(&bar[XB_TOP], 1u);
            const unsigned tg = og / nx;
            if (og + 1u == (tg + 1u) * nx) xb_add(&bar[XB_TOPGEN], 1u);
            else XB_SPIN(xb_ld(&bar[XB_TOPGEN]) == tg, bar);
            __builtin_amdgcn_fence(__ATOMIC_ACQUIRE, "agent");
            xb_add(&bar[XB_XGEN(b.x)], 1u);
            asm volatile("s_waitcnt vmcnt(0)" ::: "memory");
        } else {
            XB_SPIN(xb_ld(&bar[XB_XGEN(b.x)]) == gen, bar);
            __builtin_amdgcn_fence(__ATOMIC_ACQUIRE, "agent");
            asm volatile("s_waitcnt vmcnt(0)" ::: "memory");
        }
    }
    __syncthreads();
}


__global__ void __launch_bounds__(NTHR, 2) fwd_kernel(Args a_in) {
    extern __shared__ __attribute__((aligned(16))) unsigned char lds_raw[];
    LAS unsigned char* lds = (LAS unsigned char*)lds_raw;
    cg::grid_group grid = cg::this_grid();
    const int ph_lo = a_in.ph_lo, ph_hi = a_in.ph_hi;
    volatile LAS unsigned* xst = (volatile LAS unsigned*)(lds + LDS_BYTES - 16);
    if (threadIdx.x < 2) xst[threadIdx.x] = 0u;
    __syncthreads();
    const unsigned xcc = xcd_barrier_post((unsigned*)(a_in.ws + WS_BAR), xst, (int)threadIdx.x).x;
    for (int ph = ph_lo; ph < ph_hi; ++ph) {
#if defined(__HIP_DEVICE_COMPILE__)
        typedef const __attribute__((address_space(4))) unsigned long long* cu64p4;
        cu64p4 ap = (cu64p4)__builtin_amdgcn_kernarg_segment_ptr();
        asm volatile("" : "+s"(ap));
        Args a;
#pragma unroll
        for (int i = 0; i < 17; ++i) a.in[i] = (const float*)ap[i];
        a.out = (float*)ap[17]; a.ws = (unsigned char*)ap[18]; a.ph_lo = ph_lo; a.ph_hi = ph_hi;
#else
        const Args a = a_in;
#endif
        int tid = threadIdx.x, G = gridDim.x, bid = blockIdx.x;
        asm volatile("" : "+v"(tid)); asm volatile("" : "+s"(G)); asm volatile("" : "+s"(bid));
        unsigned char* ws = a.ws;
        bf16* Wb = (bf16*)(ws + WS_W);
        bf16* QKV = (bf16*)(ws + WS_R1); bf16* U = QKV + (size_t)CH * 2304; bf16* GV = U + (size_t)CH * 1024; bf16* GT = GV + (size_t)CH * 1024;
        bf16* AF = (bf16*)(ws + WS_R1);
        bf16* MG = GV;
        bf16* OUTG = (bf16*)(ws + WS_R2); bf16* OA = OUTG + (size_t)3 * CH * 256; float* LSE = (float*)(OA + (size_t)CH * 256);
        bf16* FG = (bf16*)(ws + WS_R2);
        bf16* XB = (bf16*)(ws + WS_XB); float* SS = (float*)(ws + WS_SS); float* SSV = (float*)(ws + WS_SSV);
        if (ph < NP0) p0_weights(a, lds, tid, G, bid);
        else {
            const int chunk = (ph - NP0) / PH_PER_CHUNK, sub = (ph - NP0) % PH_PER_CHUNK;
            const int S = chunk == 0 ? 8192 : 2048;
            if (sub == 0) { p0x(a, chunk, tid, G, bid); if (PROBE_KIND == 10) p0x(a, chunk, tid, G, bid); }
            else if (sub == PH_PER_CHUNK - 1) pfinal(a, chunk, tid, G, bid);
            else {
                const int l = (sub - 1) / KPL, ki = (sub - 1) % KPL, k = (KPL == 9 && ki > PROBE_DUPK) ? ki - 1 : ki; const bool dup = (KPL == 9 && ki == PROBE_DUPK + 1);
                const bf16* wl = Wb + (size_t)l * W_LAYER;
                float* X = a.out + (size_t)chunk * CH * DM;
                if (k == 0 && !(SKIPMASK & 1)) {
                    pg8::Gemm g{XB, wl + OFF_IN, CH, NIN, DM}; pg8::StaticOrder So; So.init(CH, NIN, G, bid);
                    pg8::EpiIn E{QKV, U, GV, GT, SS, SSV};
                    pg8::gemm_phase<pg8::EpiIn, pg8::StaticOrder, true, true>(lds, g, So, E, tid);
                } else if (k == 1 && !(SKIPMASK & 2)) {
                    constexpr int NATT = 3 * (CH / 64), NSGW = (CH / 128) * 16;
                    if (!(SKIPMASK & 1024) && !(dup && PROBE_KIND == 8)) attn_phase(QKV, OUTG, LSE, (const float*)(ws + WS_BT), lds, S, tid, G, bid);
                    if (!(SKIPMASK & 2048) && (!dup || PROBE_KIND == 8)) {
                        bf16* UO = dup ? (bf16*)(ws + WS_R2 + (size_t)CH * 2096) : U;
                        const int wave = __builtin_amdgcn_readfirstlane(tid >> 6);
                        for (int wu = bid * 8 + wave; wu < NSGW; wu += G * 8) sg_wave_unit(U, UO, GV, SSV, wl + OFF_WS, a.in[5] + l * 1024, a.in[7] + l * 1024, lds + wave * SG_WLDS, wu, tid & 63);
                    }
                } else if (k == 2 && !(SKIPMASK & 4)) p_merge(OUTG, LSE, OA, tid, G, bid);
                else if (k == 3 && !(SKIPMASK & 8)) {
                    if (!(SKIPMASK & 4096)) { int kpa = 256; asm volatile("" : "+s"(kpa)); pg8::Gemm g{OA, wl + OFF_PA, CH, DM, kpa}; pg8::StaticOrder So; So.init(CH, DM, G, bid);
                      pg8::EpiGate<0> E{MG, GT, 0};
                      pg8::gemm_phase<pg8::EpiGate<0>, pg8::StaticOrder, true, true>(lds, g, So, E, tid); }
                    if (!(SKIPMASK & 8192)) { pg8::Gemm g{U, wl + OFF_PB, CH, DM, DM}; pg8::StaticOrder So; So.init(CH, DM, G, bid);
                      pg8::EpiGate<1> E{MG, GT, 1024};
                      pg8::gemm_phase<pg8::EpiGate<1>, pg8::StaticOrder, true, true>(lds, g, So, E, tid); }
                } else if (k == 4 && !(SKIPMASK & 16)) {
                    pg8::Gemm g{MG, wl + OFF_OUT, CH, DM, DM}; pg8::StaticOrder So; So.init(CH, DM, G, bid);
                    pg8::EpiRes E{dup ? QKV + (size_t)CH * 1024 : (bf16*)(ws + WS_XL), dup ? QKV : XB, dup ? SSV : SS};
                    pg8::gemm_phase<pg8::EpiRes, pg8::StaticOrder, true, true>(lds, g, So, E, tid);
                } else if (k == 5 && !(SKIPMASK & 32)) {
                    pg8::Gemm g{XB, wl + OFF_UP, CH, NUP, DM}; pg8::StaticOrder So; So.init(CH, NUP, G, bid);
                    pg8::EpiUpConv E{FG, (bf16*)(ws + WS_SB), SS, a.in[13] + (size_t)l * 3 * NUP, a.in[14] + (size_t)l * NUP};
                    pg8::gemm_phase<pg8::EpiUpConv, pg8::StaticOrder, true, true>(lds, g, So, E, tid);
                } else if (k == 6 && !(SKIPMASK & 64)) p_convfix((const bf16*)(ws + WS_SB), FG, a.in[13] + (size_t)l * 3 * NUP, a.in[14] + (size_t)l * NUP, S, tid, G, bid);
                else if (!(SKIPMASK & 128)) {
                    pg8::Gemm g{FG, wl + OFF_DN, CH, DM, DFF}; pg8::StaticOrder So; So.init(CH, DM, G, bid);
                    pg8::EpiRes E{dup ? QKV + (size_t)CH * 1024 : (bf16*)(ws + WS_XL), dup ? QKV : XB, dup ? SSV : SS};
                    pg8::gemm_phase<pg8::EpiRes, pg8::StaticOrder, true, true>(lds, g, So, E, tid);
                }
            }
        }
        if (ph + 1 < ph_hi) {
            if (ph == ph_lo) grid.sync();
            XcdBarrier xb; xb.bar = (unsigned*)(a.ws + WS_BAR); xb.x = xcc; xb.st = xst;
            xcd_barrier(xb, tid);
            if (PROBE_KIND == 100) xcd_barrier(xb, tid);
        }
    }
}

extern "C" void kernel_launch(void* const* d_in, const int* in_sizes, int n_in, void* d_out, int out_size, void* d_ws, size_t ws_size, hipStream_t stream) {
    static int grid = 0;
    if (grid == 0) {
        if (n_in != 17 || out_size != NTOK * DM || ws_size < WS_END) { fprintf(stderr, "kernel_launch: unexpected shapes: n_in %d out %d ws %zu (need %zu)\n", n_in, out_size, ws_size, (size_t)WS_END); grid = -1; return; }
        int dev = 0, cus = 0, per_cu = 0;
        (void)hipGetDevice(&dev); (void)hipDeviceGetAttribute(&cus, hipDeviceAttributeMultiprocessorCount, dev);
        if (hipFuncSetAttribute((const void*)fwd_kernel, hipFuncAttributeMaxDynamicSharedMemorySize, LDS_BYTES) != hipSuccess) { fprintf(stderr, "kernel_launch: hipFuncSetAttribute failed\n"); grid = -1; return; }
        if (hipOccupancyMaxActiveBlocksPerMultiprocessor(&per_cu, (const void*)fwd_kernel, NTHR, LDS_BYTES) != hipSuccess || per_cu < 1) { fprintf(stderr, "kernel_launch: occupancy query says %d\n", per_cu); per_cu = 1; }
        (void)hipGetLastError();
        grid = cus * per_cu;
        if (grid <= 0) grid = 256;
    }
    if (grid < 0) return;
    if (hipMemsetAsync((char*)d_ws + WS_BAR, 0, 65536, stream) != hipSuccess) { fprintf(stderr, "kernel_launch: memset failed\n"); return; }
    Args a{};
    for (int i = 0; i < 17; ++i) a.in[i] = (const float*)d_in[i];
    a.out = (float*)d_out; a.ws = (unsigned char*)d_ws;
#if ONE_LAUNCH
    a.ph_lo = 0; a.ph_hi = N_PHASES;
    void* args[] = {&a};
    hipError_t e = hipLaunchCooperativeKernel((const void*)fwd_kernel, dim3(grid), dim3(NTHR), args, LDS_BYTES, stream);
    if (e != hipSuccess) fprintf(stderr, "cooperative launch failed: %s (grid %d)\n", hipGetErrorString(e), grid);
#else
    for (int ph = 0; ph < N_PHASES; ++ph) {
        a.ph_lo = ph; a.ph_hi = ph + 1;
        hipLaunchKernelGGL(fwd_kernel, dim3(grid), dim3(NTHR), LDS_BYTES, stream, a);
    }
#endif
}
```

```cpp
#include <hip/hip_runtime.h>
#include <hip/hip_cooperative_groups.h>
#include <cstdio>
#include <cstdint>
namespace cg = cooperative_groups;

#ifndef ONE_LAUNCH
#define ONE_LAUNCH 1
#endif

namespace pg8 {
#define PG8_LAS __attribute__((address_space(3)))
typedef unsigned short bf16_t;
typedef short bf16x8 __attribute__((ext_vector_type(8)));
typedef float f32x4 __attribute__((ext_vector_type(4)));
typedef unsigned u32x4 __attribute__((ext_vector_type(4)));
constexpr int BM = 256, BK = 64, HALF = 128, HTB = HALF * BK * 2  , STAGE_BYTES = 8 * HTB, NXCD = 8, WGM = 8;

__host__ __device__ __forceinline__ int lds_byte(int r, int c) { const int st = (r >> 4) * 2 + (c >> 5), rr = r & 15, cc = c & 31, ob = rr * 64 + cc * 2; return st * 1024 + (ob ^ (((ob >> 9) & 1) << 5)); }
__host__ __device__ __forceinline__ void stage_rc(int b, int& R, int& C) { const int st = b / 1024, sb = b % 1024, swz = sb ^ (((sb >> 9) & 1) << 5); R = (st >> 1) * 16 + swz / 64; C = (st & 1) * 32 + (swz % 64) / 2; }
__host__ __device__ __forceinline__ int perm32(int rho) { const int n = rho >> 4, i = rho & 15; return 8 * (i >> 2) + 4 * n + (i & 3); }

struct Unit { int pm, pn; };
struct Gemm { const bf16_t* A; const bf16_t* Bt; int M, N, K; };

struct StaticOrder {
    int nM, nN, nwg, G, c;
    __host__ __device__ void init(int M, int N, int G_, int c_) { nM = M / BM; nN = N / BM; nwg = nM * nN; G = G_; c = c_; }
    __host__ __device__ bool next(int i, Unit& u) const {
        const long L = (long)i * G + c; if (L >= nwg) return false;
        int wgid = (int)L; { const int q = nwg / NXCD, r = nwg % NXCD, xcd = wgid % NXCD, off = wgid / NXCD; wgid = (xcd < r ? xcd * (q + 1) : r * (q + 1) + (xcd - r) * q) + off; }
        const int nig = WGM * nN, gid = wgid / nig, fm = gid * WGM, gsz = (nM - fm) < WGM ? (nM - fm) : WGM;
        u.pm = fm + ((wgid % nig) % gsz); u.pn = (wgid % nig) / gsz; return true;
    }
    __device__ __forceinline__ void a_ready(const Unit&) const {}
    __device__ __forceinline__ void done(const Unit&) const {}
};

__device__ __forceinline__ unsigned cvt_pk_bf16(float lo, float hi) { unsigned r; asm volatile("v_cvt_pk_bf16_f32 %0, %1, %2" : "=v"(r) : "v"(lo), "v"(hi)); return r; }

__device__ __forceinline__ float fast_sigmoid(float x) { return __builtin_amdgcn_rcpf(1.0f + __builtin_amdgcn_exp2f(-1.4426950408889634f * x)); }
__device__ __forceinline__ float gelu_tanh(float x) {
    const float y = x * (1.0f + 0.044715f * x * x) * (2.0f * 0.7978845608028654f);
    return x * __builtin_amdgcn_rcpf(1.0f + __builtin_amdgcn_exp2f(-1.4426950408889634f * y));
}
__device__ __forceinline__ float bf2f(unsigned short b) { return __uint_as_float(((unsigned)b) << 16); }
__device__ __forceinline__ u32x4 pack8(const f32x4 a, const f32x4 b) { u32x4 w; w.x = cvt_pk_bf16(a[0], a[1]); w.y = cvt_pk_bf16(a[2], a[3]); w.z = cvt_pk_bf16(b[0], b[1]); w.w = cvt_pk_bf16(b[2], b[3]); return w; }
__device__ __forceinline__ void unpack8(const u32x4 w, f32x4& a, f32x4& b) {
    a[0] = __uint_as_float(w.x << 16); a[1] = __uint_as_float(w.x & 0xffff0000u); a[2] = __uint_as_float(w.y << 16); a[3] = __uint_as_float(w.y & 0xffff0000u);
    b[0] = __uint_as_float(w.z << 16); b[1] = __uint_as_float(w.z & 0xffff0000u); b[2] = __uint_as_float(w.w << 16); b[3] = __uint_as_float(w.w & 0xffff0000u);
}
__device__ __forceinline__ float row_rs(const float* ss, int row) {
    const f32x4* sp = (const f32x4*)(ss + (size_t)row * 16);
    const f32x4 s = (sp[0] + sp[1]) + (sp[2] + sp[3]);
    return rsqrtf(((s[0] + s[1]) + (s[2] + s[3])) * (1.0f / 1024.0f) + 1e-6f);
}

__device__ __forceinline__ void rows_rs(const float* ss, int row0, int fq, float (&rsv)[2][4]) {
    f32x4 part[2][4];
#pragma unroll
    for (int ai = 0; ai < 2; ++ai)
#pragma unroll
        for (int m = 0; m < 4; ++m) part[ai][m] = *(const f32x4*)(ss + (size_t)(row0 + ai * HALF + m * 16) * 16 + fq * 4);
#pragma unroll
    for (int ai = 0; ai < 2; ++ai)
#pragma unroll
        for (int m = 0; m < 4; ++m) { float t = (part[ai][m][0] + part[ai][m][1]) + (part[ai][m][2] + part[ai][m][3]); t += __shfl_xor(t, 16); t += __shfl_xor(t, 32); rsv[ai][m] = rsqrtf(t * (1.0f / 1024.0f) + 1e-6f); }
}

struct EpiIn {
    static constexpr bool PERM = true, AFTER_DRAIN = false;
    bf16_t* QKV; bf16_t* U; bf16_t* GV; bf16_t* G; const float* ss; float* ssv;
    __device__ __forceinline__ void operator()(const f32x4 (&acc)[2][2][4][2], const Unit& u, int wr, int wc, int fr, int fq) const {
        const int pn = u.pn;
        float rsv[2][4]; rows_rs(ss, u.pm * BM + wr * 64 + fr, fq, rsv);
#pragma unroll
        for (int ai = 0; ai < 2; ++ai)
#pragma unroll
            for (int m = 0; m < 4; ++m) {
                const int row = u.pm * BM + ai * HALF + wr * 64 + m * 16 + fr;
                const float rs = rsv[ai][m];
                float q = 0.f;
#pragma unroll
                for (int bj = 0; bj < 2; ++bj) {
                    const int col = pn * BM + bj * HALF + wc * 32 + 8 * fq;
                    f32x4 v0 = acc[ai][bj][m][0] * rs, v1 = acc[ai][bj][m][1] * rs;
                    bf16_t* dst;
                    if (pn < 9) { if (pn < 3) { v0 = v0 * (0.125f * 1.4426950408889634f); v1 = v1 * (0.125f * 1.4426950408889634f); }     dst = QKV + (size_t)row * 2304 + col; }
                    else if (pn < 17) {
#pragma unroll
                        for (int e = 0; e < 4; ++e) { v0[e] = gelu_tanh(v0[e]); v1[e] = gelu_tanh(v1[e]); }
                        if (pn < 13) dst = U + (size_t)row * 1024 + (col - 2304);
                        else { dst = GV + (size_t)row * 1024 + (col - 3328);
#pragma unroll
                            for (int e = 0; e < 4; ++e) q += v0[e] * v0[e] + v1[e] * v1[e]; }
                    } else {
#pragma unroll
                        for (int e = 0; e < 4; ++e) { v0[e] = fast_sigmoid(v0[e]); v1[e] = fast_sigmoid(v1[e]); }
                        dst = G + (size_t)row * 2048 + (col - 4352);
                    }
                    *(u32x4*)dst = pack8(v0, v1);
                }
                if (pn >= 13 && pn < 17) { q += __shfl_xor(q, 16); q += __shfl_xor(q, 32); if (fq == 0) ssv[(size_t)row * 16 + (pn - 13) * 4 + wc] = q; }
                asm volatile("" ::: "memory");
            }
    }
};
template <int MODE> struct EpiGate {
    static constexpr bool PERM = true, AFTER_DRAIN = false;
    bf16_t* O; const bf16_t* G; int goff;
    __device__ __forceinline__ void operator()(const f32x4 (&acc)[2][2][4][2], const Unit& u, int wr, int wc, int fr, int fq) const {
#pragma unroll
        for (int ai = 0; ai < 2; ++ai) {
            u32x4 gw[4][2], pw[4][2];
#pragma unroll
            for (int m = 0; m < 4; ++m)
#pragma unroll
                for (int bj = 0; bj < 2; ++bj) {
                    const int row = u.pm * BM + ai * HALF + wr * 64 + m * 16 + fr, col = u.pn * BM + bj * HALF + wc * 32 + 8 * fq;
                    gw[m][bj] = *(const u32x4*)(G + (size_t)row * 2048 + goff + col);
                    if (MODE == 1) pw[m][bj] = *(const u32x4*)(O + (size_t)row * 1024 + col);
                }
#pragma unroll
            for (int m = 0; m < 4; ++m)
#pragma unroll
                for (int bj = 0; bj < 2; ++bj) {
                    const int row = u.pm * BM + ai * HALF + wr * 64 + m * 16 + fr, col = u.pn * BM + bj * HALF + wc * 32 + 8 * fq;
                    f32x4 g0, g1; unpack8(gw[m][bj], g0, g1);
                    f32x4 v0 = acc[ai][bj][m][0] * g0, v1 = acc[ai][bj][m][1] * g1;
                    if (MODE == 1) { f32x4 p0, p1; unpack8(pw[m][bj], p0, p1); v0 = v0 + p0; v1 = v1 + p1; }
                    *(u32x4*)(O + (size_t)row * 1024 + col) = pack8(v0, v1);
                }
            asm volatile("" ::: "memory");
        }
    }
};
struct EpiRes {
    static constexpr bool PERM = true, AFTER_DRAIN = false;
    bf16_t* XL; bf16_t* XB; float* ss;
    __device__ __forceinline__ void operator()(const f32x4 (&acc)[2][2][4][2], const Unit& u, int wr, int wc, int fr, int fq) const {
#pragma unroll
        for (int ai = 0; ai < 2; ++ai)
#pragma unroll
        for (int mp = 0; mp < 2; ++mp) {
            u32x4 hv[2][2], lv[2][2];
#pragma unroll
            for (int mi = 0; mi < 2; ++mi)
#pragma unroll
                for (int bj = 0; bj < 2; ++bj) {
                    const size_t off = (size_t)(u.pm * BM + ai * HALF + wr * 64 + (2 * mp + mi) * 16 + fr) * 1024 + u.pn * BM + bj * HALF + wc * 32 + 8 * fq;
                    hv[mi][bj] = *(const u32x4*)(XB + off); lv[mi][bj] = *(const u32x4*)(XL + off);
                }
#pragma unroll
            for (int mi = 0; mi < 2; ++mi) {
                const int m = 2 * mp + mi, row = u.pm * BM + ai * HALF + wr * 64 + m * 16 + fr;
                float q = 0.f;
#pragma unroll
                for (int bj = 0; bj < 2; ++bj) {
                    const size_t off = (size_t)row * 1024 + u.pn * BM + bj * HALF + wc * 32 + 8 * fq;
                    f32x4 h0, h1, l0, l1; unpack8(hv[mi][bj], h0, h1); unpack8(lv[mi][bj], l0, l1);
                    const f32x4 x0 = (h0 + l0) + acc[ai][bj][m][0], x1 = (h1 + l1) + acc[ai][bj][m][1];
                    const u32x4 hw = pack8(x0, x1);
                    unpack8(hw, h0, h1);
                    *(u32x4*)(XB + off) = hw; *(u32x4*)(XL + off) = pack8(x0 - h0, x1 - h1);
#pragma unroll
                    for (int e = 0; e < 4; ++e) q += x0[e] * x0[e] + x1[e] * x1[e];
                }
                q += __shfl_xor(q, 16); q += __shfl_xor(q, 32);
                if (fq == 0) ss[(size_t)row * 16 + u.pn * 4 + wc] = q;
            }
            asm volatile("" ::: "memory");
        }
    }
};
struct EpiUp {
    static constexpr bool PERM = true, AFTER_DRAIN = false;
    bf16_t* A; const float* ss;
    __device__ __forceinline__ void operator()(const f32x4 (&acc)[2][2][4][2], const Unit& u, int wr, int wc, int fr, int fq) const {
        float rsv[2][4]; rows_rs(ss, u.pm * BM + wr * 64 + fr, fq, rsv);
#pragma unroll
        for (int ai = 0; ai < 2; ++ai)
#pragma unroll
            for (int m = 0; m < 4; ++m) {
                const int row = u.pm * BM + ai * HALF + wr * 64 + m * 16 + fr;
                const float rs = rsv[ai][m];
#pragma unroll
                for (int bj = 0; bj < 2; ++bj) {
                    const int col = u.pn * BM + bj * HALF + wc * 32 + 8 * fq;
                    *(u32x4*)(A + (size_t)row * 5632 + col) = pack8(acc[ai][bj][m][0] * rs, acc[ai][bj][m][1] * rs);
                }
                asm volatile("" ::: "memory");
            }
    }
};

__device__ __forceinline__ float dpp_prev(float x) { return __int_as_float(__builtin_amdgcn_update_dpp(0, __float_as_int(x), 0x121, 0xf, 0xf, false)); }
__device__ __forceinline__ float dpp_next(float x) { return __int_as_float(__builtin_amdgcn_update_dpp(0, __float_as_int(x), 0x12F, 0xf, 0xf, false)); }
__device__ __forceinline__ f32x4 rot_prev(const f32x4 v) { f32x4 r; r[0] = dpp_prev(v[0]); r[1] = dpp_prev(v[1]); r[2] = dpp_prev(v[2]); r[3] = dpp_prev(v[3]); return r; }
__device__ __forceinline__ f32x4 rot_next(const f32x4 v) { f32x4 r; r[0] = dpp_next(v[0]); r[1] = dpp_next(v[1]); r[2] = dpp_next(v[2]); r[3] = dpp_next(v[3]); return r; }
struct EpiUpConv {
    static constexpr bool PERM = true, AFTER_DRAIN = false;
    bf16_t* FG; bf16_t* SB; const float* ss; const float* cw; const float* cb;
    __device__ __forceinline__ void operator()(const f32x4 (&acc_)[2][2][4][2], const Unit& u, int wr, int wc, int fr, int fq) const {
        f32x4 (&acc)[2][2][4][2] = const_cast<f32x4 (&)[2][2][4][2]>(acc_);
        float rsv[2][4]; rows_rs(ss, u.pm * BM + wr * 64 + fr, fq, rsv);
        const int f0 = u.pn * 128 + wc * 32 + 8 * fq;
        const bool first = fr == 0, last = fr == 15;
#pragma unroll
        for (int ai = 0; ai < 2; ++ai) {
#pragma unroll
            for (int m = 0; m < 4; ++m)
#pragma unroll
                for (int h = 0; h < 2; ++h) { acc[ai][h][m][0] = acc[ai][h][m][0] * rsv[ai][m]; acc[ai][h][m][1] = acc[ai][h][m][1] * rsv[ai][m]; }
            const int blk = (u.pm * BM + ai * HALF + wr * 64) >> 6;
            if (fr <= 1) { bf16_t* sp = SB + ((size_t)blk * 4 + fr) * 5632 + f0;
                *(u32x4*)sp = pack8(acc[ai][0][0][0], acc[ai][0][0][1]); *(u32x4*)(sp + 2816) = pack8(acc[ai][1][0][0], acc[ai][1][0][1]); }
            if (fr >= 14) { bf16_t* sp = SB + ((size_t)blk * 4 + (fr - 12)) * 5632 + f0;
                *(u32x4*)sp = pack8(acc[ai][0][3][0], acc[ai][0][3][1]); *(u32x4*)(sp + 2816) = pack8(acc[ai][1][3][0], acc[ai][1][3][1]); }
        }
#pragma unroll
        for (int n = 0; n < 2; ++n) {
            f32x4 w[2][4];
#pragma unroll
            for (int h = 0; h < 2; ++h) {
#pragma unroll
                for (int k = 0; k < 3; ++k) w[h][k] = *(const f32x4*)(cw + k * 5632 + h * 2816 + f0 + 4 * n);
                w[h][3] = *(const f32x4*)(cb + h * 2816 + f0 + 4 * n);
            }
#pragma unroll
            for (int ai = 0; ai < 2; ++ai) {
#pragma unroll
                for (int m = 0; m < 4; ++m) {
                    const int row = u.pm * BM + ai * HALF + wr * 64 + m * 16 + fr;
                    f32x4 cv[2];
#pragma unroll
                    for (int h = 0; h < 2; ++h) {
                        const f32x4 cur = acc[ai][h][m][n];
                        f32x4 pv = rot_prev(cur), nx = rot_next(cur);
                        if (m > 0) { const f32x4 pw = rot_prev(acc[ai][h][m - 1][n]);
#pragma unroll
                            for (int e = 0; e < 4; ++e) pv[e] = first ? pw[e] : pv[e]; }
                        if (m < 3) { const f32x4 nw = rot_next(acc[ai][h][m + 1][n]);
#pragma unroll
                            for (int e = 0; e < 4; ++e) nx[e] = last ? nw[e] : nx[e]; }
                        cv[h] = pv * w[h][0] + cur * w[h][1] + nx * w[h][2] + w[h][3];
                    }
                    f32x4 o;
#pragma unroll
                    for (int e = 0; e < 4; ++e) o[e] = gelu_tanh(cv[0][e]) * cv[1][e];
                    const bool brow = (m == 0 && first) || (m == 3 && last);
                    if (!brow) { typedef unsigned u32x2e __attribute__((ext_vector_type(2))); u32x2e ow; ow.x = cvt_pk_bf16(o[0], o[1]); ow.y = cvt_pk_bf16(o[2], o[3]); *(u32x2e*)(FG + (size_t)row * 2816 + f0 + 4 * n) = ow; }
                }
                asm volatile("" ::: "memory");
            }
        }
    }
};

template <class Epi, class Sched, bool ALIGN_EPI = false, bool SP2 = false>
__device__ __forceinline__ void gemm_phase(PG8_LAS unsigned char* lds, const Gemm g, const Sched& S, const Epi& E, const int tid) {
    const int wid = __builtin_amdgcn_readfirstlane(tid >> 6), lane = tid & 63, wr = wid >> 2, wc = wid & 3, fr = lane & 15, fq = lane >> 4;
    const int K = g.K, nt = K / BK;
    unsigned voffA[2], voffB[2];
#pragma unroll
    for (int i = 0; i < 2; ++i) { int R, C; stage_rc(tid * 16 + i * 8192, R, C); const int Rb = Epi::PERM ? ((R & ~31) + perm32(R & 31)) : R;
        voffA[i] = (unsigned)(R * K + C) * 2u; voffB[i] = (unsigned)(Rb * K + C) * 2u; }
    const size_t kstep = (size_t)(BK * 2);
    const size_t hstep = (size_t)HALF * K * 2;
    const size_t tstep = 2 * hstep;
    const unsigned ldsw = (unsigned)wid * 1024u;
    const int aoff = lds_byte(wr * 64 + fr, fq * 8), boff = lds_byte(wc * 32 + fr, fq * 8);
#define PG8_SA(b, h) (((b) * 2 + (h)) * HTB)
#define PG8_SB(b, h) ((4 + (b) * 2 + (h)) * HTB)
#define PG8_STAGE(bufoff, gbase, voff) do { _Pragma("unroll") for (int _i = 0; _i < 2; ++_i) \
        __builtin_amdgcn_global_load_lds((const unsigned*)((const char*)(gbase) + (voff)[_i]), (PG8_LAS unsigned*)(lds + (bufoff) + ldsw + _i * 8192), 16, 0, 0); } while (0)
#define PG8_LDA(dst, b, h) do { _Pragma("unroll") for (int m = 0; m < 4; ++m) _Pragma("unroll") for (int k = 0; k < 2; ++k) dst[m][k] = *(const PG8_LAS bf16x8*)(lds + PG8_SA(b, h) + aoff + m * 2048 + k * 1024); } while (0)
#define PG8_LDB(dst, b, h) do { _Pragma("unroll") for (int n = 0; n < 2; ++n) _Pragma("unroll") for (int k = 0; k < 2; ++k) dst[n][k] = *(const PG8_LAS bf16x8*)(lds + PG8_SB(b, h) + boff + n * 2048 + k * 1024); } while (0)
#define PG8_MMA(ai, bj, At, Bt) do { __builtin_amdgcn_s_setprio(1); _Pragma("unroll") for (int m = 0; m < 4; ++m) _Pragma("unroll") for (int n = 0; n < 2; ++n) _Pragma("unroll") for (int k = 0; k < 2; ++k) \
        acc[ai][bj][m][n] = __builtin_amdgcn_mfma_f32_16x16x32_bf16(Bt[n][k], At[m][k], acc[ai][bj][m][n], 0, 0, 0); __builtin_amdgcn_s_setprio(0); } while (0)
#define PG8_WAIT_V(n) asm volatile("s_waitcnt vmcnt(" #n ")" ::: "memory")
#define PG8_WAIT_L(n) asm volatile("s_waitcnt lgkmcnt(" #n ")" ::: "memory")
#define PG8_BAR __builtin_amdgcn_s_barrier()
#define PG8_SCHED __builtin_amdgcn_sched_barrier(0)
    Unit cur, nxt; int ui = 0;
    if (!S.next(0, cur)) return;
    f32x4 acc[2][2][4][2];
#pragma unroll
    for (int a = 0; a < 2; ++a)
#pragma unroll
        for (int b = 0; b < 2; ++b)
#pragma unroll
            for (int m = 0; m < 4; ++m)
#pragma unroll
                for (int n = 0; n < 2; ++n) acc[a][b][m][n] = (f32x4){0.f, 0.f, 0.f, 0.f};
    bf16x8 At[4][2], B0[2][2], B1[2][2];
    const char* cA = (const char*)g.A + (size_t)cur.pm * tstep; const char* cB = (const char*)g.Bt + (size_t)cur.pn * tstep;
    S.a_ready(cur);
    if constexpr (SP2) {
        PG8_STAGE(PG8_SB(0, 0), cB, voffB); PG8_STAGE(PG8_SB(0, 1), cB + hstep, voffB); PG8_STAGE(PG8_SA(0, 0), cA, voffA); PG8_STAGE(PG8_SA(0, 1), cA + hstep, voffA);
        if (wr == 1) PG8_BAR;
        PG8_WAIT_V(2); PG8_BAR;
        PG8_STAGE(PG8_SB(1, 0), cB + kstep, voffB); PG8_STAGE(PG8_SA(1, 0), cA + kstep, voffA); PG8_STAGE(PG8_SB(1, 1), cB + hstep + kstep, voffB);
        PG8_WAIT_V(6); PG8_BAR;
    } else {
        PG8_STAGE(PG8_SB(0, 0), cB, voffB); PG8_STAGE(PG8_SA(0, 0), cA, voffA); PG8_STAGE(PG8_SB(0, 1), cB + hstep, voffB); PG8_STAGE(PG8_SA(0, 1), cA + hstep, voffA);
        if (wr == 1) PG8_BAR;
        PG8_WAIT_V(4); PG8_BAR;
        PG8_STAGE(PG8_SB(1, 0), cB + kstep, voffB); PG8_STAGE(PG8_SA(1, 0), cA + kstep, voffA); PG8_STAGE(PG8_SB(1, 1), cB + hstep + kstep, voffB);
        PG8_WAIT_V(6); PG8_BAR;
    }
    for (;;) {
        const bool has_next = S.next(ui + 1, nxt);
        const char* nA = has_next ? (const char*)g.A + (size_t)nxt.pm * tstep : cA; const char* nB = has_next ? (const char*)g.Bt + (size_t)nxt.pn * tstep : cB;
        for (int t = 0; t < nt; t += 2) {
            const bool last = (t == nt - 2);
            const char* a1 = cA + (size_t)(t + 1) * kstep;
            const char* a2 = last ? nA : cA + (size_t)(t + 2) * kstep; const char* b2 = last ? nB : cB + (size_t)(t + 2) * kstep;
            const char* a3 = a2 + kstep; const char* b3 = b2 + kstep;
            if (last && has_next) S.a_ready(nxt);
            if constexpr (SP2) {
            PG8_LDB(B0, 0, 0); PG8_LDB(B1, 0, 1); PG8_SCHED; PG8_LDA(At, 0, 0); PG8_STAGE(PG8_SA(1, 1), a1 + hstep, voffA);
            PG8_WAIT_V(8); PG8_WAIT_L(0); PG8_BAR; PG8_MMA(0, 0, At, B0); PG8_MMA(0, 1, At, B1); PG8_BAR; PG8_SCHED;
            PG8_LDA(At, 0, 1); PG8_STAGE(PG8_SB(0, 0), b2, voffB); PG8_STAGE(PG8_SB(0, 1), b2 + hstep, voffB); PG8_STAGE(PG8_SA(0, 0), a2, voffA);
            PG8_WAIT_V(8); PG8_WAIT_L(0); PG8_BAR; PG8_MMA(1, 0, At, B0); PG8_MMA(1, 1, At, B1); PG8_BAR; PG8_SCHED;
            PG8_LDB(B0, 1, 0); PG8_LDB(B1, 1, 1); PG8_SCHED; PG8_LDA(At, 1, 0); PG8_STAGE(PG8_SA(0, 1), a2 + hstep, voffA);
            PG8_WAIT_V(8); PG8_WAIT_L(0); PG8_BAR; PG8_MMA(0, 0, At, B0); PG8_MMA(0, 1, At, B1); PG8_BAR; PG8_SCHED;
            PG8_LDA(At, 1, 1); PG8_STAGE(PG8_SB(1, 0), b3, voffB); PG8_STAGE(PG8_SB(1, 1), b3 + hstep, voffB); PG8_STAGE(PG8_SA(1, 0), a3, voffA);
            PG8_WAIT_V(8); PG8_WAIT_L(0); PG8_BAR; PG8_MMA(1, 0, At, B0); PG8_MMA(1, 1, At, B1); PG8_BAR; PG8_SCHED;
            } else {
            PG8_LDB(B0, 0, 0); PG8_SCHED; PG8_LDA(At, 0, 0); PG8_STAGE(PG8_SA(1, 1), a1 + hstep, voffA);
            PG8_WAIT_L(8); PG8_BAR; PG8_WAIT_L(0); PG8_MMA(0, 0, At, B0); PG8_BAR; PG8_SCHED;
            PG8_LDB(B1, 0, 1); PG8_STAGE(PG8_SB(0, 0), b2, voffB);
            PG8_BAR; PG8_WAIT_L(0); PG8_MMA(0, 1, At, B1); PG8_BAR;
            PG8_LDA(At, 0, 1); PG8_STAGE(PG8_SA(0, 0), a2, voffA);
            PG8_BAR; PG8_WAIT_L(0); PG8_MMA(1, 0, At, B0); PG8_BAR; PG8_SCHED;
            PG8_STAGE(PG8_SB(0, 1), b2 + hstep, voffB);
            PG8_WAIT_V(6); PG8_BAR; PG8_MMA(1, 1, At, B1); PG8_BAR;
            PG8_LDB(B0, 1, 0); PG8_SCHED; PG8_LDA(At, 1, 0); PG8_STAGE(PG8_SA(0, 1), a2 + hstep, voffA);
            PG8_WAIT_L(8); PG8_BAR; PG8_WAIT_L(0); PG8_MMA(0, 0, At, B0); PG8_BAR; PG8_SCHED;
            PG8_LDB(B1, 1, 1); PG8_STAGE(PG8_SB(1, 0), b3, voffB);
            PG8_BAR; PG8_WAIT_L(0); PG8_MMA(0, 1, At, B1); PG8_BAR;
            PG8_LDA(At, 1, 1); PG8_STAGE(PG8_SA(1, 0), a3, voffA);
            PG8_BAR; PG8_WAIT_L(0); PG8_MMA(1, 0, At, B0); PG8_BAR; PG8_SCHED;
            PG8_STAGE(PG8_SB(1, 1), b3 + hstep, voffB);
            PG8_WAIT_V(6); PG8_BAR; PG8_MMA(1, 1, At, B1); PG8_BAR;
            }
        }
        if constexpr (ALIGN_EPI) { if (wr == 0) PG8_BAR; }
        if constexpr (!Epi::AFTER_DRAIN) { E(acc, cur, wr, wc, fr, fq); S.done(cur); }
        if (!has_next) break;
#pragma unroll
        for (int a = 0; a < 2; ++a)
#pragma unroll
            for (int b = 0; b < 2; ++b)
#pragma unroll
                for (int m = 0; m < 4; ++m)
#pragma unroll
                    for (int n = 0; n < 2; ++n) acc[a][b][m][n] = (f32x4){0.f, 0.f, 0.f, 0.f};
        cur = nxt; cA = nA; cB = nB; ++ui;
        if constexpr (ALIGN_EPI) { if (wr == 1) PG8_BAR; }
    }
    PG8_WAIT_V(0);
    if constexpr (!ALIGN_EPI) { if (wr == 0) PG8_BAR; }
    PG8_BAR;
    if constexpr (Epi::AFTER_DRAIN) { E.fused(acc, cur, wr, wc, fr, fq, lds, wid, lane); S.done(cur); }
#undef PG8_SA
#undef PG8_SB
#undef PG8_STAGE
#undef PG8_LDA
#undef PG8_LDB
#undef PG8_MMA
#undef PG8_WAIT_V
#undef PG8_WAIT_L
#undef PG8_BAR
#undef PG8_SCHED
}
}


#define LAS __attribute__((address_space(3)))
#ifndef SKIPMASK
#define SKIPMASK 0
#endif
#ifndef PROBE_KIND
#define PROBE_KIND -1
#endif
typedef unsigned short bf16;
using pg8::f32x4; using pg8::u32x4; using pg8::bf16x8;
typedef float f32x16 __attribute__((ext_vector_type(16)));
typedef short v4i16_t __attribute__((ext_vector_type(4)));
typedef unsigned u32x2 __attribute__((ext_vector_type(2)));

constexpr int DM = 1024, DEPTH = 4, NTOK = 98304, NPROMPT = 32768, CH = 32768, NCHUNK = NTOK / CH;
constexpr int NIN = 6400, DFF = 2816, NUP = 5632;
constexpr int LDS_BYTES = 147456, NTHR = 512;
constexpr float EPS = 1e-6f, LOG2E = 1.4426950408889634f;
constexpr size_t OFF_IN = 0, OFF_PA = OFF_IN + (size_t)NIN * DM, OFF_PB = OFF_PA + (size_t)DM * 256, OFF_OUT = OFF_PB + (size_t)DM * DM, OFF_UP = OFF_OUT + (size_t)DM * DM,
                 OFF_DN = OFF_UP + (size_t)NUP * DM, OFF_WS = OFF_DN + (size_t)DM * DFF, W_LAYER = OFF_WS + 8 * 128 * 128;
constexpr size_t MiB = 1u << 20;
constexpr size_t WS_W = 0, WS_R1 = 144 * MiB, WS_R2 = WS_R1 + (size_t)CH * 12800, WS_XB = WS_R2 + (size_t)CH * 5632, WS_SS = WS_XB + (size_t)CH * 2048, WS_SSV = WS_SS + (size_t)CH * 64, WS_BAR = WS_SSV + (size_t)CH * 64, WS_SB = WS_BAR + 65536, WS_XL = WS_SB + (size_t)(CH / 64) * 4 * 5632 * 2, WS_BT = WS_XL + (size_t)CH * 2048, WS_END = WS_BT + 16384;
static_assert(W_LAYER * 2 * DEPTH <= WS_R1, "weights fit");
constexpr int PROBE_DUPK = (PROBE_KIND == 8) ? 1 : PROBE_KIND;
constexpr int KPL = (PROBE_DUPK >= 0 && PROBE_DUPK < 8) ? 9 : 8;
constexpr int NP0 = (PROBE_KIND == 9) ? 2 : 1;
constexpr int PH_PER_CHUNK = 2 + KPL * DEPTH, N_PHASES = NP0 + NCHUNK * PH_PER_CHUNK;

struct Args { const float* in[17]; float* out; unsigned char* ws; int ph_lo, ph_hi; };

__device__ __forceinline__ float wave_sum(float v) {
#pragma unroll
    for (int o = 1; o < 64; o <<= 1) v += __shfl_xor(v, o);
    return v;
}
__device__ __forceinline__ unsigned pk2(float lo, float hi) { return pg8::cvt_pk_bf16(lo, hi); }
#define LDS_WAIT() asm volatile("s_waitcnt lgkmcnt(0)" ::: "memory")

__device__ __forceinline__ int t5_bucket(int rel) {
    const int n = rel < 0 ? -rel : rel;
    const int b = n < 8 ? n : 8 + (n >= 15) + (n >= 27) + (n >= 50) + (n >= 91) + (n >= 166) + (n >= 305) + (n >= 559);
    return (rel > 0 ? 16 : 0) + b;
}
__device__ __forceinline__ void tr_item(const float* W, int K, int N, bf16* WT, const float* gain, LAS float* scr, int item, int lane, bool perm_up = false) {
    const int nblk = N / 32, kb = item / nblk, nb = item % nblk, k0 = 64 * kb, n0 = 32 * nb;
    const int dn0 = perm_up ? ((n0 % DFF) / 128) * 256 + (n0 / DFF) * 128 + (n0 % 128) : n0;
#pragma unroll
    for (int i = 0; i < 8; ++i) {
        const int kk = (lane >> 3) + 8 * i, c4 = 4 * (lane & 7); const float g = gain ? gain[k0 + kk] : 1.0f;
        const f32x4 v = *(const f32x4*)(W + (size_t)(k0 + kk) * N + n0 + c4);
        scr[kk * 33 + c4 + 0] = v[0] * g; scr[kk * 33 + c4 + 1] = v[1] * g; scr[kk * 33 + c4 + 2] = v[2] * g; scr[kk * 33 + c4 + 3] = v[3] * g;
    }
    LDS_WAIT();
    const int c = lane & 7;
#pragma unroll
    for (int j = 0; j < 4; ++j) { const int n = (lane >> 3) + 8 * j; const LAS float* s = scr + (8 * c) * 33 + n;
        u32x4 o; o.x = pk2(s[0 * 33], s[1 * 33]); o.y = pk2(s[2 * 33], s[3 * 33]); o.z = pk2(s[4 * 33], s[5 * 33]); o.w = pk2(s[6 * 33], s[7 * 33]);
        *(u32x4*)(WT + (size_t)(dn0 + n) * K + k0 + 8 * c) = o; }
    LDS_WAIT();
}
__device__ __forceinline__ void p0_weights(const Args& a, LAS unsigned char* lds, int tid, int G, int bid) {
    const int wave = tid >> 6, lane = tid & 63;
    LAS float* scr = (LAS float*)(lds + wave * 16384);
    const int gw = bid * 8 + wave, NGW = G * 8;
    constexpr int I_IN = 16 * 200, I_PA = 4 * 32, I_PB = 16 * 32, I_OUT = 16 * 32, I_UP = 16 * 176, I_DN = 44 * 32, PER = I_IN + I_PA + I_PB + I_OUT + I_UP + I_DN;
    bf16* Wb = (bf16*)(a.ws + WS_W);
    for (int it = gw; it < DEPTH * PER; it += NGW) {
        const int l = it / PER; int r = it % PER; bf16* wl = Wb + (size_t)l * W_LAYER;
        if (r < I_IN) { tr_item(a.in[4] + (size_t)l * DM * NIN, DM, NIN, wl + OFF_IN, a.in[3] + l * DM, scr, r, lane); continue; } r -= I_IN;
        if (r < I_PA) { tr_item(a.in[8] + (size_t)l * 256 * DM, 256, DM, wl + OFF_PA, nullptr, scr, r, lane); continue; } r -= I_PA;
        if (r < I_PB) { tr_item(a.in[9] + (size_t)l * DM * DM, DM, DM, wl + OFF_PB, nullptr, scr, r, lane); continue; } r -= I_PB;
        if (r < I_OUT) { tr_item(a.in[10] + (size_t)l * DM * DM, DM, DM, wl + OFF_OUT, nullptr, scr, r, lane); continue; } r -= I_OUT;
        if (r < I_UP) { tr_item(a.in[12] + (size_t)l * DM * NUP, DM, NUP, wl + OFF_UP, a.in[11] + l * DM, scr, r, lane, true); continue; } r -= I_UP;
        tr_item(a.in[15] + (size_t)l * DFF * DM, DFF, DM, wl + OFF_DN, nullptr, scr, r, lane);
    }
    if (bid == 0) {
        float* BT = (float*)(a.ws + WS_BT);
        for (int i = tid; i < 3 * 768; i += NTHR) { const int g = i / 768, hh = (i % 768) / 192, j = i % 192 - 96;
            BT[i] = (j >= -64 && j <= 64) ? LOG2E * a.in[2][t5_bucket(j << (2 * g)) * 12 + g * 4 + hh] : -1e30f; }
    }
    for (int i = bid * NTHR + tid; i < DEPTH * 131072 / 4; i += G * NTHR) {
        const int l = i / 32768, e = (i % 32768) * 4;
        const f32x4 v = *(const f32x4*)(a.in[6] + (size_t)l * 131072 + e);
        u32x2 o; o.x = pk2(v[0], v[1]); o.y = pk2(v[2], v[3]);
        *(u32x2*)(Wb + (size_t)l * W_LAYER + OFF_WS + e) = o;
    }
}
__device__ __forceinline__ void p0x(const Args& a, int chunk, int tid, int G, int bid) {
    const int wave = tid >> 6, lane = tid & 63, gw = bid * 8 + wave, NGW = G * 8;
    bf16* XB = (bf16*)(a.ws + WS_XB); bf16* XL = (bf16*)(a.ws + WS_XL); float* SS = (float*)(a.ws + WS_SS);
    for (int m0 = gw; m0 < CH; m0 += 4 * NGW) {
        f32x4 v[4][4];
#pragma unroll
        for (int r = 0; r < 4; ++r) {
            const int m = m0 + r * NGW; const size_t tok = (size_t)chunk * CH + (m < CH ? m : m0);
            const float* src = tok < NPROMPT ? a.in[0] + tok * DM : a.in[1] + (tok - NPROMPT) * DM;
#pragma unroll
            for (int j = 0; j < 4; ++j) v[r][j] = *(const f32x4*)(src + (lane + 64 * j) * 4);
        }
#pragma unroll
        for (int r = 0; r < 4; ++r) {
            const int m = m0 + r * NGW;
            if (m < CH) {
                float s = 0.f;
#pragma unroll
                for (int j = 0; j < 4; ++j) { const f32x4 w = v[r][j]; s += (w[0] * w[0] + w[1] * w[1]) + (w[2] * w[2] + w[3] * w[3]);
                    u32x2 o; o.x = pk2(w[0], w[1]); o.y = pk2(w[2], w[3]); *(u32x2*)(XB + (size_t)m * DM + (lane + 64 * j) * 4) = o;
                    u32x2 lo; lo.x = pk2(w[0] - __uint_as_float(o.x << 16), w[1] - __uint_as_float(o.x & 0xffff0000u)); lo.y = pk2(w[2] - __uint_as_float(o.y << 16), w[3] - __uint_as_float(o.y & 0xffff0000u));
                    *(u32x2*)(XL + (size_t)m * DM + (lane + 64 * j) * 4) = lo; }
                s = wave_sum(s);
                if (lane < 16) SS[(size_t)m * 16 + lane] = lane == 0 ? s : 0.f;
            }
        }
    }
}
__device__ __forceinline__ void pfinal(const Args& a, int chunk, int tid, int G, int bid) {
    const int wave = tid >> 6, lane = tid & 63, gw = bid * 8 + wave, NGW = G * 8;
    const bf16* XB = (const bf16*)(a.ws + WS_XB); const bf16* XL = (const bf16*)(a.ws + WS_XL);
    const float* SS = (const float*)(a.ws + WS_SS); const float* nf = a.in[16];
    f32x4 g[2][2];
#pragma unroll
    for (int j = 0; j < 2; ++j) { g[j][0] = *(const f32x4*)(nf + (lane + 64 * j) * 8); g[j][1] = *(const f32x4*)(nf + (lane + 64 * j) * 8 + 4); }
    for (int m0 = gw; m0 < CH; m0 += 4 * NGW) {
        u32x4 hw[4][2], lw[4][2]; f32x4 sp[4];
#pragma unroll
        for (int r = 0; r < 4; ++r) {
            const int m = (m0 + r * NGW < CH) ? m0 + r * NGW : m0;
            sp[r] = *(const f32x4*)(SS + (size_t)m * 16 + 4 * (lane & 3));
#pragma unroll
            for (int j = 0; j < 2; ++j) { hw[r][j] = *(const u32x4*)(XB + (size_t)m * DM + (lane + 64 * j) * 8); lw[r][j] = *(const u32x4*)(XL + (size_t)m * DM + (lane + 64 * j) * 8); }
        }
#pragma unroll
        for (int r = 0; r < 4; ++r) {
            const int m = m0 + r * NGW;
            if (m < CH) {
                float t = (sp[r][0] + sp[r][1]) + (sp[r][2] + sp[r][3]); t += __shfl_xor(t, 1); t += __shfl_xor(t, 2);
                const float rs = rsqrtf(t * (1.0f / 1024.0f) + EPS);
                float* x = a.out + ((size_t)chunk * CH + m) * DM;
#pragma unroll
                for (int j = 0; j < 2; ++j) { const int c = (lane + 64 * j) * 8; f32x4 h0, h1, l0, l1; pg8::unpack8(hw[r][j], h0, h1); pg8::unpack8(lw[r][j], l0, l1);
                    *(f32x4*)(x + c) = (h0 + l0) * rs * g[j][0]; *(f32x4*)(x + c + 4) = (h1 + l1) * rs * g[j][1]; }
            }
        }
    }
}
struct AttU { int g, d, L, tokbase, qb; };
__device__ __forceinline__ AttU att_decode(int unit, int S) {
    constexpr int upg = CH / 64;
    AttU u; u.g = unit / upg; const int rem = unit % upg, ups = S / 64, seq = rem / ups, rem2 = rem % ups;
    u.d = 1 << (2 * u.g); u.L = S / u.d; const int nqb = u.L / 64, r = rem2 / nqb; u.qb = rem2 % nqb; u.tokbase = seq * S + r;
    return u;
}
template <int KT0, int KT1, bool WITHQ>
__device__ __forceinline__ void att_load_qk(const bf16* QKV, const AttU& u, int h, int qh, int n, int hi, bf16x8 (&qf)[4], bf16x8 (&kf)[5][4]) {
    const int qbase = 64 * u.qb + 32 * qh;
    if (WITHQ) {
        const bf16* qp = QKV + ((size_t)u.tokbase + (size_t)(qbase + n) * u.d) * 2304 + u.g * 256 + h * 64 + 8 * hi;
#pragma unroll
        for (int s = 0; s < 4; ++s) qf[s] = *(const bf16x8*)(qp + 16 * s);
    }
#pragma unroll
    for (int kt = KT0; kt < KT1; ++kt) {
        const int lk = qbase - 64 + 32 * kt + n, lkc = lk < 0 ? 0 : (lk > u.L - 1 ? u.L - 1 : lk);
        const bf16* kp = QKV + (size_t)(u.tokbase + lkc * u.d) * 2304 + 768 + u.g * 256 + h * 64 + 8 * hi;
#pragma unroll
        for (int s = 0; s < 4; ++s) kf[kt][s] = *(const bf16x8*)(kp + 16 * s);
    }
}
__device__ __forceinline__ void attn_phase(const bf16* QKV, bf16* OUTG, float* LSE, const float* BT, LAS unsigned char* lds, int S, int tid, int G, int bid) {
    constexpr int NATT = 3 * (CH / 64);
    int it = (G % 8 == 0) ? (bid & 7) * (G / 8) + (bid >> 3) : bid;
    if (it >= NATT) return;
    AttU u = att_decode(it, S);
    bf16x8 qf[4], kf[5][4];
    att_load_qk<0, 4, false>(QKV, u, (tid >> 6) & 3, tid >> 8, tid & 31, (tid >> 5) & 1, qf, kf);
    for (; it < NATT; it += G) {
        int tl = tid; asm volatile("" : "+v"(tl));
        const int h = (tl >> 6) & 3, qh = tl >> 8, n = tl & 31, hi = (tl >> 5) & 1, lane = tl & 63;
        const int g = u.g, d = u.d, L = u.L, tokbase = u.tokbase, qb = u.qb, qbase = 64 * qb + 32 * qh;
        att_load_qk<4, 5, true>(QKV, u, h, qh, n, hi, qf, kf);
        u32x4 vv[12];
#pragma unroll
        for (int i = 0; i < 12; ++i) {
            const int idx = tl + i * NTHR, kk = idx >> 5, ch = idx & 31, lk = 64 * qb - 64 + kk;
            vv[i] = (u32x4){0u, 0u, 0u, 0u};
            if (lk >= 0 && lk < L) vv[i] = *(const u32x4*)(QKV + (size_t)(tokbase + lk * d) * 2304 + 1536 + g * 256 + ch * 8);
        }
        const float bt0 = BT[g * 768 + tid], bt1 = tid < 256 ? BT[g * 768 + 512 + tid] : 0.f;
        f32x16 st[5];
#pragma unroll
        for (int kt = 0; kt < 5; ++kt) {
            f32x16 acc;
#pragma unroll
            for (int e = 0; e < 16; ++e) acc[e] = 0.f;
#pragma unroll
            for (int s = 0; s < 4; ++s) acc = __builtin_amdgcn_mfma_f32_32x32x16_bf16(kf[kt][s], qf[s], acc, 0, 0, 0);
            st[kt] = acc;
        }
#pragma unroll
        for (int i = 0; i < 12; ++i) { const int idx = tl + i * NTHR, kk = idx >> 5, ch = idx & 31; *(LAS u32x4*)(lds + kk * 576 + ch * 16) = vv[i]; }
        LAS float* bt = (LAS float*)(lds + 110592);
        bt[tid] = bt0; if (tid < 256) bt[512 + tid] = bt1;
        asm volatile("" :: "v"(st[4][15]) : "memory");
        AttU un = u;
        if (it + G < NATT) { un = att_decode(it + G, S); att_load_qk<0, 4, false>(QKV, un, h, qh, n, hi, qf, kf); }
        __syncthreads();
        float mx = -3.0e38f;
        {
            const LAS float* btl = bt + h * 192 + 32 + 4 * hi - n;
            const bool edge = (qb == 0) || (64 * qb + 128 > L);
#pragma unroll
            for (int kt = 0; kt < 5; ++kt)
#pragma unroll
                for (int i = 0; i < 16; ++i) {
                    float sv = st[kt][i] + btl[32 * kt + (i & 3) + 8 * (i >> 2)];
                    if (edge) { const int lk2 = qbase - 64 + 32 * kt + (i & 3) + 8 * (i >> 2) + 4 * hi; sv = (lk2 >= 0 && lk2 < L) ? sv : -1e30f; }
                    st[kt][i] = sv; mx = fmaxf(mx, sv);
                }
        }
        mx = fmaxf(mx, __shfl_xor(mx, 32));
        float sum = 0.f;
#pragma unroll
        for (int kt = 0; kt < 5; ++kt)
#pragma unroll
            for (int i = 0; i < 16; ++i) { const float pe = __builtin_amdgcn_exp2f(st[kt][i] - mx); st[kt][i] = pe; sum += pe; }
        sum += __shfl_xor(sum, 32);
        const float inv = 1.0f / sum, lse = (mx + __log2f(sum)) * 0.6931471805599453f;
        f32x16 o0, o1;
#pragma unroll
        for (int e = 0; e < 16; ++e) { o0[e] = 0.f; o1[e] = 0.f; }
        const int q4 = (lane & 15) >> 2, p4 = lane & 3, gsel = (lane >> 4) & 1;
        const unsigned vbase = (unsigned)((32 * qh + 4 * hi + q4) * 576 + h * 128 + (16 * gsel + 4 * p4) * 2);
#pragma unroll
        for (int kt = 0; kt < 5; ++kt)
#pragma unroll
            for (int s2 = 0; s2 < 2; ++s2) {
                u32x4 pw; pw.x = pk2(st[kt][8 * s2 + 0], st[kt][8 * s2 + 1]); pw.y = pk2(st[kt][8 * s2 + 2], st[kt][8 * s2 + 3]); pw.z = pk2(st[kt][8 * s2 + 4], st[kt][8 * s2 + 5]); pw.w = pk2(st[kt][8 * s2 + 6], st[kt][8 * s2 + 7]);
                const bf16x8 pf = __builtin_bit_cast(bf16x8, pw);
                const unsigned ro = vbase + (unsigned)((32 * kt + 16 * s2) * 576);
                {
                    const v4i16_t r1 = __builtin_amdgcn_ds_read_tr16_b64_v4i16((LAS v4i16_t*)(lds + ro)), r2 = __builtin_amdgcn_ds_read_tr16_b64_v4i16((LAS v4i16_t*)(lds + ro + 8 * 576));
                    const bf16x8 vf = (bf16x8){r1[0], r1[1], r1[2], r1[3], r2[0], r2[1], r2[2], r2[3]};
                    o0 = __builtin_amdgcn_mfma_f32_32x32x16_bf16(vf, pf, o0, 0, 0, 0);
                }
                {
                    const v4i16_t r1 = __builtin_amdgcn_ds_read_tr16_b64_v4i16((LAS v4i16_t*)(lds + ro + 64)), r2 = __builtin_amdgcn_ds_read_tr16_b64_v4i16((LAS v4i16_t*)(lds + ro + 64 + 8 * 576));
                    const bf16x8 vf = (bf16x8){r1[0], r1[1], r1[2], r1[3], r2[0], r2[1], r2[2], r2[3]};
                    o1 = __builtin_amdgcn_mfma_f32_32x32x16_bf16(vf, pf, o1, 0, 0, 0);
                }
            }
        const size_t tokq = (size_t)tokbase + (size_t)(qbase + n) * d;
        bf16* op = OUTG + ((size_t)g * CH + tokq) * 256 + h * 64;
#pragma unroll
        for (int grp = 0; grp < 4; ++grp) {
            u32x2 w0, w1;
            w0.x = pk2(o0[4 * grp + 0] * inv, o0[4 * grp + 1] * inv); w0.y = pk2(o0[4 * grp + 2] * inv, o0[4 * grp + 3] * inv);
            w1.x = pk2(o1[4 * grp + 0] * inv, o1[4 * grp + 1] * inv); w1.y = pk2(o1[4 * grp + 2] * inv, o1[4 * grp + 3] * inv);
            *(u32x2*)(op + 8 * grp + 4 * hi) = w0; *(u32x2*)(op + 32 + 8 * grp + 4 * hi) = w1;
        }
        if (hi == 0) LSE[((size_t)g * CH + tokq) * 4 + h] = lse;
        __syncthreads();
        u = un;
    }
}
constexpr int SG_WLDS = 17920;
__device__ __forceinline__ void sg_wave_unit(bf16* U, bf16* UO, const bf16* GV, const float* ssv, const bf16* WSb, const float* gain, const float* bs, LAS unsigned char* wl, int unit, int lane) {
    const int hf = unit & 1, gg = (unit >> 1) & 7, nch = unit >> 4, tok0 = nch * 128, cb = gg * 128 + hf * 64;
    LAS float* rvl = (LAS float*)(wl + 17408);
    rvl[lane] = pg8::row_rs(ssv, tok0 + lane); rvl[lane + 64] = pg8::row_rs(ssv, tok0 + lane + 64);
    LDS_WAIT();
    {
        const int c8 = lane & 7, q0 = lane >> 3;
#pragma unroll
        for (int i = 0; i < 16; ++i) {
            const int q = q0 + 8 * i;
            f32x4 a0, a1; pg8::unpack8(*(const u32x4*)(GV + (size_t)(tok0 + q) * 1024 + cb + c8 * 8), a0, a1);
            const float r = rvl[q];
            const u32x4 w = pg8::pack8(a0 * r, a1 * r);
            *(LAS u32x2*)(wl + q * 136 + c8 * 16) = (u32x2){w.x, w.y}; *(LAS u32x2*)(wl + q * 136 + c8 * 16 + 8) = (u32x2){w.z, w.w};
        }
    }
    LDS_WAIT();
    const int ln = lane & 15, kq = lane >> 4, qq = ln >> 2, pp = ln & 3;
    bf16x8 afr[4][4];
#pragma unroll
    for (int ct = 0; ct < 4; ++ct)
#pragma unroll
        for (int ks = 0; ks < 4; ++ks) {
            const unsigned ad = (unsigned)((32 * ks + 8 * kq + qq) * 136 + (32 * (ct >> 1) + 8 * pp + 4 * (ct & 1)) * 2);
            const v4i16_t r1 = __builtin_amdgcn_ds_read_tr16_b64_v4i16((LAS v4i16_t*)(wl + ad)), r2 = __builtin_amdgcn_ds_read_tr16_b64_v4i16((LAS v4i16_t*)(wl + ad + 4 * 136));
            afr[ct][ks] = (bf16x8){r1[0], r1[1], r1[2], r1[3], r2[0], r2[1], r2[2], r2[3]};
        }
    f32x4 gn[2][2];
#pragma unroll
    for (int t = 0; t < 2; ++t) { gn[t][0] = *(const f32x4*)(gain + cb + 32 * t + 8 * kq); gn[t][1] = *(const f32x4*)(gain + cb + 32 * t + 8 * kq + 4); }
#pragma unroll 2
    for (int pt = 0; pt < 8; ++pt) {
        const int pr = pt * 16 + ln;
        bf16x8 bfr[4];
#pragma unroll
        for (int ks = 0; ks < 4; ++ks) bfr[ks] = *(const bf16x8*)(WSb + (size_t)gg * 16384 + pr * 128 + 32 * ks + 8 * kq);
        bf16* up = U + (size_t)(tok0 + pr) * 1024 + cb + 8 * kq; bf16* uo = UO + (size_t)(tok0 + pr) * 1024 + cb + 8 * kq;
        const u32x4 uw0 = *(const u32x4*)up, uw1 = *(const u32x4*)(up + 32);
        const float bias = bs[gg * 128 + pr];
        f32x4 acc[4];
#pragma unroll
        for (int ct = 0; ct < 4; ++ct) {
            acc[ct] = (f32x4){0.f, 0.f, 0.f, 0.f};
#pragma unroll
            for (int ks = 0; ks < 4; ++ks) acc[ct] = __builtin_amdgcn_mfma_f32_16x16x32_bf16(afr[ct][ks], bfr[ks], acc[ct], 0, 0, 0);
        }
        f32x4 u0, u1;
        pg8::unpack8(uw0, u0, u1);
        *(u32x4*)uo = pg8::pack8(u0 * (gn[0][0] * acc[0] + bias), u1 * (gn[0][1] * acc[1] + bias));
        pg8::unpack8(uw1, u0, u1);
        *(u32x4*)(uo + 32) = pg8::pack8(u0 * (gn[1][0] * acc[2] + bias), u1 * (gn[1][1] * acc[3] + bias));
    }
    LDS_WAIT();
}
__device__ __forceinline__ void p_merge(const bf16* OUTG, const float* LSE, bf16* OA, int tid, int G, int bid) {
    for (int it = bid * NTHR + tid; it < CH * 32; it += G * NTHR) {
        const int tok = it >> 5, c8 = it & 31, h = c8 >> 3;
        const float l0 = LSE[(size_t)tok * 4 + h], l1 = LSE[((size_t)CH + tok) * 4 + h], l2 = LSE[((size_t)2 * CH + tok) * 4 + h];
        const float mx = fmaxf(l0, fmaxf(l1, l2));
        float w0 = __expf(l0 - mx), w1 = __expf(l1 - mx), w2 = __expf(l2 - mx);
        const float inv = 1.0f / (w0 + w1 + w2); w0 *= inv; w1 *= inv; w2 *= inv;
        f32x4 a0, a1, b0, b1, c0, c1;
        pg8::unpack8(*(const u32x4*)(OUTG + (size_t)tok * 256 + c8 * 8), a0, a1);
        pg8::unpack8(*(const u32x4*)(OUTG + ((size_t)CH + tok) * 256 + c8 * 8), b0, b1);
        pg8::unpack8(*(const u32x4*)(OUTG + ((size_t)2 * CH + tok) * 256 + c8 * 8), c0, c1);
        *(u32x4*)(OA + (size_t)tok * 256 + c8 * 8) = pg8::pack8(a0 * w0 + b0 * w1 + c0 * w2, a1 * w0 + b1 * w1 + c1 * w2);
    }
}
__device__ __forceinline__ void p_conv(const bf16* A, bf16* FG, const float* cw, const float* cb, int S, int tid, int G, int bid) {
    constexpr int RUN = 8, NFC = DFF / 8;
    for (int it = bid * NTHR + tid; it < (CH / RUN) * NFC; it += G * NTHR) {
        const int fc = it % NFC, t0 = (it / NFC) * RUN, f = fc * 8;
        f32x4 wg[3][2], wv[3][2], bg[2], bv[2];
#pragma unroll
        for (int k = 0; k < 3; ++k) { wg[k][0] = *(const f32x4*)(cw + k * NUP + f); wg[k][1] = *(const f32x4*)(cw + k * NUP + f + 4); wv[k][0] = *(const f32x4*)(cw + k * NUP + DFF + f); wv[k][1] = *(const f32x4*)(cw + k * NUP + DFF + f + 4); }
        bg[0] = *(const f32x4*)(cb + f); bg[1] = *(const f32x4*)(cb + f + 4); bv[0] = *(const f32x4*)(cb + DFF + f); bv[1] = *(const f32x4*)(cb + DFF + f + 4);
        const f32x4 z4 = (f32x4){0.f, 0.f, 0.f, 0.f};
        f32x4 pg0 = z4, pg1 = z4, pv0 = z4, pv1 = z4, cg0, cg1, cv0, cv1;
        if ((t0 & (S - 1)) != 0) { pg8::unpack8(*(const u32x4*)(A + (size_t)(t0 - 1) * NUP + f), pg0, pg1); pg8::unpack8(*(const u32x4*)(A + (size_t)(t0 - 1) * NUP + DFF + f), pv0, pv1); }
        pg8::unpack8(*(const u32x4*)(A + (size_t)t0 * NUP + f), cg0, cg1); pg8::unpack8(*(const u32x4*)(A + (size_t)t0 * NUP + DFF + f), cv0, cv1);
#pragma unroll
        for (int i = 0; i < RUN; ++i) {
            const int t = t0 + i;
            f32x4 ng0 = z4, ng1 = z4, nv0 = z4, nv1 = z4;
            if (((t + 1) & (S - 1)) != 0) { pg8::unpack8(*(const u32x4*)(A + (size_t)(t + 1) * NUP + f), ng0, ng1); pg8::unpack8(*(const u32x4*)(A + (size_t)(t + 1) * NUP + DFF + f), nv0, nv1); }
            f32x4 g0 = pg0 * wg[0][0] + cg0 * wg[1][0] + ng0 * wg[2][0] + bg[0], g1 = pg1 * wg[0][1] + cg1 * wg[1][1] + ng1 * wg[2][1] + bg[1];
            const f32x4 v0 = pv0 * wv[0][0] + cv0 * wv[1][0] + nv0 * wv[2][0] + bv[0], v1 = pv1 * wv[0][1] + cv1 * wv[1][1] + nv1 * wv[2][1] + bv[1];
#pragma unroll
            for (int e = 0; e < 4; ++e) { g0[e] = pg8::gelu_tanh(g0[e]) * v0[e]; g1[e] = pg8::gelu_tanh(g1[e]) * v1[e]; }
            *(u32x4*)(FG + (size_t)t * DFF + f) = pg8::pack8(g0, g1);
            pg0 = cg0; pg1 = cg1; pv0 = cv0; pv1 = cv1; cg0 = ng0; cg1 = ng1; cv0 = nv0; cv1 = nv1;
        }
    }
}

__device__ __forceinline__ void p_convfix(const bf16* SB, bf16* FG, const float* cw, const float* cb, int S, int tid, int G, int bid) {
    constexpr int NFC = DFF / 8, NB = CH / 64;
    for (int it = bid * NTHR + tid; it < NB * 2 * NFC; it += G * NTHR) {
        const int fc = it % NFC, r2 = it / NFC, which = r2 & 1, b = r2 >> 1, f = fc * 8, t = b * 64 + (which ? 63 : 0);
        const f32x4 z4 = (f32x4){0.f, 0.f, 0.f, 0.f};
        f32x4 pg0 = z4, pg1 = z4, pv0 = z4, pv1 = z4, cg0, cg1, cv0, cv1, ng0 = z4, ng1 = z4, nv0 = z4, nv1 = z4;
        const bf16* bp = SB + (size_t)b * 4 * NUP + f;
        if (which == 0) {
            if ((t & (S - 1)) != 0) { pg8::unpack8(*(const u32x4*)(bp - NUP), pg0, pg1); pg8::unpack8(*(const u32x4*)(bp - NUP + DFF), pv0, pv1); }
            pg8::unpack8(*(const u32x4*)bp, cg0, cg1); pg8::unpack8(*(const u32x4*)(bp + DFF), cv0, cv1);
            pg8::unpack8(*(const u32x4*)(bp + NUP), ng0, ng1); pg8::unpack8(*(const u32x4*)(bp + NUP + DFF), nv0, nv1);
        } else {
            pg8::unpack8(*(const u32x4*)(bp + 2 * NUP), pg0, pg1); pg8::unpack8(*(const u32x4*)(bp + 2 * NUP + DFF), pv0, pv1);
            pg8::unpack8(*(const u32x4*)(bp + 3 * NUP), cg0, cg1); pg8::unpack8(*(const u32x4*)(bp + 3 * NUP + DFF), cv0, cv1);
            if (((t + 1) & (S - 1)) != 0) { pg8::unpack8(*(const u32x4*)(bp + 4 * NUP), ng0, ng1); pg8::unpack8(*(const u32x4*)(bp + 4 * NUP + DFF), nv0, nv1); }
        }
        f32x4 g0 = *(const f32x4*)(cb + f), g1 = *(const f32x4*)(cb + f + 4), v0 = *(const f32x4*)(cb + DFF + f), v1 = *(const f32x4*)(cb + DFF + f + 4);
        g0 = g0 + pg0 * *(const f32x4*)(cw + f) + cg0 * *(const f32x4*)(cw + NUP + f) + ng0 * *(const f32x4*)(cw + 2 * NUP + f);
        g1 = g1 + pg1 * *(const f32x4*)(cw + f + 4) + cg1 * *(const f32x4*)(cw + NUP + f + 4) + ng1 * *(const f32x4*)(cw + 2 * NUP + f + 4);
        v0 = v0 + pv0 * *(const f32x4*)(cw + DFF + f) + cv0 * *(const f32x4*)(cw + NUP + DFF + f) + nv0 * *(const f32x4*)(cw + 2 * NUP + DFF + f);
        v1 = v1 + pv1 * *(const f32x4*)(cw + DFF + f + 4) + cv1 * *(const f32x4*)(cw + NUP + DFF + f + 4) + nv1 * *(const f32x4*)(cw + 2 * NUP + DFF + f + 4);
#pragma unroll
        for (int e = 0; e < 4; ++e) { g0[e] = pg8::gelu_tanh(g0[e]) * v0[e]; g1[e] = pg8::gelu_tanh(g1[e]) * v1[e]; }
        *(u32x4*)(FG + (size_t)t * DFF + f) = pg8::pack8(g0, g1);
    }
}
#define XB_TMO      128
#define XB_XCNT(j)  (256  + 64 * (j))
#define XB_XSUB(j)  (1280 + 64 * (j))
#define XB_XGEN(j)  (2304 + 64 * (j))
#define XB_TOP      3328
#define XB_TOPGEN   3392
#define XCD_BAR_WORDS 3456
#define XB_SPIN_CAP (1u << 18)

__device__ __forceinline__ unsigned xb_ld(unsigned* p)              { return __hip_atomic_load(p, __ATOMIC_RELAXED, __HIP_MEMORY_SCOPE_AGENT); }
__device__ __forceinline__ unsigned xb_add(unsigned* p, unsigned v) { return __hip_atomic_fetch_add(p, v, __ATOMIC_RELAXED, __HIP_MEMORY_SCOPE_AGENT); }
__device__ __forceinline__ unsigned xb_xcc_id() { return (unsigned)__builtin_amdgcn_s_getreg((3 << 11) | 20) & 0xFu; }
#define XB_SPIN(cond, bar) do { unsigned _sp = 0; while (cond) { __builtin_amdgcn_s_sleep(1); \
    if ((++_sp & 255u) == 0u) { if (xb_ld(&(bar)[XB_TMO])) break; if (_sp > XB_SPIN_CAP) { atomicAdd(&(bar)[XB_TMO], 1u); break; } } } } while (0)

struct XcdBarrier {
    unsigned* bar; unsigned x;
    volatile LAS unsigned* st;
};

__device__ __forceinline__ XcdBarrier xcd_barrier_post(unsigned* bar, volatile LAS unsigned* st, const int tid) {
    XcdBarrier b; b.bar = bar; b.x = xb_xcc_id(); b.st = st;
    if (tid == 0) (void)xb_add(&bar[XB_XCNT(b.x)], 1u);
    return b;
}
__device__ __forceinline__ void xcd_barrier_complete(unsigned* bar, unsigned x, unsigned& nloc, unsigned& nx) {
    const unsigned G = gridDim.x * gridDim.y * gridDim.z;
    unsigned sum, cnt, mine, sp = 0u;
    for (;;) {
        sum = 0u; cnt = 0u; mine = 0u;
#pragma unroll
        for (unsigned j = 0; j < 16; ++j) { const unsigned c = xb_ld(&bar[XB_XCNT(j)]); sum += c; cnt += (c > 0u) ? 1u : 0u; mine = (j == x) ? c : mine; }
        if (sum == G) break;
        __builtin_amdgcn_s_sleep(1);
        if ((++sp & 255u) == 0u) { if (xb_ld(&bar[XB_TMO])) break; if (sp > XB_SPIN_CAP) { atomicAdd(&bar[XB_TMO], 1u); break; } }
    }
    nloc = mine > 0u ? mine : 1u; nx = cnt > 0u ? cnt : 1u;
}

__device__ __forceinline__ void xcd_barrier(const XcdBarrier& b, const int tid) {
    asm volatile("s_waitcnt vmcnt(0)" ::: "memory");
    __syncthreads();
    if (tid == 0) {
        unsigned* bar = b.bar;
        __builtin_amdgcn_s_waitcnt(0);
        unsigned nloc = b.st[0], nx = b.st[1];
        if (nloc == 0u) { xcd_barrier_complete(bar, b.x, nloc, nx); b.st[0] = nloc; b.st[1] = nx; }
        const unsigned old = xb_add(&bar[XB_XSUB(b.x)], 1u);
        const unsigned gen = old / nloc;
        if (old + 1u == (gen + 1u) * nloc) {
            __builtin_amdgcn_fence(__ATOMIC_RELEASE, "agent");
            asm volatile("s_waitcnt vmcnt(0)" ::: "memory");
            const unsigned og = xb_add(&bar[XB_TOP], 1u);
            const unsigned tg = og / nx;
            if (og + 1u == (tg + 1u) * nx) xb_add(&bar[XB_TOPGEN], 1u);
            else XB_SPIN(xb_ld(&bar[XB_TOPGEN]) == tg, bar);
            __builtin_amdgcn_fence(__ATOMIC_ACQUIRE, "agent");
            xb_add(&bar[XB_XGEN(b.x)], 1u);
            asm volatile("s_waitcnt vmcnt(0)" ::: "memory");
        } else {
            XB_SPIN(xb_ld(&bar[XB_XGEN(b.x)]) == gen, bar);
            __builtin_amdgcn_fence(__ATOMIC_ACQUIRE, "agent");
            asm volatile("s_waitcnt vmcnt(0)" ::: "memory");
        }
    }
    __syncthreads();
}


__global__ void __launch_bounds__(NTHR, 2) fwd_kernel(Args a_in) {
    extern __shared__ __attribute__((aligned(16))) unsigned char lds_raw[];
    LAS unsigned char* lds = (LAS unsigned char*)lds_raw;
    cg::grid_group grid = cg::this_grid();
    const int ph_lo = a_in.ph_lo, ph_hi = a_in.ph_hi;
    volatile LAS unsigned* xst = (volatile LAS unsigned*)(lds + LDS_BYTES - 16);
    if (threadIdx.x < 2) xst[threadIdx.x] = 0u;
    __syncthreads();
    const unsigned xcc = xcd_barrier_post((unsigned*)(a_in.ws + WS_BAR), xst, (int)threadIdx.x).x;
    for (int ph = ph_lo; ph < ph_hi; ++ph) {
#if defined(__HIP_DEVICE_COMPILE__)
        typedef const __attribute__((address_space(4))) unsigned long long* cu64p4;
        cu64p4 ap = (cu64p4)__builtin_amdgcn_kernarg_segment_ptr();
        asm volatile("" : "+s"(ap));
        Args a;
#pragma unroll
        for (int i = 0; i < 17; ++i) a.in[i] = (const float*)(const __attribute__((address_space(1))) float*)ap[i];
        a.out = (float*)(__attribute__((address_space(1))) float*)ap[17]; a.ws = (unsigned char*)(__attribute__((address_space(1))) unsigned char*)ap[18]; a.ph_lo = ph_lo; a.ph_hi = ph_hi;
#else
        const Args a = a_in;
#endif
        int tid = threadIdx.x, G = gridDim.x, bid = blockIdx.x;
        asm volatile("" : "+v"(tid)); asm volatile("" : "+s"(G)); asm volatile("" : "+s"(bid));
        unsigned char* ws = a.ws;
        bf16* Wb = (bf16*)(ws + WS_W);
        bf16* QKV = (bf16*)(ws + WS_R1); bf16* U = QKV + (size_t)CH * 2304; bf16* GV = U + (size_t)CH * 1024; bf16* GT = GV + (size_t)CH * 1024;
        bf16* AF = (bf16*)(ws + WS_R1);
        bf16* MG = GV;
        bf16* OUTG = (bf16*)(ws + WS_R2); bf16* OA = OUTG + (size_t)3 * CH * 256; float* LSE = (float*)(OA + (size_t)CH * 256);
        bf16* FG = (bf16*)(ws + WS_R2);
        bf16* XB = (bf16*)(ws + WS_XB); float* SS = (float*)(ws + WS_SS); float* SSV = (float*)(ws + WS_SSV);
        if (ph < NP0) p0_weights(a, lds, tid, G, bid);
        else {
            const int chunk = (ph - NP0) / PH_PER_CHUNK, sub = (ph - NP0) % PH_PER_CHUNK;
            const int S = chunk == 0 ? 8192 : 2048;
            if (sub == 0) { p0x(a, chunk, tid, G, bid); if (PROBE_KIND == 10) p0x(a, chunk, tid, G, bid); }
            else if (sub == PH_PER_CHUNK - 1) pfinal(a, chunk, tid, G, bid);
            else {
                const int l = (sub - 1) / KPL, ki = (sub - 1) % KPL, k = (KPL == 9 && ki > PROBE_DUPK) ? ki - 1 : ki; const bool dup = (KPL == 9 && ki == PROBE_DUPK + 1);
                const bf16* wl = Wb + (size_t)l * W_LAYER;
                float* X = a.out + (size_t)chunk * CH * DM;
                if (k == 0 && !(SKIPMASK & 1)) {
                    pg8::Gemm g{XB, wl + OFF_IN, CH, NIN, DM}; pg8::StaticOrder So; So.init(CH, NIN, G, bid);
                    pg8::EpiIn E{QKV, U, GV, GT, SS, SSV};
                    pg8::gemm_phase<pg8::EpiIn, pg8::StaticOrder, true, true>(lds, g, So, E, tid);
                } else if (k == 1 && !(SKIPMASK & 2)) {
                    constexpr int NATT = 3 * (CH / 64), NSGW = (CH / 128) * 16;
                    if (!(SKIPMASK & 1024) && !(dup && PROBE_KIND == 8)) attn_phase(QKV, OUTG, LSE, (const float*)(ws + WS_BT), lds, S, tid, G, bid);
                    if (!(SKIPMASK & 2048) && (!dup || PROBE_KIND == 8)) {
                        bf16* UO = dup ? (bf16*)(ws + WS_R2 + (size_t)CH * 2096) : U;
                        const int wave = __builtin_amdgcn_readfirstlane(tid >> 6);
                        for (int wu = bid * 8 + wave; wu < NSGW; wu += G * 8) sg_wave_unit(U, UO, GV, SSV, wl + OFF_WS, a.in[5] + l * 1024, a.in[7] + l * 1024, lds + wave * SG_WLDS, wu, tid & 63);
                    }
                } else if (k == 2 && !(SKIPMASK & 4)) p_merge(OUTG, LSE, OA, tid, G, bid);
                else if (k == 3 && !(SKIPMASK & 8)) {
                    if (!(SKIPMASK & 4096)) { int kpa = 256; asm volatile("" : "+s"(kpa)); pg8::Gemm g{OA, wl + OFF_PA, CH, DM, kpa}; pg8::StaticOrder So; So.init(CH, DM, G, bid);
                      pg8::EpiGate<0> E{MG, GT, 0};
                      pg8::gemm_phase<pg8::EpiGate<0>, pg8::StaticOrder, true, true>(lds, g, So, E, tid); }
                    if (!(SKIPMASK & 8192)) { pg8::Gemm g{U, wl + OFF_PB, CH, DM, DM}; pg8::StaticOrder So; So.init(CH, DM, G, bid);
                      pg8::EpiGate<1> E{MG, GT, 1024};
                      pg8::gemm_phase<pg8::EpiGate<1>, pg8::StaticOrder, true, true>(lds, g, So, E, tid); }
                } else if (k == 4 && !(SKIPMASK & 16)) {
                    pg8::Gemm g{MG, wl + OFF_OUT, CH, DM, DM}; pg8::StaticOrder So; So.init(CH, DM, G, bid);
                    pg8::EpiRes E{dup ? QKV + (size_t)CH * 1024 : (bf16*)(ws + WS_XL), dup ? QKV : XB, dup ? SSV : SS};
                    pg8::gemm_phase<pg8::EpiRes, pg8::StaticOrder, true, true>(lds, g, So, E, tid);
                } else if (k == 5 && !(SKIPMASK & 32)) {
                    pg8::Gemm g{XB, wl + OFF_UP, CH, NUP, DM}; pg8::StaticOrder So; So.init(CH, NUP, G, bid);
                    pg8::EpiUpConv E{FG, (bf16*)(ws + WS_SB), SS, a.in[13] + (size_t)l * 3 * NUP, a.in[14] + (size_t)l * NUP};
                    pg8::gemm_phase<pg8::EpiUpConv, pg8::StaticOrder, true, true>(lds, g, So, E, tid);
                } else if (k == 6 && !(SKIPMASK & 64)) p_convfix((const bf16*)(ws + WS_SB), FG, a.in[13] + (size_t)l * 3 * NUP, a.in[14] + (size_t)l * NUP, S, tid, G, bid);
                else if (!(SKIPMASK & 128)) {
                    pg8::Gemm g{FG, wl + OFF_DN, CH, DM, DFF}; pg8::StaticOrder So; So.init(CH, DM, G, bid);
                    pg8::EpiRes E{dup ? QKV + (size_t)CH * 1024 : (bf16*)(ws + WS_XL), dup ? QKV : XB, dup ? SSV : SS};
                    pg8::gemm_phase<pg8::EpiRes, pg8::StaticOrder, true, true>(lds, g, So, E, tid);
                }
            }
        }
        if (ph + 1 < ph_hi) {
            if (ph == ph_lo) grid.sync();
            XcdBarrier xb; xb.bar = (unsigned*)(a.ws + WS_BAR); xb.x = xcc; xb.st = xst;
            xcd_barrier(xb, tid);
            if (PROBE_KIND == 100) xcd_barrier(xb, tid);
        }
    }
}

extern "C" void kernel_launch(void* const* d_in, const int* in_sizes, int n_in, void* d_out, int out_size, void* d_ws, size_t ws_size, hipStream_t stream) {
    static int grid = 0;
    if (grid == 0) {
        if (n_in != 17 || out_size != NTOK * DM || ws_size < WS_END) { fprintf(stderr, "kernel_launch: unexpected shapes: n_in %d out %d ws %zu (need %zu)\n", n_in, out_size, ws_size, (size_t)WS_END); grid = -1; return; }
        int dev = 0, cus = 0, per_cu = 0;
        (void)hipGetDevice(&dev); (void)hipDeviceGetAttribute(&cus, hipDeviceAttributeMultiprocessorCount, dev);
        if (hipFuncSetAttribute((const void*)fwd_kernel, hipFuncAttributeMaxDynamicSharedMemorySize, LDS_BYTES) != hipSuccess) { fprintf(stderr, "kernel_launch: hipFuncSetAttribute failed\n"); grid = -1; return; }
        if (hipOccupancyMaxActiveBlocksPerMultiprocessor(&per_cu, (const void*)fwd_kernel, NTHR, LDS_BYTES) != hipSuccess || per_cu < 1) { fprintf(stderr, "kernel_launch: occupancy query says %d\n", per_cu); per_cu = 1; }
        (void)hipGetLastError();
        grid = cus * per_cu;
        if (grid <= 0) grid = 256;
    }
    if (grid < 0) return;
    if (hipMemsetAsync((char*)d_ws + WS_BAR, 0, 65536, stream) != hipSuccess) { fprintf(stderr, "kernel_launch: memset failed\n"); return; }
    Args a{};
    for (int i = 0; i < 17; ++i) a.in[i] = (const float*)d_in[i];
    a.out = (float*)d_out; a.ws = (unsigned char*)d_ws;
#if ONE_LAUNCH
    a.ph_lo = 0; a.ph_hi = N_PHASES;
    void* args[] = {&a};
    hipError_t e = hipLaunchCooperativeKernel((const void*)fwd_kernel, dim3(grid), dim3(NTHR), args, LDS_BYTES, stream);
    if (e != hipSuccess) fprintf(stderr, "cooperative launch failed: %s (grid %d)\n", hipGetErrorString(e), grid);
#else
    for (int ph = 0; ph < N_PHASES; ++ph) {
        a.ph_lo = ph; a.ph_hi = ph + 1;
        hipLaunchKernelGGL(fwd_kernel, dim3(grid), dim3(NTHR), LDS_BYTES, stream, a);
    }
#endif
}
```

```cpp
#include <hip/hip_runtime.h>
#include <hip/hip_cooperative_groups.h>
#include <cstdio>
#include <cstdint>
namespace cg = cooperative_groups;

#ifndef ONE_LAUNCH
#define ONE_LAUNCH 1
#endif

namespace pg8 {
#define PG8_LAS __attribute__((address_space(3)))
typedef unsigned short bf16_t;
typedef short bf16x8 __attribute__((ext_vector_type(8)));
typedef float f32x4 __attribute__((ext_vector_type(4)));
typedef unsigned u32x4 __attribute__((ext_vector_type(4)));
constexpr int BM = 256, BK = 64, HALF = 128, HTB = HALF * BK * 2  , STAGE_BYTES = 8 * HTB, NXCD = 8, WGM = 8;

__host__ __device__ __forceinline__ int lds_byte(int r, int c) { const int st = (r >> 4) * 2 + (c >> 5), rr = r & 15, cc = c & 31, ob = rr * 64 + cc * 2; return st * 1024 + (ob ^ (((ob >> 9) & 1) << 5)); }
__host__ __device__ __forceinline__ void stage_rc(int b, int& R, int& C) { const int st = b / 1024, sb = b % 1024, swz = sb ^ (((sb >> 9) & 1) << 5); R = (st >> 1) * 16 + swz / 64; C = (st & 1) * 32 + (swz % 64) / 2; }
__host__ __device__ __forceinline__ int perm32(int rho) { const int n = rho >> 4, i = rho & 15; return 8 * (i >> 2) + 4 * n + (i & 3); }

struct Unit { int pm, pn; };
struct Gemm { const bf16_t* A; const bf16_t* Bt; int M, N, K; };

struct StaticOrder {
    int nM, nN, nwg, G, c;
    __host__ __device__ void init(int M, int N, int G_, int c_) { nM = M / BM; nN = N / BM; nwg = nM * nN; G = G_; c = c_; }
    __host__ __device__ bool next(int i, Unit& u) const {
        const long L = (long)i * G + c; if (L >= nwg) return false;
        int wgid = (int)L; { const int q = nwg / NXCD, r = nwg % NXCD, xcd = wgid % NXCD, off = wgid / NXCD; wgid = (xcd < r ? xcd * (q + 1) : r * (q + 1) + (xcd - r) * q) + off; }
        const int nig = WGM * nN, gid = wgid / nig, fm = gid * WGM, gsz = (nM - fm) < WGM ? (nM - fm) : WGM;
        u.pm = fm + ((wgid % nig) % gsz); u.pn = (wgid % nig) / gsz; return true;
    }
    __device__ __forceinline__ void a_ready(const Unit&) const {}
    __device__ __forceinline__ void done(const Unit&) const {}
};

__device__ __forceinline__ unsigned cvt_pk_bf16(float lo, float hi) { unsigned r; asm volatile("v_cvt_pk_bf16_f32 %0, %1, %2" : "=v"(r) : "v"(lo), "v"(hi)); return r; }

__device__ __forceinline__ float fast_sigmoid(float x) { return __builtin_amdgcn_rcpf(1.0f + __builtin_amdgcn_exp2f(-1.4426950408889634f * x)); }
__device__ __forceinline__ float gelu_tanh(float x) {
    const float y = x * (1.0f + 0.044715f * x * x) * (2.0f * 0.7978845608028654f);
    return x * __builtin_amdgcn_rcpf(1.0f + __builtin_amdgcn_exp2f(-1.4426950408889634f * y));
}
__device__ __forceinline__ float bf2f(unsigned short b) { return __uint_as_float(((unsigned)b) << 16); }
__device__ __forceinline__ u32x4 pack8(const f32x4 a, const f32x4 b) { u32x4 w; w.x = cvt_pk_bf16(a[0], a[1]); w.y = cvt_pk_bf16(a[2], a[3]); w.z = cvt_pk_bf16(b[0], b[1]); w.w = cvt_pk_bf16(b[2], b[3]); return w; }
__device__ __forceinline__ void unpack8(const u32x4 w, f32x4& a, f32x4& b) {
    a[0] = __uint_as_float(w.x << 16); a[1] = __uint_as_float(w.x & 0xffff0000u); a[2] = __uint_as_float(w.y << 16); a[3] = __uint_as_float(w.y & 0xffff0000u);
    b[0] = __uint_as_float(w.z << 16); b[1] = __uint_as_float(w.z & 0xffff0000u); b[2] = __uint_as_float(w.w << 16); b[3] = __uint_as_float(w.w & 0xffff0000u);
}
__device__ __forceinline__ float row_rs(const float* ss, int row) {
    const f32x4* sp = (const f32x4*)(ss + (size_t)row * 16);
    const f32x4 s = (sp[0] + sp[1]) + (sp[2] + sp[3]);
    return rsqrtf(((s[0] + s[1]) + (s[2] + s[3])) * (1.0f / 1024.0f) + 1e-6f);
}

__device__ __forceinline__ void rows_rs(const float* ss, int row0, int fq, float (&rsv)[2][4]) {
    f32x4 part[2][4];
#pragma unroll
    for (int ai = 0; ai < 2; ++ai)
#pragma unroll
        for (int m = 0; m < 4; ++m) part[ai][m] = *(const f32x4*)(ss + (size_t)(row0 + ai * HALF + m * 16) * 16 + fq * 4);
#pragma unroll
    for (int ai = 0; ai < 2; ++ai)
#pragma unroll
        for (int m = 0; m < 4; ++m) { float t = (part[ai][m][0] + part[ai][m][1]) + (part[ai][m][2] + part[ai][m][3]); t += __shfl_xor(t, 16); t += __shfl_xor(t, 32); rsv[ai][m] = rsqrtf(t * (1.0f / 1024.0f) + 1e-6f); }
}

struct EpiIn {
    static constexpr bool PERM = true, AFTER_DRAIN = false;
    bf16_t* QKV; bf16_t* U; bf16_t* GV; bf16_t* G; const float* ss; float* ssv;
    __device__ __forceinline__ void operator()(const f32x4 (&acc)[2][2][4][2], const Unit& u, int wr, int wc, int fr, int fq) const {
        const int pn = u.pn;
        float rsv[2][4]; rows_rs(ss, u.pm * BM + wr * 64 + fr, fq, rsv);
#pragma unroll
        for (int ai = 0; ai < 2; ++ai)
#pragma unroll
            for (int m = 0; m < 4; ++m) {
                const int row = u.pm * BM + ai * HALF + wr * 64 + m * 16 + fr;
                const float rs = rsv[ai][m];
                float q = 0.f;
#pragma unroll
                for (int bj = 0; bj < 2; ++bj) {
                    const int col = pn * BM + bj * HALF + wc * 32 + 8 * fq;
                    f32x4 v0 = acc[ai][bj][m][0] * rs, v1 = acc[ai][bj][m][1] * rs;
                    bf16_t* dst;
                    if (pn < 9) { if (pn < 3) { v0 = v0 * (0.125f * 1.4426950408889634f); v1 = v1 * (0.125f * 1.4426950408889634f); }     dst = QKV + (size_t)row * 2304 + col; }
                    else if (pn < 17) {
#pragma unroll
                        for (int e = 0; e < 4; ++e) { v0[e] = gelu_tanh(v0[e]); v1[e] = gelu_tanh(v1[e]); }
                        if (pn < 13) dst = U + (size_t)row * 1024 + (col - 2304);
                        else { dst = GV + (size_t)row * 1024 + (col - 3328);
#pragma unroll
                            for (int e = 0; e < 4; ++e) q += v0[e] * v0[e] + v1[e] * v1[e]; }
                    } else {
#pragma unroll
                        for (int e = 0; e < 4; ++e) { v0[e] = fast_sigmoid(v0[e]); v1[e] = fast_sigmoid(v1[e]); }
                        dst = G + (size_t)row * 2048 + (col - 4352);
                    }
                    *(u32x4*)dst = pack8(v0, v1);
                }
                if (pn >= 13 && pn < 17) { q += __shfl_xor(q, 16); q += __shfl_xor(q, 32); if (fq == 0) ssv[(size_t)row * 16 + (pn - 13) * 4 + wc] = q; }
                asm volatile("" ::: "memory");
            }
    }
};
template <int MODE> struct EpiGate {
    static constexpr bool PERM = true, AFTER_DRAIN = false;
    bf16_t* O; const bf16_t* G; int goff;
    __device__ __forceinline__ void operator()(const f32x4 (&acc)[2][2][4][2], const Unit& u, int wr, int wc, int fr, int fq) const {
#pragma unroll
        for (int ai = 0; ai < 2; ++ai) {
            u32x4 gw[4][2], pw[4][2];
#pragma unroll
            for (int m = 0; m < 4; ++m)
#pragma unroll
                for (int bj = 0; bj < 2; ++bj) {
                    const int row = u.pm * BM + ai * HALF + wr * 64 + m * 16 + fr, col = u.pn * BM + bj * HALF + wc * 32 + 8 * fq;
                    gw[m][bj] = *(const u32x4*)(G + (size_t)row * 2048 + goff + col);
                    if (MODE == 1) pw[m][bj] = *(const u32x4*)(O + (size_t)row * 1024 + col);
                }
#pragma unroll
            for (int m = 0; m < 4; ++m)
#pragma unroll
                for (int bj = 0; bj < 2; ++bj) {
                    const int row = u.pm * BM + ai * HALF + wr * 64 + m * 16 + fr, col = u.pn * BM + bj * HALF + wc * 32 + 8 * fq;
                    f32x4 g0, g1; unpack8(gw[m][bj], g0, g1);
                    f32x4 v0 = acc[ai][bj][m][0] * g0, v1 = acc[ai][bj][m][1] * g1;
                    if (MODE == 1) { f32x4 p0, p1; unpack8(pw[m][bj], p0, p1); v0 = v0 + p0; v1 = v1 + p1; }
                    *(u32x4*)(O + (size_t)row * 1024 + col) = pack8(v0, v1);
                }
            asm volatile("" ::: "memory");
        }
    }
};
struct EpiRes {
    static constexpr bool PERM = true, AFTER_DRAIN = false;
    bf16_t* XL; bf16_t* XB; float* ss;
    __device__ __forceinline__ void operator()(const f32x4 (&acc)[2][2][4][2], const Unit& u, int wr, int wc, int fr, int fq) const {
#pragma unroll
        for (int ai = 0; ai < 2; ++ai)
#pragma unroll
        for (int mp = 0; mp < 2; ++mp) {
            u32x4 hv[2][2], lv[2][2];
#pragma unroll
            for (int mi = 0; mi < 2; ++mi)
#pragma unroll
                for (int bj = 0; bj < 2; ++bj) {
                    const size_t off = (size_t)(u.pm * BM + ai * HALF + wr * 64 + (2 * mp + mi) * 16 + fr) * 1024 + u.pn * BM + bj * HALF + wc * 32 + 8 * fq;
                    hv[mi][bj] = *(const u32x4*)(XB + off); lv[mi][bj] = *(const u32x4*)(XL + off);
                }
#pragma unroll
            for (int mi = 0; mi < 2; ++mi) {
                const int m = 2 * mp + mi, row = u.pm * BM + ai * HALF + wr * 64 + m * 16 + fr;
                float q = 0.f;
#pragma unroll
                for (int bj = 0; bj < 2; ++bj) {
                    const size_t off = (size_t)row * 1024 + u.pn * BM + bj * HALF + wc * 32 + 8 * fq;
                    f32x4 h0, h1, l0, l1; unpack8(hv[mi][bj], h0, h1); unpack8(lv[mi][bj], l0, l1);
                    const f32x4 x0 = (h0 + l0) + acc[ai][bj][m][0], x1 = (h1 + l1) + acc[ai][bj][m][1];
                    const u32x4 hw = pack8(x0, x1);
                    unpack8(hw, h0, h1);
                    *(u32x4*)(XB + off) = hw; *(u32x4*)(XL + off) = pack8(x0 - h0, x1 - h1);
#pragma unroll
                    for (int e = 0; e < 4; ++e) q += x0[e] * x0[e] + x1[e] * x1[e];
                }
                q += __shfl_xor(q, 16); q += __shfl_xor(q, 32);
                if (fq == 0) ss[(size_t)row * 16 + u.pn * 4 + wc] = q;
            }
            asm volatile("" ::: "memory");
        }
    }
};
struct EpiUp {
    static constexpr bool PERM = true, AFTER_DRAIN = false;
    bf16_t* A; const float* ss;
    __device__ __forceinline__ void operator()(const f32x4 (&acc)[2][2][4][2], const Unit& u, int wr, int wc, int fr, int fq) const {
        float rsv[2][4]; rows_rs(ss, u.pm * BM + wr * 64 + fr, fq, rsv);
#pragma unroll
        for (int ai = 0; ai < 2; ++ai)
#pragma unroll
            for (int m = 0; m < 4; ++m) {
                const int row = u.pm * BM + ai * HALF + wr * 64 + m * 16 + fr;
                const float rs = rsv[ai][m];
#pragma unroll
                for (int bj = 0; bj < 2; ++bj) {
                    const int col = u.pn * BM + bj * HALF + wc * 32 + 8 * fq;
                    *(u32x4*)(A + (size_t)row * 5632 + col) = pack8(acc[ai][bj][m][0] * rs, acc[ai][bj][m][1] * rs);
                }
                asm volatile("" ::: "memory");
            }
    }
};

__device__ __forceinline__ float dpp_prev(float x) { return __int_as_float(__builtin_amdgcn_update_dpp(0, __float_as_int(x), 0x121, 0xf, 0xf, false)); }
__device__ __forceinline__ float dpp_next(float x) { return __int_as_float(__builtin_amdgcn_update_dpp(0, __float_as_int(x), 0x12F, 0xf, 0xf, false)); }
__device__ __forceinline__ f32x4 rot_prev(const f32x4 v) { f32x4 r; r[0] = dpp_prev(v[0]); r[1] = dpp_prev(v[1]); r[2] = dpp_prev(v[2]); r[3] = dpp_prev(v[3]); return r; }
__device__ __forceinline__ f32x4 rot_next(const f32x4 v) { f32x4 r; r[0] = dpp_next(v[0]); r[1] = dpp_next(v[1]); r[2] = dpp_next(v[2]); r[3] = dpp_next(v[3]); return r; }
struct EpiUpConv {
    static constexpr bool PERM = true, AFTER_DRAIN = false;
    bf16_t* FG; bf16_t* SB; const float* ss; const float* cw; const float* cb;
    __device__ __forceinline__ void operator()(const f32x4 (&acc_)[2][2][4][2], const Unit& u, int wr, int wc, int fr, int fq) const {
        f32x4 (&acc)[2][2][4][2] = const_cast<f32x4 (&)[2][2][4][2]>(acc_);
        float rsv[2][4]; rows_rs(ss, u.pm * BM + wr * 64 + fr, fq, rsv);
        const int f0 = u.pn * 128 + wc * 32 + 8 * fq;
        const bool first = fr == 0, last = fr == 15;
#pragma unroll
        for (int ai = 0; ai < 2; ++ai) {
#pragma unroll
            for (int m = 0; m < 4; ++m)
#pragma unroll
                for (int h = 0; h < 2; ++h) { acc[ai][h][m][0] = acc[ai][h][m][0] * rsv[ai][m]; acc[ai][h][m][1] = acc[ai][h][m][1] * rsv[ai][m]; }
            const int blk = (u.pm * BM + ai * HALF + wr * 64) >> 6;
            if (fr <= 1) { bf16_t* sp = SB + ((size_t)blk * 4 + fr) * 5632 + f0;
                *(u32x4*)sp = pack8(acc[ai][0][0][0], acc[ai][0][0][1]); *(u32x4*)(sp + 2816) = pack8(acc[ai][1][0][0], acc[ai][1][0][1]); }
            if (fr >= 14) { bf16_t* sp = SB + ((size_t)blk * 4 + (fr - 12)) * 5632 + f0;
                *(u32x4*)sp = pack8(acc[ai][0][3][0], acc[ai][0][3][1]); *(u32x4*)(sp + 2816) = pack8(acc[ai][1][3][0], acc[ai][1][3][1]); }
        }
#pragma unroll
        for (int n = 0; n < 2; ++n) {
            f32x4 w[2][4];
#pragma unroll
            for (int h = 0; h < 2; ++h) {
#pragma unroll
                for (int k = 0; k < 3; ++k) w[h][k] = *(const f32x4*)(cw + k * 5632 + h * 2816 + f0 + 4 * n);
                w[h][3] = *(const f32x4*)(cb + h * 2816 + f0 + 4 * n);
            }
#pragma unroll
            for (int ai = 0; ai < 2; ++ai) {
#pragma unroll
                for (int m = 0; m < 4; ++m) {
                    const int row = u.pm * BM + ai * HALF + wr * 64 + m * 16 + fr;
                    f32x4 cv[2];
#pragma unroll
                    for (int h = 0; h < 2; ++h) {
                        const f32x4 cur = acc[ai][h][m][n];
                        f32x4 pv = rot_prev(cur), nx = rot_next(cur);
                        if (m > 0) { const f32x4 pw = rot_prev(acc[ai][h][m - 1][n]);
#pragma unroll
                            for (int e = 0; e < 4; ++e) pv[e] = first ? pw[e] : pv[e]; }
                        if (m < 3) { const f32x4 nw = rot_next(acc[ai][h][m + 1][n]);
#pragma unroll
                            for (int e = 0; e < 4; ++e) nx[e] = last ? nw[e] : nx[e]; }
                        cv[h] = pv * w[h][0] + cur * w[h][1] + nx * w[h][2] + w[h][3];
                    }
                    f32x4 o;
#pragma unroll
                    for (int e = 0; e < 4; ++e) o[e] = gelu_tanh(cv[0][e]) * cv[1][e];
                    const bool brow = (m == 0 && first) || (m == 3 && last);
                    if (!brow) { typedef unsigned u32x2e __attribute__((ext_vector_type(2))); u32x2e ow; ow.x = cvt_pk_bf16(o[0], o[1]); ow.y = cvt_pk_bf16(o[2], o[3]); *(u32x2e*)(FG + (size_t)row * 2816 + f0 + 4 * n) = ow; }
                }
                asm volatile("" ::: "memory");
            }
        }
    }
};

template <class Epi, class Sched, bool ALIGN_EPI = false, bool SP2 = false>
__device__ __forceinline__ void gemm_phase(PG8_LAS unsigned char* lds, const Gemm g, const Sched& S, const Epi& E, const int tid) {
    const int wid = __builtin_amdgcn_readfirstlane(tid >> 6), lane = tid & 63, wr = wid >> 2, wc = wid & 3, fr = lane & 15, fq = lane >> 4;
    const int K = g.K, nt = K / BK;
    unsigned voffA[2], voffB[2];
#pragma unroll
    for (int i = 0; i < 2; ++i) { int R, C; stage_rc(tid * 16 + i * 8192, R, C); const int Rb = Epi::PERM ? ((R & ~31) + perm32(R & 31)) : R;
        voffA[i] = (unsigned)(R * K + C) * 2u; voffB[i] = (unsigned)(Rb * K + C) * 2u; }
    const size_t kstep = (size_t)(BK * 2);
    const size_t hstep = (size_t)HALF * K * 2;
    const size_t tstep = 2 * hstep;
    const unsigned ldsw = (unsigned)wid * 1024u;
    const int aoff = lds_byte(wr * 64 + fr, fq * 8), boff = lds_byte(wc * 32 + fr, fq * 8);
#define PG8_SA(b, h) (((b) * 2 + (h)) * HTB)
#define PG8_SB(b, h) ((4 + (b) * 2 + (h)) * HTB)
#define PG8_STAGE(bufoff, gbase, voff) do { _Pragma("unroll") for (int _i = 0; _i < 2; ++_i) \
        __builtin_amdgcn_global_load_lds((const unsigned*)((const char*)(gbase) + (voff)[_i]), (PG8_LAS unsigned*)(lds + (bufoff) + ldsw + _i * 8192), 16, 0, 0); } while (0)
#define PG8_LDA(dst, b, h) do { _Pragma("unroll") for (int m = 0; m < 4; ++m) _Pragma("unroll") for (int k = 0; k < 2; ++k) dst[m][k] = *(const PG8_LAS bf16x8*)(lds + PG8_SA(b, h) + aoff + m * 2048 + k * 1024); } while (0)
#define PG8_LDB(dst, b, h) do { _Pragma("unroll") for (int n = 0; n < 2; ++n) _Pragma("unroll") for (int k = 0; k < 2; ++k) dst[n][k] = *(const PG8_LAS bf16x8*)(lds + PG8_SB(b, h) + boff + n * 2048 + k * 1024); } while (0)
#define PG8_MMA(ai, bj, At, Bt) do { __builtin_amdgcn_s_setprio(1); _Pragma("unroll") for (int m = 0; m < 4; ++m) _Pragma("unroll") for (int n = 0; n < 2; ++n) _Pragma("unroll") for (int k = 0; k < 2; ++k) \
        acc[ai][bj][m][n] = __builtin_amdgcn_mfma_f32_16x16x32_bf16(Bt[n][k], At[m][k], acc[ai][bj][m][n], 0, 0, 0); __builtin_amdgcn_s_setprio(0); } while (0)
#define PG8_WAIT_V(n) asm volatile("s_waitcnt vmcnt(" #n ")" ::: "memory")
#define PG8_WAIT_L(n) asm volatile("s_waitcnt lgkmcnt(" #n ")" ::: "memory")
#define PG8_BAR __builtin_amdgcn_s_barrier()
#define PG8_SCHED __builtin_amdgcn_sched_barrier(0)
    Unit cur, nxt; int ui = 0;
    if (!S.next(0, cur)) return;
    f32x4 acc[2][2][4][2];
#pragma unroll
    for (int a = 0; a < 2; ++a)
#pragma unroll
        for (int b = 0; b < 2; ++b)
#pragma unroll
            for (int m = 0; m < 4; ++m)
#pragma unroll
                for (int n = 0; n < 2; ++n) acc[a][b][m][n] = (f32x4){0.f, 0.f, 0.f, 0.f};
    bf16x8 At[4][2], B0[2][2], B1[2][2];
    const char* cA = (const char*)g.A + (size_t)cur.pm * tstep; const char* cB = (const char*)g.Bt + (size_t)cur.pn * tstep;
    S.a_ready(cur);
    if constexpr (SP2) {
        PG8_STAGE(PG8_SB(0, 0), cB, voffB); PG8_STAGE(PG8_SB(0, 1), cB + hstep, voffB); PG8_STAGE(PG8_SA(0, 0), cA, voffA); PG8_STAGE(PG8_SA(0, 1), cA + hstep, voffA);
        if (wr == 1) PG8_BAR;
        PG8_WAIT_V(2); PG8_BAR;
        PG8_STAGE(PG8_SB(1, 0), cB + kstep, voffB); PG8_STAGE(PG8_SA(1, 0), cA + kstep, voffA); PG8_STAGE(PG8_SB(1, 1), cB + hstep + kstep, voffB);
        PG8_WAIT_V(6); PG8_BAR;
    } else {
        PG8_STAGE(PG8_SB(0, 0), cB, voffB); PG8_STAGE(PG8_SA(0, 0), cA, voffA); PG8_STAGE(PG8_SB(0, 1), cB + hstep, voffB); PG8_STAGE(PG8_SA(0, 1), cA + hstep, voffA);
        if (wr == 1) PG8_BAR;
        PG8_WAIT_V(4); PG8_BAR;
        PG8_STAGE(PG8_SB(1, 0), cB + kstep, voffB); PG8_STAGE(PG8_SA(1, 0), cA + kstep, voffA); PG8_STAGE(PG8_SB(1, 1), cB + hstep + kstep, voffB);
        PG8_WAIT_V(6); PG8_BAR;
    }
    for (;;) {
        const bool has_next = S.next(ui + 1, nxt);
        const char* nA = has_next ? (const char*)g.A + (size_t)nxt.pm * tstep : cA; const char* nB = has_next ? (const char*)g.Bt + (size_t)nxt.pn * tstep : cB;
        for (int t = 0; t < nt; t += 2) {
            const bool last = (t == nt - 2);
            const char* a1 = cA + (size_t)(t + 1) * kstep;
            const char* a2 = last ? nA : cA + (size_t)(t + 2) * kstep; const char* b2 = last ? nB : cB + (size_t)(t + 2) * kstep;
            const char* a3 = a2 + kstep; const char* b3 = b2 + kstep;
            if (last && has_next) S.a_ready(nxt);
            if constexpr (SP2) {
            PG8_LDB(B0, 0, 0); PG8_LDB(B1, 0, 1); PG8_SCHED; PG8_LDA(At, 0, 0); PG8_STAGE(PG8_SA(1, 1), a1 + hstep, voffA);
            PG8_WAIT_V(8); PG8_WAIT_L(0); PG8_BAR; PG8_MMA(0, 0, At, B0); PG8_MMA(0, 1, At, B1); PG8_BAR; PG8_SCHED;
            PG8_LDA(At, 0, 1); PG8_STAGE(PG8_SB(0, 0), b2, voffB); PG8_STAGE(PG8_SB(0, 1), b2 + hstep, voffB); PG8_STAGE(PG8_SA(0, 0), a2, voffA);
            PG8_WAIT_V(8); PG8_WAIT_L(0); PG8_BAR; PG8_MMA(1, 0, At, B0); PG8_MMA(1, 1, At, B1); PG8_BAR; PG8_SCHED;
            PG8_LDB(B0, 1, 0); PG8_LDB(B1, 1, 1); PG8_SCHED; PG8_LDA(At, 1, 0); PG8_STAGE(PG8_SA(0, 1), a2 + hstep, voffA);
            PG8_WAIT_V(8); PG8_WAIT_L(0); PG8_BAR; PG8_MMA(0, 0, At, B0); PG8_MMA(0, 1, At, B1); PG8_BAR; PG8_SCHED;
            PG8_LDA(At, 1, 1); PG8_STAGE(PG8_SB(1, 0), b3, voffB); PG8_STAGE(PG8_SB(1, 1), b3 + hstep, voffB); PG8_STAGE(PG8_SA(1, 0), a3, voffA);
            PG8_WAIT_V(8); PG8_WAIT_L(0); PG8_BAR; PG8_MMA(1, 0, At, B0); PG8_MMA(1, 1, At, B1); PG8_BAR; PG8_SCHED;
            } else {
            PG8_LDB(B0, 0, 0); PG8_SCHED; PG8_LDA(At, 0, 0); PG8_STAGE(PG8_SA(1, 1), a1 + hstep, voffA);
            PG8_WAIT_L(8); PG8_BAR; PG8_WAIT_L(0); PG8_MMA(0, 0, At, B0); PG8_BAR; PG8_SCHED;
            PG8_LDB(B1, 0, 1); PG8_STAGE(PG8_SB(0, 0), b2, voffB);
            PG8_BAR; PG8_WAIT_L(0); PG8_MMA(0, 1, At, B1); PG8_BAR;
            PG8_LDA(At, 0, 1); PG8_STAGE(PG8_SA(0, 0), a2, voffA);
            PG8_BAR; PG8_WAIT_L(0); PG8_MMA(1, 0, At, B0); PG8_BAR; PG8_SCHED;
            PG8_STAGE(PG8_SB(0, 1), b2 + hstep, voffB);
            PG8_WAIT_V(6); PG8_BAR; PG8_MMA(1, 1, At, B1); PG8_BAR;
            PG8_LDB(B0, 1, 0); PG8_SCHED; PG8_LDA(At, 1, 0); PG8_STAGE(PG8_SA(0, 1), a2 + hstep, voffA);
            PG8_WAIT_L(8); PG8_BAR; PG8_WAIT_L(0); PG8_MMA(0, 0, At, B0); PG8_BAR; PG8_SCHED;
            PG8_LDB(B1, 1, 1); PG8_STAGE(PG8_SB(1, 0), b3, voffB);
            PG8_BAR; PG8_WAIT_L(0); PG8_MMA(0, 1, At, B1); PG8_BAR;
            PG8_LDA(At, 1, 1); PG8_STAGE(PG8_SA(1, 0), a3, voffA);
            PG8_BAR; PG8_WAIT_L(0); PG8_MMA(1, 0, At, B0); PG8_BAR; PG8_SCHED;
            PG8_STAGE(PG8_SB(1, 1), b3 + hstep, voffB);
            PG8_WAIT_V(6); PG8_BAR; PG8_MMA(1, 1, At, B1); PG8_BAR;
            }
        }
        if constexpr (ALIGN_EPI) { if (wr == 0) PG8_BAR; }
        if constexpr (!Epi::AFTER_DRAIN) { E(acc, cur, wr, wc, fr, fq); S.done(cur); }
        if (!has_next) break;
#pragma unroll
        for (int a = 0; a < 2; ++a)
#pragma unroll
            for (int b = 0; b < 2; ++b)
#pragma unroll
                for (int m = 0; m < 4; ++m)
#pragma unroll
                    for (int n = 0; n < 2; ++n) acc[a][b][m][n] = (f32x4){0.f, 0.f, 0.f, 0.f};
        cur = nxt; cA = nA; cB = nB; ++ui;
        if constexpr (ALIGN_EPI) { if (wr == 1) PG8_BAR; }
    }
    PG8_WAIT_V(0);
    if constexpr (!ALIGN_EPI) { if (wr == 0) PG8_BAR; }
    PG8_BAR;
    if constexpr (Epi::AFTER_DRAIN) { E.fused(acc, cur, wr, wc, fr, fq, lds, wid, lane); S.done(cur); }
#undef PG8_SA
#undef PG8_SB
#undef PG8_STAGE
#undef PG8_LDA
#undef PG8_LDB
#undef PG8_MMA
#undef PG8_WAIT_V
#undef PG8_WAIT_L
#undef PG8_BAR
#undef PG8_SCHED
}
}


#define LAS __attribute__((address_space(3)))
#ifndef SKIPMASK
#define SKIPMASK 0
#endif
#ifndef PROBE_KIND
#define PROBE_KIND -1
#endif
typedef unsigned short bf16;
using pg8::f32x4; using pg8::u32x4; using pg8::bf16x8;
typedef float f32x16 __attribute__((ext_vector_type(16)));
typedef short v4i16_t __attribute__((ext_vector_type(4)));
typedef unsigned u32x2 __attribute__((ext_vector_type(2)));

constexpr int DM = 1024, DEPTH = 4, NTOK = 98304, NPROMPT = 32768, CH = 32768, NCHUNK = NTOK / CH;
constexpr int NIN = 6400, DFF = 2816, NUP = 5632;
constexpr int LDS_BYTES = 147456, NTHR = 512;
constexpr float EPS = 1e-6f, LOG2E = 1.4426950408889634f;
constexpr size_t OFF_IN = 0, OFF_PA = OFF_IN + (size_t)NIN * DM, OFF_PB = OFF_PA + (size_t)DM * 256, OFF_OUT = OFF_PB + (size_t)DM * DM, OFF_UP = OFF_OUT + (size_t)DM * DM,
                 OFF_DN = OFF_UP + (size_t)NUP * DM, OFF_WS = OFF_DN + (size_t)DM * DFF, W_LAYER = OFF_WS + 8 * 128 * 128;
constexpr size_t MiB = 1u << 20;
constexpr size_t WS_W = 0, WS_R1 = 144 * MiB, WS_R2 = WS_R1 + (size_t)CH * 12800, WS_XB = WS_R2 + (size_t)CH * 5632, WS_SS = WS_XB + (size_t)CH * 2048, WS_SSV = WS_SS + (size_t)CH * 64, WS_BAR = WS_SSV + (size_t)CH * 64, WS_SB = WS_BAR + 65536, WS_XL = WS_SB + (size_t)(CH / 64) * 4 * 5632 * 2, WS_BT = WS_XL + (size_t)CH * 2048, WS_END = WS_BT + 16384;
static_assert(W_LAYER * 2 * DEPTH <= WS_R1, "weights fit");
constexpr int PROBE_DUPK = (PROBE_KIND == 8) ? 1 : PROBE_KIND;
constexpr int KPL = (PROBE_DUPK >= 0 && PROBE_DUPK < 8) ? 9 : 8;
constexpr int NP0 = (PROBE_KIND == 9) ? 2 : 1;
constexpr int PH_PER_CHUNK = 2 + KPL * DEPTH, N_PHASES = NP0 + NCHUNK * PH_PER_CHUNK;

struct Args { const float* in[17]; float* out; unsigned char* ws; int ph_lo, ph_hi; };

__device__ __forceinline__ float wave_sum(float v) {
#pragma unroll
    for (int o = 1; o < 64; o <<= 1) v += __shfl_xor(v, o);
    return v;
}
__device__ __forceinline__ unsigned pk2(float lo, float hi) { return pg8::cvt_pk_bf16(lo, hi); }
#define LDS_WAIT() asm volatile("s_waitcnt lgkmcnt(0)" ::: "memory")

__device__ __forceinline__ int t5_bucket(int rel) {
    const int n = rel < 0 ? -rel : rel;
    const int b = n < 8 ? n : 8 + (n >= 15) + (n >= 27) + (n >= 50) + (n >= 91) + (n >= 166) + (n >= 305) + (n >= 559);
    return (rel > 0 ? 16 : 0) + b;
}
__device__ __forceinline__ void tr_item(const float* W, int K, int N, bf16* WT, const float* gain, LAS float* scr, int item, int lane, bool perm_up = false) {
    const int nblk = N / 32, kb = item / nblk, nb = item % nblk, k0 = 64 * kb, n0 = 32 * nb;
    const int dn0 = perm_up ? ((n0 % DFF) / 128) * 256 + (n0 / DFF) * 128 + (n0 % 128) : n0;
#pragma unroll
    for (int i = 0; i < 8; ++i) {
        const int kk = (lane >> 3) + 8 * i, c4 = 4 * (lane & 7); const float g = gain ? gain[k0 + kk] : 1.0f;
        const f32x4 v = *(const f32x4*)(W + (size_t)(k0 + kk) * N + n0 + c4);
        scr[kk * 33 + c4 + 0] = v[0] * g; scr[kk * 33 + c4 + 1] = v[1] * g; scr[kk * 33 + c4 + 2] = v[2] * g; scr[kk * 33 + c4 + 3] = v[3] * g;
    }
    LDS_WAIT();
    const int c = lane & 7;
#pragma unroll
    for (int j = 0; j < 4; ++j) { const int n = (lane >> 3) + 8 * j; const LAS float* s = scr + (8 * c) * 33 + n;
        u32x4 o; o.x = pk2(s[0 * 33], s[1 * 33]); o.y = pk2(s[2 * 33], s[3 * 33]); o.z = pk2(s[4 * 33], s[5 * 33]); o.w = pk2(s[6 * 33], s[7 * 33]);
        *(u32x4*)(WT + (size_t)(dn0 + n) * K + k0 + 8 * c) = o; }
    LDS_WAIT();
}
__device__ __forceinline__ void p0_weights(const Args& a, LAS unsigned char* lds, int tid, int G, int bid) {
    const int wave = tid >> 6, lane = tid & 63;
    LAS float* scr = (LAS float*)(lds + wave * 16384);
    const int gw = bid * 8 + wave, NGW = G * 8;
    constexpr int I_IN = 16 * 200, I_PA = 4 * 32, I_PB = 16 * 32, I_OUT = 16 * 32, I_UP = 16 * 176, I_DN = 44 * 32, PER = I_IN + I_PA + I_PB + I_OUT + I_UP + I_DN;
    bf16* Wb = (bf16*)(a.ws + WS_W);
    for (int it = gw; it < DEPTH * PER; it += NGW) {
        const int l = it / PER; int r = it % PER; bf16* wl = Wb + (size_t)l * W_LAYER;
        if (r < I_IN) { tr_item(a.in[4] + (size_t)l * DM * NIN, DM, NIN, wl + OFF_IN, a.in[3] + l * DM, scr, r, lane); continue; } r -= I_IN;
        if (r < I_PA) { tr_item(a.in[8] + (size_t)l * 256 * DM, 256, DM, wl + OFF_PA, nullptr, scr, r, lane); continue; } r -= I_PA;
        if (r < I_PB) { tr_item(a.in[9] + (size_t)l * DM * DM, DM, DM, wl + OFF_PB, nullptr, scr, r, lane); continue; } r -= I_PB;
        if (r < I_OUT) { tr_item(a.in[10] + (size_t)l * DM * DM, DM, DM, wl + OFF_OUT, nullptr, scr, r, lane); continue; } r -= I_OUT;
        if (r < I_UP) { tr_item(a.in[12] + (size_t)l * DM * NUP, DM, NUP, wl + OFF_UP, a.in[11] + l * DM, scr, r, lane, true); continue; } r -= I_UP;
        tr_item(a.in[15] + (size_t)l * DFF * DM, DFF, DM, wl + OFF_DN, nullptr, scr, r, lane);
    }
    if (bid == 0) {
        float* BT = (float*)(a.ws + WS_BT);
        for (int i = tid; i < 3 * 768; i += NTHR) { const int g = i / 768, hh = (i % 768) / 192, j = i % 192 - 96;
            BT[i] = (j >= -64 && j <= 64) ? LOG2E * a.in[2][t5_bucket(j << (2 * g)) * 12 + g * 4 + hh] : -1e30f; }
    }
    for (int i = bid * NTHR + tid; i < DEPTH * 131072 / 4; i += G * NTHR) {
        const int l = i / 32768, e = (i % 32768) * 4;
        const f32x4 v = *(const f32x4*)(a.in[6] + (size_t)l * 131072 + e);
        u32x2 o; o.x = pk2(v[0], v[1]); o.y = pk2(v[2], v[3]);
        *(u32x2*)(Wb + (size_t)l * W_LAYER + OFF_WS + e) = o;
    }
}
__device__ __forceinline__ void p0x(const Args& a, int chunk, int tid, int G, int bid) {
    const int wave = tid >> 6, lane = tid & 63, gw = bid * 8 + wave, NGW = G * 8;
    bf16* XB = (bf16*)(a.ws + WS_XB); bf16* XL = (bf16*)(a.ws + WS_XL); float* SS = (float*)(a.ws + WS_SS);
    for (int m0 = gw; m0 < CH; m0 += 4 * NGW) {
        f32x4 v[4][4];
#pragma unroll
        for (int r = 0; r < 4; ++r) {
            const int m = m0 + r * NGW; const size_t tok = (size_t)chunk * CH + (m < CH ? m : m0);
            const float* src = tok < NPROMPT ? a.in[0] + tok * DM : a.in[1] + (tok - NPROMPT) * DM;
#pragma unroll
            for (int j = 0; j < 4; ++j) v[r][j] = *(const f32x4*)(src + (lane + 64 * j) * 4);
        }
#pragma unroll
        for (int r = 0; r < 4; ++r) {
            const int m = m0 + r * NGW;
            if (m < CH) {
                float s = 0.f;
#pragma unroll
                for (int j = 0; j < 4; ++j) { const f32x4 w = v[r][j]; s += (w[0] * w[0] + w[1] * w[1]) + (w[2] * w[2] + w[3] * w[3]);
                    u32x2 o; o.x = pk2(w[0], w[1]); o.y = pk2(w[2], w[3]); *(u32x2*)(XB + (size_t)m * DM + (lane + 64 * j) * 4) = o;
                    u32x2 lo; lo.x = pk2(w[0] - __uint_as_float(o.x << 16), w[1] - __uint_as_float(o.x & 0xffff0000u)); lo.y = pk2(w[2] - __uint_as_float(o.y << 16), w[3] - __uint_as_float(o.y & 0xffff0000u));
                    *(u32x2*)(XL + (size_t)m * DM + (lane + 64 * j) * 4) = lo; }
                s = wave_sum(s);
                if (lane < 16) SS[(size_t)m * 16 + lane] = lane == 0 ? s : 0.f;
            }
        }
    }
}
__device__ __forceinline__ void pfinal(const Args& a, int chunk, int tid, int G, int bid) {
    const int wave = tid >> 6, lane = tid & 63, gw = bid * 8 + wave, NGW = G * 8;
    const bf16* XB = (const bf16*)(a.ws + WS_XB); const bf16* XL = (const bf16*)(a.ws + WS_XL);
    const float* SS = (const float*)(a.ws + WS_SS); const float* nf = a.in[16];
    f32x4 g[2][2];
#pragma unroll
    for (int j = 0; j < 2; ++j) { g[j][0] = *(const f32x4*)(nf + (lane + 64 * j) * 8); g[j][1] = *(const f32x4*)(nf + (lane + 64 * j) * 8 + 4); }
    for (int m0 = gw; m0 < CH; m0 += 4 * NGW) {
        u32x4 hw[4][2], lw[4][2]; f32x4 sp[4];
#pragma unroll
        for (int r = 0; r < 4; ++r) {
            const int m = (m0 + r * NGW < CH) ? m0 + r * NGW : m0;
            sp[r] = *(const f32x4*)(SS + (size_t)m * 16 + 4 * (lane & 3));
#pragma unroll
            for (int j = 0; j < 2; ++j) { hw[r][j] = *(const u32x4*)(XB + (size_t)m * DM + (lane + 64 * j) * 8); lw[r][j] = *(const u32x4*)(XL + (size_t)m * DM + (lane + 64 * j) * 8); }
        }
#pragma unroll
        for (int r = 0; r < 4; ++r) {
            const int m = m0 + r * NGW;
            if (m < CH) {
                float t = (sp[r][0] + sp[r][1]) + (sp[r][2] + sp[r][3]); t += __shfl_xor(t, 1); t += __shfl_xor(t, 2);
                const float rs = rsqrtf(t * (1.0f / 1024.0f) + EPS);
                float* x = a.out + ((size_t)chunk * CH + m) * DM;
#pragma unroll
                for (int j = 0; j < 2; ++j) { const int c = (lane + 64 * j) * 8; f32x4 h0, h1, l0, l1; pg8::unpack8(hw[r][j], h0, h1); pg8::unpack8(lw[r][j], l0, l1);
                    *(f32x4*)(x + c) = (h0 + l0) * rs * g[j][0]; *(f32x4*)(x + c + 4) = (h1 + l1) * rs * g[j][1]; }
            }
        }
    }
}
struct AttU { int g, d, L, tokbase, qb; };
__device__ __forceinline__ AttU att_decode(int unit, int S) {
    constexpr int upg = CH / 64;
    AttU u; u.g = unit / upg; const int rem = unit % upg, ups = S / 64, seq = rem / ups, rem2 = rem % ups;
    u.d = 1 << (2 * u.g); u.L = S / u.d; const int nqb = u.L / 64, r = rem2 / nqb; u.qb = rem2 % nqb; u.tokbase = seq * S + r;
    return u;
}
template <int KT0, int KT1, bool WITHQ>
__device__ __forceinline__ void att_load_qk(const bf16* QKV, const AttU& u, int h, int qh, int n, int hi, bf16x8 (&qf)[4], bf16x8 (&kf)[5][4]) {
    const int qbase = 64 * u.qb + 32 * qh;
    if (WITHQ) {
        const bf16* qp = QKV + ((size_t)u.tokbase + (size_t)(qbase + n) * u.d) * 2304 + u.g * 256 + h * 64 + 8 * hi;
#pragma unroll
        for (int s = 0; s < 4; ++s) qf[s] = *(const bf16x8*)(qp + 16 * s);
    }
#pragma unroll
    for (int kt = KT0; kt < KT1; ++kt) {
        const int lk = qbase - 64 + 32 * kt + n, lkc = lk < 0 ? 0 : (lk > u.L - 1 ? u.L - 1 : lk);
        const bf16* kp = QKV + (size_t)(u.tokbase + lkc * u.d) * 2304 + 768 + u.g * 256 + h * 64 + 8 * hi;
#pragma unroll
        for (int s = 0; s < 4; ++s) kf[kt][s] = *(const bf16x8*)(kp + 16 * s);
    }
}
__device__ __forceinline__ void attn_phase(const bf16* QKV, bf16* OUTG, float* LSE, const float* BT, LAS unsigned char* lds, int S, int tid, int G, int bid) {
    constexpr int NATT = 3 * (CH / 64);
    int it = (G % 8 == 0) ? (bid & 7) * (G / 8) + (bid >> 3) : bid;
    if (it >= NATT) return;
    AttU u = att_decode(it, S);
    bf16x8 qf[4], kf[5][4];
    att_load_qk<0, 4, false>(QKV, u, (tid >> 6) & 3, tid >> 8, tid & 31, (tid >> 5) & 1, qf, kf);
    for (; it < NATT; it += G) {
        int tl = tid; asm volatile("" : "+v"(tl));
        const int h = (tl >> 6) & 3, qh = tl >> 8, n = tl & 31, hi = (tl >> 5) & 1, lane = tl & 63;
        const int g = u.g, d = u.d, L = u.L, tokbase = u.tokbase, qb = u.qb, qbase = 64 * qb + 32 * qh;
        att_load_qk<4, 5, true>(QKV, u, h, qh, n, hi, qf, kf);
        u32x4 vv[12];
#pragma unroll
        for (int i = 0; i < 12; ++i) {
            const int idx = tl + i * NTHR, kk = idx >> 5, ch = idx & 31, lk = 64 * qb - 64 + kk;
            vv[i] = (u32x4){0u, 0u, 0u, 0u};
            if (lk >= 0 && lk < L) vv[i] = *(const u32x4*)(QKV + (size_t)(tokbase + lk * d) * 2304 + 1536 + g * 256 + ch * 8);
        }
        const float bt0 = BT[g * 768 + tid], bt1 = tid < 256 ? BT[g * 768 + 512 + tid] : 0.f;
        f32x16 st[5];
#pragma unroll
        for (int kt = 0; kt < 5; ++kt) {
            f32x16 acc;
#pragma unroll
            for (int e = 0; e < 16; ++e) acc[e] = 0.f;
#pragma unroll
            for (int s = 0; s < 4; ++s) acc = __builtin_amdgcn_mfma_f32_32x32x16_bf16(kf[kt][s], qf[s], acc, 0, 0, 0);
            st[kt] = acc;
        }
#pragma unroll
        for (int i = 0; i < 12; ++i) { const int idx = tl + i * NTHR, kk = idx >> 5, ch = idx & 31; *(LAS u32x4*)(lds + kk * 576 + ch * 16) = vv[i]; }
        LAS float* bt = (LAS float*)(lds + 110592);
        bt[tid] = bt0; if (tid < 256) bt[512 + tid] = bt1;
        asm volatile("" :: "v"(st[4][15]) : "memory");
        AttU un = u;
        if (it + G < NATT) { un = att_decode(it + G, S); att_load_qk<0, 4, false>(QKV, un, h, qh, n, hi, qf, kf); }
        __syncthreads();
        float mx = -3.0e38f;
        {
            const LAS float* btl = bt + h * 192 + 32 + 4 * hi - n;
            const bool edge = (qb == 0) || (64 * qb + 128 > L);
#pragma unroll
            for (int kt = 0; kt < 5; ++kt)
#pragma unroll
                for (int i = 0; i < 16; ++i) {
                    float sv = st[kt][i] + btl[32 * kt + (i & 3) + 8 * (i >> 2)];
                    if (edge) { const int lk2 = qbase - 64 + 32 * kt + (i & 3) + 8 * (i >> 2) + 4 * hi; sv = (lk2 >= 0 && lk2 < L) ? sv : -1e30f; }
                    st[kt][i] = sv; mx = fmaxf(mx, sv);
                }
        }
        mx = fmaxf(mx, __shfl_xor(mx, 32));
        float sum = 0.f;
#pragma unroll
        for (int kt = 0; kt < 5; ++kt)
#pragma unroll
            for (int i = 0; i < 16; ++i) { const float pe = __builtin_amdgcn_exp2f(st[kt][i] - mx); st[kt][i] = pe; sum += pe; }
        sum += __shfl_xor(sum, 32);
        const float inv = 1.0f / sum, lse = (mx + __log2f(sum)) * 0.6931471805599453f;
        f32x16 o0, o1;
#pragma unroll
        for (int e = 0; e < 16; ++e) { o0[e] = 0.f; o1[e] = 0.f; }
        const int q4 = (lane & 15) >> 2, p4 = lane & 3, gsel = (lane >> 4) & 1;
        const unsigned vbase = (unsigned)((32 * qh + 4 * hi + q4) * 576 + h * 128 + (16 * gsel + 4 * p4) * 2);
#pragma unroll
        for (int kt = 0; kt < 5; ++kt)
#pragma unroll
            for (int s2 = 0; s2 < 2; ++s2) {
                u32x4 pw; pw.x = pk2(st[kt][8 * s2 + 0], st[kt][8 * s2 + 1]); pw.y = pk2(st[kt][8 * s2 + 2], st[kt][8 * s2 + 3]); pw.z = pk2(st[kt][8 * s2 + 4], st[kt][8 * s2 + 5]); pw.w = pk2(st[kt][8 * s2 + 6], st[kt][8 * s2 + 7]);
                const bf16x8 pf = __builtin_bit_cast(bf16x8, pw);
                const unsigned ro = vbase + (unsigned)((32 * kt + 16 * s2) * 576);
                {
                    const v4i16_t r1 = __builtin_amdgcn_ds_read_tr16_b64_v4i16((LAS v4i16_t*)(lds + ro)), r2 = __builtin_amdgcn_ds_read_tr16_b64_v4i16((LAS v4i16_t*)(lds + ro + 8 * 576));
                    const bf16x8 vf = (bf16x8){r1[0], r1[1], r1[2], r1[3], r2[0], r2[1], r2[2], r2[3]};
                    o0 = __builtin_amdgcn_mfma_f32_32x32x16_bf16(vf, pf, o0, 0, 0, 0);
                }
                {
                    const v4i16_t r1 = __builtin_amdgcn_ds_read_tr16_b64_v4i16((LAS v4i16_t*)(lds + ro + 64)), r2 = __builtin_amdgcn_ds_read_tr16_b64_v4i16((LAS v4i16_t*)(lds + ro + 64 + 8 * 576));
                    const bf16x8 vf = (bf16x8){r1[0], r1[1], r1[2], r1[3], r2[0], r2[1], r2[2], r2[3]};
                    o1 = __builtin_amdgcn_mfma_f32_32x32x16_bf16(vf, pf, o1, 0, 0, 0);
                }
            }
        const size_t tokq = (size_t)tokbase + (size_t)(qbase + n) * d;
        bf16* op = OUTG + ((size_t)g * CH + tokq) * 256 + h * 64;
#pragma unroll
        for (int grp = 0; grp < 4; ++grp) {
            u32x2 w0, w1;
            w0.x = pk2(o0[4 * grp + 0] * inv, o0[4 * grp + 1] * inv); w0.y = pk2(o0[4 * grp + 2] * inv, o0[4 * grp + 3] * inv);
            w1.x = pk2(o1[4 * grp + 0] * inv, o1[4 * grp + 1] * inv); w1.y = pk2(o1[4 * grp + 2] * inv, o1[4 * grp + 3] * inv);
            *(u32x2*)(op + 8 * grp + 4 * hi) = w0; *(u32x2*)(op + 32 + 8 * grp + 4 * hi) = w1;
        }
        if (hi == 0) LSE[((size_t)g * CH + tokq) * 4 + h] = lse;
        __syncthreads();
        u = un;
    }
}
constexpr int SG_WLDS = 17920;
__device__ __forceinline__ void sg_wave_unit(bf16* U, bf16* UO, const bf16* GV, const float* ssv, const bf16* WSb, const float* gain, const float* bs, LAS unsigned char* wl, int unit, int lane) {
    const int hf = unit & 1, gg = (unit >> 1) & 7, nch = unit >> 4, tok0 = nch * 128, cb = gg * 128 + hf * 64;
    LAS float* rvl = (LAS float*)(wl + 17408);
    rvl[lane] = pg8::row_rs(ssv, tok0 + lane); rvl[lane + 64] = pg8::row_rs(ssv, tok0 + lane + 64);
    LDS_WAIT();
    {
        const int c8 = lane & 7, q0 = lane >> 3;
#pragma unroll
        for (int i = 0; i < 16; ++i) {
            const int q = q0 + 8 * i;
            f32x4 a0, a1; pg8::unpack8(*(const u32x4*)(GV + (size_t)(tok0 + q) * 1024 + cb + c8 * 8), a0, a1);
            const float r = rvl[q];
            const u32x4 w = pg8::pack8(a0 * r, a1 * r);
            *(LAS u32x2*)(wl + q * 136 + c8 * 16) = (u32x2){w.x, w.y}; *(LAS u32x2*)(wl + q * 136 + c8 * 16 + 8) = (u32x2){w.z, w.w};
        }
    }
    LDS_WAIT();
    const int ln = lane & 15, kq = lane >> 4, qq = ln >> 2, pp = ln & 3;
    bf16x8 afr[4][4];
#pragma unroll
    for (int ct = 0; ct < 4; ++ct)
#pragma unroll
        for (int ks = 0; ks < 4; ++ks) {
            const unsigned ad = (unsigned)((32 * ks + 8 * kq + qq) * 136 + (32 * (ct >> 1) + 8 * pp + 4 * (ct & 1)) * 2);
            const v4i16_t r1 = __builtin_amdgcn_ds_read_tr16_b64_v4i16((LAS v4i16_t*)(wl + ad)), r2 = __builtin_amdgcn_ds_read_tr16_b64_v4i16((LAS v4i16_t*)(wl + ad + 4 * 136));
            afr[ct][ks] = (bf16x8){r1[0], r1[1], r1[2], r1[3], r2[0], r2[1], r2[2], r2[3]};
        }
    f32x4 gn[2][2];
#pragma unroll
    for (int t = 0; t < 2; ++t) { gn[t][0] = *(const f32x4*)(gain + cb + 32 * t + 8 * kq); gn[t][1] = *(const f32x4*)(gain + cb + 32 * t + 8 * kq + 4); }
#pragma unroll 2
    for (int pt = 0; pt < 8; ++pt) {
        const int pr = pt * 16 + ln;
        bf16x8 bfr[4];
#pragma unroll
        for (int ks = 0; ks < 4; ++ks) bfr[ks] = *(const bf16x8*)(WSb + (size_t)gg * 16384 + pr * 128 + 32 * ks + 8 * kq);
        bf16* up = U + (size_t)(tok0 + pr) * 1024 + cb + 8 * kq; bf16* uo = UO + (size_t)(tok0 + pr) * 1024 + cb + 8 * kq;
        const u32x4 uw0 = *(const u32x4*)up, uw1 = *(const u32x4*)(up + 32);
        const float bias = bs[gg * 128 + pr];
        f32x4 acc[4];
#pragma unroll
        for (int ct = 0; ct < 4; ++ct) {
            acc[ct] = (f32x4){0.f, 0.f, 0.f, 0.f};
#pragma unroll
            for (int ks = 0; ks < 4; ++ks) acc[ct] = __builtin_amdgcn_mfma_f32_16x16x32_bf16(afr[ct][ks], bfr[ks], acc[ct], 0, 0, 0);
        }
        f32x4 u0, u1;
        pg8::unpack8(uw0, u0, u1);
        *(u32x4*)uo = pg8::pack8(u0 * (gn[0][0] * acc[0] + bias), u1 * (gn[0][1] * acc[1] + bias));
        pg8::unpack8(uw1, u0, u1);
        *(u32x4*)(uo + 32) = pg8::pack8(u0 * (gn[1][0] * acc[2] + bias), u1 * (gn[1][1] * acc[3] + bias));
    }
    LDS_WAIT();
}
__device__ __forceinline__ void p_merge(const bf16* OUTG, const float* LSE, bf16* OA, int tid, int G, int bid) {
    for (int it = bid * NTHR + tid; it < CH * 32; it += G * NTHR) {
        const int tok = it >> 5, c8 = it & 31, h = c8 >> 3;
        const float l0 = LSE[(size_t)tok * 4 + h], l1 = LSE[((size_t)CH + tok) * 4 + h], l2 = LSE[((size_t)2 * CH + tok) * 4 + h];
        const float mx = fmaxf(l0, fmaxf(l1, l2));
        float w0 = __expf(l0 - mx), w1 = __expf(l1 - mx), w2 = __expf(l2 - mx);
        const float inv = 1.0f / (w0 + w1 + w2); w0 *= inv; w1 *= inv; w2 *= inv;
        f32x4 a0, a1, b0, b1, c0, c1;
        pg8::unpack8(*(const u32x4*)(OUTG + (size_t)tok * 256 + c8 * 8), a0, a1);
        pg8::unpack8(*(const u32x4*)(OUTG + ((size_t)CH + tok) * 256 + c8 * 8), b0, b1);
        pg8::unpack8(*(const u32x4*)(OUTG + ((size_t)2 * CH + tok) * 256 + c8 * 8), c0, c1);
        *(u32x4*)(OA + (size_t)tok * 256 + c8 * 8) = pg8::pack8(a0 * w0 + b0 * w1 + c0 * w2, a1 * w0 + b1 * w1 + c1 * w2);
    }
}
__device__ __forceinline__ void p_conv(const bf16* A, bf16* FG, const float* cw, const float* cb, int S, int tid, int G, int bid) {
    constexpr int RUN = 8, NFC = DFF / 8;
    for (int it = bid * NTHR + tid; it < (CH / RUN) * NFC; it += G * NTHR) {
        const int fc = it % NFC, t0 = (it / NFC) * RUN, f = fc * 8;
        f32x4 wg[3][2], wv[3][2], bg[2], bv[2];
#pragma unroll
        for (int k = 0; k < 3; ++k) { wg[k][0] = *(const f32x4*)(cw + k * NUP + f); wg[k][1] = *(const f32x4*)(cw + k * NUP + f + 4); wv[k][0] = *(const f32x4*)(cw + k * NUP + DFF + f); wv[k][1] = *(const f32x4*)(cw + k * NUP + DFF + f + 4); }
        bg[0] = *(const f32x4*)(cb + f); bg[1] = *(const f32x4*)(cb + f + 4); bv[0] = *(const f32x4*)(cb + DFF + f); bv[1] = *(const f32x4*)(cb + DFF + f + 4);
        const f32x4 z4 = (f32x4){0.f, 0.f, 0.f, 0.f};
        f32x4 pg0 = z4, pg1 = z4, pv0 = z4, pv1 = z4, cg0, cg1, cv0, cv1;
        if ((t0 & (S - 1)) != 0) { pg8::unpack8(*(const u32x4*)(A + (size_t)(t0 - 1) * NUP + f), pg0, pg1); pg8::unpack8(*(const u32x4*)(A + (size_t)(t0 - 1) * NUP + DFF + f), pv0, pv1); }
        pg8::unpack8(*(const u32x4*)(A + (size_t)t0 * NUP + f), cg0, cg1); pg8::unpack8(*(const u32x4*)(A + (size_t)t0 * NUP + DFF + f), cv0, cv1);
#pragma unroll
        for (int i = 0; i < RUN; ++i) {
            const int t = t0 + i;
            f32x4 ng0 = z4, ng1 = z4, nv0 = z4, nv1 = z4;
            if (((t + 1) & (S - 1)) != 0) { pg8::unpack8(*(const u32x4*)(A + (size_t)(t + 1) * NUP + f), ng0, ng1); pg8::unpack8(*(const u32x4*)(A + (size_t)(t + 1) * NUP + DFF + f), nv0, nv1); }
            f32x4 g0 = pg0 * wg[0][0] + cg0 * wg[1][0] + ng0 * wg[2][0] + bg[0], g1 = pg1 * wg[0][1] + cg1 * wg[1][1] + ng1 * wg[2][1] + bg[1];
            const f32x4 v0 = pv0 * wv[0][0] + cv0 * wv[1][0] + nv0 * wv[2][0] + bv[0], v1 = pv1 * wv[0][1] + cv1 * wv[1][1] + nv1 * wv[2][1] + bv[1];
#pragma unroll
            for (int e = 0; e < 4; ++e) { g0[e] = pg8::gelu_tanh(g0[e]) * v0[e]; g1[e] = pg8::gelu_tanh(g1[e]) * v1[e]; }
            *(u32x4*)(FG + (size_t)t * DFF + f) = pg8::pack8(g0, g1);
            pg0 = cg0; pg1 = cg1; pv0 = cv0; pv1 = cv1; cg0 = ng0; cg1 = ng1; cv0 = nv0; cv1 = nv1;
        }
    }
}

__device__ __forceinline__ void p_convfix(const bf16* SB, bf16* FG, const float* cw, const float* cb, int S, int tid, int G, int bid) {
    constexpr int NFC = DFF / 8, NB = CH / 64;
    for (int it = bid * NTHR + tid; it < NB * 2 * NFC; it += G * NTHR) {
        const int fc = it % NFC, r2 = it / NFC, which = r2 & 1, b = r2 >> 1, f = fc * 8, t = b * 64 + (which ? 63 : 0);
        const f32x4 z4 = (f32x4){0.f, 0.f, 0.f, 0.f};
        f32x4 pg0 = z4, pg1 = z4, pv0 = z4, pv1 = z4, cg0, cg1, cv0, cv1, ng0 = z4, ng1 = z4, nv0 = z4, nv1 = z4;
        const bf16* bp = SB + (size_t)b * 4 * NUP + f;
        if (which == 0) {
            if ((t & (S - 1)) != 0) { pg8::unpack8(*(const u32x4*)(bp - NUP), pg0, pg1); pg8::unpack8(*(const u32x4*)(bp - NUP + DFF), pv0, pv1); }
            pg8::unpack8(*(const u32x4*)bp, cg0, cg1); pg8::unpack8(*(const u32x4*)(bp + DFF), cv0, cv1);
            pg8::unpack8(*(const u32x4*)(bp + NUP), ng0, ng1); pg8::unpack8(*(const u32x4*)(bp + NUP + DFF), nv0, nv1);
        } else {
            pg8::unpack8(*(const u32x4*)(bp + 2 * NUP), pg0, pg1); pg8::unpack8(*(const u32x4*)(bp + 2 * NUP + DFF), pv0, pv1);
            pg8::unpack8(*(const u32x4*)(bp + 3 * NUP), cg0, cg1); pg8::unpack8(*(const u32x4*)(bp + 3 * NUP + DFF), cv0, cv1);
            if (((t + 1) & (S - 1)) != 0) { pg8::unpack8(*(const u32x4*)(bp + 4 * NUP), ng0, ng1); pg8::unpack8(*(const u32x4*)(bp + 4 * NUP + DFF), nv0, nv1); }
        }
        f32x4 g0 = *(const f32x4*)(cb + f), g1 = *(const f32x4*)(cb + f + 4), v0 = *(const f32x4*)(cb + DFF + f), v1 = *(const f32x4*)(cb + DFF + f + 4);
        g0 = g0 + pg0 * *(const f32x4*)(cw + f) + cg0 * *(const f32x4*)(cw + NUP + f) + ng0 * *(const f32x4*)(cw + 2 * NUP + f);
        g1 = g1 + pg1 * *(const f32x4*)(cw + f + 4) + cg1 * *(const f32x4*)(cw + NUP + f + 4) + ng1 * *(const f32x4*)(cw + 2 * NUP + f + 4);
        v0 = v0 + pv0 * *(const f32x4*)(cw + DFF + f) + cv0 * *(const f32x4*)(cw + NUP + DFF + f) + nv0 * *(const f32x4*)(cw + 2 * NUP + DFF + f);
        v1 = v1 + pv1 * *(const f32x4*)(cw + DFF + f + 4) + cv1 * *(const f32x4*)(cw + NUP + DFF + f + 4) + nv1 * *(const f32x4*)(cw + 2 * NUP + DFF + f + 4);
#pragma unroll
        for (int e = 0; e < 4; ++e) { g0[e] = pg8::gelu_tanh(g0[e]) * v0[e]; g1[e] = pg8::gelu_tanh(g1[e]) * v1[e]; }
        *(u32x4*)(FG + (size_t)t * DFF + f) = pg8::pack8(g0, g1);
    }
}
#define XB_TMO      128
#define XB_XCNT(j)  (256  + 64 * (j))
#define XB_XSUB(j)  (1280 + 64 * (j))
#define XB_XGEN(j)  (2304 + 64 * (j))
#define XB_TOP      3328
#define XB_TOPGEN   3392
#define XCD_BAR_WORDS 3456
#define XB_SPIN_CAP (1u << 18)

__device__ __forceinline__ unsigned xb_ld(unsigned* p)              { return __hip_atomic_load(p, __ATOMIC_RELAXED, __HIP_MEMORY_SCOPE_AGENT); }
__device__ __forceinline__ unsigned xb_add(unsigned* p, unsigned v) { return __hip_atomic_fetch_add(p, v, __ATOMIC_RELAXED, __HIP_MEMORY_SCOPE_AGENT); }
__device__ __forceinline__ unsigned xb_xcc_id() { return (unsigned)__builtin_amdgcn_s_getreg((3 << 11) | 20) & 0xFu; }
#define XB_SPIN(cond, bar) do { unsigned _sp = 0; while (cond) { __builtin_amdgcn_s_sleep(1); \
    if ((++_sp & 255u) == 0u) { if (xb_ld(&(bar)[XB_TMO])) break; if (_sp > XB_SPIN_CAP) { atomicAdd(&(bar)[XB_TMO], 1u); break; } } } } while (0)

struct XcdBarrier {
    unsigned* bar; unsigned x;
    volatile LAS unsigned* st;
};

__device__ __forceinline__ XcdBarrier xcd_barrier_post(unsigned* bar, volatile LAS unsigned* st, const int tid) {
    XcdBarrier b; b.bar = bar; b.x = xb_xcc_id(); b.st = st;
    if (tid == 0) (void)xb_add(&bar[XB_XCNT(b.x)], 1u);
    return b;
}
__device__ __forceinline__ void xcd_barrier_complete(unsigned* bar, unsigned x, unsigned& nloc, unsigned& nx) {
    const unsigned G = gridDim.x * gridDim.y * gridDim.z;
    unsigned sum, cnt, mine, sp = 0u;
    for (;;) {
        sum = 0u; cnt = 0u; mine = 0u;
#pragma unroll
        for (unsigned j = 0; j < 16; ++j) { const unsigned c = xb_ld(&bar[XB_XCNT(j)]); sum += c; cnt += (c > 0u) ? 1u : 0u; mine = (j == x) ? c : mine; }
        if (sum == G) break;
        __builtin_amdgcn_s_sleep(1);
        if ((++sp & 255u) == 0u) { if (xb_ld(&bar[XB_TMO])) break; if (sp > XB_SPIN_CAP) { atomicAdd(&bar[XB_TMO], 1u); break; } }
    }
    nloc = mine > 0u ? mine : 1u; nx = cnt > 0u ? cnt : 1u;
}

__device__ __forceinline__ void xcd_barrier(const XcdBarrier& b, const int tid) {
    asm volatile("s_waitcnt vmcnt(0)" ::: "memory");
    __syncthreads();
    if (tid == 0) {
        unsigned* bar = b.bar;
        __builtin_amdgcn_s_waitcnt(0);
        unsigned nloc = b.st[0], nx = b.st[1];
        if (nloc == 0u) { xcd_barrier_complete(bar, b.x, nloc, nx); b.st[0] = nloc; b.st[1] = nx; }
        const unsigned old = xb_add(&bar[XB_XSUB(b.x)], 1u);
        const unsigned gen = old / nloc;
        if (old + 1u == (gen + 1u) * nloc) {
            __builtin_amdgcn_fence(__ATOMIC_RELEASE, "agent");
            asm volatile("s_waitcnt vmcnt(0)" ::: "memory");
            const unsigned og = xb_add(&bar[XB_TOP], 1u);
            const unsigned tg = og / nx;
            if (og + 1u == (tg + 1u) * nx) xb_add(&bar[XB_TOPGEN], 1u);
            else XB_SPIN(xb_ld(&bar[XB_TOPGEN]) == tg, bar);
            __builtin_amdgcn_fence(__ATOMIC_ACQUIRE, "agent");
            xb_add(&bar[XB_XGEN(b.x)], 1u);
            asm volatile("s_waitcnt vmcnt(0)" ::: "memory");
        } else {
            XB_SPIN(xb_ld(&bar[XB_XGEN(b.x)]) == gen, bar);
            __builtin_amdgcn_fence(__ATOMIC_ACQUIRE, "agent");
            asm volatile("s_waitcnt vmcnt(0)" ::: "memory");
        }
    }
    __syncthreads();
}


__global__ void __launch_bounds__(NTHR, 2) fwd_kernel(Args a_in) {
    extern __shared__ __attribute__((aligned(16))) unsigned char lds_raw[];
    LAS unsigned char* lds = (LAS unsigned char*)lds_raw;
    cg::grid_group grid = cg::this_grid();
    const int ph_lo = a_in.ph_lo, ph_hi = a_in.ph_hi;
    volatile LAS unsigned* xst = (volatile LAS unsigned*)(lds + LDS_BYTES - 16);
    if (threadIdx.x < 2) xst[threadIdx.x] = 0u;
    __syncthreads();
    const unsigned xcc = xcd_barrier_post((unsigned*)(a_in.ws + WS_BAR), xst, (int)threadIdx.x).x;
    for (int ph = ph_lo; ph < ph_hi; ++ph) {
#if defined(__HIP_DEVICE_COMPILE__)
        typedef const __attribute__((address_space(4))) unsigned long long* cu64p4;
        cu64p4 ap = (cu64p4)__builtin_amdgcn_kernarg_segment_ptr();
        asm volatile("" : "+s"(ap));
        Args a;
#pragma unroll
        for (int i = 0; i < 17; ++i) a.in[i] = (const float*)(const __attribute__((address_space(1))) float*)ap[i];
        a.out = (float*)(__attribute__((address_space(1))) float*)ap[17]; a.ws = (unsigned char*)(__attribute__((address_space(1))) unsigned char*)ap[18]; a.ph_lo = ph_lo; a.ph_hi = ph_hi;
#else
        const Args a = a_in;
#endif
        int tid = threadIdx.x, G = gridDim.x, bid = blockIdx.x;
        asm volatile("" : "+v"(tid)); asm volatile("" : "+s"(G)); asm volatile("" : "+s"(bid));
        unsigned char* ws = a.ws;
        bf16* Wb = (bf16*)(ws + WS_W);
        bf16* QKV = (bf16*)(ws + WS_R1); bf16* U = QKV + (size_t)CH * 2304; bf16* GV = U + (size_t)CH * 1024; bf16* GT = GV + (size_t)CH * 1024;
        bf16* AF = (bf16*)(ws + WS_R1);
        bf16* MG = GV;
        bf16* OUTG = (bf16*)(ws + WS_R2); bf16* OA = OUTG + (size_t)3 * CH * 256; float* LSE = (float*)(OA + (size_t)CH * 256);
        bf16* FG = (bf16*)(ws + WS_R2);
        bf16* XB = (bf16*)(ws + WS_XB); float* SS = (float*)(ws + WS_SS); float* SSV = (float*)(ws + WS_SSV);
        if (ph < NP0) p0_weights(a, lds, tid, G, bid);
        else {
            const int chunk = (ph - NP0) / PH_PER_CHUNK, sub = (ph - NP0) % PH_PER_CHUNK;
            const int S = chunk == 0 ? 8192 : 2048;
            if (sub == 0) { p0x(a, chunk, tid, G, bid); if (PROBE_KIND == 10) p0x(a, chunk, tid, G, bid); }
            else if (sub == PH_PER_CHUNK - 1) pfinal(a, chunk, tid, G, bid);
            else {
                const int l = (sub - 1) / KPL, ki = (sub - 1) % KPL, k = (KPL == 9 && ki > PROBE_DUPK) ? ki - 1 : ki; const bool dup = (KPL == 9 && ki == PROBE_DUPK + 1);
                const bf16* wl = Wb + (size_t)l * W_LAYER;
                float* X = a.out + (size_t)chunk * CH * DM;
                if (k == 0 && !(SKIPMASK & 1)) {
                    pg8::Gemm g{XB, wl + OFF_IN, CH, NIN, DM}; pg8::StaticOrder So; So.init(CH, NIN, G, bid);
                    pg8::EpiIn E{QKV, U, GV, GT, SS, SSV};
                    pg8::gemm_phase<pg8::EpiIn, pg8::StaticOrder, true, true>(lds, g, So, E, tid);
                } else if (k == 1 && !(SKIPMASK & 2)) {
                    constexpr int NATT = 3 * (CH / 64), NSGW = (CH / 128) * 16;
                    if (!(SKIPMASK & 1024) && !(dup && PROBE_KIND == 8)) attn_phase(QKV, OUTG, LSE, (const float*)(ws + WS_BT), lds, S, tid, G, bid);
                    if (!(SKIPMASK & 2048) && (!dup || PROBE_KIND == 8)) {
                        bf16* UO = dup ? (bf16*)(ws + WS_R2 + (size_t)CH * 2096) : U;
                        const int wave = __builtin_amdgcn_readfirstlane(tid >> 6);
                        for (int wu = bid * 8 + wave; wu < NSGW; wu += G * 8) sg_wave_unit(U, UO, GV, SSV, wl + OFF_WS, a.in[5] + l * 1024, a.in[7] + l * 1024, lds + wave * SG_WLDS, wu, tid & 63);
                    }
                } else if (k == 2 && !(SKIPMASK & 4)) p_merge(OUTG, LSE, OA, tid, G, bid);
                else if (k == 3 && !(SKIPMASK & 8)) {
                    if (!(SKIPMASK & 4096)) { int kpa = 256; asm volatile("" : "+s"(kpa)); pg8::Gemm g{OA, wl + OFF_PA, CH, DM, kpa}; pg8::StaticOrder So; So.init(CH, DM, G, bid);
                      pg8::EpiGate<0> E{MG, GT, 0};
                      pg8::gemm_phase<pg8::EpiGate<0>, pg8::StaticOrder, false, true>(lds, g, So, E, tid); }
                    if (!(SKIPMASK & 8192)) { pg8::Gemm g{U, wl + OFF_PB, CH, DM, DM}; pg8::StaticOrder So; So.init(CH, DM, G, bid);
                      pg8::EpiGate<1> E{MG, GT, 1024};
                      pg8::gemm_phase<pg8::EpiGate<1>, pg8::StaticOrder, false, true>(lds, g, So, E, tid); }
                } else if (k == 4 && !(SKIPMASK & 16)) {
                    pg8::Gemm g{MG, wl + OFF_OUT, CH, DM, DM}; pg8::StaticOrder So; So.init(CH, DM, G, bid);
                    pg8::EpiRes E{dup ? QKV + (size_t)CH * 1024 : (bf16*)(ws + WS_XL), dup ? QKV : XB, dup ? SSV : SS};
                    pg8::gemm_phase<pg8::EpiRes, pg8::StaticOrder, false, true>(lds, g, So, E, tid);
                } else if (k == 5 && !(SKIPMASK & 32)) {
                    pg8::Gemm g{XB, wl + OFF_UP, CH, NUP, DM}; pg8::StaticOrder So; So.init(CH, NUP, G, bid);
                    pg8::EpiUpConv E{FG, (bf16*)(ws + WS_SB), SS, a.in[13] + (size_t)l * 3 * NUP, a.in[14] + (size_t)l * NUP};
                    pg8::gemm_phase<pg8::EpiUpConv, pg8::StaticOrder, true, true>(lds, g, So, E, tid);
                } else if (k == 6 && !(SKIPMASK & 64)) p_convfix((const bf16*)(ws + WS_SB), FG, a.in[13] + (size_t)l * 3 * NUP, a.in[14] + (size_t)l * NUP, S, tid, G, bid);
                else if (!(SKIPMASK & 128)) {
                    pg8::Gemm g{FG, wl + OFF_DN, CH, DM, DFF}; pg8::StaticOrder So; So.init(CH, DM, G, bid);
                    pg8::EpiRes E{dup ? QKV + (size_t)CH * 1024 : (bf16*)(ws + WS_XL), dup ? QKV : XB, dup ? SSV : SS};
                    pg8::gemm_phase<pg8::EpiRes, pg8::StaticOrder, false, true>(lds, g, So, E, tid);
                }
            }
        }
        if (ph + 1 < ph_hi) {
            if (ph == ph_lo) grid.sync();
            XcdBarrier xb; xb.bar = (unsigned*)(a.ws + WS_BAR); xb.x = xcc; xb.st = xst;
            xcd_barrier(xb, tid);
            if (PROBE_KIND == 100) xcd_barrier(xb, tid);
        }
    }
}

extern "C" void kernel_launch(void* const* d_in, const int* in_sizes, int n_in, void* d_out, int out_size, void* d_ws, size_t ws_size, hipStream_t stream) {
    static int grid = 0;
    if (grid == 0) {
        if (n_in != 17 || out_size != NTOK * DM || ws_size < WS_END) { fprintf(stderr, "kernel_launch: unexpected shapes: n_in %d out %d ws %zu (need %zu)\n", n_in, out_size, ws_size, (size_t)WS_END); grid = -1; return; }
        int dev = 0, cus = 0, per_cu = 0;
        (void)hipGetDevice(&dev); (void)hipDeviceGetAttribute(&cus, hipDeviceAttributeMultiprocessorCount, dev);
        if (hipFuncSetAttribute((const void*)fwd_kernel, hipFuncAttributeMaxDynamicSharedMemorySize, LDS_BYTES) != hipSuccess) { fprintf(stderr, "kernel_launch: hipFuncSetAttribute failed\n"); grid = -1; return; }
        if (hipOccupancyMaxActiveBlocksPerMultiprocessor(&per_cu, (const void*)fwd_kernel, NTHR, LDS_BYTES) != hipSuccess || per_cu < 1) { fprintf(stderr, "kernel_launch: occupancy query says %d\n", per_cu); per_cu = 1; }
        (void)hipGetLastError();
        grid = cus * per_cu;
        if (grid <= 0) grid = 256;
    }
    if (grid < 0) return;
    if (hipMemsetAsync((char*)d_ws + WS_BAR, 0, 65536, stream) != hipSuccess) { fprintf(stderr, "kernel_launch: memset failed\n"); return; }
    Args a{};
    for (int i = 0; i < 17; ++i) a.in[i] = (const float*)d_in[i];
    a.out = (float*)d_out; a.ws = (unsigned char*)d_ws;
#if ONE_LAUNCH
    a.ph_lo = 0; a.ph_hi = N_PHASES;
    void* args[] = {&a};
    hipError_t e = hipLaunchCooperativeKernel((const void*)fwd_kernel, dim3(grid), dim3(NTHR), args, LDS_BYTES, stream);
    if (e != hipSuccess) fprintf(stderr, "cooperative launch failed: %s (grid %d)\n", hipGetErrorString(e), grid);
#else
    for (int ph = 0; ph < N_PHASES; ++ph) {
        a.ph_lo = ph; a.ph_hi = ph + 1;
        hipLaunchKernelGGL(fwd_kernel, dim3(grid), dim3(NTHR), LDS_BYTES, stream, a);
    }
#endif
}
```

```cpp
#include <hip/hip_runtime.h>
#include <hip/hip_cooperative_groups.h>
#include <cstdio>
#include <cstdint>
namespace cg = cooperative_groups;

#ifndef ONE_LAUNCH
#define ONE_LAUNCH 1
#endif

namespace pg8 {
#define PG8_LAS __attribute__((address_space(3)))
typedef unsigned short bf16_t;
typedef short bf16x8 __attribute__((ext_vector_type(8)));
typedef float f32x4 __attribute__((ext_vector_type(4)));
typedef unsigned u32x4 __attribute__((ext_vector_type(4)));
constexpr int BM = 256, BK = 64, HALF = 128, HTB = HALF * BK * 2  , STAGE_BYTES = 8 * HTB, NXCD = 8, WGM = 8;

__host__ __device__ __forceinline__ int lds_byte(int r, int c) { const int st = (r >> 4) * 2 + (c >> 5), rr = r & 15, cc = c & 31, ob = rr * 64 + cc * 2; return st * 1024 + (ob ^ (((ob >> 9) & 1) << 5)); }
__host__ __device__ __forceinline__ void stage_rc(int b, int& R, int& C) { const int st = b / 1024, sb = b % 1024, swz = sb ^ (((sb >> 9) & 1) << 5); R = (st >> 1) * 16 + swz / 64; C = (st & 1) * 32 + (swz % 64) / 2; }
__host__ __device__ __forceinline__ int perm32(int rho) { const int n = rho >> 4, i = rho & 15; return 8 * (i >> 2) + 4 * n + (i & 3); }

struct Unit { int pm, pn; };
struct Gemm { const bf16_t* A; const bf16_t* Bt; int M, N, K; };

struct StaticOrder {
    int nM, nN, nwg, G, c;
    __host__ __device__ void init(int M, int N, int G_, int c_) { nM = M / BM; nN = N / BM; nwg = nM * nN; G = G_; c = c_; }
    __host__ __device__ bool next(int i, Unit& u) const {
        const long L = (long)i * G + c; if (L >= nwg) return false;
        int wgid = (int)L; { const int q = nwg / NXCD, r = nwg % NXCD, xcd = wgid % NXCD, off = wgid / NXCD; wgid = (xcd < r ? xcd * (q + 1) : r * (q + 1) + (xcd - r) * q) + off; }
        const int nig = WGM * nN, gid = wgid / nig, fm = gid * WGM, gsz = (nM - fm) < WGM ? (nM - fm) : WGM;
        u.pm = fm + ((wgid % nig) % gsz); u.pn = (wgid % nig) / gsz; return true;
    }
    __device__ __forceinline__ void a_ready(const Unit&) const {}
    __device__ __forceinline__ void done(const Unit&) const {}
};

__device__ __forceinline__ unsigned cvt_pk_bf16(float lo, float hi) { unsigned r; asm volatile("v_cvt_pk_bf16_f32 %0, %1, %2" : "=v"(r) : "v"(lo), "v"(hi)); return r; }

__device__ __forceinline__ float fast_sigmoid(float x) { return __builtin_amdgcn_rcpf(1.0f + __builtin_amdgcn_exp2f(-1.4426950408889634f * x)); }
__device__ __forceinline__ float gelu_tanh(float x) {
    const float y = x * (1.0f + 0.044715f * x * x) * (2.0f * 0.7978845608028654f);
    return x * __builtin_amdgcn_rcpf(1.0f + __builtin_amdgcn_exp2f(-1.4426950408889634f * y));
}
__device__ __forceinline__ float bf2f(unsigned short b) { return __uint_as_float(((unsigned)b) << 16); }
__device__ __forceinline__ u32x4 pack8(const f32x4 a, const f32x4 b) { u32x4 w; w.x = cvt_pk_bf16(a[0], a[1]); w.y = cvt_pk_bf16(a[2], a[3]); w.z = cvt_pk_bf16(b[0], b[1]); w.w = cvt_pk_bf16(b[2], b[3]); return w; }
__device__ __forceinline__ void unpack8(const u32x4 w, f32x4& a, f32x4& b) {
    a[0] = __uint_as_float(w.x << 16); a[1] = __uint_as_float(w.x & 0xffff0000u); a[2] = __uint_as_float(w.y << 16); a[3] = __uint_as_float(w.y & 0xffff0000u);
    b[0] = __uint_as_float(w.z << 16); b[1] = __uint_as_float(w.z & 0xffff0000u); b[2] = __uint_as_float(w.w << 16); b[3] = __uint_as_float(w.w & 0xffff0000u);
}
__device__ __forceinline__ float row_rs(const float* ss, int row) {
    const f32x4* sp = (const f32x4*)(ss + (size_t)row * 16);
    const f32x4 s = (sp[0] + sp[1]) + (sp[2] + sp[3]);
    return rsqrtf(((s[0] + s[1]) + (s[2] + s[3])) * (1.0f / 1024.0f) + 1e-6f);
}

__device__ __forceinline__ void rows_rs(const float* ss, int row0, int fq, float (&rsv)[2][4]) {
    f32x4 part[2][4];
#pragma unroll
    for (int ai = 0; ai < 2; ++ai)
#pragma unroll
        for (int m = 0; m < 4; ++m) part[ai][m] = *(const f32x4*)(ss + (size_t)(row0 + ai * HALF + m * 16) * 16 + fq * 4);
#pragma unroll
    for (int ai = 0; ai < 2; ++ai)
#pragma unroll
        for (int m = 0; m < 4; ++m) { float t = (part[ai][m][0] + part[ai][m][1]) + (part[ai][m][2] + part[ai][m][3]); t += __shfl_xor(t, 16); t += __shfl_xor(t, 32); rsv[ai][m] = rsqrtf(t * (1.0f / 1024.0f) + 1e-6f); }
}

struct EpiIn {
    static constexpr bool PERM = true, AFTER_DRAIN = false;
    bf16_t* QKV; bf16_t* U; bf16_t* GV; bf16_t* G; const float* ss; float* ssv;
    __device__ __forceinline__ void operator()(const f32x4 (&acc)[2][2][4][2], const Unit& u, int wr, int wc, int fr, int fq) const {
        const int pn = u.pn;
        float rsv[2][4]; rows_rs(ss, u.pm * BM + wr * 64 + fr, fq, rsv);
#pragma unroll
        for (int ai = 0; ai < 2; ++ai)
#pragma unroll
            for (int m = 0; m < 4; ++m) {
                const int row = u.pm * BM + ai * HALF + wr * 64 + m * 16 + fr;
                const float rs = rsv[ai][m];
                float q = 0.f;
#pragma unroll
                for (int bj = 0; bj < 2; ++bj) {
                    const int col = pn * BM + bj * HALF + wc * 32 + 8 * fq;
                    f32x4 v0 = acc[ai][bj][m][0] * rs, v1 = acc[ai][bj][m][1] * rs;
                    bf16_t* dst;
                    if (pn < 9) { if (pn < 3) { v0 = v0 * (0.125f * 1.4426950408889634f); v1 = v1 * (0.125f * 1.4426950408889634f); }     dst = QKV + (size_t)row * 2304 + col; }
                    else if (pn < 17) {
#pragma unroll
                        for (int e = 0; e < 4; ++e) { v0[e] = gelu_tanh(v0[e]); v1[e] = gelu_tanh(v1[e]); }
                        if (pn < 13) dst = U + (size_t)row * 1024 + (col - 2304);
                        else { dst = GV + (size_t)row * 1024 + (col - 3328);
#pragma unroll
                            for (int e = 0; e < 4; ++e) q += v0[e] * v0[e] + v1[e] * v1[e]; }
                    } else {
#pragma unroll
                        for (int e = 0; e < 4; ++e) { v0[e] = fast_sigmoid(v0[e]); v1[e] = fast_sigmoid(v1[e]); }
                        dst = G + (size_t)row * 2048 + (col - 4352);
                    }
                    *(u32x4*)dst = pack8(v0, v1);
                }
                if (pn >= 13 && pn < 17) { q += __shfl_xor(q, 16); q += __shfl_xor(q, 32); if (fq == 0) ssv[(size_t)row * 16 + (pn - 13) * 4 + wc] = q; }
                asm volatile("" ::: "memory");
            }
    }
};
template <int MODE> struct EpiGate {
    static constexpr bool PERM = true, AFTER_DRAIN = false;
    bf16_t* O; const bf16_t* G; int goff;
    __device__ __forceinline__ void operator()(const f32x4 (&acc)[2][2][4][2], const Unit& u, int wr, int wc, int fr, int fq) const {
#pragma unroll
        for (int ai = 0; ai < 2; ++ai) {
            u32x4 gw[4][2], pw[4][2];
#pragma unroll
            for (int m = 0; m < 4; ++m)
#pragma unroll
                for (int bj = 0; bj < 2; ++bj) {
                    const int row = u.pm * BM + ai * HALF + wr * 64 + m * 16 + fr, col = u.pn * BM + bj * HALF + wc * 32 + 8 * fq;
                    gw[m][bj] = *(const u32x4*)(G + (size_t)row * 2048 + goff + col);
                    if (MODE == 1) pw[m][bj] = *(const u32x4*)(O + (size_t)row * 1024 + col);
                }
#pragma unroll
            for (int m = 0; m < 4; ++m)
#pragma unroll
                for (int bj = 0; bj < 2; ++bj) {
                    const int row = u.pm * BM + ai * HALF + wr * 64 + m * 16 + fr, col = u.pn * BM + bj * HALF + wc * 32 + 8 * fq;
                    f32x4 g0, g1; unpack8(gw[m][bj], g0, g1);
                    f32x4 v0 = acc[ai][bj][m][0] * g0, v1 = acc[ai][bj][m][1] * g1;
                    if (MODE == 1) { f32x4 p0, p1; unpack8(pw[m][bj], p0, p1); v0 = v0 + p0; v1 = v1 + p1; }
                    *(u32x4*)(O + (size_t)row * 1024 + col) = pack8(v0, v1);
                }
            asm volatile("" ::: "memory");
        }
    }
};
struct EpiRes {
    static constexpr bool PERM = true, AFTER_DRAIN = false;
    bf16_t* XL; bf16_t* XB; float* ss;
    __device__ __forceinline__ void operator()(const f32x4 (&acc)[2][2][4][2], const Unit& u, int wr, int wc, int fr, int fq) const {
#pragma unroll
        for (int ai = 0; ai < 2; ++ai)
#pragma unroll
        for (int mp = 0; mp < 2; ++mp) {
            u32x4 hv[2][2], lv[2][2];
#pragma unroll
            for (int mi = 0; mi < 2; ++mi)
#pragma unroll
                for (int bj = 0; bj < 2; ++bj) {
                    const size_t off = (size_t)(u.pm * BM + ai * HALF + wr * 64 + (2 * mp + mi) * 16 + fr) * 1024 + u.pn * BM + bj * HALF + wc * 32 + 8 * fq;
                    hv[mi][bj] = *(const u32x4*)(XB + off); lv[mi][bj] = *(const u32x4*)(XL + off);
                }
#pragma unroll
            for (int mi = 0; mi < 2; ++mi) {
                const int m = 2 * mp + mi, row = u.pm * BM + ai * HALF + wr * 64 + m * 16 + fr;
                float q = 0.f;
#pragma unroll
                for (int bj = 0; bj < 2; ++bj) {
                    const size_t off = (size_t)row * 1024 + u.pn * BM + bj * HALF + wc * 32 + 8 * fq;
                    f32x4 h0, h1, l0, l1; unpack8(hv[mi][bj], h0, h1); unpack8(lv[mi][bj], l0, l1);
                    const f32x4 x0 = (h0 + l0) + acc[ai][bj][m][0], x1 = (h1 + l1) + acc[ai][bj][m][1];
                    const u32x4 hw = pack8(x0, x1);
                    unpack8(hw, h0, h1);
                    *(u32x4*)(XB + off) = hw; *(u32x4*)(XL + off) = pack8(x0 - h0, x1 - h1);
#pragma unroll
                    for (int e = 0; e < 4; ++e) q += x0[e] * x0[e] + x1[e] * x1[e];
                }
                q += __shfl_xor(q, 16); q += __shfl_xor(q, 32);
                if (fq == 0) ss[(size_t)row * 16 + u.pn * 4 + wc] = q;
            }
            asm volatile("" ::: "memory");
        }
    }
};
struct EpiUp {
    static constexpr bool PERM = true, AFTER_DRAIN = false;
    bf16_t* A; const float* ss;
    __device__ __forceinline__ void operator()(const f32x4 (&acc)[2][2][4][2], const Unit& u, int wr, int wc, int fr, int fq) const {
        float rsv[2][4]; rows_rs(ss, u.pm * BM + wr * 64 + fr, fq, rsv);
#pragma unroll
        for (int ai = 0; ai < 2; ++ai)
#pragma unroll
            for (int m = 0; m < 4; ++m) {
                const int row = u.pm * BM + ai * HALF + wr * 64 + m * 16 + fr;
                const float rs = rsv[ai][m];
#pragma unroll
                for (int bj = 0; bj < 2; ++bj) {
                    const int col = u.pn * BM + bj * HALF + wc * 32 + 8 * fq;
                    *(u32x4*)(A + (size_t)row * 5632 + col) = pack8(acc[ai][bj][m][0] * rs, acc[ai][bj][m][1] * rs);
                }
                asm volatile("" ::: "memory");
            }
    }
};

__device__ __forceinline__ float dpp_prev(float x) { return __int_as_float(__builtin_amdgcn_update_dpp(0, __float_as_int(x), 0x121, 0xf, 0xf, false)); }
__device__ __forceinline__ float dpp_next(float x) { return __int_as_float(__builtin_amdgcn_update_dpp(0, __float_as_int(x), 0x12F, 0xf, 0xf, false)); }
__device__ __forceinline__ f32x4 rot_prev(const f32x4 v) { f32x4 r; r[0] = dpp_prev(v[0]); r[1] = dpp_prev(v[1]); r[2] = dpp_prev(v[2]); r[3] = dpp_prev(v[3]); return r; }
__device__ __forceinline__ f32x4 rot_next(const f32x4 v) { f32x4 r; r[0] = dpp_next(v[0]); r[1] = dpp_next(v[1]); r[2] = dpp_next(v[2]); r[3] = dpp_next(v[3]); return r; }
struct EpiUpConv {
    static constexpr bool PERM = true, AFTER_DRAIN = false;
    bf16_t* FG; bf16_t* SB; const float* ss; const float* cw; const float* cb;
    __device__ __forceinline__ void operator()(const f32x4 (&acc_)[2][2][4][2], const Unit& u, int wr, int wc, int fr, int fq) const {
        f32x4 (&acc)[2][2][4][2] = const_cast<f32x4 (&)[2][2][4][2]>(acc_);
        float rsv[2][4]; rows_rs(ss, u.pm * BM + wr * 64 + fr, fq, rsv);
        const int f0 = u.pn * 128 + wc * 32 + 8 * fq;
        const bool first = fr == 0, last = fr == 15;
#pragma unroll
        for (int ai = 0; ai < 2; ++ai) {
#pragma unroll
            for (int m = 0; m < 4; ++m)
#pragma unroll
                for (int h = 0; h < 2; ++h) { acc[ai][h][m][0] = acc[ai][h][m][0] * rsv[ai][m]; acc[ai][h][m][1] = acc[ai][h][m][1] * rsv[ai][m]; }
            const int blk = (u.pm * BM + ai * HALF + wr * 64) >> 6;
            if (fr <= 1) { bf16_t* sp = SB + ((size_t)blk * 4 + fr) * 5632 + f0;
                *(u32x4*)sp = pack8(acc[ai][0][0][0], acc[ai][0][0][1]); *(u32x4*)(sp + 2816) = pack8(acc[ai][1][0][0], acc[ai][1][0][1]); }
            if (fr >= 14) { bf16_t* sp = SB + ((size_t)blk * 4 + (fr - 12)) * 5632 + f0;
                *(u32x4*)sp = pack8(acc[ai][0][3][0], acc[ai][0][3][1]); *(u32x4*)(sp + 2816) = pack8(acc[ai][1][3][0], acc[ai][1][3][1]); }
        }
#pragma unroll
        for (int n = 0; n < 2; ++n) {
            f32x4 w[2][4];
#pragma unroll
            for (int h = 0; h < 2; ++h) {
#pragma unroll
                for (int k = 0; k < 3; ++k) w[h][k] = *(const f32x4*)(cw + k * 5632 + h * 2816 + f0 + 4 * n);
                w[h][3] = *(const f32x4*)(cb + h * 2816 + f0 + 4 * n);
            }
#pragma unroll
            for (int ai = 0; ai < 2; ++ai) {
#pragma unroll
                for (int m = 0; m < 4; ++m) {
                    const int row = u.pm * BM + ai * HALF + wr * 64 + m * 16 + fr;
                    f32x4 cv[2];
#pragma unroll
                    for (int h = 0; h < 2; ++h) {
                        const f32x4 cur = acc[ai][h][m][n];
                        f32x4 pv = rot_prev(cur), nx = rot_next(cur);
                        if (m > 0) { const f32x4 pw = rot_prev(acc[ai][h][m - 1][n]);
#pragma unroll
                            for (int e = 0; e < 4; ++e) pv[e] = first ? pw[e] : pv[e]; }
                        if (m < 3) { const f32x4 nw = rot_next(acc[ai][h][m + 1][n]);
#pragma unroll
                            for (int e = 0; e < 4; ++e) nx[e] = last ? nw[e] : nx[e]; }
                        cv[h] = pv * w[h][0] + cur * w[h][1] + nx * w[h][2] + w[h][3];
                    }
                    f32x4 o;
#pragma unroll
                    for (int e = 0; e < 4; ++e) o[e] = gelu_tanh(cv[0][e]) * cv[1][e];
                    const bool brow = (m == 0 && first) || (m == 3 && last);
                    if (!brow) { typedef unsigned u32x2e __attribute__((ext_vector_type(2))); u32x2e ow; ow.x = cvt_pk_bf16(o[0], o[1]); ow.y = cvt_pk_bf16(o[2], o[3]); *(u32x2e*)(FG + (size_t)row * 2816 + f0 + 4 * n) = ow; }
                }
                asm volatile("" ::: "memory");
            }
        }
    }
};

template <class Epi, class Sched, bool ALIGN_EPI = false, bool SP2 = false>
__device__ __forceinline__ void gemm_phase(PG8_LAS unsigned char* lds, const Gemm g, const Sched& S, const Epi& E, const int tid) {
    const int wid = __builtin_amdgcn_readfirstlane(tid >> 6), lane = tid & 63, wr = wid >> 2, wc = wid & 3, fr = lane & 15, fq = lane >> 4;
    const int K = g.K, nt = K / BK;
    unsigned voffA[2], voffB[2];
#pragma unroll
    for (int i = 0; i < 2; ++i) { int R, C; stage_rc(tid * 16 + i * 8192, R, C); const int Rb = Epi::PERM ? ((R & ~31) + perm32(R & 31)) : R;
        voffA[i] = (unsigned)(R * K + C) * 2u; voffB[i] = (unsigned)(Rb * K + C) * 2u; }
    const size_t kstep = (size_t)(BK * 2);
    const size_t hstep = (size_t)HALF * K * 2;
    const size_t tstep = 2 * hstep;
    const unsigned ldsw = (unsigned)wid * 1024u;
    const int aoff = lds_byte(wr * 64 + fr, fq * 8), boff = lds_byte(wc * 32 + fr, fq * 8);
#define PG8_SA(b, h) (((b) * 2 + (h)) * HTB)
#define PG8_SB(b, h) ((4 + (b) * 2 + (h)) * HTB)
#define PG8_STAGE(bufoff, gbase, voff) do { _Pragma("unroll") for (int _i = 0; _i < 2; ++_i) \
        __builtin_amdgcn_global_load_lds((const unsigned*)((const char*)(gbase) + (voff)[_i]), (PG8_LAS unsigned*)(lds + (bufoff) + ldsw + _i * 8192), 16, 0, 0); } while (0)
#define PG8_LDA(dst, b, h) do { _Pragma("unroll") for (int m = 0; m < 4; ++m) _Pragma("unroll") for (int k = 0; k < 2; ++k) dst[m][k] = *(const PG8_LAS bf16x8*)(lds + PG8_SA(b, h) + aoff + m * 2048 + k * 1024); } while (0)
#define PG8_LDB(dst, b, h) do { _Pragma("unroll") for (int n = 0; n < 2; ++n) _Pragma("unroll") for (int k = 0; k < 2; ++k) dst[n][k] = *(const PG8_LAS bf16x8*)(lds + PG8_SB(b, h) + boff + n * 2048 + k * 1024); } while (0)
#define PG8_MMA(ai, bj, At, Bt) do { __builtin_amdgcn_s_setprio(1); _Pragma("unroll") for (int m = 0; m < 4; ++m) _Pragma("unroll") for (int n = 0; n < 2; ++n) _Pragma("unroll") for (int k = 0; k < 2; ++k) \
        acc[ai][bj][m][n] = __builtin_amdgcn_mfma_f32_16x16x32_bf16(Bt[n][k], At[m][k], acc[ai][bj][m][n], 0, 0, 0); __builtin_amdgcn_s_setprio(0); } while (0)
#define PG8_WAIT_V(n) asm volatile("s_waitcnt vmcnt(" #n ")" ::: "memory")
#define PG8_WAIT_L(n) asm volatile("s_waitcnt lgkmcnt(" #n ")" ::: "memory")
#define PG8_BAR __builtin_amdgcn_s_barrier()
#define PG8_SCHED __builtin_amdgcn_sched_barrier(0)
    Unit cur, nxt; int ui = 0;
    if (!S.next(0, cur)) return;
    f32x4 acc[2][2][4][2];
#pragma unroll
    for (int a = 0; a < 2; ++a)
#pragma unroll
        for (int b = 0; b < 2; ++b)
#pragma unroll
            for (int m = 0; m < 4; ++m)
#pragma unroll
                for (int n = 0; n < 2; ++n) acc[a][b][m][n] = (f32x4){0.f, 0.f, 0.f, 0.f};
    bf16x8 At[4][2], B0[2][2], B1[2][2];
    const char* cA = (const char*)g.A + (size_t)cur.pm * tstep; const char* cB = (const char*)g.Bt + (size_t)cur.pn * tstep;
    S.a_ready(cur);
    if constexpr (SP2) {
        PG8_STAGE(PG8_SB(0, 0), cB, voffB); PG8_STAGE(PG8_SB(0, 1), cB + hstep, voffB); PG8_STAGE(PG8_SA(0, 0), cA, voffA); PG8_STAGE(PG8_SA(0, 1), cA + hstep, voffA);
        if (wr == 1) PG8_BAR;
        PG8_WAIT_V(2); PG8_BAR;
        PG8_STAGE(PG8_SB(1, 0), cB + kstep, voffB); PG8_STAGE(PG8_SA(1, 0), cA + kstep, voffA); PG8_STAGE(PG8_SB(1, 1), cB + hstep + kstep, voffB);
        PG8_WAIT_V(6); PG8_BAR;
    } else {
        PG8_STAGE(PG8_SB(0, 0), cB, voffB); PG8_STAGE(PG8_SA(0, 0), cA, voffA); PG8_STAGE(PG8_SB(0, 1), cB + hstep, voffB); PG8_STAGE(PG8_SA(0, 1), cA + hstep, voffA);
        if (wr == 1) PG8_BAR;
        PG8_WAIT_V(4); PG8_BAR;
        PG8_STAGE(PG8_SB(1, 0), cB + kstep, voffB); PG8_STAGE(PG8_SA(1, 0), cA + kstep, voffA); PG8_STAGE(PG8_SB(1, 1), cB + hstep + kstep, voffB);
        PG8_WAIT_V(6); PG8_BAR;
    }
    for (;;) {
        const bool has_next = S.next(ui + 1, nxt);
        const char* nA = has_next ? (const char*)g.A + (size_t)nxt.pm * tstep : cA; const char* nB = has_next ? (const char*)g.Bt + (size_t)nxt.pn * tstep : cB;
        for (int t = 0; t < nt; t += 2) {
            const bool last = (t == nt - 2);
            const char* a1 = cA + (size_t)(t + 1) * kstep;
            const char* a2 = last ? nA : cA + (size_t)(t + 2) * kstep; const char* b2 = last ? nB : cB + (size_t)(t + 2) * kstep;
            const char* a3 = a2 + kstep; const char* b3 = b2 + kstep;
            if (last && has_next) S.a_ready(nxt);
            if constexpr (SP2) {
            PG8_LDB(B0, 0, 0); PG8_LDB(B1, 0, 1); PG8_SCHED; PG8_LDA(At, 0, 0); PG8_STAGE(PG8_SA(1, 1), a1 + hstep, voffA);
            PG8_WAIT_V(8); PG8_WAIT_L(0); PG8_BAR; PG8_MMA(0, 0, At, B0); PG8_MMA(0, 1, At, B1); PG8_BAR; PG8_SCHED;
            PG8_LDA(At, 0, 1); PG8_STAGE(PG8_SB(0, 0), b2, voffB); PG8_STAGE(PG8_SB(0, 1), b2 + hstep, voffB); PG8_STAGE(PG8_SA(0, 0), a2, voffA);
            PG8_WAIT_V(8); PG8_WAIT_L(0); PG8_BAR; PG8_MMA(1, 0, At, B0); PG8_MMA(1, 1, At, B1); PG8_BAR; PG8_SCHED;
            PG8_LDB(B0, 1, 0); PG8_LDB(B1, 1, 1); PG8_SCHED; PG8_LDA(At, 1, 0); PG8_STAGE(PG8_SA(0, 1), a2 + hstep, voffA);
            PG8_WAIT_V(8); PG8_WAIT_L(0); PG8_BAR; PG8_MMA(0, 0, At, B0); PG8_MMA(0, 1, At, B1); PG8_BAR; PG8_SCHED;
            PG8_LDA(At, 1, 1); PG8_STAGE(PG8_SB(1, 0), b3, voffB); PG8_STAGE(PG8_SB(1, 1), b3 + hstep, voffB); PG8_STAGE(PG8_SA(1, 0), a3, voffA);
            PG8_WAIT_V(8); PG8_WAIT_L(0); PG8_BAR; PG8_MMA(1, 0, At, B0); PG8_MMA(1, 1, At, B1); PG8_BAR; PG8_SCHED;
            } else {
            PG8_LDB(B0, 0, 0); PG8_SCHED; PG8_LDA(At, 0, 0); PG8_STAGE(PG8_SA(1, 1), a1 + hstep, voffA);
            PG8_WAIT_L(8); PG8_BAR; PG8_WAIT_L(0); PG8_MMA(0, 0, At, B0); PG8_BAR; PG8_SCHED;
            PG8_LDB(B1, 0, 1); PG8_STAGE(PG8_SB(0, 0), b2, voffB);
            PG8_BAR; PG8_WAIT_L(0); PG8_MMA(0, 1, At, B1); PG8_BAR;
            PG8_LDA(At, 0, 1); PG8_STAGE(PG8_SA(0, 0), a2, voffA);
            PG8_BAR; PG8_WAIT_L(0); PG8_MMA(1, 0, At, B0); PG8_BAR; PG8_SCHED;
            PG8_STAGE(PG8_SB(0, 1), b2 + hstep, voffB);
            PG8_WAIT_V(6); PG8_BAR; PG8_MMA(1, 1, At, B1); PG8_BAR;
            PG8_LDB(B0, 1, 0); PG8_SCHED; PG8_LDA(At, 1, 0); PG8_STAGE(PG8_SA(0, 1), a2 + hstep, voffA);
            PG8_WAIT_L(8); PG8_BAR; PG8_WAIT_L(0); PG8_MMA(0, 0, At, B0); PG8_BAR; PG8_SCHED;
            PG8_LDB(B1, 1, 1); PG8_STAGE(PG8_SB(1, 0), b3, voffB);
            PG8_BAR; PG8_WAIT_L(0); PG8_MMA(0, 1, At, B1); PG8_BAR;
            PG8_LDA(At, 1, 1); PG8_STAGE(PG8_SA(1, 0), a3, voffA);
            PG8_BAR; PG8_WAIT_L(0); PG8_MMA(1, 0, At, B0); PG8_BAR; PG8_SCHED;
            PG8_STAGE(PG8_SB(1, 1), b3 + hstep, voffB);
            PG8_WAIT_V(6); PG8_BAR; PG8_MMA(1, 1, At, B1); PG8_BAR;
            }
        }
        if constexpr (ALIGN_EPI) { if (wr == 0) PG8_BAR; }
        if constexpr (!Epi::AFTER_DRAIN) { E(acc, cur, wr, wc, fr, fq); S.done(cur); }
        if (!has_next) break;
#pragma unroll
        for (int a = 0; a < 2; ++a)
#pragma unroll
            for (int b = 0; b < 2; ++b)
#pragma unroll
                for (int m = 0; m < 4; ++m)
#pragma unroll
                    for (int n = 0; n < 2; ++n) acc[a][b][m][n] = (f32x4){0.f, 0.f, 0.f, 0.f};
        cur = nxt; cA = nA; cB = nB; ++ui;
        if constexpr (ALIGN_EPI) { if (wr == 1) PG8_BAR; }
    }
    PG8_WAIT_V(0);
    if constexpr (!ALIGN_EPI) { if (wr == 0) PG8_BAR; }
    PG8_BAR;
    if constexpr (Epi::AFTER_DRAIN) { E.fused(acc, cur, wr, wc, fr, fq, lds, wid, lane); S.done(cur); }
#undef PG8_SA
#undef PG8_SB
#undef PG8_STAGE
#undef PG8_LDA
#undef PG8_LDB
#undef PG8_MMA
#undef PG8_WAIT_V
#undef PG8_WAIT_L
#undef PG8_BAR
#undef PG8_SCHED
}
}


#define LAS __attribute__((address_space(3)))
#ifndef SKIPMASK
#define SKIPMASK 0
#endif
#ifndef PROBE_KIND
#define PROBE_KIND -1
#endif
typedef unsigned short bf16;
using pg8::f32x4; using pg8::u32x4; using pg8::bf16x8;
typedef float f32x16 __attribute__((ext_vector_type(16)));
typedef short v4i16_t __attribute__((ext_vector_type(4)));
typedef unsigned u32x2 __attribute__((ext_vector_type(2)));

constexpr int DM = 1024, DEPTH = 4, NTOK = 98304, NPROMPT = 32768, CH = 32768, NCHUNK = NTOK / CH;
constexpr int NIN = 6400, DFF = 2816, NUP = 5632;
constexpr int LDS_BYTES = 147456, NTHR = 512;
constexpr float EPS = 1e-6f, LOG2E = 1.4426950408889634f;
constexpr size_t OFF_IN = 0, OFF_PA = OFF_IN + (size_t)NIN * DM, OFF_PB = OFF_PA + (size_t)DM * 256, OFF_OUT = OFF_PB + (size_t)DM * DM, OFF_UP = OFF_OUT + (size_t)DM * DM,
                 OFF_DN = OFF_UP + (size_t)NUP * DM, OFF_WS = OFF_DN + (size_t)DM * DFF, W_LAYER = OFF_WS + 8 * 128 * 128;
constexpr size_t MiB = 1u << 20;
constexpr size_t WS_W = 0, WS_R1 = 144 * MiB, WS_R2 = WS_R1 + (size_t)CH * 12800, WS_XB = WS_R2 + (size_t)CH * 5632, WS_SS = WS_XB + (size_t)CH * 2048, WS_SSV = WS_SS + (size_t)CH * 64, WS_BAR = WS_SSV + (size_t)CH * 64, WS_SB = WS_BAR + 65536, WS_XL = WS_SB + (size_t)(CH / 64) * 4 * 5632 * 2, WS_BT = WS_XL + (size_t)CH * 2048, WS_END = WS_BT + 16384;
static_assert(W_LAYER * 2 * DEPTH <= WS_R1, "weights fit");
constexpr int PROBE_DUPK = (PROBE_KIND == 8) ? 1 : PROBE_KIND;
constexpr int KPL = (PROBE_DUPK >= 0 && PROBE_DUPK < 8) ? 9 : 8;
constexpr int NP0 = (PROBE_KIND == 9) ? 2 : 1;
constexpr int PH_PER_CHUNK = 2 + KPL * DEPTH, N_PHASES = NP0 + NCHUNK * PH_PER_CHUNK;

struct Args { const float* in[17]; float* out; unsigned char* ws; int ph_lo, ph_hi; };

__device__ __forceinline__ float wave_sum(float v) {
#pragma unroll
    for (int o = 1; o < 64; o <<= 1) v += __shfl_xor(v, o);
    return v;
}
__device__ __forceinline__ unsigned pk2(float lo, float hi) { return pg8::cvt_pk_bf16(lo, hi); }
#define LDS_WAIT() asm volatile("s_waitcnt lgkmcnt(0)" ::: "memory")

__device__ __forceinline__ int t5_bucket(int rel) {
    const int n = rel < 0 ? -rel : rel;
    const int b = n < 8 ? n : 8 + (n >= 15) + (n >= 27) + (n >= 50) + (n >= 91) + (n >= 166) + (n >= 305) + (n >= 559);
    return (rel > 0 ? 16 : 0) + b;
}
__device__ __forceinline__ void tr_item(const float* W, int K, int N, bf16* WT, const float* gain, LAS float* scr, int item, int lane, bool perm_up = false) {
    const int nblk = N / 32, kb = item / nblk, nb = item % nblk, k0 = 64 * kb, n0 = 32 * nb;
    const int dn0 = perm_up ? ((n0 % DFF) / 128) * 256 + (n0 / DFF) * 128 + (n0 % 128) : n0;
#pragma unroll
    for (int i = 0; i < 8; ++i) {
        const int kk = (lane >> 3) + 8 * i, c4 = 4 * (lane & 7); const float g = gain ? gain[k0 + kk] : 1.0f;
        const f32x4 v = *(const f32x4*)(W + (size_t)(k0 + kk) * N + n0 + c4);
        scr[kk * 33 + c4 + 0] = v[0] * g; scr[kk * 33 + c4 + 1] = v[1] * g; scr[kk * 33 + c4 + 2] = v[2] * g; scr[kk * 33 + c4 + 3] = v[3] * g;
    }
    LDS_WAIT();
    const int c = lane & 7;
#pragma unroll
    for (int j = 0; j < 4; ++j) { const int n = (lane >> 3) + 8 * j; const LAS float* s = scr + (8 * c) * 33 + n;
        u32x4 o; o.x = pk2(s[0 * 33], s[1 * 33]); o.y = pk2(s[2 * 33], s[3 * 33]); o.z = pk2(s[4 * 33], s[5 * 33]); o.w = pk2(s[6 * 33], s[7 * 33]);
        *(u32x4*)(WT + (size_t)(dn0 + n) * K + k0 + 8 * c) = o; }
    LDS_WAIT();
}
__device__ __forceinline__ void p0_weights(const Args& a, LAS unsigned char* lds, int tid, int G, int bid) {
    const int wave = tid >> 6, lane = tid & 63;
    LAS float* scr = (LAS float*)(lds + wave * 16384);
    const int gw = bid * 8 + wave, NGW = G * 8;
    constexpr int I_IN = 16 * 200, I_PA = 4 * 32, I_PB = 16 * 32, I_OUT = 16 * 32, I_UP = 16 * 176, I_DN = 44 * 32, PER = I_IN + I_PA + I_PB + I_OUT + I_UP + I_DN;
    bf16* Wb = (bf16*)(a.ws + WS_W);
    for (int it = gw; it < DEPTH * PER; it += NGW) {
        const int l = it / PER; int r = it % PER; bf16* wl = Wb + (size_t)l * W_LAYER;
        if (r < I_IN) { tr_item(a.in[4] + (size_t)l * DM * NIN, DM, NIN, wl + OFF_IN, a.in[3] + l * DM, scr, r, lane); continue; } r -= I_IN;
        if (r < I_PA) { tr_item(a.in[8] + (size_t)l * 256 * DM, 256, DM, wl + OFF_PA, nullptr, scr, r, lane); continue; } r -= I_PA;
        if (r < I_PB) { tr_item(a.in[9] + (size_t)l * DM * DM, DM, DM, wl + OFF_PB, nullptr, scr, r, lane); continue; } r -= I_PB;
        if (r < I_OUT) { tr_item(a.in[10] + (size_t)l * DM * DM, DM, DM, wl + OFF_OUT, nullptr, scr, r, lane); continue; } r -= I_OUT;
        if (r < I_UP) { tr_item(a.in[12] + (size_t)l * DM * NUP, DM, NUP, wl + OFF_UP, a.in[11] + l * DM, scr, r, lane, true); continue; } r -= I_UP;
        tr_item(a.in[15] + (size_t)l * DFF * DM, DFF, DM, wl + OFF_DN, nullptr, scr, r, lane);
    }
    if (bid == 0) {
        float* BT = (float*)(a.ws + WS_BT);
        for (int i = tid; i < 3 * 768; i += NTHR) { const int g = i / 768, hh = (i % 768) / 192, j = i % 192 - 96;
            BT[i] = (j >= -64 && j <= 64) ? LOG2E * a.in[2][t5_bucket(j << (2 * g)) * 12 + g * 4 + hh] : -1e30f; }
    }
    for (int i = bid * NTHR + tid; i < DEPTH * 131072 / 4; i += G * NTHR) {
        const int l = i / 32768, e = (i % 32768) * 4;
        const f32x4 v = *(const f32x4*)(a.in[6] + (size_t)l * 131072 + e);
        u32x2 o; o.x = pk2(v[0], v[1]); o.y = pk2(v[2], v[3]);
        *(u32x2*)(Wb + (size_t)l * W_LAYER + OFF_WS + e) = o;
    }
}
__device__ __forceinline__ void p0x(const Args& a, int chunk, int tid, int G, int bid) {
    const int wave = tid >> 6, lane = tid & 63, gw = bid * 8 + wave, NGW = G * 8;
    bf16* XB = (bf16*)(a.ws + WS_XB); bf16* XL = (bf16*)(a.ws + WS_XL); float* SS = (float*)(a.ws + WS_SS);
    for (int m0 = gw; m0 < CH; m0 += 4 * NGW) {
        f32x4 v[4][4];
#pragma unroll
        for (int r = 0; r < 4; ++r) {
            const int m = m0 + r * NGW; const size_t tok = (size_t)chunk * CH + (m < CH ? m : m0);
            const float* src = tok < NPROMPT ? a.in[0] + tok * DM : a.in[1] + (tok - NPROMPT) * DM;
#pragma unroll
            for (int j = 0; j < 4; ++j) v[r][j] = *(const f32x4*)(src + (lane + 64 * j) * 4);
        }
#pragma unroll
        for (int r = 0; r < 4; ++r) {
            const int m = m0 + r * NGW;
            if (m < CH) {
                float s = 0.f;
#pragma unroll
                for (int j = 0; j < 4; ++j) { const f32x4 w = v[r][j]; s += (w[0] * w[0] + w[1] * w[1]) + (w[2] * w[2] + w[3] * w[3]);
                    u32x2 o; o.x = pk2(w[0], w[1]); o.y = pk2(w[2], w[3]); *(u32x2*)(XB + (size_t)m * DM + (lane + 64 * j) * 4) = o;
                    u32x2 lo; lo.x = pk2(w[0] - __uint_as_float(o.x << 16), w[1] - __uint_as_float(o.x & 0xffff0000u)); lo.y = pk2(w[2] - __uint_as_float(o.y << 16), w[3] - __uint_as_float(o.y & 0xffff0000u));
                    *(u32x2*)(XL + (size_t)m * DM + (lane + 64 * j) * 4) = lo; }
                s = wave_sum(s);
                if (lane < 16) SS[(size_t)m * 16 + lane] = lane == 0 ? s : 0.f;
            }
        }
    }
}
__device__ __forceinline__ void pfinal(const Args& a, int chunk, int tid, int G, int bid) {
    const int wave = tid >> 6, lane = tid & 63, gw = bid * 8 + wave, NGW = G * 8;
    const bf16* XB = (const bf16*)(a.ws + WS_XB); const bf16* XL = (const bf16*)(a.ws + WS_XL);
    const float* SS = (const float*)(a.ws + WS_SS); const float* nf = a.in[16];
    f32x4 g[2][2];
#pragma unroll
    for (int j = 0; j < 2; ++j) { g[j][0] = *(const f32x4*)(nf + (lane + 64 * j) * 8); g[j][1] = *(const f32x4*)(nf + (lane + 64 * j) * 8 + 4); }
    for (int m0 = gw; m0 < CH; m0 += 4 * NGW) {
        u32x4 hw[4][2], lw[4][2]; f32x4 sp[4];
#pragma unroll
        for (int r = 0; r < 4; ++r) {
            const int m = (m0 + r * NGW < CH) ? m0 + r * NGW : m0;
            sp[r] = *(const f32x4*)(SS + (size_t)m * 16 + 4 * (lane & 3));
#pragma unroll
            for (int j = 0; j < 2; ++j) { hw[r][j] = *(const u32x4*)(XB + (size_t)m * DM + (lane + 64 * j) * 8); lw[r][j] = *(const u32x4*)(XL + (size_t)m * DM + (lane + 64 * j) * 8); }
        }
#pragma unroll
        for (int r = 0; r < 4; ++r) {
            const int m = m0 + r * NGW;
            if (m < CH) {
                float t = (sp[r][0] + sp[r][1]) + (sp[r][2] + sp[r][3]); t += __shfl_xor(t, 1); t += __shfl_xor(t, 2);
                const float rs = rsqrtf(t * (1.0f / 1024.0f) + EPS);
                float* x = a.out + ((size_t)chunk * CH + m) * DM;
#pragma unroll
                for (int j = 0; j < 2; ++j) { const int c = (lane + 64 * j) * 8; f32x4 h0, h1, l0, l1; pg8::unpack8(hw[r][j], h0, h1); pg8::unpack8(lw[r][j], l0, l1);
                    *(f32x4*)(x + c) = (h0 + l0) * rs * g[j][0]; *(f32x4*)(x + c + 4) = (h1 + l1) * rs * g[j][1]; }
            }
        }
    }
}
struct AttU { int g, d, L, tokbase, qb; };
__device__ __forceinline__ AttU att_decode(int unit, int S) {
    constexpr int upg = CH / 64;
    AttU u; u.g = unit / upg; const int rem = unit % upg, ups = S / 64, seq = rem / ups, rem2 = rem % ups;
    u.d = 1 << (2 * u.g); u.L = S / u.d; const int nqb = u.L / 64, r = rem2 / nqb; u.qb = rem2 % nqb; u.tokbase = seq * S + r;
    return u;
}
template <int KT0, int KT1, bool WITHQ>
__device__ __forceinline__ void att_load_qk(const bf16* QKV, const AttU& u, int h, int qh, int n, int hi, bf16x8 (&qf)[4], bf16x8 (&kf)[5][4]) {
    const int qbase = 64 * u.qb + 32 * qh;
    if (WITHQ) {
        const bf16* qp = QKV + ((size_t)u.tokbase + (size_t)(qbase + n) * u.d) * 2304 + u.g * 256 + h * 64 + 8 * hi;
#pragma unroll
        for (int s = 0; s < 4; ++s) qf[s] = *(const bf16x8*)(qp + 16 * s);
    }
#pragma unroll
    for (int kt = KT0; kt < KT1; ++kt) {
        const int lk = qbase - 64 + 32 * kt + n, lkc = lk < 0 ? 0 : (lk > u.L - 1 ? u.L - 1 : lk);
        const bf16* kp = QKV + (size_t)(u.tokbase + lkc * u.d) * 2304 + 768 + u.g * 256 + h * 64 + 8 * hi;
#pragma unroll
        for (int s = 0; s < 4; ++s) kf[kt][s] = *(const bf16x8*)(kp + 16 * s);
    }
}
__device__ __forceinline__ void attn_phase(const bf16* QKV, bf16* OUTG, float* LSE, const float* BT, LAS unsigned char* lds, int S, int tid, int G, int bid) {
    constexpr int NATT = 3 * (CH / 64);
    int it = (G % 8 == 0) ? (bid & 7) * (G / 8) + (bid >> 3) : bid;
    if (it >= NATT) return;
    AttU u = att_decode(it, S);
    bf16x8 qf[4], kf[5][4];
    att_load_qk<0, 4, false>(QKV, u, (tid >> 6) & 3, tid >> 8, tid & 31, (tid >> 5) & 1, qf, kf);
    for (; it < NATT; it += G) {
        int tl = tid; asm volatile("" : "+v"(tl));
        const int h = (tl >> 6) & 3, qh = tl >> 8, n = tl & 31, hi = (tl >> 5) & 1, lane = tl & 63;
        const int g = u.g, d = u.d, L = u.L, tokbase = u.tokbase, qb = u.qb, qbase = 64 * qb + 32 * qh;
        att_load_qk<4, 5, true>(QKV, u, h, qh, n, hi, qf, kf);
        u32x4 vv[12];
#pragma unroll
        for (int i = 0; i < 12; ++i) {
            const int idx = tl + i * NTHR, kk = idx >> 5, ch = idx & 31, lk = 64 * qb - 64 + kk;
            vv[i] = (u32x4){0u, 0u, 0u, 0u};
            if (lk >= 0 && lk < L) vv[i] = *(const u32x4*)(QKV + (size_t)(tokbase + lk * d) * 2304 + 1536 + g * 256 + ch * 8);
        }
        const float bt0 = BT[g * 768 + tid], bt1 = tid < 256 ? BT[g * 768 + 512 + tid] : 0.f;
        f32x16 st[5];
#pragma unroll
        for (int kt = 0; kt < 5; ++kt) {
            f32x16 acc;
#pragma unroll
            for (int e = 0; e < 16; ++e) acc[e] = 0.f;
#pragma unroll
            for (int s = 0; s < 4; ++s) acc = __builtin_amdgcn_mfma_f32_32x32x16_bf16(kf[kt][s], qf[s], acc, 0, 0, 0);
            st[kt] = acc;
        }
#pragma unroll
        for (int i = 0; i < 12; ++i) { const int idx = tl + i * NTHR, kk = idx >> 5, ch = idx & 31; *(LAS u32x4*)(lds + kk * 576 + ch * 16) = vv[i]; }
        LAS float* bt = (LAS float*)(lds + 110592);
        bt[tid] = bt0; if (tid < 256) bt[512 + tid] = bt1;
        asm volatile("" :: "v"(st[4][15]) : "memory");
        AttU un = u;
        if (it + G < NATT) { un = att_decode(it + G, S); att_load_qk<0, 4, false>(QKV, un, h, qh, n, hi, qf, kf); }
        __syncthreads();
        float mx = -3.0e38f;
        {
            const LAS float* btl = bt + h * 192 + 32 + 4 * hi - n;
            const bool edge = (qb == 0) || (64 * qb + 128 > L);
#pragma unroll
            for (int kt = 0; kt < 5; ++kt)
#pragma unroll
                for (int i = 0; i < 16; ++i) {
                    float sv = st[kt][i] + btl[32 * kt + (i & 3) + 8 * (i >> 2)];
                    if (edge) { const int lk2 = qbase - 64 + 32 * kt + (i & 3) + 8 * (i >> 2) + 4 * hi; sv = (lk2 >= 0 && lk2 < L) ? sv : -1e30f; }
                    st[kt][i] = sv; mx = fmaxf(mx, sv);
                }
        }
        mx = fmaxf(mx, __shfl_xor(mx, 32));
        float sum = 0.f;
#pragma unroll
        for (int kt = 0; kt < 5; ++kt)
#pragma unroll
            for (int i = 0; i < 16; ++i) { const float pe = __builtin_amdgcn_exp2f(st[kt][i] - mx); st[kt][i] = pe; sum += pe; }
        sum += __shfl_xor(sum, 32);
        const float inv = 1.0f / sum, lse = (mx + __log2f(sum)) * 0.6931471805599453f;
        f32x16 o0, o1;
#pragma unroll
        for (int e = 0; e < 16; ++e) { o0[e] = 0.f; o1[e] = 0.f; }
        const int q4 = (lane & 15) >> 2, p4 = lane & 3, gsel = (lane >> 4) & 1;
        const unsigned vbase = (unsigned)((32 * qh + 4 * hi + q4) * 576 + h * 128 + (16 * gsel + 4 * p4) * 2);
#pragma unroll
        for (int kt = 0; kt < 5; ++kt)
#pragma unroll
            for (int s2 = 0; s2 < 2; ++s2) {
                u32x4 pw; pw.x = pk2(st[kt][8 * s2 + 0], st[kt][8 * s2 + 1]); pw.y = pk2(st[kt][8 * s2 + 2], st[kt][8 * s2 + 3]); pw.z = pk2(st[kt][8 * s2 + 4], st[kt][8 * s2 + 5]); pw.w = pk2(st[kt][8 * s2 + 6], st[kt][8 * s2 + 7]);
                const bf16x8 pf = __builtin_bit_cast(bf16x8, pw);
                const unsigned ro = vbase + (unsigned)((32 * kt + 16 * s2) * 576);
                {
                    const v4i16_t r1 = __builtin_amdgcn_ds_read_tr16_b64_v4i16((LAS v4i16_t*)(lds + ro)), r2 = __builtin_amdgcn_ds_read_tr16_b64_v4i16((LAS v4i16_t*)(lds + ro + 8 * 576));
                    const bf16x8 vf = (bf16x8){r1[0], r1[1], r1[2], r1[3], r2[0], r2[1], r2[2], r2[3]};
                    o0 = __builtin_amdgcn_mfma_f32_32x32x16_bf16(vf, pf, o0, 0, 0, 0);
                }
                {
                    const v4i16_t r1 = __builtin_amdgcn_ds_read_tr16_b64_v4i16((LAS v4i16_t*)(lds + ro + 64)), r2 = __builtin_amdgcn_ds_read_tr16_b64_v4i16((LAS v4i16_t*)(lds + ro + 64 + 8 * 576));
                    const bf16x8 vf = (bf16x8){r1[0], r1[1], r1[2], r1[3], r2[0], r2[1], r2[2], r2[3]};
                    o1 = __builtin_amdgcn_mfma_f32_32x32x16_bf16(vf, pf, o1, 0, 0, 0);
                }
            }
        const size_t tokq = (size_t)tokbase + (size_t)(qbase + n) * d;
        bf16* op = OUTG + ((size_t)g * CH + tokq) * 256 + h * 64;
#pragma unroll
        for (int grp = 0; grp < 4; ++grp) {
            u32x2 w0, w1;
            w0.x = pk2(o0[4 * grp + 0] * inv, o0[4 * grp + 1] * inv); w0.y = pk2(o0[4 * grp + 2] * inv, o0[4 * grp + 3] * inv);
            w1.x = pk2(o1[4 * grp + 0] * inv, o1[4 * grp + 1] * inv); w1.y = pk2(o1[4 * grp + 2] * inv, o1[4 * grp + 3] * inv);
            *(u32x2*)(op + 8 * grp + 4 * hi) = w0; *(u32x2*)(op + 32 + 8 * grp + 4 * hi) = w1;
        }
        if (hi == 0) LSE[((size_t)g * CH + tokq) * 4 + h] = lse;
        __syncthreads();
        u = un;
    }
}
constexpr int SG_WLDS = 17920;
__device__ __forceinline__ void sg_wave_unit(bf16* U, bf16* UO, const bf16* GV, const float* ssv, const bf16* WSb, const float* gain, const float* bs, LAS unsigned char* wl, int unit, int lane) {
    const int hf = unit & 1, gg = (unit >> 1) & 7, nch = unit >> 4, tok0 = nch * 128, cb = gg * 128 + hf * 64;
    LAS float* rvl = (LAS float*)(wl + 17408);
    {
        const int c8 = lane & 7, q0 = lane >> 3;
        u32x4 gvw[16];
#pragma unroll
        for (int i = 0; i < 16; ++i) gvw[i] = *(const u32x4*)(GV + (size_t)(tok0 + q0 + 8 * i) * 1024 + cb + c8 * 8);
        rvl[lane] = pg8::row_rs(ssv, tok0 + lane); rvl[lane + 64] = pg8::row_rs(ssv, tok0 + lane + 64);
        LDS_WAIT();
#pragma unroll
        for (int i = 0; i < 16; ++i) {
            const int q = q0 + 8 * i;
            f32x4 a0, a1; pg8::unpack8(gvw[i], a0, a1);
            const float r = rvl[q];
            const u32x4 w = pg8::pack8(a0 * r, a1 * r);
            *(LAS u32x2*)(wl + q * 136 + c8 * 16) = (u32x2){w.x, w.y}; *(LAS u32x2*)(wl + q * 136 + c8 * 16 + 8) = (u32x2){w.z, w.w};
        }
    }
    LDS_WAIT();
    const int ln = lane & 15, kq = lane >> 4, qq = ln >> 2, pp = ln & 3;
    bf16x8 afr[4][4];
#pragma unroll
    for (int ct = 0; ct < 4; ++ct)
#pragma unroll
        for (int ks = 0; ks < 4; ++ks) {
            const unsigned ad = (unsigned)((32 * ks + 8 * kq + qq) * 136 + (32 * (ct >> 1) + 8 * pp + 4 * (ct & 1)) * 2);
            const v4i16_t r1 = __builtin_amdgcn_ds_read_tr16_b64_v4i16((LAS v4i16_t*)(wl + ad)), r2 = __builtin_amdgcn_ds_read_tr16_b64_v4i16((LAS v4i16_t*)(wl + ad + 4 * 136));
            afr[ct][ks] = (bf16x8){r1[0], r1[1], r1[2], r1[3], r2[0], r2[1], r2[2], r2[3]};
        }
    f32x4 gn[2][2];
#pragma unroll
    for (int t = 0; t < 2; ++t) { gn[t][0] = *(const f32x4*)(gain + cb + 32 * t + 8 * kq); gn[t][1] = *(const f32x4*)(gain + cb + 32 * t + 8 * kq + 4); }
#pragma unroll 2
    for (int pt = 0; pt < 8; ++pt) {
        const int pr = pt * 16 + ln;
        bf16x8 bfr[4];
#pragma unroll
        for (int ks = 0; ks < 4; ++ks) bfr[ks] = *(const bf16x8*)(WSb + (size_t)gg * 16384 + pr * 128 + 32 * ks + 8 * kq);
        bf16* up = U + (size_t)(tok0 + pr) * 1024 + cb + 8 * kq; bf16* uo = UO + (size_t)(tok0 + pr) * 1024 + cb + 8 * kq;
        const u32x4 uw0 = *(const u32x4*)up, uw1 = *(const u32x4*)(up + 32);
        const float bias = bs[gg * 128 + pr];
        f32x4 acc[4];
#pragma unroll
        for (int ct = 0; ct < 4; ++ct) {
            acc[ct] = (f32x4){0.f, 0.f, 0.f, 0.f};
#pragma unroll
            for (int ks = 0; ks < 4; ++ks) acc[ct] = __builtin_amdgcn_mfma_f32_16x16x32_bf16(afr[ct][ks], bfr[ks], acc[ct], 0, 0, 0);
        }
        f32x4 u0, u1;
        pg8::unpack8(uw0, u0, u1);
        *(u32x4*)uo = pg8::pack8(u0 * (gn[0][0] * acc[0] + bias), u1 * (gn[0][1] * acc[1] + bias));
        pg8::unpack8(uw1, u0, u1);
        *(u32x4*)(uo + 32) = pg8::pack8(u0 * (gn[1][0] * acc[2] + bias), u1 * (gn[1][1] * acc[3] + bias));
    }
    LDS_WAIT();
}
__device__ __forceinline__ void p_merge(const bf16* OUTG, const float* LSE, bf16* OA, int tid, int G, int bid) {
    for (int it = bid * NTHR + tid; it < CH * 32; it += G * NTHR) {
        const int tok = it >> 5, c8 = it & 31, h = c8 >> 3;
        const float l0 = LSE[(size_t)tok * 4 + h], l1 = LSE[((size_t)CH + tok) * 4 + h], l2 = LSE[((size_t)2 * CH + tok) * 4 + h];
        const float mx = fmaxf(l0, fmaxf(l1, l2));
        float w0 = __expf(l0 - mx), w1 = __expf(l1 - mx), w2 = __expf(l2 - mx);
        const float inv = 1.0f / (w0 + w1 + w2); w0 *= inv; w1 *= inv; w2 *= inv;
        f32x4 a0, a1, b0, b1, c0, c1;
        pg8::unpack8(*(const u32x4*)(OUTG + (size_t)tok * 256 + c8 * 8), a0, a1);
        pg8::unpack8(*(const u32x4*)(OUTG + ((size_t)CH + tok) * 256 + c8 * 8), b0, b1);
        pg8::unpack8(*(const u32x4*)(OUTG + ((size_t)2 * CH + tok) * 256 + c8 * 8), c0, c1);
        *(u32x4*)(OA + (size_t)tok * 256 + c8 * 8) = pg8::pack8(a0 * w0 + b0 * w1 + c0 * w2, a1 * w0 + b1 * w1 + c1 * w2);
    }
}
__device__ __forceinline__ void p_conv(const bf16* A, bf16* FG, const float* cw, const float* cb, int S, int tid, int G, int bid) {
    constexpr int RUN = 8, NFC = DFF / 8;
    for (int it = bid * NTHR + tid; it < (CH / RUN) * NFC; it += G * NTHR) {
        const int fc = it % NFC, t0 = (it / NFC) * RUN, f = fc * 8;
        f32x4 wg[3][2], wv[3][2], bg[2], bv[2];
#pragma unroll
        for (int k = 0; k < 3; ++k) { wg[k][0] = *(const f32x4*)(cw + k * NUP + f); wg[k][1] = *(const f32x4*)(cw + k * NUP + f + 4); wv[k][0] = *(const f32x4*)(cw + k * NUP + DFF + f); wv[k][1] = *(const f32x4*)(cw + k * NUP + DFF + f + 4); }
        bg[0] = *(const f32x4*)(cb + f); bg[1] = *(const f32x4*)(cb + f + 4); bv[0] = *(const f32x4*)(cb + DFF + f); bv[1] = *(const f32x4*)(cb + DFF + f + 4);
        const f32x4 z4 = (f32x4){0.f, 0.f, 0.f, 0.f};
        f32x4 pg0 = z4, pg1 = z4, pv0 = z4, pv1 = z4, cg0, cg1, cv0, cv1;
        if ((t0 & (S - 1)) != 0) { pg8::unpack8(*(const u32x4*)(A + (size_t)(t0 - 1) * NUP + f), pg0, pg1); pg8::unpack8(*(const u32x4*)(A + (size_t)(t0 - 1) * NUP + DFF + f), pv0, pv1); }
        pg8::unpack8(*(const u32x4*)(A + (size_t)t0 * NUP + f), cg0, cg1); pg8::unpack8(*(const u32x4*)(A + (size_t)t0 * NUP + DFF + f), cv0, cv1);
#pragma unroll
        for (int i = 0; i < RUN; ++i) {
            const int t = t0 + i;
            f32x4 ng0 = z4, ng1 = z4, nv0 = z4, nv1 = z4;
            if (((t + 1) & (S - 1)) != 0) { pg8::unpack8(*(const u32x4*)(A + (size_t)(t + 1) * NUP + f), ng0, ng1); pg8::unpack8(*(const u32x4*)(A + (size_t)(t + 1) * NUP + DFF + f), nv0, nv1); }
            f32x4 g0 = pg0 * wg[0][0] + cg0 * wg[1][0] + ng0 * wg[2][0] + bg[0], g1 = pg1 * wg[0][1] + cg1 * wg[1][1] + ng1 * wg[2][1] + bg[1];
            const f32x4 v0 = pv0 * wv[0][0] + cv0 * wv[1][0] + nv0 * wv[2][0] + bv[0], v1 = pv1 * wv[0][1] + cv1 * wv[1][1] + nv1 * wv[2][1] + bv[1];
#pragma unroll
            for (int e = 0; e < 4; ++e) { g0[e] = pg8::gelu_tanh(g0[e]) * v0[e]; g1[e] = pg8::gelu_tanh(g1[e]) * v1[e]; }
            *(u32x4*)(FG + (size_t)t * DFF + f) = pg8::pack8(g0, g1);
            pg0 = cg0; pg1 = cg1; pv0 = cv0; pv1 = cv1; cg0 = ng0; cg1 = ng1; cv0 = nv0; cv1 = nv1;
        }
    }
}

__device__ __forceinline__ void p_convfix(const bf16* SB, bf16* FG, const float* cw, const float* cb, int S, int tid, int G, int bid) {
    constexpr int NFC = DFF / 8, NB = CH / 64;
    for (int it = bid * NTHR + tid; it < NB * 2 * NFC; it += G * NTHR) {
        const int fc = it % NFC, r2 = it / NFC, which = r2 & 1, b = r2 >> 1, f = fc * 8, t = b * 64 + (which ? 63 : 0);
        const f32x4 z4 = (f32x4){0.f, 0.f, 0.f, 0.f};
        f32x4 pg0 = z4, pg1 = z4, pv0 = z4, pv1 = z4, cg0, cg1, cv0, cv1, ng0 = z4, ng1 = z4, nv0 = z4, nv1 = z4;
        const bf16* bp = SB + (size_t)b * 4 * NUP + f;
        if (which == 0) {
            if ((t & (S - 1)) != 0) { pg8::unpack8(*(const u32x4*)(bp - NUP), pg0, pg1); pg8::unpack8(*(const u32x4*)(bp - NUP + DFF), pv0, pv1); }
            pg8::unpack8(*(const u32x4*)bp, cg0, cg1); pg8::unpack8(*(const u32x4*)(bp + DFF), cv0, cv1);
            pg8::unpack8(*(const u32x4*)(bp + NUP), ng0, ng1); pg8::unpack8(*(const u32x4*)(bp + NUP + DFF), nv0, nv1);
        } else {
            pg8::unpack8(*(const u32x4*)(bp + 2 * NUP), pg0, pg1); pg8::unpack8(*(const u32x4*)(bp + 2 * NUP + DFF), pv0, pv1);
            pg8::unpack8(*(const u32x4*)(bp + 3 * NUP), cg0, cg1); pg8::unpack8(*(const u32x4*)(bp + 3 * NUP + DFF), cv0, cv1);
            if (((t + 1) & (S - 1)) != 0) { pg8::unpack8(*(const u32x4*)(bp + 4 * NUP), ng0, ng1); pg8::unpack8(*(const u32x4*)(bp + 4 * NUP + DFF), nv0, nv1); }
        }
        f32x4 g0 = *(const f32x4*)(cb + f), g1 = *(const f32x4*)(cb + f + 4), v0 = *(const f32x4*)(cb + DFF + f), v1 = *(const f32x4*)(cb + DFF + f + 4);
        g0 = g0 + pg0 * *(const f32x4*)(cw + f) + cg0 * *(const f32x4*)(cw + NUP + f) + ng0 * *(const f32x4*)(cw + 2 * NUP + f);
        g1 = g1 + pg1 * *(const f32x4*)(cw + f + 4) + cg1 * *(const f32x4*)(cw + NUP + f + 4) + ng1 * *(const f32x4*)(cw + 2 * NUP + f + 4);
        v0 = v0 + pv0 * *(const f32x4*)(cw + DFF + f) + cv0 * *(const f32x4*)(cw + NUP + DFF + f) + nv0 * *(const f32x4*)(cw + 2 * NUP + DFF + f);
        v1 = v1 + pv1 * *(const f32x4*)(cw + DFF + f + 4) + cv1 * *(const f32x4*)(cw + NUP + DFF + f + 4) + nv1 * *(const f32x4*)(cw + 2 * NUP + DFF + f + 4);
#pragma unroll
        for (int e = 0; e < 4; ++e) { g0[e] = pg8::gelu_tanh(g0[e]) * v0[e]; g1[e] = pg8::gelu_tanh(g1[e]) * v1[e]; }
        *(u32x4*)(FG + (size_t)t * DFF + f) = pg8::pack8(g0, g1);
    }
}
#define XB_TMO      128
#define XB_XCNT(j)  (256  + 64 * (j))
#define XB_XSUB(j)  (1280 + 64 * (j))
#define XB_XGEN(j)  (2304 + 64 * (j))
#define XB_TOP      3328
#define XB_TOPGEN   3392
#define XCD_BAR_WORDS 3456
#define XB_SPIN_CAP (1u << 18)

__device__ __forceinline__ unsigned xb_ld(unsigned* p)              { return __hip_atomic_load(p, __ATOMIC_RELAXED, __HIP_MEMORY_SCOPE_AGENT); }
__device__ __forceinline__ unsigned xb_add(unsigned* p, unsigned v) { return __hip_atomic_fetch_add(p, v, __ATOMIC_RELAXED, __HIP_MEMORY_SCOPE_AGENT); }
__device__ __forceinline__ unsigned xb_xcc_id() { return (unsigned)__builtin_amdgcn_s_getreg((3 << 11) | 20) & 0xFu; }
#define XB_SPIN(cond, bar) do { unsigned _sp = 0; while (cond) { __builtin_amdgcn_s_sleep(1); \
    if ((++_sp & 255u) == 0u) { if (xb_ld(&(bar)[XB_TMO])) break; if (_sp > XB_SPIN_CAP) { atomicAdd(&(bar)[XB_TMO], 1u); break; } } } } while (0)

struct XcdBarrier {
    unsigned* bar; unsigned x;
    volatile LAS unsigned* st;
};

__device__ __forceinline__ XcdBarrier xcd_barrier_post(unsigned* bar, volatile LAS unsigned* st, const int tid) {
    XcdBarrier b; b.bar = bar; b.x = xb_xcc_id(); b.st = st;
    if (tid == 0) (void)xb_add(&bar[XB_XCNT(b.x)], 1u);
    return b;
}
__device__ __forceinline__ void xcd_barrier_complete(unsigned* bar, unsigned x, unsigned& nloc, unsigned& nx) {
    const unsigned G = gridDim.x * gridDim.y * gridDim.z;
    unsigned sum, cnt, mine, sp = 0u;
    for (;;) {
        sum = 0u; cnt = 0u; mine = 0u;
#pragma unroll
        for (unsigned j = 0; j < 16; ++j) { const unsigned c = xb_ld(&bar[XB_XCNT(j)]); sum += c; cnt += (c > 0u) ? 1u : 0u; mine = (j == x) ? c : mine; }
        if (sum == G) break;
        __builtin_amdgcn_s_sleep(1);
        if ((++sp & 255u) == 0u) { if (xb_ld(&bar[XB_TMO])) break; if (sp > XB_SPIN_CAP) { atomicAdd(&bar[XB_TMO], 1u); break; } }
    }
    nloc = mine > 0u ? mine : 1u; nx = cnt > 0u ? cnt : 1u;
}

__device__ __forceinline__ void xcd_barrier(const XcdBarrier& b, const int tid) {
    asm volatile("s_waitcnt vmcnt(0)" ::: "memory");
    __syncthreads();
    if (tid == 0) {
        unsigned* bar = b.bar;
        __builtin_amdgcn_s_waitcnt(0);
        unsigned nloc = b.st[0], nx = b.st[1];
        if (nloc == 0u) { xcd_barrier_complete(bar, b.x, nloc, nx); b.st[0] = nloc; b.st[1] = nx; }
        const unsigned old = xb_add(&bar[XB_XSUB(b.x)], 1u);
        const unsigned gen = old / nloc;
        if (old + 1u == (gen + 1u) * nloc) {
            __builtin_amdgcn_fence(__ATOMIC_RELEASE, "agent");
            asm volatile("s_waitcnt vmcnt(0)" ::: "memory");
            const unsigned og = xb_add(&bar[XB_TOP], 1u);
            const unsigned tg = og / nx;
            if (og + 1u == (tg + 1u) * nx) xb_add(&bar[XB_TOPGEN], 1u);
            else XB_SPIN(xb_ld(&bar[XB_TOPGEN]) == tg, bar);
            __builtin_amdgcn_fence(__ATOMIC_ACQUIRE, "agent");
            xb_add(&bar[XB_XGEN(b.x)], 1u);
            asm volatile("s_waitcnt vmcnt(0)" ::: "memory");
        } else {
            XB_SPIN(xb_ld(&bar[XB_XGEN(b.x)]) == gen, bar);
            __builtin_amdgcn_fence(__ATOMIC_ACQUIRE, "agent");
            asm volatile("s_waitcnt vmcnt(0)" ::: "memory");
        }
    }
    __syncthreads();
}


__global__ void __launch_bounds__(NTHR, 2) fwd_kernel(Args a_in) {
    extern __shared__ __attribute__((aligned(16))) unsigned char lds_raw[];
    LAS unsigned char* lds = (LAS unsigned char*)lds_raw;
    cg::grid_group grid = cg::this_grid();
    const int ph_lo = a_in.ph_lo, ph_hi = a_in.ph_hi;
    volatile LAS unsigned* xst = (volatile LAS unsigned*)(lds + LDS_BYTES - 16);
    if (threadIdx.x < 2) xst[threadIdx.x] = 0u;
    __syncthreads();
    const unsigned xcc = xcd_barrier_post((unsigned*)(a_in.ws + WS_BAR), xst, (int)threadIdx.x).x;
    for (int ph = ph_lo; ph < ph_hi; ++ph) {
#if defined(__HIP_DEVICE_COMPILE__)
        typedef const __attribute__((address_space(4))) unsigned long long* cu64p4;
        cu64p4 ap = (cu64p4)__builtin_amdgcn_kernarg_segment_ptr();
        asm volatile("" : "+s"(ap));
        Args a;
#pragma unroll
        for (int i = 0; i < 17; ++i) a.in[i] = (const float*)(const __attribute__((address_space(1))) float*)ap[i];
        a.out = (float*)(__attribute__((address_space(1))) float*)ap[17]; a.ws = (unsigned char*)(__attribute__((address_space(1))) unsigned char*)ap[18]; a.ph_lo = ph_lo; a.ph_hi = ph_hi;
#else
        const Args a = a_in;
#endif
        int tid = threadIdx.x, G = gridDim.x, bid = blockIdx.x;
        asm volatile("" : "+v"(tid)); asm volatile("" : "+s"(G)); asm volatile("" : "+s"(bid));
        unsigned char* ws = a.ws;
        bf16* Wb = (bf16*)(ws + WS_W);
        bf16* QKV = (bf16*)(ws + WS_R1); bf16* U = QKV + (size_t)CH * 2304; bf16* GV = U + (size_t)CH * 1024; bf16* GT = GV + (size_t)CH * 1024;
        bf16* AF = (bf16*)(ws + WS_R1);
        bf16* MG = GV;
        bf16* OUTG = (bf16*)(ws + WS_R2); bf16* OA = OUTG + (size_t)3 * CH * 256; float* LSE = (float*)(OA + (size_t)CH * 256);
        bf16* FG = (bf16*)(ws + WS_R2);
        bf16* XB = (bf16*)(ws + WS_XB); float* SS = (float*)(ws + WS_SS); float* SSV = (float*)(ws + WS_SSV);
        if (ph < NP0) p0_weights(a, lds, tid, G, bid);
        else {
            const int chunk = (ph - NP0) / PH_PER_CHUNK, sub = (ph - NP0) % PH_PER_CHUNK;
            const int S = chunk == 0 ? 8192 : 2048;
            if (sub == 0) { p0x(a, chunk, tid, G, bid); if (PROBE_KIND == 10) p0x(a, chunk, tid, G, bid); }
            else if (sub == PH_PER_CHUNK - 1) pfinal(a, chunk, tid, G, bid);
            else {
                const int l = (sub - 1) / KPL, ki = (sub - 1) % KPL, k = (KPL == 9 && ki > PROBE_DUPK) ? ki - 1 : ki; const bool dup = (KPL == 9 && ki == PROBE_DUPK + 1);
                const bf16* wl = Wb + (size_t)l * W_LAYER;
                float* X = a.out + (size_t)chunk * CH * DM;
                if (k == 0 && !(SKIPMASK & 1)) {
                    pg8::Gemm g{XB, wl + OFF_IN, CH, NIN, DM}; pg8::StaticOrder So; So.init(CH, NIN, G, bid);
                    pg8::EpiIn E{QKV, U, GV, GT, SS, SSV};
                    pg8::gemm_phase<pg8::EpiIn, pg8::StaticOrder, true, true>(lds, g, So, E, tid);
                } else if (k == 1 && !(SKIPMASK & 2)) {
                    constexpr int NATT = 3 * (CH / 64), NSGW = (CH / 128) * 16;
                    if (!(SKIPMASK & 1024) && !(dup && PROBE_KIND == 8)) attn_phase(QKV, OUTG, LSE, (const float*)(ws + WS_BT), lds, S, tid, G, bid);
                    if (!(SKIPMASK & 2048) && (!dup || PROBE_KIND == 8)) {
                        bf16* UO = dup ? (bf16*)(ws + WS_R2 + (size_t)CH * 2096) : U;
                        const int wave = __builtin_amdgcn_readfirstlane(tid >> 6);
                        for (int wu = bid * 8 + wave; wu < NSGW; wu += G * 8) sg_wave_unit(U, UO, GV, SSV, wl + OFF_WS, a.in[5] + l * 1024, a.in[7] + l * 1024, lds + wave * SG_WLDS, wu, tid & 63);
                    }
                } else if (k == 2 && !(SKIPMASK & 4)) p_merge(OUTG, LSE, OA, tid, G, bid);
                else if (k == 3 && !(SKIPMASK & 8)) {
                    if (!(SKIPMASK & 4096)) { int kpa = 256; asm volatile("" : "+s"(kpa)); pg8::Gemm g{OA, wl + OFF_PA, CH, DM, kpa}; pg8::StaticOrder So; So.init(CH, DM, G, bid);
                      pg8::EpiGate<0> E{MG, GT, 0};
                      pg8::gemm_phase<pg8::EpiGate<0>, pg8::StaticOrder, false, true>(lds, g, So, E, tid); }
                    if (!(SKIPMASK & 8192)) { pg8::Gemm g{U, wl + OFF_PB, CH, DM, DM}; pg8::StaticOrder So; So.init(CH, DM, G, bid);
                      pg8::EpiGate<1> E{MG, GT, 1024};
                      pg8::gemm_phase<pg8::EpiGate<1>, pg8::StaticOrder, false, true>(lds, g, So, E, tid); }
                } else if (k == 4 && !(SKIPMASK & 16)) {
                    pg8::Gemm g{MG, wl + OFF_OUT, CH, DM, DM}; pg8::StaticOrder So; So.init(CH, DM, G, bid);
                    pg8::EpiRes E{dup ? QKV + (size_t)CH * 1024 : (bf16*)(ws + WS_XL), dup ? QKV : XB, dup ? SSV : SS};
                    pg8::gemm_phase<pg8::EpiRes, pg8::StaticOrder, false, true>(lds, g, So, E, tid);
                } else if (k == 5 && !(SKIPMASK & 32)) {
                    pg8::Gemm g{XB, wl + OFF_UP, CH, NUP, DM}; pg8::StaticOrder So; So.init(CH, NUP, G, bid);
                    pg8::EpiUpConv E{FG, (bf16*)(ws + WS_SB), SS, a.in[13] + (size_t)l * 3 * NUP, a.in[14] + (size_t)l * NUP};
                    pg8::gemm_phase<pg8::EpiUpConv, pg8::StaticOrder, true, true>(lds, g, So, E, tid);
                } else if (k == 6 && !(SKIPMASK & 64)) p_convfix((const bf16*)(ws + WS_SB), FG, a.in[13] + (size_t)l * 3 * NUP, a.in[14] + (size_t)l * NUP, S, tid, G, bid);
                else if (!(SKIPMASK & 128)) {
                    pg8::Gemm g{FG, wl + OFF_DN, CH, DM, DFF}; pg8::StaticOrder So; So.init(CH, DM, G, bid);
                    pg8::EpiRes E{dup ? QKV + (size_t)CH * 1024 : (bf16*)(ws + WS_XL), dup ? QKV : XB, dup ? SSV : SS};
                    pg8::gemm_phase<pg8::EpiRes, pg8::StaticOrder, false, true>(lds, g, So, E, tid);
                }
            }
        }
        if (ph + 1 < ph_hi) {
            if (ph == ph_lo) grid.sync();
            XcdBarrier xb; xb.bar = (unsigned*)(a.ws + WS_BAR); xb.x = xcc; xb.st = xst;
            xcd_barrier(xb, tid);
            if (PROBE_KIND == 100) xcd_barrier(xb, tid);
        }
    }
}

extern "C" void kernel_launch(void* const* d_in, const int* in_sizes, int n_in, void* d_out, int out_size, void* d_ws, size_t ws_size, hipStream_t stream) {
    static int grid = 0;
    if (grid == 0) {
        if (n_in != 17 || out_size != NTOK * DM || ws_size < WS_END) { fprintf(stderr, "kernel_launch: unexpected shapes: n_in %d out %d ws %zu (need %zu)\n", n_in, out_size, ws_size, (size_t)WS_END); grid = -1; return; }
        int dev = 0, cus = 0, per_cu = 0;
        (void)hipGetDevice(&dev); (void)hipDeviceGetAttribute(&cus, hipDeviceAttributeMultiprocessorCount, dev);
        if (hipFuncSetAttribute((const void*)fwd_kernel, hipFuncAttributeMaxDynamicSharedMemorySize, LDS_BYTES) != hipSuccess) { fprintf(stderr, "kernel_launch: hipFuncSetAttribute failed\n"); grid = -1; return; }
        if (hipOccupancyMaxActiveBlocksPerMultiprocessor(&per_cu, (const void*)fwd_kernel, NTHR, LDS_BYTES) != hipSuccess || per_cu < 1) { fprintf(stderr, "kernel_launch: occupancy query says %d\n", per_cu); per_cu = 1; }
        (void)hipGetLastError();
        grid = cus * per_cu;
        if (grid <= 0) grid = 256;
    }
    if (grid < 0) return;
    if (hipMemsetAsync((char*)d_ws + WS_BAR, 0, 65536, stream) != hipSuccess) { fprintf(stderr, "kernel_launch: memset failed\n"); return; }
    Args a{};
    for (int i = 0; i < 17; ++i) a.in[i] = (const float*)d_in[i];
    a.out = (float*)d_out; a.ws = (unsigned char*)d_ws;
#if ONE_LAUNCH
    a.ph_lo = 0; a.ph_hi = N_PHASES;
    void* args[] = {&a};
    hipError_t e = hipLaunchCooperativeKernel((const void*)fwd_kernel, dim3(grid), dim3(NTHR), args, LDS_BYTES, stream);
    if (e != hipSuccess) fprintf(stderr, "cooperative launch failed: %s (grid %d)\n", hipGetErrorString(e), grid);
#else
    for (int ph = 0; ph < N_PHASES; ++ph) {
        a.ph_lo = ph; a.ph_hi = ph + 1;
        hipLaunchKernelGGL(fwd_kernel, dim3(grid), dim3(NTHR), LDS_BYTES, stream, a);
    }
#endif
}
```
